# Optimizing an MI355X kernel written in HIP

```python
import jax
import jax.numpy as jnp
from jax import lax
import numpy as np

D_MODEL = 1024
BATCH = 2
SEQ = 8192
DEPTH = 2

GRID_W = 64
CTX_LEN = 256

N_EVEN = (DEPTH + 1) // 2
N_ODD = DEPTH // 2
DEEPNORM_ALPHA = (2.0 * DEPTH) ** 0.25
DEEPNORM_BETA = (8.0 * DEPTH) ** -0.25
LN_EPS = 1e-5
NEG_INF = -1e30
F32 = jnp.float32

NA_HEAD_DIM = 64
NA_WIDTH = D_MODEL // 2
NA_HEADS = NA_WIDTH // NA_HEAD_DIM
NA_WIN_ROWS = 8
NA_WIN_COLS = 16
NA_SCALE = NA_HEAD_DIM ** -0.5

RW_HEAD_DIM = 64
RW_WIDTH = D_MODEL // 2
RW_HEADS = RW_WIDTH // RW_HEAD_DIM
RW_DECAY_LORA = 32
RW_AAA_LORA = 32
RW_GATE_LORA = 96
RW_GN_EPS = 64e-5

ML_HEADS = 8
ML_V_DIM = D_MODEL // ML_HEADS
ML_QK_DIM = ML_V_DIM // 2
ML_WIDTH = ML_HEADS * ML_V_DIM
ML_CHUNK = 128
ML_NORM_EPS = 1e-6
ROPE_BASE = 10000.0

N_EXPERTS = 256
TOP_K = 8
N_GROUPS = 8
TOPK_GROUPS = 4
EXPERT_FF = 256
SHARED_FF = 256
ROUTED_SCALE = 2.5
MOE_BLOCK = 128

EVEN_LAYOUT = (
    ('na_q', NA_WIDTH), ('na_k', NA_WIDTH), ('na_v', NA_WIDTH),
    ('rw_r', RW_WIDTH), ('rw_k', RW_WIDTH), ('rw_v', RW_WIDTH),
    ('rw_wf', RW_DECAY_LORA), ('rw_wb', RW_DECAY_LORA),
    ('rw_af', RW_AAA_LORA), ('rw_ab', RW_AAA_LORA), ('rw_g', RW_GATE_LORA),
)
EVEN_COLS = sum(w for _, w in EVEN_LAYOUT)
RW_SHIFT_COLS = sum(w for n, w in EVEN_LAYOUT if n.startswith('rw_'))
ODD_LAYOUT = (
    ('ml_q', ML_HEADS * ML_QK_DIM), ('ml_k', ML_HEADS * ML_QK_DIM),
    ('ml_v', ML_WIDTH), ('ml_o', ML_WIDTH),
    ('ml_if', ML_HEADS), ('ml_ib', ML_HEADS), ('ml_ff', ML_HEADS), ('ml_fb', ML_HEADS),
)
ODD_COLS = sum(w for _, w in ODD_LAYOUT)
EVEN_CTX_STATE_COLS = ('na_k', 'na_v', 'rw_k', 'rw_v', 'rw_wf', 'rw_wb', 'rw_af', 'rw_ab')
ODD_CTX_STATE_COLS = ('ml_k', 'ml_v', 'ml_if', 'ml_ib', 'ml_ff', 'ml_fb')

kernel_name = 'hybrid_natten_rwkv7_mlstm_moe_dit'


def _offsets(layout, prefix=''):
    offs, o = {}, 0
    for name, width in layout:
        if name.startswith(prefix):
            offs[name] = (o, width)
            o += width
    return offs


def project(h, w, layout, names):
    offs = _offsets(layout)
    if len(names) == len(layout):
        y = jnp.einsum('btd,de->bte', h, w)
        return {n: y[..., offs[n][0]:offs[n][0] + offs[n][1]] for n in names}
    return {n: jnp.einsum('btd,de->bte', h, w[:, offs[n][0]:offs[n][0] + offs[n][1]]) for n in names}


def layer_norm(x, g, b):
    xf = x.astype(F32)
    mu = xf.mean(-1, keepdims=True)
    var = jnp.square(xf - mu).mean(-1, keepdims=True)
    return ((xf - mu) * lax.rsqrt(var + LN_EPS) * g + b).astype(x.dtype)


def modulate(h, shift, scale):
    return h * (1.0 + scale) + shift


def centred_shift(p, mu):
    zero = jnp.zeros_like(p[:, :1])
    prev = jnp.concatenate([zero, p[:, :-1]], 1)
    nxt = jnp.concatenate([p[:, 1:], zero], 1)
    return p + mu * (0.5 * (prev + nxt) - p)


def axial_rope(z):
    T, dh = z.shape[1], z.shape[-1]
    half = dh // 2
    nf = half // 2
    t = jnp.arange(T)
    row = (t // GRID_W).astype(F32)
    col = (t % GRID_W).astype(F32)
    inv = ROPE_BASE ** (-jnp.arange(nf, dtype=F32) / nf)

    def rot(u, pos):
        ang = pos[:, None] * inv[None, :]
        cos = jnp.cos(ang)[None, :, None, :]
        sin = jnp.sin(ang)[None, :, None, :]
        u1, u2 = u[..., :nf], u[..., nf:]
        return jnp.concatenate([u1 * cos - u2 * sin, u1 * sin + u2 * cos], -1)

    return jnp.concatenate([rot(z[..., :half], row), rot(z[..., half:], col)], -1).astype(z.dtype)


def neighbourhood_attention(q, k, v, k_ctx, v_ctx, rpb):
    B, N, H, dh = q.shape
    rows = N // GRID_W
    kh = min(NA_WIN_ROWS, rows)
    kw = NA_WIN_COLS
    grid = lambda z: z.reshape(B, rows, GRID_W, H, dh)
    qg, kg, vg = grid(q), grid(k), grid(v)
    r_idx = jnp.arange(rows)
    row_start = jnp.clip(r_idx - kh // 2, 0, rows - kh)
    band_rows = row_start[:, None] + jnp.arange(kh)[None, :]
    k_band = kg[:, band_rows]
    v_band = vg[:, band_rows]
    j_idx = jnp.arange(GRID_W)
    col_start = jnp.clip(j_idx - kw // 2, 0, GRID_W - kw)
    col_in = (j_idx[None, :] >= col_start[:, None]) & (j_idx[None, :] < col_start[:, None] + kw)
    row_off = band_rows - r_idx[:, None] + (NA_WIN_ROWS - 1)
    col_off = jnp.clip(j_idx[None, :] - j_idx[:, None], -(kw - 1), kw - 1) + (kw - 1)
    bias = rpb.astype(F32)[:, row_off[:, None, :, None], col_off[None, :, None, :]]
    bias = jnp.where(col_in[None, None, :, None, :], bias, NEG_INF)
    s_loc = jnp.einsum('brjhd,brachd->bhrjac', qg, k_band).astype(F32) + bias[None]
    s_ctx = jnp.einsum('brjhd,bchd->bhrjc', qg, k_ctx).astype(F32)
    n_loc = kh * GRID_W
    p = jax.nn.softmax(jnp.concatenate([s_loc.reshape(B, H, rows, GRID_W, n_loc), s_ctx], -1), axis=-1).astype(v.dtype)
    p_loc = p[..., :n_loc].reshape(B, H, rows, GRID_W, kh, GRID_W)
    out = (jnp.einsum('bhrjac,brachd->brjhd', p_loc, v_band)
           + jnp.einsum('bhrjc,bchd->brjhd', p[..., n_loc:], v_ctx))
    return out.reshape(B, N, H * dh)


def ctx_attention(q, k, v):
    s = jnp.einsum('bqhd,bkhd->bhqk', q, k).astype(F32)
    p = jax.nn.softmax(s, axis=-1).astype(v.dtype)
    return jnp.einsum('bhqk,bkhd->bqhd', p, v)


def rwkv_prep(t, w0, w_up, a0, a_up, k_k, k_a):
    B, T = t['rw_k'].shape[:2]
    heads = lambda z: z.reshape(B, T, RW_HEADS, RW_HEAD_DIM).astype(F32)
    k = t['rw_k'].astype(F32)
    kk = heads(k * k_k)
    kk = kk / jnp.maximum(jnp.linalg.norm(kk, axis=-1, keepdims=True), 1e-12)
    dirs = []
    for d, (wn, an) in enumerate((('rw_wf', 'rw_af'), ('rw_wb', 'rw_ab'))):
        w_log = -jax.nn.softplus(-(w0[d] + jnp.tanh(t[wn].astype(F32)) @ w_up[d])) - 0.5
        decay = jnp.exp(-jnp.exp(w_log))
        a = jax.nn.sigmoid(a0[d] + t[an].astype(F32) @ a_up[d])
        k_d = k * (1.0 + (a - 1.0) * k_a)
        dirs.append((heads(decay), heads(a), heads(k_d)))
    return kk, heads(t['rw_v']), dirs


def rwkv_scan(s0, decay, a, k, kk, v, r, reverse):
    seq = lambda z: jnp.moveaxis(z, 1, 0)
    xs = (seq(decay), seq(-kk), seq(kk * a), seq(k), seq(v))
    if r is not None:
        xs = xs + (seq(r),)

    def step(s, inp):
        s = (s * inp[0][:, :, None, :]
             + jnp.einsum('bhvk,bhk->bhv', s, inp[1])[..., None] * inp[2][:, :, None, :]
             + inp[4][..., None] * inp[3][:, :, None, :])
        return s, (jnp.einsum('bhvk,bhk->bhv', s, inp[5]) if len(inp) == 6 else None)

    s, ys = lax.scan(step, s0, xs, reverse=reverse)
    return s, (None if r is None else jnp.moveaxis(ys, 0, 1))


def rwkv_readout(y, r, v, dirs, g_low, r_k, g_up, gn_g, gn_b):
    B, T = y.shape[:2]
    mu = y.mean(-1, keepdims=True)
    var = jnp.square(y - mu).mean(-1, keepdims=True)
    yn = ((y - mu) * lax.rsqrt(var + RW_GN_EPS) * gn_g.reshape(RW_HEADS, RW_HEAD_DIM)
          + gn_b.reshape(RW_HEADS, RW_HEAD_DIM))
    bonus = (jnp.sum(r * dirs[0][2] * r_k, -1, keepdims=True)
             + jnp.sum(r * dirs[1][2] * r_k, -1, keepdims=True)) * v
    gate = jax.nn.sigmoid(g_low.astype(F32)) @ g_up
    return (yn + bonus).reshape(B, T, RW_WIDTH) * gate


def ml_prep(t, gate_b, rope, need_q):
    B, T = t['ml_k'].shape[:2]
    heads = lambda z, dh: z.reshape(B, T, ML_HEADS, dh).astype(F32)
    k = heads(t['ml_k'], ML_QK_DIM)
    q = heads(t['ml_q'], ML_QK_DIM) * ML_QK_DIM ** -0.5 if need_q else None
    if rope:
        k = axial_rope(k)
        q = axial_rope(q)
    v = heads(t['ml_v'], ML_V_DIM)
    gb = gate_b.astype(F32)
    bht = lambda z: z.astype(F32).transpose(0, 2, 1)
    ig = (bht(t['ml_if'] + gb[0]), bht(t['ml_ib'] + gb[1]))
    lf = (jax.nn.log_sigmoid(bht(t['ml_ff'] + gb[2])), jax.nn.log_sigmoid(bht(t['ml_fb'] + gb[3])))
    bhtd = lambda z: None if z is None else z.transpose(0, 2, 1, 3)
    return bhtd(q), bhtd(k), bhtd(v), ig, lf


def ml_chunk_states(k, v, ig, lf, state0):
    B, H, T, dk = k.shape
    dv = v.shape[-1]
    L = min(ML_CHUNK, T)
    nc = T // L
    kc = k.reshape(B, H, nc, L, dk)
    vc = v.reshape(B, H, nc, L, dv)
    b = jnp.cumsum(lf.reshape(B, H, nc, L), -1)
    b_end = b[..., -1]
    g = b_end[..., None] - b + ig.reshape(B, H, nc, L)
    m_chunk = g.max(-1)
    wgt = jnp.exp(g - m_chunk[..., None])
    kv = jnp.einsum('bhnl,bhnlk,bhnlv->bhnkv', wgt, kc, vc)
    ks = jnp.einsum('bhnl,bhnlk->bhnk', wgt, kc)

    def step(state, inp):
        c_mem, n_mem, m = state
        be, mc, kv_n, ks_n = inp
        m_new = jnp.maximum(be + m, mc)
        fa = jnp.exp(be + m - m_new)
        fb = jnp.exp(mc - m_new)
        c_new = fa[..., None, None] * c_mem + fb[..., None, None] * kv_n
        n_new = fa[..., None] * n_mem + fb[..., None] * ks_n
        return (c_new, n_new, m_new), state

    xs = tuple(jnp.moveaxis(z, 2, 0) for z in (b_end, m_chunk, kv, ks))
    final, starts = lax.scan(step, state0, xs)
    return tuple(jnp.moveaxis(z, 0, 2) for z in starts), final


def ml_chunk_outputs(q, k, v, ig, lf, starts):
    B, H, T, dk = q.shape
    dv = v.shape[-1]
    L = min(ML_CHUNK, T)
    nc = T // L
    qc = q.reshape(B, H, nc, L, dk)
    kc = k.reshape(B, H, nc, L, dk)
    vc = v.reshape(B, H, nc, L, dv)
    b = jnp.cumsum(lf.reshape(B, H, nc, L), -1)
    c0, n0, m0 = starts
    causal = jnp.tril(jnp.ones((L, L), bool))
    dlog = jnp.where(causal, b[..., :, None] - b[..., None, :] + ig.reshape(B, H, nc, L)[..., None, :], NEG_INF)
    inter = b + m0[..., None]
    m = jnp.maximum(dlog.max(-1), inter)
    dw = jnp.exp(dlog - m[..., None])
    iw = jnp.exp(inter - m)
    s = jnp.einsum('bhntd,bhnsd->bhnts', qc, kc) * dw
    num = jnp.einsum('bhnts,bhnsv->bhntv', s, vc) + iw[..., None] * jnp.einsum('bhntd,bhndv->bhntv', qc, c0)
    den = s.sum(-1) + iw * jnp.einsum('bhntd,bhnd->bhnt', qc, n0)
    h = num / jnp.maximum(jnp.abs(den), jnp.exp(-m))[..., None]
    return h.reshape(B, H, T, dv)


def ml_readout(h, o, norm_g):
    B, H, T, dv = h.shape
    hn = h * lax.rsqrt(jnp.mean(h * h, -1, keepdims=True) + ML_NORM_EPS)
    hn = hn.transpose(0, 2, 1, 3).reshape(B, T, H * dv) * norm_g
    return hn * jax.nn.sigmoid(o.astype(F32))


def even_mixer(a_lat, a_ctx, w_in, w_out, rpb, mu, w0, w_up, a0, a_up, g_up, k_k, k_a, r_k, gn_g, gn_b, need_ctx):
    names = tuple(n for n, _ in EVEN_LAYOUT)
    shift_offs = _offsets(EVEN_LAYOUT, 'rw_')

    def prep(h, cols):
        t = project(h, w_in, EVEN_LAYOUT, cols)
        for n in cols:
            if n in shift_offs:
                o, wd = shift_offs[n]
                t[n] = centred_shift(t[n], mu[o:o + wd])
        return t

    t_lat = prep(a_lat, names)
    t_ctx = prep(a_ctx, names if need_ctx else EVEN_CTX_STATE_COLS)
    B, N = a_lat.shape[:2]
    C = a_ctx.shape[1]
    na_h = lambda z: z.reshape(z.shape[0], z.shape[1], NA_HEADS, NA_HEAD_DIM)
    rw_h = lambda z: z.reshape(z.shape[0], z.shape[1], RW_HEADS, RW_HEAD_DIM).astype(F32)
    k_c, v_c = na_h(t_ctx['na_k']), na_h(t_ctx['na_v'])
    na_lat = neighbourhood_attention(na_h(t_lat['na_q']) * NA_SCALE, na_h(t_lat['na_k']),
                                     na_h(t_lat['na_v']), k_c, v_c, rpb)
    kk_c, vr_c, dirs_c = rwkv_prep(t_ctx, w0, w_up, a0, a_up, k_k, k_a)
    kk_l, vr_l, dirs_l = rwkv_prep(t_lat, w0, w_up, a0, a_up, k_k, k_a)
    r_l = rw_h(t_lat['rw_r'])
    r_c = rw_h(t_ctx['rw_r']) if need_ctx else None
    s0 = jnp.zeros((B, RW_HEADS, RW_HEAD_DIM, RW_HEAD_DIM), F32)
    y_l, y_c = [], []
    for d in range(2):
        s_ctx, yc = rwkv_scan(s0, *dirs_c[d], kk_c, vr_c, r_c, d == 1)
        _, yl = rwkv_scan(s_ctx, *dirs_l[d], kk_l, vr_l, r_l, d == 1)
        y_l.append(yl)
        y_c.append(yc)
    rw_lat = rwkv_readout(y_l[0] + y_l[1], r_l, vr_l, dirs_l, t_lat['rw_g'], r_k, g_up, gn_g, gn_b)
    y_lat = jnp.einsum('btd,de->bte', jnp.concatenate([na_lat.astype(F32), rw_lat], -1), w_out).astype(a_lat.dtype)
    if not need_ctx:
        return y_lat, None
    na_ctx = ctx_attention(na_h(t_ctx['na_q']) * NA_SCALE, k_c, v_c).reshape(B, C, NA_WIDTH)
    rw_ctx = rwkv_readout(y_c[0] + y_c[1], r_c, vr_c, dirs_c, t_ctx['rw_g'], r_k, g_up, gn_g, gn_b)
    y_ctx = jnp.einsum('btd,de->bte', jnp.concatenate([na_ctx.astype(F32), rw_ctx], -1), w_out).astype(a_ctx.dtype)
    return y_lat, y_ctx


def odd_mixer(a_lat, a_ctx, w_in, w_out, gate_b, norm_g, need_ctx):
    names = tuple(n for n, _ in ODD_LAYOUT)
    t_lat = project(a_lat, w_in, ODD_LAYOUT, names)
    t_ctx = project(a_ctx, w_in, ODD_LAYOUT, names if need_ctx else ODD_CTX_STATE_COLS)
    q_l, k_l, v_l, ig_l, lf_l = ml_prep(t_lat, gate_b, True, True)
    q_c, k_c, v_c, ig_c, lf_c = ml_prep(t_ctx, gate_b, False, need_ctx)
    B = a_lat.shape[0]
    zero = (jnp.zeros((B, ML_HEADS, ML_QK_DIM, ML_V_DIM), F32),
            jnp.zeros((B, ML_HEADS, ML_QK_DIM), F32),
            jnp.zeros((B, ML_HEADS), F32))
    h_l, h_c = [], []
    for d in range(2):
        f = (lambda z: jnp.flip(z, 2)) if d == 1 else (lambda z: z)
        starts_c, final_c = ml_chunk_states(f(k_c), f(v_c), f(ig_c[d]), f(lf_c[d]), zero)
        starts_l, _ = ml_chunk_states(f(k_l), f(v_l), f(ig_l[d]), f(lf_l[d]), final_c)
        h_l.append(f(ml_chunk_outputs(f(q_l), f(k_l), f(v_l), f(ig_l[d]), f(lf_l[d]), starts_l)))
        if need_ctx:
            h_c.append(f(ml_chunk_outputs(f(q_c), f(k_c), f(v_c), f(ig_c[d]), f(lf_c[d]), starts_c)))
    y_lat = jnp.einsum('btd,de->bte', ml_readout(h_l[0] + h_l[1], t_lat['ml_o'], norm_g), w_out).astype(a_lat.dtype)
    if not need_ctx:
        return y_lat, None
    y_ctx = jnp.einsum('btd,de->bte', ml_readout(h_c[0] + h_c[1], t_ctx['ml_o'], norm_g), w_out).astype(a_ctx.dtype)
    return y_lat, y_ctx


def swiglu(h, wg, wu, wd):
    return jnp.dot(jax.nn.silu(jnp.dot(h, wg)) * jnp.dot(h, wu), wd)


def moe_ffn(h, router_w, router_b, wg, wu, wd, sg, su, sd):
    T, D = h.shape
    E = router_w.shape[-1]
    s = jax.nn.sigmoid(jnp.dot(h, router_w).astype(F32))
    grp = (s + router_b.astype(F32)).reshape(T, N_GROUPS, E // N_GROUPS)
    g_score = lax.top_k(grp, 2)[0].sum(-1)
    g_keep = jax.nn.one_hot(lax.top_k(g_score, TOPK_GROUPS)[1], N_GROUPS).sum(1) > 0
    choice = jnp.where(g_keep[:, :, None], grp, NEG_INF).reshape(T, E)
    e_idx = lax.top_k(choice, TOP_K)[1]
    w_sel = jnp.take_along_axis(s, e_idx, 1)
    w_sel = w_sel / w_sel.sum(-1, keepdims=True) * ROUTED_SCALE
    n_asg = T * TOP_K
    flat_e = e_idx.reshape(-1)
    order = jnp.argsort(flat_e)
    se = flat_e[order]
    st = (order // TOP_K).astype(jnp.int32)
    sw = w_sel.reshape(-1)[order]
    counts = jnp.bincount(flat_e, length=E)
    padded = (counts + MOE_BLOCK - 1) // MOE_BLOCK * MOE_BLOCK
    ends_pad = jnp.cumsum(padded)
    pos = (ends_pad - padded)[se] + jnp.arange(n_asg) - (jnp.cumsum(counts) - counts)[se]
    n_blocks = -(-n_asg // MOE_BLOCK) + E
    buf_tok = jnp.full((n_blocks * MOE_BLOCK,), T, jnp.int32).at[pos].set(st)
    buf_w = jnp.zeros((n_blocks * MOE_BLOCK,), F32).at[pos].set(sw)
    blk_e = jnp.minimum(jnp.searchsorted(ends_pad, jnp.arange(n_blocks) * MOE_BLOCK, side='right'), E - 1)
    h_pad = jnp.concatenate([h, jnp.zeros((1, D), h.dtype)], 0)

    def block(acc, blk):
        tok, wt, e = blk
        y = swiglu(h_pad[tok], wg[e], wu[e], wd[e]) * wt[:, None]
        return acc.at[tok].add(y.astype(acc.dtype)), None

    acc, _ = lax.scan(block, jnp.zeros((T + 1, D), h.dtype),
                      (buf_tok.reshape(n_blocks, MOE_BLOCK), buf_w.reshape(n_blocks, MOE_BLOCK), blk_e))
    return acc[:T] + swiglu(h, sg, su, sd)


def setup_inputs(seed: int = 0) -> dict:
    key = jax.random.key(seed)
    ks = iter(jax.random.split(key, 48))

    def nrm(shape, scale):
        return jax.random.normal(next(ks), shape, F32) * scale

    D = D_MODEL
    MIX_E = NA_WIDTH + RW_WIDTH
    return {
        'x': nrm((BATCH, SEQ, D), 1.0),
        'c': nrm((BATCH, D), 1.0),
        'ctx': nrm((BATCH, CTX_LEN, D), 1.0),
        'c_ctx': nrm((D,), 1.0),
        'ada_w': nrm((DEPTH, D, 6 * D), 0.5 * D ** -0.5),
        'ada_b': nrm((DEPTH, 6 * D), 0.02),
        'ln_g': 1.0 + nrm((DEPTH, 2, D), 0.02),
        'ln_b': nrm((DEPTH, 2, D), 0.02),
        'ev_w_in': nrm((N_EVEN, D, EVEN_COLS), D ** -0.5),
        'ev_w_out': nrm((N_EVEN, MIX_E, D), DEEPNORM_BETA * MIX_E ** -0.5),
        'na_rpb': nrm((N_EVEN, NA_HEADS, 2 * NA_WIN_ROWS - 1, 2 * NA_WIN_COLS - 1), 0.5),
        'rw_mu': jax.random.uniform(next(ks), (N_EVEN, RW_SHIFT_COLS), F32),
        'rw_w0': nrm((N_EVEN, 2, RW_WIDTH), 1.0) - 2.0,
        'rw_w_up': nrm((N_EVEN, 2, RW_DECAY_LORA, RW_WIDTH), 0.1),
        'rw_a0': nrm((N_EVEN, 2, RW_WIDTH), 0.5),
        'rw_a_up': nrm((N_EVEN, 2, RW_AAA_LORA, RW_WIDTH), RW_AAA_LORA ** -0.5),
        'rw_g_up': nrm((N_EVEN, RW_GATE_LORA, RW_WIDTH), RW_GATE_LORA ** -0.5),
        'rw_k_k': 0.85 + nrm((N_EVEN, RW_WIDTH), 0.05),
        'rw_k_a': 1.0 + nrm((N_EVEN, RW_WIDTH), 0.05),
        'rw_r_k': nrm((N_EVEN, RW_HEADS, RW_HEAD_DIM), 0.1),
        'rw_gn_g': 1.0 + nrm((N_EVEN, RW_WIDTH), 0.02),
        'rw_gn_b': nrm((N_EVEN, RW_WIDTH), 0.02),
        'od_w_in': nrm((N_ODD, D, ODD_COLS), D ** -0.5),
        'od_w_out': nrm((N_ODD, ML_WIDTH, D), DEEPNORM_BETA * ML_WIDTH ** -0.5),
        'ml_gate_b': jnp.concatenate([nrm((N_ODD, 2, ML_HEADS), 0.1),
                                      3.0 + nrm((N_ODD, 2, ML_HEADS), 0.5)], axis=1),
        'ml_norm_g': 1.0 + nrm((N_ODD, ML_WIDTH), 0.02),
        'moe_router': nrm((DEPTH, D, N_EXPERTS), D ** -0.5),
        'moe_bias': nrm((DEPTH, N_EXPERTS), 0.01),
        'moe_w_gate': nrm((DEPTH, N_EXPERTS, D, EXPERT_FF), D ** -0.5),
        'moe_w_up': nrm((DEPTH, N_EXPERTS, D, EXPERT_FF), D ** -0.5),
        'moe_w_down': nrm((DEPTH, N_EXPERTS, EXPERT_FF, D), DEEPNORM_BETA * EXPERT_FF ** -0.5),
        'sh_w_gate': nrm((DEPTH, D, SHARED_FF), D ** -0.5),
        'sh_w_up': nrm((DEPTH, D, SHARED_FF), D ** -0.5),
        'sh_w_down': nrm((DEPTH, SHARED_FF, D), DEEPNORM_BETA * SHARED_FF ** -0.5),
    }


def reference(x, c, ctx, c_ctx, ada_w, ada_b, ln_g, ln_b, ev_w_in, ev_w_out, na_rpb, rw_mu, rw_w0, rw_w_up,
              rw_a0, rw_a_up, rw_g_up, rw_k_k, rw_k_a, rw_r_k, rw_gn_g, rw_gn_b, od_w_in, od_w_out, ml_gate_b,
              ml_norm_g, moe_router, moe_bias, moe_w_gate, moe_w_up, moe_w_down, sh_w_gate, sh_w_up, sh_w_down):
    B, N, D = x.shape
    C = ctx.shape[1]
    silu_c = jax.nn.silu(c)
    silu_cc = jax.nn.silu(c_ctx)
    h_lat, h_ctx = x, ctx
    for l in range(DEPTH):
        last = l == DEPTH - 1
        mods = jnp.split(silu_c @ ada_w[l] + ada_b[l], 6, axis=-1)
        n_cm = 2 if last else 6
        mods_c = jnp.split(silu_cc @ ada_w[l][:, :n_cm * D] + ada_b[l][:n_cm * D], n_cm, axis=-1)
        a_lat = modulate(h_lat, mods[0][:, None], mods[1][:, None])
        a_ctx = modulate(h_ctx, mods_c[0], mods_c[1])
        if l % 2 == 0:
            e = l // 2
            y_lat, y_ctx = even_mixer(a_lat, a_ctx, ev_w_in[e], ev_w_out[e], na_rpb[e], rw_mu[e], rw_w0[e],
                                      rw_w_up[e], rw_a0[e], rw_a_up[e], rw_g_up[e], rw_k_k[e], rw_k_a[e],
                                      rw_r_k[e], rw_gn_g[e], rw_gn_b[e], not last)
        else:
            o = l // 2
            y_lat, y_ctx = odd_mixer(a_lat, a_ctx, od_w_in[o], od_w_out[o], ml_gate_b[o], ml_norm_g[o], not last)
        h_lat = layer_norm(DEEPNORM_ALPHA * h_lat + mods[2][:, None] * y_lat, ln_g[l, 0], ln_b[l, 0])
        f_lat = modulate(h_lat, mods[3][:, None], mods[4][:, None]).reshape(B * N, D)
        moe_args = (moe_router[l], moe_bias[l], moe_w_gate[l], moe_w_up[l], moe_w_down[l],
                    sh_w_gate[l], sh_w_up[l], sh_w_down[l])
        if last:
            ff = moe_ffn(f_lat, *moe_args).reshape(B, N, D)
            h_lat = layer_norm(DEEPNORM_ALPHA * h_lat + mods[5][:, None] * ff, ln_g[l, 1], ln_b[l, 1])
        else:
            h_ctx = layer_norm(DEEPNORM_ALPHA * h_ctx + mods_c[2] * y_ctx, ln_g[l, 0], ln_b[l, 0])
            f_ctx = modulate(h_ctx, mods_c[3], mods_c[4]).reshape(B * C, D)
            ff = moe_ffn(jnp.concatenate([f_lat, f_ctx], 0), *moe_args)
            h_lat = layer_norm(DEEPNORM_ALPHA * h_lat + mods[5][:, None] * ff[:B * N].reshape(B, N, D),
                               ln_g[l, 1], ln_b[l, 1])
            h_ctx = layer_norm(DEEPNORM_ALPHA * h_ctx + mods_c[5] * ff[B * N:].reshape(B, C, D),
                               ln_g[l, 1], ln_b[l, 1])
    return h_lat
```

```cpp
#include <hip/hip_runtime.h>
#include <stdint.h>

#ifndef MK_MULTI
#define MK_MULTI 0
#endif

#ifndef PROBE_DUP
#define PROBE_DUP 0ull
#endif
#define DI __device__ __forceinline__
typedef unsigned short bf16_t;
typedef short bf16x8 __attribute__((ext_vector_type(8)));
typedef float f32x4 __attribute__((ext_vector_type(4)));
typedef unsigned u32x4 __attribute__((ext_vector_type(4)));
typedef unsigned u32x2 __attribute__((ext_vector_type(2)));

constexpr int NTHR = 512;
constexpr int TLB = 8192, TCB = 256, TL = 16384, TC = 512, TT = 16896;
constexpr int EVC = 3296, ODC = 3104, RWC = 1760;
constexpr float ALPHA = 1.41421356237f;
constexpr int SH_BASE = 200704;
constexpr int NSLOT = SH_BASE + TT;
constexpr int MAXTILES = 784 + 66;
constexpr int EPI_OFF = 98304, EPI_WAVE_B = 4352;
constexpr int LDS_XB = 153600;
constexpr int LDS_BYTES = LDS_XB + 256;

#define XB_TMO      128
#define XB_XCNT(j)  (256  + 64 * (j))
#define XB_XSUB(j)  (1280 + 64 * (j))
#define XB_XGEN(j)  (2304 + 64 * (j))
#define XB_TOP      3328
#define XB_TOPGEN   3392
#define XCD_BAR_WORDS 3456
#define XB_SPIN_CAP (1u << 18)
#define LAS __attribute__((address_space(3)))

__device__ __forceinline__ unsigned xb_ld(unsigned* p)              { return __hip_atomic_load(p, __ATOMIC_RELAXED, __HIP_MEMORY_SCOPE_AGENT); }
__device__ __forceinline__ unsigned xb_add(unsigned* p, unsigned v) { return __hip_atomic_fetch_add(p, v, __ATOMIC_RELAXED, __HIP_MEMORY_SCOPE_AGENT); }
__device__ __forceinline__ unsigned xb_xcc_id() { return (unsigned)__builtin_amdgcn_s_getreg((3 << 11) | 20) & 0xFu; }
#define XB_SPIN(cond, bar) do { unsigned _sp = 0; while (cond) { __builtin_amdgcn_s_sleep(1); \
    if ((++_sp & 255u) == 0u) { if (xb_ld(&(bar)[XB_TMO])) break; if (_sp > XB_SPIN_CAP) { atomicAdd(&(bar)[XB_TMO], 1u); break; } } } } while (0)

struct XcdBarrier {
    unsigned* bar; unsigned x;
    volatile LAS unsigned* st;
};
__device__ __forceinline__ XcdBarrier xcd_barrier_post(unsigned* bar, volatile LAS unsigned* st) {
    XcdBarrier b; b.bar = bar; b.x = xb_xcc_id(); b.st = st;
    if (threadIdx.x == 0) (void)xb_add(&bar[XB_XCNT(b.x)], 1u);
    return b;
}
__device__ __forceinline__ void xcd_barrier_complete(unsigned* bar, unsigned x, unsigned& nloc, unsigned& nx) {
    const unsigned G = gridDim.x * gridDim.y * gridDim.z;
    unsigned sum, cnt, mine, sp = 0u;
    for (;;) {
        sum = 0u; cnt = 0u; mine = 0u;
#pragma unroll
        for (unsigned j = 0; j < 16; ++j) { const unsigned c = xb_ld(&bar[XB_XCNT(j)]); sum += c; cnt += (c > 0u) ? 1u : 0u; mine = (j == x) ? c : mine; }
        if (sum == G) break;
        __builtin_amdgcn_s_sleep(1);
        if ((++sp & 255u) == 0u) { if (xb_ld(&bar[XB_TMO])) break; if (sp > XB_SPIN_CAP) { atomicAdd(&bar[XB_TMO], 1u); break; } }
    }
    nloc = mine > 0u ? mine : 1u; nx = cnt > 0u ? cnt : 1u;
}
__device__ __forceinline__ void xcd_barrier(const XcdBarrier& b) {
    asm volatile("s_waitcnt vmcnt(0)" ::: "memory");
    __syncthreads();
    if (threadIdx.x == 0) {
        unsigned* bar = b.bar;
        __builtin_amdgcn_s_waitcnt(0);
        unsigned nloc = b.st[0], nx = b.st[1];
        if (nloc == 0u) { xcd_barrier_complete(bar, b.x, nloc, nx); b.st[0] = nloc; b.st[1] = nx; }
        const unsigned old = xb_add(&bar[XB_XSUB(b.x)], 1u);
        const unsigned gen = old / nloc;
        if (old + 1u == (gen + 1u) * nloc) {
            __builtin_amdgcn_fence(__ATOMIC_RELEASE, "agent");
            asm volatile("s_waitcnt vmcnt(0)" ::: "memory");
            const unsigned og = xb_add(&bar[XB_TOP], 1u);
            const unsigned tg = og / nx;
            if (og + 1u == (tg + 1u) * nx) xb_add(&bar[XB_TOPGEN], 1u);
            else XB_SPIN(xb_ld(&bar[XB_TOPGEN]) == tg, bar);
            __builtin_amdgcn_fence(__ATOMIC_ACQUIRE, "agent");
            xb_add(&bar[XB_XGEN(b.x)], 1u);
            asm volatile("s_waitcnt vmcnt(0)" ::: "memory");
        } else {
            XB_SPIN(xb_ld(&bar[XB_XGEN(b.x)]) == gen, bar);
            __builtin_amdgcn_fence(__ATOMIC_ACQUIRE, "agent");
            asm volatile("s_waitcnt vmcnt(0)" ::: "memory");
        }
    }
    __syncthreads();
}

struct Params {
    const float *x, *c, *ctx, *c_ctx, *ada_w, *ada_b, *ln_g, *ln_b, *ev_w_in, *ev_w_out, *na_rpb, *rw_mu, *rw_w0, *rw_w_up, *rw_a0,
        *rw_a_up, *rw_g_up, *rw_k_k, *rw_k_a, *rw_r_k, *rw_gn_g, *rw_gn_b, *od_w_in, *od_w_out, *ml_gate_b, *ml_norm_g, *moe_router,
        *moe_bias, *moe_w_gate, *moe_w_up, *moe_w_down, *sh_w_gate, *sh_w_up, *sh_w_down;
    float* out;
    unsigned* bar;
    int* ictl;
    float* mods;
    bf16_t* Abuf;
    float *HA, *HB;
    bf16_t *Q0, *K0, *V0, *VT0L, *VT0C;
    float* RWP;
    unsigned* WF;
    float *SW, *BONUS, *YS;
    unsigned *SBP, *SKP, *SNV, *SRG;
    bf16_t *CM, *CRH, *CN, *CP3;
    bf16_t* MIX;
    float* YL;
    float* LOGITS;
    int *EIDX, *APOS, *SLOT_TOK, *TILE_E, *TILE_R0, *HIST;
    float *EW, *SLOT_W;
    bf16_t *HBUF, *YB;
    bf16_t *P1, *K1TL, *K1TC, *V1TL, *V1TC, *C0T;
    float *G1, *KVT, *KS, *BEMC, *N0, *M0;
};

DI int opaque_tid() { int t = threadIdx.x; asm volatile("" : "+v"(t)); return t; }
typedef __bf16 bf16x2_t __attribute__((ext_vector_type(2)));
typedef float f32x2_t __attribute__((ext_vector_type(2)));
DI unsigned cvt_pk_bf16_asm(float lo, float hi) { unsigned r; asm volatile("v_cvt_pk_bf16_f32 %0, %1, %2" : "=v"(r) : "v"(lo), "v"(hi)); return r; }
DI unsigned cvt_pk_bf16(float lo, float hi) { const f32x2_t v = {lo, hi}; return __builtin_bit_cast(unsigned, __builtin_convertvector(v, bf16x2_t)); }
DI float bf2f(bf16_t b) { return __uint_as_float(((unsigned)b) << 16); }
DI float bflo(unsigned w) { return __uint_as_float(w << 16); }
DI float bfhi(unsigned w) { return __uint_as_float(w & 0xffff0000u); }
DI float sigmoidf_(float x) { return 1.0f / (1.0f + __expf(-x)); }
DI float siluf_(float x) { return x / (1.0f + __expf(-x)); }
DI float tanhf_(float x) { return 1.0f - 2.0f / (__expf(2.0f * x) + 1.0f); }
DI float softplusf_(float x) { return fmaxf(x, 0.f) + __logf(1.0f + __expf(-fabsf(x))); }
DI float logsigmoidf_(float x) { return -softplusf_(-x); }
DI f32x4 mfma16(bf16x8 a, bf16x8 b, f32x4 c) { return __builtin_amdgcn_mfma_f32_16x16x32_bf16(a, b, c, 0, 0, 0); }
DI bf16x8 pack8(f32x4 a, f32x4 b) {
    u32x4 w; w.x = cvt_pk_bf16(a[0], a[1]); w.y = cvt_pk_bf16(a[2], a[3]); w.z = cvt_pk_bf16(b[0], b[1]); w.w = cvt_pk_bf16(b[2], b[3]);
    return __builtin_bit_cast(bf16x8, w);
}
DI bf16x8 join8(u32x2 lo, u32x2 hi) { u32x4 w; w.x = lo.x; w.y = lo.y; w.z = hi.x; w.w = hi.y; return __builtin_bit_cast(bf16x8, w); }
DI float wave_allsum(float v) {
#pragma unroll
    for (int d = 1; d < 64; d <<= 1) v += __shfl_xor(v, d);
    return v;
}
DI float wave_allmax(float v) {
#pragma unroll
    for (int d = 1; d < 64; d <<= 1) v = fmaxf(v, __shfl_xor(v, d));
    return v;
}
template <int CTRL, int RM> DI float dpp_f(float x) {
    return __builtin_bit_cast(float, __builtin_amdgcn_update_dpp(0, __builtin_bit_cast(int, x), CTRL, RM, 0xF, false));
}
DI float wave_sum63(float x) {
    x += dpp_f<0xB1, 0xF>(x);
    x += dpp_f<0x4E, 0xF>(x);
    x += dpp_f<0x141, 0xF>(x);
    x += dpp_f<0x140, 0xF>(x);
    x += dpp_f<0x142, 0xA>(x);
    x += dpp_f<0x143, 0xC>(x);
    return x;
}
template <int CTRL> DI float dpp_add(float x) { return x + __builtin_bit_cast(float, __builtin_amdgcn_update_dpp(0, __builtin_bit_cast(int, x), CTRL, 0xF, 0xF, false)); }
DI float row16_allsum(float x) { x = dpp_add<0xB1>(x); x = dpp_add<0x4E>(x); x = dpp_add<0x141>(x); x = dpp_add<0x140>(x); return x; }
DI void seq_info(int row, int& t, int& T) { if (row < TL) { t = row & (TLB - 1); T = TLB; } else { t = (row - TL) & (TCB - 1); T = TCB; } }
DI int mods_row(int row) { return row < TL ? (row >> 13) : 2; }

DI int lds_byte(int r, int c) { const int st = (r >> 4) * 2 + (c >> 5), rr = r & 15, cc = c & 31, ob = rr * 64 + cc * 2; return st * 1024 + (ob ^ (((ob >> 9) & 1) << 5)); }

DI int a_row(int tid) { return (tid >> 4) * 2 + ((tid >> 2) & 1); }
DI int a_c8(int tid) { return ((tid >> 3) & 1) * 4 + (tid & 3); }
template <int NP> struct PtrLoader { const bf16_t* base; unsigned p[NP]; };
struct PtrLoaderF { const float* base0; const float* base1; unsigned p[4]; int ld; };
typedef short s16x4 __attribute__((ext_vector_type(4)));
DI int b_img(int k, int seg, int bo) { return 256 * k + 32 * (seg ^ ((k & 3) + 4 * ((k >> 3) & 1))) + bo; }
DI bf16x8 tr_frag(const char* base, int xl, int c, int ks) {
    const char* a = base + (xl ^ (c << 5)) + 8192 * ks;
    const s16x4 lo = __builtin_amdgcn_ds_read_tr16_b64_v4i16((LAS s16x4*)(a));
    const s16x4 hi = __builtin_amdgcn_ds_read_tr16_b64_v4i16((LAS s16x4*)(a + 1024));
    return __builtin_shufflevector(lo, hi, 0, 1, 2, 3, 4, 5, 6, 7);
}

DI void tile_of(int u, int ntm, int ntn, int& tm, int& tn) {
    const int gid = u / (4 * ntn), within = u % (4 * ntn);
    const int gsz = (ntm - gid * 4) < 4 ? (ntm - gid * 4) : 4;
    tm = gid * 4 + within % gsz; tn = within / gsz;
}
DI void fill_bf(PtrLoaderF& bl, const float* W, int ld, int n0, int nvalid) {
    bl.ld = ld; bl.base0 = W; bl.base1 = W;
    const int tz = opaque_tid();
#pragma unroll
    for (int i = 0; i < 4; ++i) { int n = n0 + 32 * i + (tz & 7) * 4; n = n < nvalid ? n : nvalid - 4; bl.p[i] = (unsigned)((tz >> 3) * ld + n); }
}
template <int V> struct IC { static constexpr int value = V; };
template <int WR, int WC, int MT, int NT, class BL, int NTU, int MODE = 0, class MK, class PF, class PRE, class SINK>
DI void gemm_stream(char* lds, int nunits, int nk, MK&& mk, PF&& pf, PRE&& pre, SINK&& sink) {
    constexpr bool BF32 = __is_same(BL, PtrLoaderF);
    constexpr int BM = WR * MT * 16, BN = WC * NT * 16, APC = BM * 8 / NTHR, BPC = BF32 ? 4 : BN * 8 / NTHR;
    constexpr int ABYTES = BM * 128, STAGE = (BM + BN) * 128;
    static_assert(WR * WC == 8, "8 waves");
    static_assert(!BF32 || BN == 128, "f32 B path is written for 128-column tiles");
    const int tid = opaque_tid(), lane = tid & 63, wid = tid >> 6, wr = wid / WC, wc = wid % WC, fr = lane & 15, fq = lane >> 4;
    const int ubase = (blockIdx.x & 7) * 32 + (blockIdx.x >> 3), ustep = (int)gridDim.x;
    if (ubase >= nunits) return;
    int lu = ubase, lkt = 0, cu = ubase, ckt = 0;
    int lun = (lu + ustep < nunits) ? lu + ustep : lu;
    f32x4 acc[MT][NT];
#pragma unroll
    for (int m = 0; m < MT; ++m)
#pragma unroll
        for (int n = 0; n < NT; ++n) acc[m][n] = (f32x4){0.f, 0.f, 0.f, 0.f};
    const int sa0 = lds_byte(a_row(tid), a_c8(tid) * 8);
    const int xl = b_img(8 * fq + ((lane & 15) >> 2), 0, 8 * (lane & 3));
    auto sbo = [&](int i) -> int {
        if constexpr (BF32) { const int k = tid >> 3, n4 = 8 * i + (tid & 7); return ABYTES + b_img(k, n4 >> 2, 8 * (n4 & 3)); }
        else return ABYTES + lds_byte((tid >> 3) + 64 * i, (tid & 7) * 8);
    };
    PtrLoader<APC> al; BL bl;
    int nx[4] = {0, 0, 0, 0};
    pf(lu, nx, 2);
    mk(lu, al, bl, nx);
    pf(lun, nx, 2);
    u32x4 ra[APC], rb[BPC];
    auto issue = [&](auto hc) {
        if constexpr (MODE == 2) return;
#pragma unroll
        for (int i = 0; i < APC; ++i) ra[i] = *(const u32x4*)(al.base + al.p[i] + lkt * 64);
#pragma unroll
        for (int i = 0; i < BPC; ++i) {
            if constexpr (BF32) rb[i] = *(const u32x4*)(((i & 1) ? bl.base1 : bl.base0) + bl.p[i] + (size_t)lkt * 64 * bl.ld);
            else rb[i] = *(const u32x4*)(bl.base + bl.p[i] + lkt * 64);
        }
        const int use[4] = {nx[0], nx[1], nx[2], nx[3]};
        pf(lun, nx, decltype(hc)::value);
        if (++lkt == nk) { lkt = 0; lu = lun; lun = (lu + ustep < nunits) ? lu + ustep : lu; mk(lu, al, bl, use); }
    };
    auto stash = [&](char* st) {
        if constexpr (MODE == 2) return;
#pragma unroll
        for (int i = 0; i < APC; ++i) *(u32x4*)(st + sa0 + 8192 * i) = ra[i];
#pragma unroll
        for (int i = 0; i < BPC; ++i) {
            if constexpr (BF32) {
                u32x2 w; w.x = cvt_pk_bf16_asm(__uint_as_float(rb[i].x), __uint_as_float(rb[i].y)); w.y = cvt_pk_bf16_asm(__uint_as_float(rb[i].z), __uint_as_float(rb[i].w));
                *(u32x2*)(st + sbo(i)) = w;
            } else *(u32x4*)(st + sbo(i)) = rb[i];
        }
    };
    auto compute = [&](const char* st) {
        if constexpr (MODE == 1) return;
#pragma unroll
        for (int ks = 0; ks < 2; ++ks) {
            bf16x8 af[MT], bfr[NT];
#pragma unroll
            for (int m = 0; m < MT; ++m) af[m] = *(const bf16x8*)(st + lds_byte(wr * MT * 16 + m * 16 + fr, ks * 32 + fq * 8));
#pragma unroll
            for (int n = 0; n < NT; ++n) {
                if constexpr (BF32) bfr[n] = tr_frag(st + ABYTES, xl, wc * NT + n, ks);
                else bfr[n] = *(const bf16x8*)(st + ABYTES + lds_byte(wc * NT * 16 + n * 16 + fr, ks * 32 + fq * 8));
            }
#pragma unroll
            for (int m = 0; m < MT; ++m)
#pragma unroll
                for (int n = 0; n < NT; ++n) acc[m][n] = mfma16(bfr[n], af[m], acc[m][n]);
        }
    };
    auto ep = [&](int u, f32x4 (&a)[MT][NT], int, int) {
        float* W = (float*)(lds + EPI_OFF + wid * EPI_WAVE_B);
        constexpr int LPR = NTU * 4, RPI = 64 / LPR, NJ = 16 / RPI;
        const int c4 = lane % LPR, rb = lane / LPR;
#pragma unroll
        for (int mi = 0; mi < MT; ++mi) {
            f32x4 o[NTU];
            pre(u, mi, a[mi], o, wr * MT * 16 + mi * 16 + fr, wc * NT * 16 + 4 * fq);
#pragma unroll
            for (int ni = 0; ni < NTU; ++ni) *(f32x4*)(W + fr * 68 + ni * 16 + 4 * fq) = o[ni];
#pragma unroll
            for (int j = 0; j < NJ; ++j) {
                const f32x4 v = *(const f32x4*)(W + (rb + RPI * j) * 68 + 4 * c4);
                const f32x4 pv = *(const f32x4*)(W + (rb + RPI * j) * 68 + 4 * (c4 ^ 4));
                sink(u, wr * MT * 16 + mi * 16 + rb + RPI * j, wc * NTU * 16 + 4 * c4, v, pv);
            }
        }
    };
    issue(IC<0>{});
    stash(lds);
    if (wid >= 4) issue(IC<1>{});
    __syncthreads();
    bool first = true;
    auto epilogue = [&]() {
        if (ckt == 0 && !first) {
            if constexpr (MODE == 0 || MODE == 4) ep(cu - ustep, acc, wr * MT * 16 + fr, wc * NT * 16 + 4 * fq);
            else { asm volatile("" :: "v"(acc[0][0]), "v"(acc[MT - 1][NT - 1])); }
#pragma unroll
            for (int m = 0; m < MT; ++m)
#pragma unroll
                for (int n = 0; n < NT; ++n) acc[m][n] = (f32x4){0.f, 0.f, 0.f, 0.f};
        }
    };
    while (cu < nunits) {
        if (wid < 4) {
            epilogue(); issue(IC<1>{}); compute(lds); stash(lds + STAGE);
            __syncthreads();
            issue(IC<0>{}); compute(lds + STAGE); stash(lds);
            __syncthreads();
        } else {
            stash(lds + STAGE); epilogue(); issue(IC<0>{}); compute(lds);
            __syncthreads();
            stash(lds); issue(IC<1>{}); compute(lds + STAGE);
            __syncthreads();
        }
        first = false;
        ckt += 2;
        if (ckt == nk) { ckt = 0; cu += ustep; }
    }
    if constexpr (MODE == 0 || MODE == 4) ep(cu - ustep, acc, wr * MT * 16 + fr, wc * NT * 16 + 4 * fq);
    else {
#pragma unroll
        for (int m = 0; m < MT; ++m)
#pragma unroll
            for (int n = 0; n < NT; ++n) asm volatile("" :: "v"(acc[m][n]));
        if constexpr (MODE == 1) { asm volatile("" :: "v"(ra[0]), "v"(rb[0])); }
    }
}

DI void ph_prologue(const Params& p, char* lds) {
    const int tid = opaque_tid(), bid = blockIdx.x, nb = gridDim.x;
    for (int i = bid * NTHR + tid; i < 1026; i += nb * NTHR) p.ictl[i] = 0;
    for (int i = bid * NTHR + tid; i < 2 * NSLOT; i += nb * NTHR) {
        const int s = i % NSLOT;
        p.SLOT_TOK[i] = s >= SH_BASE ? s - SH_BASE : 0;
        p.SLOT_W[i] = s >= SH_BASE ? 1.0f : 0.0f;
    }
    if (bid >= 192) {
        for (int idx = (bid - 192) * NTHR + tid; idx < 8 * 4 * 7 * 64; idx += (nb - 192) * NTHR) {
            const int ln = idx & 63, s = (idx >> 6) % 7, hn = (idx >> 6) / 7;
            const int c = hn * 16 + (ln & 15);
            const float* wc_ = (s < 2 ? p.rw_w_up + s * 32 * 512 : (s < 4 ? p.rw_a_up + (s - 2) * 32 * 512 : p.rw_g_up + (s - 4) * 32 * 512)) + 8 * (ln >> 4) * 512 + c;
            u32x4 w;
            w.x = cvt_pk_bf16(wc_[0], wc_[512]); w.y = cvt_pk_bf16(wc_[1024], wc_[1536]); w.z = cvt_pk_bf16(wc_[2048], wc_[2560]); w.w = cvt_pk_bf16(wc_[3072], wc_[3584]);
            *(u32x4*)(p.WF + (size_t)idx * 4) = w;
        }
    }
    constexpr int J_MODS = 192;
    for (int job = bid; job < J_MODS; job += nb) {
        const int j = job;
        if (j < J_MODS) {
            const int l = j / 96, cb = j % 96;
            float* sc = (float*)lds;
            float* red = sc + 3072;
            for (int idx = tid; idx < 3072; idx += NTHR) {
                const int r = idx >> 10, k = idx & 1023;
                const float cv = r < 2 ? p.c[r * 1024 + k] : p.c_ctx[k];
                sc[idx] = siluf_(cv);
            }
            __syncthreads();
            const int kq = tid >> 6, cl = tid & 63, col = cb * 64 + cl;
            float a0 = 0.f, a1 = 0.f, a2 = 0.f;
            const float* w = p.ada_w + (size_t)l * 1024 * 6144 + col;
            for (int k = kq * 128; k < kq * 128 + 128; ++k) {
                const float wv = w[(size_t)k * 6144];
                a0 += sc[k] * wv; a1 += sc[1024 + k] * wv; a2 += sc[2048 + k] * wv;
            }
            red[(kq * 3 + 0) * 64 + cl] = a0; red[(kq * 3 + 1) * 64 + cl] = a1; red[(kq * 3 + 2) * 64 + cl] = a2;
            __syncthreads();
            if (tid < 192) {
                const int r = tid >> 6, c2 = tid & 63;
                float s = 0.f;
#pragma unroll
                for (int q = 0; q < 8; ++q) s += red[(q * 3 + r) * 64 + c2];
                p.mods[(size_t)(l * 3 + r) * 6144 + cb * 64 + c2] = s + p.ada_b[l * 6144 + cb * 64 + c2];
            }
            __syncthreads();
            continue;
        }
    }
}

DI void ph_modulate0(const Params& p) {
    const int nb = gridDim.x;
#pragma unroll 4
    for (int i = blockIdx.x * NTHR + opaque_tid(); i < TT * 256; i += nb * NTHR) {
        const int row = i >> 8, c = (i & 255) * 4;
        const float* src = row < TL ? p.x + (size_t)row * 1024 : p.ctx + (size_t)(row - TL) * 1024;
        const float* m = p.mods + (size_t)(0 * 3 + mods_row(row)) * 6144;
        const f32x4 v = *(const f32x4*)(src + c), sh = *(const f32x4*)(m + c), scv = *(const f32x4*)(m + 1024 + c);
        const f32x4 a = v * (1.0f + scv) + sh;
        u32x2 w; w.x = cvt_pk_bf16(a[0], a[1]); w.y = cvt_pk_bf16(a[2], a[3]);
        *(u32x2*)(p.Abuf + (size_t)row * 1024 + c) = w;
    }
}

DI void ph_inproj0(const Params& p, char* lds) {
    const int tid = opaque_tid();
    constexpr int NTN = 26, NTM = 66;
    gemm_stream<4, 2, 4, 4, PtrLoaderF, 4>(lds, NTN * NTM, 16, [&](int u, PtrLoader<4>& al, PtrLoaderF& bl, const int (&nx)[4]) {
        int tm, tn; tile_of(u, NTM, NTN, tm, tn);
#pragma unroll
        for (int i = 0; i < 4; ++i) al.p[i] = (unsigned)((tm * 256 + a_row(tid) + 64 * i) * 1024 + a_c8(tid) * 8);
        al.base = p.Abuf;
        fill_bf(bl, p.ev_w_in, EVC, tn * 128, EVC);
    }, [&](int u, int (&nx)[4], int) {}, [&](int u, int mi, const f32x4 (&a)[4], f32x4 (&o)[4], int r0, int c0) {
#pragma unroll
        for (int ni = 0; ni < 4; ++ni) o[ni] = a[ni];
    }, [&](int u, int r, int c, f32x4 v, f32x4 pv) {
        int tm, tn; tile_of(u, NTM, NTN, tm, tn);
        const int row = tm * 256 + r, col = tn * 128 + c;
        if (tn < 12) {
            bf16_t* dst = (tn < 4 ? p.Q0 + col : (tn < 8 ? p.K0 + (col - 512) : p.V0 + (col - 1024))) + (size_t)row * 512;
            u32x2 w; w.x = cvt_pk_bf16(v[0], v[1]); w.y = cvt_pk_bf16(v[2], v[3]);
            *(u32x2*)dst = w;
        } else if (col < EVC) {
            *(f32x4*)(p.RWP + (size_t)row * RWC + (col - 1536)) = v;
        }
    });
}

DI void transpose_tile(char* ldsc, const bf16_t* src, int ld, int row0, int col0, bf16_t* dstL, bf16_t* dstC, int ncols) {
    bf16_t* T = (bf16_t*)ldsc;
    const int tid = opaque_tid();
    {
        const int tok = tid >> 3, d8 = tid & 7;
        *(u32x4*)(T + tok * 72 + d8 * 8) = *(const u32x4*)(src + (size_t)(row0 + tok) * ld + col0 + d8 * 8);
    }
    __syncthreads();
    {
        const int d = tid >> 3, t8 = tid & 7;
        u32x4 w;
        w.x = (unsigned)T[(t8 * 8 + 0) * 72 + d] | ((unsigned)T[(t8 * 8 + 1) * 72 + d] << 16);
        w.y = (unsigned)T[(t8 * 8 + 2) * 72 + d] | ((unsigned)T[(t8 * 8 + 3) * 72 + d] << 16);
        w.z = (unsigned)T[(t8 * 8 + 4) * 72 + d] | ((unsigned)T[(t8 * 8 + 5) * 72 + d] << 16);
        w.w = (unsigned)T[(t8 * 8 + 6) * 72 + d] | ((unsigned)T[(t8 * 8 + 7) * 72 + d] << 16);
        bf16_t* dst;
        if (row0 < TL) dst = dstL + ((size_t)((row0 >> 13) * ncols + col0 + d)) * TLB + (row0 & (TLB - 1));
        else { const int rc = row0 - TL; dst = dstC + ((size_t)((rc >> 8) * ncols + col0 + d)) * TCB + (rc & (TCB - 1)); }
        *(u32x4*)(dst + t8 * 8) = w;
    }
    __syncthreads();
}

template <int NOSTORE = 0>
DI void ph_rw_prep(const Params& p, char* ldsc) {
    constexpr int TG = 16, LRP = 232;
    bf16_t* LR = (bf16_t*)ldsc;
    const int tid = opaque_tid(), lane = tid & 63, hh = tid >> 6, q = lane & 15, g = lane >> 4;
    bf16_t* SH = (bf16_t*)(ldsc + 8192);
    bf16x8 wq[7];
    auto wload = [&](int nt_) {
        unsigned co_ = (unsigned)(((hh * 4 + nt_) * 7 * 64 + lane) * 4); asm volatile("" : "+v"(co_));
#pragma unroll
        for (int s = 0; s < 7; ++s) wq[s] = __builtin_bit_cast(bf16x8, *(const u32x4*)(p.WF + co_ + s * 256));
    };
    wload(0);
    for (int grp = blockIdx.x; grp < TT / TG; grp += gridDim.x) {
        const int row0 = grp * TG;
        int t0, Tseq; seq_info(row0, t0, Tseq);
#pragma unroll 4
        for (int idx = tid; idx < TG * 440; idx += NTHR) {
            const int tk = idx / 440, c4 = (idx % 440) * 4;
            const int t = t0 + tk;
            const float* pr = p.RWP + (size_t)(row0 + tk) * RWC + c4;
            const f32x4 pc = *(const f32x4*)pr;
            const f32x4 pv = t > 0 ? *(const f32x4*)(pr - RWC) : (f32x4){0.f, 0.f, 0.f, 0.f};
            const f32x4 nx = t < Tseq - 1 ? *(const f32x4*)(pr + RWC) : (f32x4){0.f, 0.f, 0.f, 0.f};
            const f32x4 mu = *(const f32x4*)(p.rw_mu + c4);
            f32x4 v = pc + mu * (0.5f * (pv + nx) - pc);
            if (c4 < 1536) {
                u32x2 w; w.x = cvt_pk_bf16(v[0], v[1]); w.y = cvt_pk_bf16(v[2], v[3]);
                *(u32x2*)(SH + tk * 1536 + c4) = w;
            } else {
                const int j = c4 - 1536;
                if (j < 64) { v[0] = tanhf_(v[0]); v[1] = tanhf_(v[1]); v[2] = tanhf_(v[2]); v[3] = tanhf_(v[3]); }
                else if (j >= 128) { v[0] = sigmoidf_(v[0]); v[1] = sigmoidf_(v[1]); v[2] = sigmoidf_(v[2]); v[3] = sigmoidf_(v[3]); }
                u32x2 w; w.x = cvt_pk_bf16(v[0], v[1]); w.y = cvt_pk_bf16(v[2], v[3]);
                *(u32x2*)(LR + tk * LRP + j) = w;
            }
        }
        __syncthreads();
        float nrm[4];
#pragma unroll
        for (int r = 0; r < 4; ++r) {
            float ss = 0.f;
#pragma unroll
            for (int nt = 0; nt < 4; ++nt) {
                const int c = hh * 64 + 16 * nt + q;
                const float kk0 = bf2f(SH[(4 * g + r) * 1536 + 512 + c]) * p.rw_k_k[c];
                ss += kk0 * kk0;
            }
            nrm[r] = 1.0f / fmaxf(sqrtf(row16_allsum(ss)), 1e-12f);
        }
        float bon[4] = {0.f, 0.f, 0.f, 0.f};
        const f32x4 z4 = (f32x4){0.f, 0.f, 0.f, 0.f};
#pragma unroll
        for (int nt = 0; nt < 4; ++nt) {
            const int c = hh * 64 + 16 * nt + q;
            auto afrag = [&](int s) -> bf16x8 { return *(const bf16x8*)(LR + q * LRP + 32 * s + 8 * g); };
            f32x4 wl0, wl1, al0, al1, gl;
            {
                bf16x8 wc[7];
#pragma unroll
                for (int s = 0; s < 7; ++s) wc[s] = wq[s];
                wload((nt + 1) & 3);
                wl0 = mfma16(afrag(0), wc[0], z4); wl1 = mfma16(afrag(1), wc[1], z4); al0 = mfma16(afrag(2), wc[2], z4); al1 = mfma16(afrag(3), wc[3], z4);
                gl = mfma16(afrag(6), wc[6], mfma16(afrag(5), wc[5], mfma16(afrag(4), wc[4], z4)));
            }
            asm volatile("" ::: "memory");
            const float kkw = p.rw_k_k[c], kaw = p.rw_k_a[c], rkw = p.rw_r_k[c];
            const float w00 = p.rw_w0[c], w01 = p.rw_w0[512 + c], a00 = p.rw_a0[c], a01 = p.rw_a0[512 + c];
#pragma unroll
            for (int r = 0; r < 4; ++r) {
                const int row = row0 + 4 * g + r;
                const bf16_t* sh = SH + (4 * g + r) * 1536 + c;
                const float r_ = bf2f(sh[0]), k_ = bf2f(sh[512]), v_ = bf2f(sh[1024]);
                const float kk = k_ * kkw * nrm[r];
                const float wlog0 = -softplusf_(-(w00 + wl0[r])) - 0.5f, wlog1 = -softplusf_(-(w01 + wl1[r])) - 0.5f;
                const float dec0 = __expf(-__expf(wlog0)), dec1 = __expf(-__expf(wlog1));
                const float av0 = sigmoidf_(a00 + al0[r]), av1 = sigmoidf_(a01 + al1[r]);
                const float kd0 = k_ * (1.0f + (av0 - 1.0f) * kaw), kd1 = k_ * (1.0f + (av1 - 1.0f) * kaw);
                bon[r] += r_ * (kd0 + kd1) * rkw;
                const size_t o = (size_t)row * 512 + c;
                if (NOSTORE) { asm volatile("" :: "v"(dec0), "v"(dec1), "v"(kk * av0 + kk * av1 + kd0 + kd1 + v_ + gl[r])); continue; }
                typedef float f32x2s __attribute__((ext_vector_type(2)));
                *(f32x2s*)(p.SW + 2 * o) = (f32x2s){dec0, dec1};
                p.SBP[o] = cvt_pk_bf16(kk * av0, kk * av1); p.SKP[o] = cvt_pk_bf16(kd0, kd1);
                p.SNV[o] = cvt_pk_bf16(-kk, v_); p.SRG[o] = cvt_pk_bf16(r_, gl[r]);
                if (r & 1) asm volatile("" ::: "memory");
            }
        }
#pragma unroll
        for (int r = 0; r < 4; ++r) {
            const float bs = row16_allsum(bon[r]);
            if (q == 0) p.BONUS[(row0 + 4 * g + r) * 8 + hh] = bs;
        }
        __syncthreads();
    }
}

template <bool LAT>
DI void na_unit(const Params& p, int b, int r, int h, int w, int lane) {
    const int q = lane & 15, g = lane >> 4;
    const int j = 16 * w + q;
    const int qtok = LAT ? (b * TLB + r * 64 + j) : (TL + b * TCB + j);
    bf16x8 qf[2];
#pragma unroll
    for (int ks = 0; ks < 2; ++ks) qf[ks] = *(const bf16x8*)(p.Q0 + (size_t)qtok * 512 + h * 64 + 32 * ks + 8 * g);
    const int row_start = LAT ? (r - 4 < 0 ? 0 : (r - 4 > 120 ? 120 : r - 4)) : 0;
    const int c0 = LAT ? (w == 0 ? 0 : (w == 1 ? 8 : (w == 2 ? 24 : 32))) : 0;
    int cs = j - 8; cs = cs < 0 ? 0 : (cs > 48 ? 48 : cs);
    auto score_local = [&](int a, int tt) -> f32x4 {
        const int ktok = b * TLB + (row_start + a) * 64 + c0 + 16 * tt + q;
        f32x4 s = (f32x4){0.f, 0.f, 0.f, 0.f};
#pragma unroll
        for (int ks = 0; ks < 2; ++ks) {
            const bf16x8 kf = *(const bf16x8*)(p.K0 + (size_t)ktok * 512 + h * 64 + 32 * ks + 8 * g);
            s = mfma16(kf, qf[ks], s);
        }
        const int row_off = row_start + a - r + 7;
#pragma unroll
        for (int rr = 0; rr < 4; ++rr) {
            const int cc = c0 + 16 * tt + 4 * g + rr;
            int co = cc - j; co = co < -15 ? -15 : (co > 15 ? 15 : co);
            const bool in = (cc >= cs) && (cc < cs + 16);
            const float bias = p.na_rpb[(h * 15 + row_off) * 31 + co + 15];
            s[rr] = in ? (s[rr] * 0.125f + bias) : -1.0e30f;
        }
        return s;
    };
    auto score_ctx = [&](int ct) -> f32x4 {
        const int ktok = TL + b * TCB + 16 * ct + q;
        f32x4 s = (f32x4){0.f, 0.f, 0.f, 0.f};
#pragma unroll
        for (int ks = 0; ks < 2; ++ks) {
            const bf16x8 kf = *(const bf16x8*)(p.K0 + (size_t)ktok * 512 + h * 64 + 32 * ks + 8 * g);
            s = mfma16(kf, qf[ks], s);
        }
        return s * 0.125f;
    };
    float mx = -3.0e38f;
    if (LAT) {
        for (int a = 0; a < 8; ++a) {
#pragma unroll
            for (int tt = 0; tt < 2; ++tt) { const f32x4 s = score_local(a, tt); mx = fmaxf(mx, fmaxf(fmaxf(s[0], s[1]), fmaxf(s[2], s[3]))); }
        }
    }
    for (int ct = 0; ct < 16; ++ct) { const f32x4 s = score_ctx(ct); mx = fmaxf(mx, fmaxf(fmaxf(s[0], s[1]), fmaxf(s[2], s[3]))); }
    mx = fmaxf(mx, __shfl_xor(mx, 16)); mx = fmaxf(mx, __shfl_xor(mx, 32));
    float sum = 0.f;
    f32x4 o[4];
#pragma unroll
    for (int dm = 0; dm < 4; ++dm) o[dm] = (f32x4){0.f, 0.f, 0.f, 0.f};
    if (LAT) {
        for (int a = 0; a < 8; ++a) {
            f32x4 s0 = score_local(a, 0), s1 = score_local(a, 1);
#pragma unroll
            for (int rr = 0; rr < 4; ++rr) { s0[rr] = __expf(s0[rr] - mx); s1[rr] = __expf(s1[rr] - mx); sum += s0[rr] + s1[rr]; }
            const bf16x8 pb = pack8(s0, s1);
#pragma unroll
            for (int dm = 0; dm < 4; ++dm) {
                const bf16_t* vr = p.VT0L + ((size_t)(b * 512 + h * 64 + 16 * dm + q)) * TLB + (row_start + a) * 64 + c0 + 4 * g;
                const bf16x8 va = join8(*(const u32x2*)vr, *(const u32x2*)(vr + 16));
                o[dm] = mfma16(va, pb, o[dm]);
            }
        }
    }
    for (int u = 0; u < 8; ++u) {
        f32x4 s0 = score_ctx(2 * u), s1 = score_ctx(2 * u + 1);
#pragma unroll
        for (int rr = 0; rr < 4; ++rr) { s0[rr] = __expf(s0[rr] - mx); s1[rr] = __expf(s1[rr] - mx); sum += s0[rr] + s1[rr]; }
        const bf16x8 pb = pack8(s0, s1);
#pragma unroll
        for (int dm = 0; dm < 4; ++dm) {
            const bf16_t* vr = p.VT0C + ((size_t)(b * 512 + h * 64 + 16 * dm + q)) * TCB + 32 * u + 4 * g;
            const bf16x8 va = join8(*(const u32x2*)vr, *(const u32x2*)(vr + 16));
            o[dm] = mfma16(va, pb, o[dm]);
        }
    }
    sum += __shfl_xor(sum, 16); sum += __shfl_xor(sum, 32);
    const float inv = 1.0f / sum;
#pragma unroll
    for (int dm = 0; dm < 4; ++dm) {
        u32x2 wv; wv.x = cvt_pk_bf16(o[dm][0] * inv, o[dm][1] * inv); wv.y = cvt_pk_bf16(o[dm][2] * inv, o[dm][3] * inv);
        *(u32x2*)(p.MIX + (size_t)qtok * 1024 + h * 64 + 16 * dm + 4 * g) = wv;
    }
}

constexpr int CK_NCH = (TCB + TLB) / 16;
constexpr int CPW = 19200;
constexpr int CP_TMU = 0, CP_TMB = 2304, CP_TMK = 4608, CP_TMR = 6912, CP_TRU = 9216, CP_TRB = 11264, CP_TRV = 13312;
constexpr int CP_TT = 15360, CP_ARB = 15872, CP_AUKT = 16384, CP_H = 16896, CP_Q = 17408, CP_AUB = 17920, CP_G = 18944;
constexpr int CP_GT = CP_TMU, CP_WT = CP_TMB;

DI void cp_unit(const Params& p, char* W, int unit, int lane) {
    const int chain = unit / CK_NCH, c = unit % CK_NCH;
    const int b = chain >> 4, h = (chain >> 1) & 7, dir = chain & 1;
    const int q = lane & 15, g = lane >> 4;
    auto step_row = [&](int i) -> int {
        if (i < TCB) return TL + b * TCB + (dir == 0 ? i : TCB - 1 - i);
        const int jj = i - TCB;
        return b * TLB + (dir == 0 ? jj : TLB - 1 - jj);
    };
    {
        const float* SWd = p.SW + 2 * (h * 64 + lane) + dir;
        const unsigned* SBd = p.SBP + h * 64 + lane;
        const unsigned* SKDd = p.SKP + h * 64 + lane;
        const unsigned* SNd = p.SNV + h * 64 + lane;
        const unsigned* SRd = p.SRG + h * 64 + lane;
        float gam = 1.0f;
        unsigned pu[8], pb[8], pv[8];
        float lu = 0.f, lb = 0.f, lv = 0.f;
#pragma unroll
        for (int i4 = 0; i4 < 4; ++i4) {
            float w_[4], n_[4], b_[4], k_[4], r_[4], v_[4];
#pragma unroll
            for (int e = 0; e < 4; ++e) {
                const size_t ro = (size_t)step_row(c * 16 + 4 * i4 + e) * 512;
                w_[e] = SWd[2 * ro];
                { const unsigned nv = SNd[ro], bw = SBd[ro], kw = SKDd[ro], rw = SRd[ro];
                  n_[e] = bflo(nv); v_[e] = bfhi(nv); b_[e] = dir ? bfhi(bw) : bflo(bw); k_[e] = dir ? bfhi(kw) : bflo(kw); r_[e] = bflo(rw); }
            }
#pragma unroll
            for (int e = 0; e < 4; ++e) {
                const int i = 4 * i4 + e;
                const float gp = gam; gam *= w_[e];
                const float ig = 1.0f / gam;
                const float ut = gp * n_[e], bt = b_[e] * ig, kt = k_[e] * ig, rt = gam * r_[e];
                const unsigned wub = cvt_pk_bf16(ut, bt), wkr = cvt_pk_bf16(kt, rt);
                *(bf16_t*)(W + CP_TMU + i * 144 + lane * 2) = (bf16_t)(wub & 0xffff);
                *(bf16_t*)(W + CP_TMB + i * 144 + lane * 2) = (bf16_t)(wub >> 16);
                *(bf16_t*)(W + CP_TMK + i * 144 + lane * 2) = (bf16_t)(wkr & 0xffff);
                *(bf16_t*)(W + CP_TMR + i * 144 + lane * 2) = (bf16_t)(wkr >> 16);
                if (i & 1) { pu[i >> 1] = cvt_pk_bf16(lu, ut); pb[i >> 1] = cvt_pk_bf16(lb, bt); pv[i >> 1] = cvt_pk_bf16(lv, v_[e]); }
                else { lu = ut; lb = bt; lv = v_[e]; }
            }
        }
        *(u32x4*)(W + CP_TRU + lane * 32) = (u32x4){pu[0], pu[1], pu[2], pu[3]}; *(u32x4*)(W + CP_TRU + lane * 32 + 16) = (u32x4){pu[4], pu[5], pu[6], pu[7]};
        *(u32x4*)(W + CP_TRB + lane * 32) = (u32x4){pb[0], pb[1], pb[2], pb[3]}; *(u32x4*)(W + CP_TRB + lane * 32 + 16) = (u32x4){pb[4], pb[5], pb[6], pb[7]};
        *(u32x4*)(W + CP_TRV + lane * 32) = (u32x4){pv[0], pv[1], pv[2], pv[3]}; *(u32x4*)(W + CP_TRV + lane * 32 + 16) = (u32x4){pv[4], pv[5], pv[6], pv[7]};
        *(float*)(W + CP_G + lane * 4) = gam;
    }
    auto fr64 = [&](int off, int ks) -> bf16x8 { return *(const bf16x8*)(W + off + q * 144 + (32 * ks + 8 * g) * 2); };
    auto fr16 = [&](int off, int row) -> bf16x8 {
        u32x4 z = (u32x4){0u, 0u, 0u, 0u};
        if (g < 2) z = *(const u32x4*)(W + off + row * 32 + g * 16);
        return __builtin_bit_cast(bf16x8, z);
    };
    const f32x4 zero4 = (f32x4){0.f, 0.f, 0.f, 0.f};
    asm volatile("" ::: "memory");
    f32x4 arkT;
    {
        const bf16x8 fu0 = fr64(CP_TMU, 0), fu1 = fr64(CP_TMU, 1), fb0 = fr64(CP_TMB, 0), fb1 = fr64(CP_TMB, 1);
        const bf16x8 fk0 = fr64(CP_TMK, 0), fk1 = fr64(CP_TMK, 1), fr0 = fr64(CP_TMR, 0), fr1 = fr64(CP_TMR, 1);
        f32x4 d = mfma16(fb1, fu1, mfma16(fb0, fu0, zero4));
#pragma unroll
        for (int r = 0; r < 4; ++r) d[r] = (4 * g + r < q) ? d[r] : 0.f;
        *(f32x4*)(W + CP_AUB + q * 64 + 16 * g) = d;
        d = mfma16(fb1, fr1, mfma16(fb0, fr0, zero4));
#pragma unroll
        for (int r = 0; r < 4; ++r) d[r] = (4 * g + r <= q) ? d[r] : 0.f;
        { u32x2 w; w.x = cvt_pk_bf16(d[0], d[1]); w.y = cvt_pk_bf16(d[2], d[3]); *(u32x2*)(W + CP_ARB + q * 32 + 8 * g) = w; }
        d = mfma16(fu1, fk1, mfma16(fu0, fk0, zero4));
#pragma unroll
        for (int r = 0; r < 4; ++r) d[r] = (q < 4 * g + r) ? d[r] : 0.f;
        { u32x2 w; w.x = cvt_pk_bf16(d[0], d[1]); w.y = cvt_pk_bf16(d[2], d[3]); *(u32x2*)(W + CP_AUKT + q * 32 + 8 * g) = w; }
        arkT = mfma16(fk1, fr1, mfma16(fk0, fr0, zero4));
#pragma unroll
        for (int r = 0; r < 4; ++r) arkT[r] = (4 * g + r <= q) ? arkT[r] : 0.f;
    }
    asm volatile("" ::: "memory");
    {
        float t[16];
#pragma unroll
        for (int i = 0; i < 16; ++i) t[i] = 0.f;
#pragma unroll
        for (int i = 0; i < 16; ++i) {
            float s = (i == q) ? 1.0f : 0.f;
#pragma unroll
            for (int m4 = 0; m4 < 4; ++m4) {
                if (4 * m4 < i) {
                    const f32x4 a = *(const f32x4*)(W + CP_AUB + i * 64 + 16 * m4);
                    s += (a[0] * t[4 * m4] + a[1] * t[4 * m4 + 1]) + (a[2] * t[4 * m4 + 2] + a[3] * t[4 * m4 + 3]);
                }
            }
            t[i] = s;
        }
        if (g == 0) {
            *(u32x4*)(W + CP_TT + q * 32) = (u32x4){cvt_pk_bf16(t[0], t[1]), cvt_pk_bf16(t[2], t[3]), cvt_pk_bf16(t[4], t[5]), cvt_pk_bf16(t[6], t[7])};
            *(u32x4*)(W + CP_TT + q * 32 + 16) = (u32x4){cvt_pk_bf16(t[8], t[9]), cvt_pk_bf16(t[10], t[11]), cvt_pk_bf16(t[12], t[13]), cvt_pk_bf16(t[14], t[15])};
        }
    }
    asm volatile("" ::: "memory");
    {
        const f32x4 d = mfma16(fr16(CP_TT, q), fr16(CP_ARB, q), zero4);
        u32x2 w; w.x = cvt_pk_bf16(d[0], d[1]); w.y = cvt_pk_bf16(d[2], d[3]); *(u32x2*)(W + CP_H + q * 32 + 8 * g) = w;
    }
    asm volatile("" ::: "memory");
    {
        const f32x4 d = mfma16(fr16(CP_AUKT, q), fr16(CP_H, q), arkT);
        u32x2 w; w.x = cvt_pk_bf16(d[0], d[1]); w.y = cvt_pk_bf16(d[2], d[3]); *(u32x2*)(W + CP_Q + q * 32 + 8 * g) = w;
    }
    asm volatile("" ::: "memory");
    {
        const bf16x8 ft = fr16(CP_TT, q);
#pragma unroll
        for (int nt = 0; nt < 4; ++nt) {
            const f32x4 d = mfma16(ft, fr16(CP_TRB, 16 * nt + q), zero4);
            u32x2 w; w.x = cvt_pk_bf16(d[0], d[1]); w.y = cvt_pk_bf16(d[2], d[3]); *(u32x2*)(W + CP_GT + (16 * nt + q) * 32 + 8 * g) = w;
        }
    }
    asm volatile("" ::: "memory");
    {
        const bf16x8 fa = fr16(CP_AUKT, q);
#pragma unroll
        for (int nt = 0; nt < 4; ++nt) {
            f32x4 kt;
#pragma unroll
            for (int r = 0; r < 4; ++r) kt[r] = bf2f(*(const bf16_t*)(W + CP_TMK + (4 * g + r) * 144 + (16 * nt + q) * 2));
            const f32x4 d = mfma16(fa, fr16(CP_GT, 16 * nt + q), kt);
            u32x2 w; w.x = cvt_pk_bf16(d[0], d[1]); w.y = cvt_pk_bf16(d[2], d[3]); *(u32x2*)(W + CP_WT + (16 * nt + q) * 32 + 8 * g) = w;
        }
    }
    asm volatile("" ::: "memory");
    {
        const bf16x8 fh = fr16(CP_H, q), fq = fr16(CP_Q, q);
        bf16_t* RHg = p.CRH + (size_t)unit * 1024;
        bf16_t* P3g = p.CP3 + (size_t)unit * 1024;
        bf16_t* Mg = p.CM + (size_t)unit * 4096;
        bf16_t* Ng = p.CN + (size_t)unit * 4096;
#pragma unroll
        for (int mt = 0; mt < 4; ++mt) {
            const u32x2 rw = *(const u32x2*)(W + CP_TMR + q * 144 + (16 * mt + 4 * g) * 2);
            const f32x4 rt = (f32x4){bflo(rw.x), bfhi(rw.x), bflo(rw.y), bfhi(rw.y)};
            const f32x4 d = mfma16(fr16(CP_TRU, 16 * mt + q), fh, rt);
            u32x2 w; w.x = cvt_pk_bf16(d[0], d[1]); w.y = cvt_pk_bf16(d[2], d[3]);
            *(u32x2*)(RHg + (((mt >> 1) * 64 + lane) * 8 + (mt & 1) * 4)) = w;
        }
#pragma unroll
        for (int vs = 0; vs < 4; ++vs) {
            const f32x4 d = mfma16(fq, fr16(CP_TRV, 16 * vs + q), zero4);
            { u32x2 w; w.x = cvt_pk_bf16(d[0], d[1]); w.y = cvt_pk_bf16(d[2], d[3]); *(u32x2*)(P3g + (vs * 64 + lane) * 4) = w; }
        }
#pragma unroll
        for (int nt = 0; nt < 4; ++nt) {
            const bf16x8 fg = fr16(CP_GT, 16 * nt + q);
            const float gc = *(const float*)(W + CP_G + (16 * nt + q) * 4);
#pragma unroll
            for (int mt = 0; mt < 4; ++mt) {
                f32x4 d = mfma16(fr16(CP_TRU, 16 * mt + q), fg, zero4);
#pragma unroll
                for (int r = 0; r < 4; ++r) d[r] = gc * (d[r] + ((16 * mt + 4 * g + r == 16 * nt + q) ? 1.0f : 0.f));
                u32x2 w; w.x = cvt_pk_bf16(d[0], d[1]); w.y = cvt_pk_bf16(d[2], d[3]);
                *(u32x2*)(Mg + (((nt * 2 + (mt >> 1)) * 64 + lane) * 8 + (mt & 1) * 4)) = w;
            }
        }
#pragma unroll
        for (int mt = 0; mt < 4; ++mt) {
            const bf16x8 fw = fr16(CP_WT, 16 * mt + q);
            const f32x4 gc = *(const f32x4*)(W + CP_G + (16 * mt + 4 * g) * 4);
#pragma unroll
            for (int vs = 0; vs < 4; ++vs) {
                const f32x4 d = mfma16(fw, fr16(CP_TRV, 16 * vs + q), zero4) * gc;
                { u32x2 w; w.x = cvt_pk_bf16(d[0], d[1]); w.y = cvt_pk_bf16(d[2], d[3]); *(u32x2*)(Ng + ((vs * 4 + mt) * 64 + lane) * 4) = w; }
            }
        }
    }
    asm volatile("" ::: "memory");
}

DI void sq_wave(const Params& p, int chain, int vs, int lane) {
    const int b = chain >> 4, h = (chain >> 1) & 7, dir = chain & 1;
    const int q = lane & 15, g = lane >> 4;
    auto step_row = [&](int i) -> int {
        if (i < TCB) return TL + b * TCB + (dir == 0 ? i : TCB - 1 - i);
        const int jj = i - TCB;
        return b * TLB + (dir == 0 ? jj : TLB - 1 - jj);
    };
    float* YCd = p.YS + ((size_t)chain * CK_NCH * 4 + vs) * 256 + lane * 4;
    f32x4 st[4];
#pragma unroll
    for (int mt = 0; mt < 4; ++mt) st[mt] = (f32x4){0.f, 0.f, 0.f, 0.f};
    struct Ops { u32x4 m[4][2]; u32x4 r[2]; u32x2 n[4]; u32x2 p3; };
    auto load = [&](Ops& o, int c) {
        const size_t unit = (size_t)chain * CK_NCH + c;
        const bf16_t* Mg = p.CM + unit * 4096; const bf16_t* RHg = p.CRH + unit * 1024;
        const bf16_t* Ng = p.CN + unit * 4096 + (size_t)vs * 1024; const bf16_t* P3g = p.CP3 + unit * 1024 + vs * 256;
#pragma unroll
        for (int mt = 0; mt < 4; ++mt)
#pragma unroll
            for (int s = 0; s < 2; ++s) o.m[mt][s] = *(const u32x4*)(Mg + ((mt * 2 + s) * 64 + lane) * 8);
#pragma unroll
        for (int s = 0; s < 2; ++s) o.r[s] = *(const u32x4*)(RHg + (s * 64 + lane) * 8);
#pragma unroll
        for (int mt = 0; mt < 4; ++mt) o.n[mt] = *(const u32x2*)(Ng + (mt * 64 + lane) * 4);
        o.p3 = *(const u32x2*)(P3g + lane * 4);
    };
    auto stepc = [&](const Ops& o, int c) {
        const bf16x8 sb0 = pack8(st[0], st[1]), sb1 = pack8(st[2], st[3]);
        f32x4 y = mfma16(__builtin_bit_cast(bf16x8, o.r[0]), sb0, (f32x4){bflo(o.p3.x), bfhi(o.p3.x), bflo(o.p3.y), bfhi(o.p3.y)});
        y = mfma16(__builtin_bit_cast(bf16x8, o.r[1]), sb1, y);
#pragma unroll
        for (int mt = 0; mt < 4; ++mt) {
            f32x4 a = mfma16(__builtin_bit_cast(bf16x8, o.m[mt][0]), sb0, (f32x4){bflo(o.n[mt].x), bfhi(o.n[mt].x), bflo(o.n[mt].y), bfhi(o.n[mt].y)});
            st[mt] = mfma16(__builtin_bit_cast(bf16x8, o.m[mt][1]), sb1, a);
        }
        *(f32x4*)(YCd + ((size_t)c * 4) * 256) = y;
    };
    Ops oa, ob, oc;
    load(oa, 0); load(ob, 1); load(oc, 2);
    for (int c = 0; c < CK_NCH; c += 3) {
        stepc(oa, c);     __builtin_amdgcn_sched_barrier(0); load(oa, (c + 3 < CK_NCH) ? c + 3 : CK_NCH - 1); __builtin_amdgcn_sched_barrier(0);
        stepc(ob, c + 1); __builtin_amdgcn_sched_barrier(0); load(ob, (c + 4 < CK_NCH) ? c + 4 : CK_NCH - 1); __builtin_amdgcn_sched_barrier(0);
        stepc(oc, c + 2); __builtin_amdgcn_sched_barrier(0); load(oc, (c + 5 < CK_NCH) ? c + 5 : CK_NCH - 1); __builtin_amdgcn_sched_barrier(0);
    }
}

DI void na_block_unit(const Params& p, char* lds, int U) {
    const int tid = opaque_tid(), lane = tid & 63, wv = tid >> 6, q = lane & 15, g = lane >> 4;
    const bool lat = U < 1024;
    int b, r, hp, qb;
    if (lat) { hp = U & 3; r = (U >> 2) & 127; b = U >> 9; qb = 0; } else { const int V = U - 1024; qb = V & 3; hp = (V >> 2) & 3; b = V >> 4; r = 0; }
    const int hh = wv >> 2, w = wv & 3, h = 2 * hp + hh;
    const int j = 16 * w + q;
    const int qtok = lat ? (b * TLB + r * 64 + j) : (TL + b * TCB + 64 * qb + j);
    const int row_start = lat ? (r - 4 < 0 ? 0 : (r - 4 > 120 ? 120 : r - 4)) : 0;
    const int c0 = (w == 0 ? 0 : (w == 1 ? 8 : (w == 2 ? 24 : 32)));
    int cs = j - 8; cs = cs < 0 ? 0 : (cs > 48 ? 48 : cs);
    const int nch = lat ? 12 : 4, first_ctx = lat ? 8 : 0;
    bf16x8 qf[2];
#pragma unroll
    for (int ks = 0; ks < 2; ++ks) qf[ks] = *(const bf16x8*)(p.Q0 + (size_t)qtok * 512 + h * 64 + 32 * ks + 8 * g);
    u32x4 rk[2], rv[2];
    auto issue = [&](int ci) {
        const bool isctx = ci >= first_ctx;
        const int cc = ci - first_ctx;
#pragma unroll
        for (int i = 0; i < 2; ++i) {
            const int pc = tid + NTHR * i;
            const int key = pc >> 4, c16 = pc & 15;
            const int tok = isctx ? (TL + b * TCB + cc * 64 + key) : (b * TLB + (row_start + ci) * 64 + key);
            rk[i] = *(const u32x4*)(p.K0 + (size_t)tok * 512 + hp * 128 + c16 * 8);
            const int row = pc >> 3, k8 = pc & 7;
            const bf16_t* vsrc = isctx ? (p.VT0C + ((size_t)(b * 512 + hp * 128 + row)) * TCB + cc * 64 + k8 * 8)
                                       : (p.VT0L + ((size_t)(b * 512 + hp * 128 + row)) * TLB + (row_start + ci) * 64 + k8 * 8);
            rv[i] = *(const u32x4*)vsrc;
        }
    };
    auto stash = [&](char* st) {
#pragma unroll
        for (int i = 0; i < 2; ++i) {
            const int pc = tid + NTHR * i;
            const int key = pc >> 4, c16 = pc & 15;
            *(u32x4*)(st + (c16 >> 3) * 8192 + lds_byte(key, (c16 & 7) * 8)) = rk[i];
            const int row = pc >> 3, k8 = pc & 7;
            *(u32x4*)(st + 16384 + (row >> 6) * 8192 + lds_byte(row & 63, k8 * 8)) = rv[i];
        }
    };
    float m = -3.0e38f, sum = 0.f;
    f32x4 o[4];
#pragma unroll
    for (int dm = 0; dm < 4; ++dm) o[dm] = (f32x4){0.f, 0.f, 0.f, 0.f};
    auto qk = [&](const char* kimg, int kc0, f32x4 (&s)[2]) {
#pragma unroll
        for (int hf = 0; hf < 2; ++hf) {
            const int key = kc0 + 8 * (q >> 2) + 4 * hf + (q & 3);
            f32x4 a = (f32x4){0.f, 0.f, 0.f, 0.f};
#pragma unroll
            for (int ks = 0; ks < 2; ++ks) a = mfma16(*(const bf16x8*)(kimg + lds_byte(key, 32 * ks + 8 * g)), qf[ks], a);
            s[hf] = a;
        }
    };
    auto pv = [&](const char* vimg, int kc0, const f32x4 (&s)[2]) {
        const bf16x8 pb = pack8(s[0], s[1]);
#pragma unroll
        for (int dm = 0; dm < 4; ++dm) o[dm] = mfma16(*(const bf16x8*)(vimg + lds_byte(16 * dm + q, kc0 + 8 * g)), pb, o[dm]);
    };
    issue(0);
    stash(lds);
    __syncthreads();
    for (int ci = 0; ci < nch; ++ci) {
        const bool more = ci + 1 < nch;
        if (more) issue(ci + 1);
        const char* st = lds + (ci & 1) * 32768;
        const char* kimg = st + hh * 8192;
        const char* vimg = st + 16384 + hh * 8192;
        if (ci < first_ctx) {
            f32x4 s[2];
            qk(kimg, c0, s);
            const int row_off = row_start + ci - r + 7;
            float cmax = -3.0e38f;
#pragma unroll
            for (int hf = 0; hf < 2; ++hf)
#pragma unroll
                for (int rr = 0; rr < 4; ++rr) {
                    const int cc_ = c0 + 8 * g + 4 * hf + rr;
                    int co = cc_ - j; co = co < -15 ? -15 : (co > 15 ? 15 : co);
                    const bool in = (cc_ >= cs) && (cc_ < cs + 16);
                    const float bias = p.na_rpb[(h * 15 + row_off) * 31 + co + 15];
                    const float sv = in ? (s[hf][rr] * 0.125f + bias) : -1.0e30f;
                    s[hf][rr] = sv; cmax = fmaxf(cmax, sv);
                }
            cmax = fmaxf(cmax, __shfl_xor(cmax, 16)); cmax = fmaxf(cmax, __shfl_xor(cmax, 32));
            const float mn = fmaxf(m, cmax), al = __expf(m - mn);
            m = mn; sum *= al;
#pragma unroll
            for (int dm = 0; dm < 4; ++dm) o[dm] = o[dm] * al;
#pragma unroll
            for (int hf = 0; hf < 2; ++hf)
#pragma unroll
                for (int rr = 0; rr < 4; ++rr) { s[hf][rr] = __expf(s[hf][rr] - mn); sum += s[hf][rr]; }
            pv(vimg, c0, s);
        } else {
            f32x4 s0[2], s1[2];
            qk(kimg, 0, s0); qk(kimg, 32, s1);
            float cmax = -3.0e38f;
#pragma unroll
            for (int hf = 0; hf < 2; ++hf)
#pragma unroll
                for (int rr = 0; rr < 4; ++rr) { s0[hf][rr] *= 0.125f; s1[hf][rr] *= 0.125f; cmax = fmaxf(cmax, fmaxf(s0[hf][rr], s1[hf][rr])); }
            cmax = fmaxf(cmax, __shfl_xor(cmax, 16)); cmax = fmaxf(cmax, __shfl_xor(cmax, 32));
            const float mn = fmaxf(m, cmax), al = __expf(m - mn);
            m = mn; sum *= al;
#pragma unroll
            for (int dm = 0; dm < 4; ++dm) o[dm] = o[dm] * al;
#pragma unroll
            for (int hf = 0; hf < 2; ++hf)
#pragma unroll
                for (int rr = 0; rr < 4; ++rr) { s0[hf][rr] = __expf(s0[hf][rr] - mn); s1[hf][rr] = __expf(s1[hf][rr] - mn); sum += s0[hf][rr] + s1[hf][rr]; }
            pv(vimg, 0, s0); pv(vimg, 32, s1);
        }
        if (more) stash(lds + ((ci + 1) & 1) * 32768);
        __syncthreads();
    }
    sum += __shfl_xor(sum, 16); sum += __shfl_xor(sum, 32);
    const float inv = 1.0f / sum;
#pragma unroll
    for (int dm = 0; dm < 4; ++dm) {
        u32x2 wv_; wv_.x = cvt_pk_bf16(o[dm][0] * inv, o[dm][1] * inv); wv_.y = cvt_pk_bf16(o[dm][2] * inv, o[dm][3] * inv);
        *(u32x2*)(p.MIX + (size_t)qtok * 1024 + h * 64 + 16 * dm + 4 * g) = wv_;
    }
}

template <int PARTS = 3>
DI void ph_attn_cp(const Params& p, char* lds) {
    const int tz_ = opaque_tid(), lane = tz_ & 63, wv = tz_ >> 6;
    char* W = lds + wv * CPW;
    const int gw = blockIdx.x * 8 + wv, nw = (int)gridDim.x * 8;
    constexpr int NCP = 32 * CK_NCH;
    if (PARTS & 1) for (int U = gw; U < NCP; U += nw) cp_unit(p, W, U, lane);
    if (PARTS & 2) {
        __syncthreads();
        for (int U = blockIdx.x; U < 1024 + 32; U += gridDim.x) na_block_unit(p, lds, U);
    }
}
DI void ph_sq(const Params& p, char* lds) {
    const int tz_ = opaque_tid(), lane = tz_ & 63, wv = tz_ >> 6;
    const int nsq = gridDim.x >= 256 ? 128 : 0;
    if ((int)blockIdx.x < nsq) { if (wv == 0) sq_wave(p, blockIdx.x >> 2, blockIdx.x & 3, lane); return; }
    if (nsq == 0) { if (wv == 0) for (int u = blockIdx.x; u < 128; u += gridDim.x) sq_wave(p, u >> 2, u & 3, lane); __syncthreads(); }
    for (int U = (int)blockIdx.x - nsq; U < 1024 + 32; U += (int)gridDim.x - nsq) na_block_unit(p, lds, U);
}

DI void ph_rw_readout(const Params& p) {
    const int c = opaque_tid(), hh = c >> 6;
    const float gg = p.rw_gn_g[c], gb = p.rw_gn_b[c];
    for (int row = blockIdx.x; row < TT; row += gridDim.x) {
        const size_t o = (size_t)row * 512 + c;
        float y;
        {
            const bool lat = row < TL;
            const int bb = lat ? (row >> 13) : ((row - TL) >> 8), t = lat ? (row & (TLB - 1)) : ((row - TL) & (TCB - 1));
            const int pf = lat ? TCB + t : t, pb = lat ? TCB + (TLB - 1 - t) : (TCB - 1 - t);
            const int vs = (c >> 4) & 3, q = c & 15;
            const size_t cf = (size_t)((bb * 8 + hh) * 2 + 0) * CK_NCH + (pf >> 4), cb = (size_t)((bb * 8 + hh) * 2 + 1) * CK_NCH + (pb >> 4);
            y = p.YS[(cf * 4 + vs) * 256 + (16 * ((pf & 15) >> 2) + q) * 4 + (pf & 3)] + p.YS[(cb * 4 + vs) * 256 + (16 * ((pb & 15) >> 2) + q) * 4 + (pb & 3)];
        }
        const float mu = wave_allsum(y) * (1.0f / 64.0f);
        const float d = y - mu;
        const float var = wave_allsum(d * d) * (1.0f / 64.0f);
        const float yn = d * rsqrtf(var + 64e-5f) * gg + gb;
        const float outv = (yn + p.BONUS[row * 8 + hh] * bfhi(p.SNV[o])) * bfhi(p.SRG[o]);
        p.MIX[(size_t)row * 1024 + 512 + c] = (bf16_t)(cvt_pk_bf16(outv, 0.f) & 0xffff);
    }
}

DI void gemm_f32out(char* lds, const bf16_t* A, int M, const float* W, int N, float* C) {
    const int tid = opaque_tid();
    const int ntn = N / 128, ntm = M / 256;
    gemm_stream<4, 2, 4, 4, PtrLoaderF, 4>(lds, ntn * ntm, 16, [&](int u, PtrLoader<4>& al, PtrLoaderF& bl, const int (&nx)[4]) {
        int tm, tn; tile_of(u, ntm, ntn, tm, tn);
#pragma unroll
        for (int i = 0; i < 4; ++i) al.p[i] = (unsigned)((tm * 256 + a_row(tid) + 64 * i) * 1024 + a_c8(tid) * 8);
        al.base = A;
        fill_bf(bl, W, N, tn * 128, N);
    }, [&](int u, int (&nx)[4], int) {}, [&](int u, int mi, const f32x4 (&a)[4], f32x4 (&o)[4], int r0, int c0) {
#pragma unroll
        for (int ni = 0; ni < 4; ++ni) o[ni] = a[ni];
    }, [&](int u, int r, int c, f32x4 v, f32x4 pv) {
        int tm, tn; tile_of(u, ntm, ntn, tm, tn);
        *(f32x4*)(C + (size_t)(tm * 256 + r) * N + tn * 128 + c) = v;
    });
}

DI void ln_row(f32x4 (&v)[4], const float* g, const float* bta, int lane) {
    float s = 0.f;
#pragma unroll
    for (int i = 0; i < 4; ++i) s += (v[i][0] + v[i][1]) + (v[i][2] + v[i][3]);
    const float mu = wave_allsum(s) * (1.0f / 1024.0f);
    float q = 0.f;
#pragma unroll
    for (int i = 0; i < 4; ++i) { v[i] = v[i] - mu; q += (v[i][0] * v[i][0] + v[i][1] * v[i][1]) + (v[i][2] * v[i][2] + v[i][3] * v[i][3]); }
    const float rstd = rsqrtf(wave_allsum(q) * (1.0f / 1024.0f) + 1e-5f);
#pragma unroll
    for (int i = 0; i < 4; ++i) {
        const int c = 4 * lane + 256 * i;
        v[i] = v[i] * rstd * (*(const f32x4*)(g + c)) + (*(const f32x4*)(bta + c));
    }
}

template <int L>
DI void ph_ln1(const Params& p) {
    const int tz_ = opaque_tid(), lane = tz_ & 63, wv = tz_ >> 6;
    const int nrows = (L == 0) ? TT : TL;
    for (int row = blockIdx.x * 8 + wv; row < nrows; row += gridDim.x * 8) {
        const float* hin = (L == 0) ? (row < TL ? p.x + (size_t)row * 1024 : p.ctx + (size_t)(row - TL) * 1024) : p.HB + (size_t)row * 1024;
        const float* m = p.mods + (size_t)(L * 3 + mods_row(row)) * 6144;
        f32x4 v[4];
#pragma unroll
        for (int i = 0; i < 4; ++i) {
            const int c = 4 * lane + 256 * i;
            v[i] = ALPHA * (*(const f32x4*)(hin + c)) + (*(const f32x4*)(m + 2048 + c)) * (*(const f32x4*)(p.YL + (size_t)row * 1024 + c));
        }
        ln_row(v, p.ln_g + (L * 2 + 0) * 1024, p.ln_b + (L * 2 + 0) * 1024, lane);
#pragma unroll
        for (int i = 0; i < 4; ++i) {
            const int c = 4 * lane + 256 * i;
            *(f32x4*)(p.HA + (size_t)row * 1024 + c) = v[i];
            const f32x4 f = v[i] * (1.0f + *(const f32x4*)(m + 4096 + c)) + *(const f32x4*)(m + 3072 + c);
            u32x2 w; w.x = cvt_pk_bf16(f[0], f[1]); w.y = cvt_pk_bf16(f[2], f[3]);
            *(u32x2*)(p.Abuf + (size_t)row * 1024 + c) = w;
        }
    }
}

template <int CTRL, int RM> DI float dpp_keep(float x) {
    return __builtin_bit_cast(float, __builtin_amdgcn_update_dpp(__builtin_bit_cast(int, x), __builtin_bit_cast(int, x), CTRL, RM, 0xF, false));
}
DI float wave_max_uniform(float x) {
    x = fmaxf(x, dpp_keep<0xB1, 0xF>(x)); x = fmaxf(x, dpp_keep<0x4E, 0xF>(x));
    x = fmaxf(x, dpp_keep<0x141, 0xF>(x)); x = fmaxf(x, dpp_keep<0x140, 0xF>(x));
    x = fmaxf(x, dpp_keep<0x142, 0xA>(x)); x = fmaxf(x, dpp_keep<0x143, 0xC>(x));
    return __builtin_bit_cast(float, __builtin_amdgcn_readlane(__builtin_bit_cast(int, x), 63));
}
template <int L>
DI void ph_route(const Params& p, char* ldsc) {
    const int tz_ = opaque_tid(), lane = tz_ & 63, wv = tz_ >> 6;
    const int nrows = (L == 0) ? TT : TL;
    int* hist = (int*)ldsc;
    if (tz_ < 256) hist[tz_] = 0;
    __syncthreads();
    const f32x4 bias = *(const f32x4*)(p.moe_bias + L * 256 + 4 * lane);
    for (int row = blockIdx.x * 8 + wv; row < nrows; row += gridDim.x * 8) {
        const f32x4 lg = *(const f32x4*)(p.LOGITS + (size_t)row * 256 + 4 * lane);
        const float s0 = sigmoidf_(lg[0]), s1 = sigmoidf_(lg[1]), s2 = sigmoidf_(lg[2]), s3 = sigmoidf_(lg[3]);
        float v0 = s0 + bias[0], v1 = s1 + bias[1], v2 = s2 + bias[2], v3 = s3 + bias[3];
        float m1 = fmaxf(v0, v1), m2 = fminf(v0, v1);
        { const float a = fmaxf(v2, v3), bq = fminf(v2, v3); const float n1 = fmaxf(m1, a); const float n2 = fmaxf(fminf(m1, a), fmaxf(m2, bq)); m1 = n1; m2 = n2; }
        { const float o1 = dpp_keep<0xB1, 0xF>(m1), o2 = dpp_keep<0xB1, 0xF>(m2); const float n1 = fmaxf(m1, o1), n2 = fmaxf(fminf(m1, o1), fmaxf(m2, o2)); m1 = n1; m2 = n2; }
        { const float o1 = dpp_keep<0x4E, 0xF>(m1), o2 = dpp_keep<0x4E, 0xF>(m2); const float n1 = fmaxf(m1, o1), n2 = fmaxf(fminf(m1, o1), fmaxf(m2, o2)); m1 = n1; m2 = n2; }
        { const float o1 = dpp_keep<0x141, 0xF>(m1), o2 = dpp_keep<0x141, 0xF>(m2); const float n1 = fmaxf(m1, o1), n2 = fmaxf(fminf(m1, o1), fmaxf(m2, o2)); m1 = n1; m2 = n2; }
        const float gs = m1 + m2;
        const int myg = lane >> 3;
        int rank = 0;
#pragma unroll
        for (int gg = 0; gg < 8; ++gg) {
            const float og = __builtin_bit_cast(float, __builtin_amdgcn_readlane(__builtin_bit_cast(int, gs), gg * 8));
            rank += ((og > gs) || (og == gs && gg < myg)) ? 1 : 0;
        }
        if (rank >= 4) { v0 = -1.0e30f; v1 = -1.0e30f; v2 = -1.0e30f; v3 = -1.0e30f; }
        int sel_e = 0; float sel_s = 0.f, ssum = 0.f;
#pragma unroll
        for (int rd = 0; rd < 8; ++rd) {
            float bv = v0; int bi = 0; float bs = s0;
            if (v1 > bv) { bv = v1; bi = 1; bs = s1; }
            if (v2 > bv) { bv = v2; bi = 2; bs = s2; }
            if (v3 > bv) { bv = v3; bi = 3; bs = s3; }
            const float mx = wave_max_uniform(bv);
            const unsigned long long bal = __ballot(bv == mx);
            const int ol = __builtin_amdgcn_readfirstlane((int)__builtin_ctzll(bal));
            const int oi = __builtin_amdgcn_readlane(bi, ol);
            const float sv = __builtin_bit_cast(float, __builtin_amdgcn_readlane(__builtin_bit_cast(int, bs), ol));
            if (lane == ol) { if (oi == 0) v0 = -3.0e30f; else if (oi == 1) v1 = -3.0e30f; else if (oi == 2) v2 = -3.0e30f; else v3 = -3.0e30f; }
            ssum += sv;
            if (lane == rd) { sel_e = 4 * ol + oi; sel_s = sv; }
        }
        if (lane < 8) {
            p.EIDX[(size_t)row * 8 + lane] = sel_e;
            p.EW[(size_t)row * 8 + lane] = sel_s / ssum * 2.5f;
            atomicAdd(&hist[sel_e], 1);
        }
    }
    __syncthreads();
    if (tz_ < 256) p.HIST[((size_t)L * 256 + blockIdx.x) * 256 + tz_] = hist[tz_];
    __syncthreads();
}

template <int L>
DI void ph_scatter(const Params& p, char* ldsc) {
    int* sbase = (int*)ldsc;
    int* cursor = sbase + 320;
    const int tid = opaque_tid(), lane = tid & 63, wv = tid >> 6;
    const int nrows = (L == 0) ? TT : TL;
    int mypre = 0;
    if (tid < 256) {
        const int* hcol = p.HIST + (size_t)L * 256 * 256 + tid;
        int tot = 0;
#pragma unroll 16
        for (int bq = 0; bq < (int)gridDim.x; ++bq) { const int hv = hcol[bq * 256]; tot += hv; mypre += (bq < (int)blockIdx.x) ? hv : 0; }
        sbase[tid] = (tot + 255) & ~255;
    }
    __syncthreads();
    if (tid == 0) { int run = 0; for (int e = 0; e < 256; ++e) { const int pd = sbase[e]; sbase[e] = run; run += pd; } sbase[256] = run; }
    __syncthreads();
    if (tid < 256) cursor[tid] = sbase[tid] + mypre;
    if (blockIdx.x == 0) {
        int* te = p.TILE_E + L * MAXTILES; int* tr = p.TILE_R0 + L * MAXTILES;
        if (tid < 256) { const int b0 = sbase[tid], b1 = sbase[tid + 1]; for (int r = b0; r < b1; r += 256) { te[r >> 8] = tid; tr[r >> 8] = r; } }
        const int nt = sbase[256] >> 8, nsh = nrows / 256;
        for (int i = tid; i < nsh; i += NTHR) { te[nt + i] = 256; tr[nt + i] = SH_BASE + 256 * i; }
        if (tid == 0) p.ictl[1024 + L] = nt + nsh;
    }
    __syncthreads();
    int* stok = p.SLOT_TOK + (size_t)L * NSLOT; float* sw = p.SLOT_W + (size_t)L * NSLOT;
    for (int row = blockIdx.x * 8 + wv; row < nrows; row += gridDim.x * 8) {
        if (lane < 8) {
            const int a = row * 8 + lane;
            const int e = p.EIDX[a];
            const int pos = atomicAdd(&cursor[e], 1);
            stok[pos] = row; sw[pos] = p.EW[a]; p.APOS[a] = pos;
        }
    }
    __syncthreads();
}

template <int L>
DI void ph_moe1(const Params& p, char* lds) {
    const int tid = opaque_tid();
    const int ntiles = p.ictl[1024 + L];
    const int* te = p.TILE_E + L * MAXTILES; const int* tr = p.TILE_R0 + L * MAXTILES;
    const int* stok = p.SLOT_TOK + (size_t)L * NSLOT;
    gemm_stream<4, 2, 4, 4, PtrLoaderF, 2>(lds, ntiles * 4, 16, [&](int u, PtrLoader<4>& al, PtrLoaderF& bl, const int (&nx)[4]) {
        const int ti = u >> 2, tn = u & 3;
        const int e = te[ti];
#pragma unroll
        for (int i = 0; i < 4; ++i) al.p[i] = (unsigned)(nx[i] * 1024 + a_c8(tid) * 8);
        al.base = p.Abuf;
        const float* gsrc = e < 256 ? p.moe_w_gate + ((size_t)(L * 256 + e)) * 1024 * 256 : p.sh_w_gate + (size_t)L * 1024 * 256;
        const float* usrc = e < 256 ? p.moe_w_up + ((size_t)(L * 256 + e)) * 1024 * 256 : p.sh_w_up + (size_t)L * 1024 * 256;
        bl.ld = 256; bl.base0 = gsrc; bl.base1 = usrc;
#pragma unroll
        for (int i = 0; i < 4; ++i) bl.p[i] = (unsigned)((tid >> 3) * 256 + 32 * (2 * tn + (i >> 1)) + (tid & 7) * 4);
    }, [&](int u, int (&nx)[4], int half) {
        const int row0 = tr[u >> 2];
#pragma unroll
        for (int i = 0; i < 4; ++i) if (half == 2 || (i >> 1) == half) nx[i] = stok[row0 + a_row(tid) + 64 * i];
    }, [&](int u, int mi, const f32x4 (&a)[4], f32x4 (&o)[2], int r0, int c0) {
#pragma unroll
        for (int ni = 0; ni < 2; ++ni)
#pragma unroll
            for (int j = 0; j < 4; ++j) o[ni][j] = siluf_(a[ni][j]) * a[ni + 2][j];
    }, [&](int u, int r, int c, f32x4 v, f32x4 pv) {
        const int ti = u >> 2, tn = u & 3;
        u32x2 w; w.x = cvt_pk_bf16(v[0], v[1]); w.y = cvt_pk_bf16(v[2], v[3]);
        *(u32x2*)(p.HBUF + (size_t)(tr[ti] + r) * 256 + tn * 64 + c) = w;
    });
}
template <int L>
DI void ph_moe2(const Params& p, char* lds) {
    const int tid = opaque_tid();
    const int ntiles = p.ictl[1024 + L];
    const int* te = p.TILE_E + L * MAXTILES; const int* tr = p.TILE_R0 + L * MAXTILES;
    const float* sw = p.SLOT_W + (size_t)L * NSLOT;
    float sc4[4] = {0.f, 0.f, 0.f, 0.f};
    gemm_stream<4, 2, 4, 4, PtrLoaderF, 4>(lds, ntiles * 8, 4, [&](int u, PtrLoader<4>& al, PtrLoaderF& bl, const int (&nx)[4]) {
        const int ti = u >> 3, tn = u & 7;
        const int e = te[ti], row0 = tr[ti];
#pragma unroll
        for (int i = 0; i < 4; ++i) al.p[i] = (unsigned)((row0 + a_row(tid) + 64 * i) * 256 + a_c8(tid) * 8);
        al.base = p.HBUF;
        const float* dsrc = e < 256 ? p.moe_w_down + ((size_t)(L * 256 + e)) * 256 * 1024 : p.sh_w_down + (size_t)L * 256 * 1024;
        fill_bf(bl, dsrc, 1024, tn * 128, 1024);
    }, [&](int u, int (&nx)[4], int) {}, [&](int u, int mi, const f32x4 (&a)[4], f32x4 (&o)[4], int r0, int c0) {
        if (mi == 0) {
            const float* s_ = sw + tr[u >> 3] + r0;
#pragma unroll
            for (int m = 0; m < 4; ++m) sc4[m] = s_[16 * m];
        }
#pragma unroll
        for (int ni = 0; ni < 4; ++ni) o[ni] = a[ni] * sc4[mi];
    }, [&](int u, int r, int c, f32x4 v, f32x4 pv) {
        const int ti = u >> 3, tn = u & 7;
        const int row = tr[ti] + r;
        u32x2 w; w.x = cvt_pk_bf16(v[0], v[1]); w.y = cvt_pk_bf16(v[2], v[3]);
        *(u32x2*)(p.YB + (size_t)row * 1024 + tn * 128 + c) = w;
    });
}

template <int L>
DI void ph_combine(const Params& p) {
    const int tz_ = opaque_tid(), lane = tz_ & 63, wv = tz_ >> 6;
    const int nrows = (L == 0) ? TT : TL;
    for (int row = blockIdx.x * 8 + wv; row < nrows; row += gridDim.x * 8) {
        int rr[9];
#pragma unroll
        for (int k = 0; k < 8; ++k) rr[k] = p.APOS[(size_t)row * 8 + k];
        rr[8] = SH_BASE + row;
        const float* m = p.mods + (size_t)(L * 3 + mods_row(row)) * 6144;
        f32x4 v[4];
#pragma unroll
        for (int i = 0; i < 4; ++i) {
            const int c = 4 * lane + 256 * i;
            f32x4 ff = (f32x4){0.f, 0.f, 0.f, 0.f};
#pragma unroll
            for (int k = 0; k < 9; ++k) {
                const u32x2 w = *(const u32x2*)(p.YB + (size_t)rr[k] * 1024 + c);
                ff[0] += bflo(w.x); ff[1] += bfhi(w.x); ff[2] += bflo(w.y); ff[3] += bfhi(w.y);
            }
            v[i] = ALPHA * (*(const f32x4*)(p.HA + (size_t)row * 1024 + c)) + (*(const f32x4*)(m + 5120 + c)) * ff;
        }
        ln_row(v, p.ln_g + (L * 2 + 1) * 1024, p.ln_b + (L * 2 + 1) * 1024, lane);
        if (L == 0) {
            const float* m1 = p.mods + (size_t)(1 * 3 + mods_row(row)) * 6144;
#pragma unroll
            for (int i = 0; i < 4; ++i) {
                const int c = 4 * lane + 256 * i;
                *(f32x4*)(p.HB + (size_t)row * 1024 + c) = v[i];
                const f32x4 a = v[i] * (1.0f + *(const f32x4*)(m1 + 1024 + c)) + *(const f32x4*)(m1 + c);
                u32x2 w; w.x = cvt_pk_bf16(a[0], a[1]); w.y = cvt_pk_bf16(a[2], a[3]);
                *(u32x2*)(p.Abuf + (size_t)row * 1024 + c) = w;
            }
        } else {
#pragma unroll
            for (int i = 0; i < 4; ++i) *(f32x4*)(p.out + (size_t)row * 1024 + 4 * lane + 256 * i) = v[i];
        }
    }
}

DI void gemm_router(char* lds, const bf16_t* A, int M, const float* W, float* C) {
    const int tid = opaque_tid();
    const int ntn = 2, ntm = M / 128;
    gemm_stream<2, 4, 4, 2, PtrLoaderF, 2>(lds, ntn * ntm, 16, [&](int u, PtrLoader<2>& al, PtrLoaderF& bl, const int (&nx)[4]) {
        int tm, tn; tile_of(u, ntm, ntn, tm, tn);
#pragma unroll
        for (int i = 0; i < 2; ++i) al.p[i] = (unsigned)((tm * 128 + a_row(tid) + 64 * i) * 1024 + a_c8(tid) * 8);
        al.base = A;
        fill_bf(bl, W, 256, tn * 128, 256);
    }, [&](int u, int (&nx)[4], int) {}, [&](int u, int mi, const f32x4 (&a)[2], f32x4 (&o)[2], int r0, int c0) {
#pragma unroll
        for (int ni = 0; ni < 2; ++ni) o[ni] = a[ni];
    }, [&](int u, int r, int c, f32x4 v, f32x4 pv) {
        int tm, tn; tile_of(u, ntm, ntn, tm, tn);
        *(f32x4*)(C + (size_t)(tm * 128 + r) * 256 + tn * 128 + c) = v;
    });
}

DI void ph_inproj1(const Params& p, char* lds) {
    const int tid = opaque_tid();
    constexpr int NTN = 25, NTM = 66;
    gemm_stream<4, 2, 4, 4, PtrLoaderF, 4>(lds, NTN * NTM, 16, [&](int u, PtrLoader<4>& al, PtrLoaderF& bl, const int (&nx)[4]) {
        int tm, tn; tile_of(u, NTM, NTN, tm, tn);
#pragma unroll
        for (int i = 0; i < 4; ++i) al.p[i] = (unsigned)((tm * 256 + a_row(tid) + 64 * i) * 1024 + a_c8(tid) * 8);
        al.base = p.Abuf;
        fill_bf(bl, p.od_w_in, ODC, tn * 128, ODC);
    }, [&](int u, int (&nx)[4], int) {}, [&](int u, int mi, const f32x4 (&a)[4], f32x4 (&o)[4], int r0, int c0) {
#pragma unroll
        for (int ni = 0; ni < 4; ++ni) o[ni] = a[ni];
    }, [&](int u, int r, int c, f32x4 v, f32x4 pv) {
        int tm, tn; tile_of(u, NTM, NTN, tm, tn);
        const int row = tm * 256 + r, col = tn * 128 + c;
        if (tn < 8 && row < TL) {
            const int t = row & (TLB - 1);
            const float pos = (c & 32) ? (float)(t & 63) : (float)(t >> 6);
            const float sgn = (c & 16) ? 1.0f : -1.0f;
#pragma unroll
            for (int j = 0; j < 4; ++j) {
                const float ang = pos * exp2f(-(float)((c & 15) + j) * (13.287712379549449f / 16.0f));
                v[j] = v[j] * __cosf(ang) + sgn * pv[j] * __sinf(ang);
            }
            if (tn < 4) v = v * 0.125f;
        }
        if (tn < 24) {
            u32x2 w; w.x = cvt_pk_bf16(v[0], v[1]); w.y = cvt_pk_bf16(v[2], v[3]);
            *(u32x2*)(p.P1 + (size_t)row * 3072 + col) = w;
        } else if (col < ODC) *(f32x4*)(p.G1 + (size_t)row * 32 + (col - 3072)) = v;
    });
}

DI float wave_incl_sum(float v, int lane) {
#pragma unroll
    for (int d = 1; d < 64; d <<= 1) { const float t = __shfl_up(v, d); if (lane >= d) v += t; }
    return v;
}
DI float wave_incl_max(float v, int lane) {
#pragma unroll
    for (int d = 1; d < 64; d <<= 1) { const float t = __shfl_up(v, d); if (lane >= d) v = fmaxf(v, t); }
    return v;
}
DI void ml_gates(const Params& p, float* G, int row0, int h, float& ig, float& bc, float& tot, int& idx) {
    const int tid = opaque_tid(), lane = tid & 63, wv = tid >> 6;
    const int gi = (tid >> 7) & 1, e = tid & 127;
    idx = gi == 0 ? e : 127 - e;
    float c = 0.f; ig = 0.f;
    if (tid < 256) {
        const float* g = p.G1 + (size_t)(row0 + idx) * 32;
        ig = g[8 * gi + h] + p.ml_gate_b[8 * gi + h];
        const float lf = logsigmoidf_(g[16 + 8 * gi + h] + p.ml_gate_b[16 + 8 * gi + h]);
        c = wave_incl_sum(lf, lane);
        if (lane == 63) G[768 + wv] = c;
    }
    __syncthreads();
    if (tid < 256) {
        if (wv & 1) c += G[768 + wv - 1];
        G[gi * 128 + idx] = ig; G[256 + gi * 128 + idx] = c;
        if (e == 127) G[776 + gi] = c;
    }
    __syncthreads();
    bc = c; tot = G[776 + gi];
}

constexpr int MLC_T = 4096, MLC_TS = 392;
DI void ph_ml_chunks(const Params& p, char* ldsc) {
    float* G = (float*)ldsc;
    const int tid = opaque_tid(), lane = tid & 63, wv = tid >> 6, fr = lane & 15, fq = lane >> 4;
    for (int u = blockIdx.x; u < 1056; u += gridDim.x) {
        const bool lat = u < 1024;
        const int bh = lat ? (u >> 6) : ((u - 1024) >> 1), blk = lat ? (u & 63) : ((u - 1024) & 1);
        const int b = bh >> 3, h = bh & 7;
        const int Tseq = lat ? TLB : TCB;
        const int row0 = (lat ? b * TLB : TL + b * TCB) + blk * 128;
        {
            u32x4 rr[6];
#pragma unroll
            for (int i = 0; i < 6; ++i) {
                const int qd = tid + NTHR * i, row = qd / 24, cc = qd % 24;
                rr[i] = *(const u32x4*)(p.P1 + (size_t)(row0 + row) * 3072 + (cc < 8 ? 512 + h * 64 + cc * 8 : 1024 + h * 128 + (cc - 8) * 8));
            }
#pragma unroll
            for (int i = 0; i < 6; ++i) {
                const int qd = tid + NTHR * i, row = qd / 24, cc = qd % 24;
                char* d = ldsc + MLC_T + row * MLC_TS + cc * 16;
                *(u32x2*)d = (u32x2){rr[i].x, rr[i].y}; *(u32x2*)(d + 8) = (u32x2){rr[i].z, rr[i].w};
            }
        }
        float ig, bc, tot; int idx;
        ml_gates(p, G, row0, h, ig, bc, tot, idx);
        const float gl = tot - bc + ig;
        float mw = (tid < 256) ? wave_allmax(gl) : 0.f;
        if (tid < 256 && lane == 0) G[784 + wv] = mw;
        __syncthreads();
        if (tid < 256) {
            const int gi = tid >> 7;
            const float mc = fmaxf(G[784 + 2 * gi], G[784 + 2 * gi + 1]);
            G[512 + gi * 128 + idx] = __expf(gl - mc);
            if ((tid & 127) == 0) { p.BEMC[u * 4 + gi * 2 + 0] = tot; p.BEMC[u * 4 + gi * 2 + 1] = mc; }
        }
        __syncthreads();
        auto col8 = [&](int col, int l0) -> u32x4 {
            const char* s_ = ldsc + MLC_T + l0 * MLC_TS + col * 2;
            u32x4 w;
            w.x = (unsigned)*(const unsigned short*)(s_) | ((unsigned)*(const unsigned short*)(s_ + MLC_TS) << 16);
            w.y = (unsigned)*(const unsigned short*)(s_ + 2 * MLC_TS) | ((unsigned)*(const unsigned short*)(s_ + 3 * MLC_TS) << 16);
            w.z = (unsigned)*(const unsigned short*)(s_ + 4 * MLC_TS) | ((unsigned)*(const unsigned short*)(s_ + 5 * MLC_TS) << 16);
            w.w = (unsigned)*(const unsigned short*)(s_ + 6 * MLC_TS) | ((unsigned)*(const unsigned short*)(s_ + 7 * MLC_TS) << 16);
            return w;
        };
        f32x4 accf[4], accb[4];
#pragma unroll
        for (int n = 0; n < 4; ++n) { accf[n] = (f32x4){0.f, 0.f, 0.f, 0.f}; accb[n] = accf[n]; }
#pragma unroll
        for (int ks = 0; ks < 4; ++ks) {
            const int l0 = 32 * ks + 8 * fq;
            const bf16x8 va = __builtin_bit_cast(bf16x8, col8(64 + 16 * wv + fr, l0));
            const f32x4 wfa = *(const f32x4*)(G + 512 + l0), wfb = *(const f32x4*)(G + 512 + l0 + 4);
            const f32x4 wba = *(const f32x4*)(G + 640 + l0), wbb = *(const f32x4*)(G + 640 + l0 + 4);
#pragma unroll
            for (int n = 0; n < 4; ++n) {
                const u32x4 kr = col8(16 * n + fr, l0);
                const float k0 = bflo(kr.x), k1 = bfhi(kr.x), k2 = bflo(kr.y), k3 = bfhi(kr.y), k4 = bflo(kr.z), k5 = bfhi(kr.z), k6 = bflo(kr.w), k7 = bfhi(kr.w);
                u32x4 kf, kb;
                kf.x = cvt_pk_bf16(k0 * wfa[0], k1 * wfa[1]); kf.y = cvt_pk_bf16(k2 * wfa[2], k3 * wfa[3]);
                kf.z = cvt_pk_bf16(k4 * wfb[0], k5 * wfb[1]); kf.w = cvt_pk_bf16(k6 * wfb[2], k7 * wfb[3]);
                kb.x = cvt_pk_bf16(k0 * wba[0], k1 * wba[1]); kb.y = cvt_pk_bf16(k2 * wba[2], k3 * wba[3]);
                kb.z = cvt_pk_bf16(k4 * wbb[0], k5 * wbb[1]); kb.w = cvt_pk_bf16(k6 * wbb[2], k7 * wbb[3]);
                accf[n] = mfma16(va, __builtin_bit_cast(bf16x8, kf), accf[n]);
                accb[n] = mfma16(va, __builtin_bit_cast(bf16x8, kb), accb[n]);
            }
        }
        float* kvt = p.KVT + (size_t)u * 2 * 8192;
#pragma unroll
        for (int n = 0; n < 4; ++n)
#pragma unroll
            for (int j = 0; j < 4; ++j) {
                kvt[(16 * wv + 4 * fq + j) * 64 + 16 * n + fr] = accf[n][j];
                kvt[8192 + (16 * wv + 4 * fq + j) * 64 + 16 * n + fr] = accb[n][j];
            }
        if (tid < 128) {
            const int d = tid >> 6, k = tid & 63;
            float s = 0.f;
#pragma unroll 4
            for (int l = 0; l < 128; l += 8) {
                const u32x4 kq = col8(k, l);
                const f32x4 wa = *(const f32x4*)(G + 512 + d * 128 + l), wb = *(const f32x4*)(G + 512 + d * 128 + l + 4);
                s += bflo(kq.x) * wa[0] + bfhi(kq.x) * wa[1] + bflo(kq.y) * wa[2] + bfhi(kq.y) * wa[3]
                   + bflo(kq.z) * wb[0] + bfhi(kq.z) * wb[1] + bflo(kq.w) * wb[2] + bfhi(kq.w) * wb[3];
            }
            p.KS[(size_t)u * 128 + d * 64 + k] = s;
        }
        if (lat) {
            const int v = tid >> 2, part = tid & 3;
            bf16_t* dst = p.V1TL + ((size_t)(b * 1024 + h * 128 + v)) * TLB + blk * 128;
#pragma unroll
            for (int i = 0; i < 4; ++i) {
                const int tg = part + 4 * i;
                *(u32x4*)(dst + 8 * tg) = col8(64 + v, 8 * tg);
            }
        }
        __syncthreads();
    }
}

DI void ph_ml_scan(const Params& p) {
    const int tid = opaque_tid();
    for (int w = blockIdx.x; w < 256; w += gridDim.x) {
        const int chain = w & 31, slice = w >> 5;
        const int bh = chain >> 1, dir = chain & 1;
        const int e0 = slice * 1024 + tid * 2;
        float c0 = 0.f, c1 = 0.f, nn = 0.f, m = 0.f;
        const bool hasn = (slice == 0 && tid < 64);
        auto unit_of = [&](int s) -> int {
            if (s < 2) return 1024 + bh * 2 + (dir == 0 ? s : 1 - s);
            const int jj = s - 2; return bh * 64 + (dir == 0 ? jj : 63 - jj);
        };
        typedef float f32x2 __attribute__((ext_vector_type(2)));
        constexpr int DP = 6;
        f32x2 kvq[DP], bmq[DP]; float ksq[DP];
        const int nl = tid & 63;
#pragma unroll
        for (int j = 0; j < DP; ++j) {
            const int un = unit_of(j);
            kvq[j] = *(const f32x2*)(p.KVT + ((size_t)un * 2 + dir) * 8192 + e0);
            bmq[j] = *(const f32x2*)(p.BEMC + un * 4 + dir * 2);
            ksq[j] = p.KS[(size_t)un * 128 + dir * 64 + nl];
        }
#pragma unroll 1
        for (int s0 = 0; s0 < 66; s0 += DP) {
#pragma unroll
            for (int j = 0; j < DP; ++j) {
                const int s = s0 + j;
                const int u = unit_of(s);
                const f32x2 kv = kvq[j], bm = bmq[j]; const float ksv = ksq[j];
                {
                    const int sn = s + DP < 66 ? s + DP : 65;
                    const int un = unit_of(sn);
                    kvq[j] = *(const f32x2*)(p.KVT + ((size_t)un * 2 + dir) * 8192 + e0);
                    bmq[j] = *(const f32x2*)(p.BEMC + un * 4 + dir * 2);
                    ksq[j] = p.KS[(size_t)un * 128 + dir * 64 + nl];
                }
                {
                    bf16_t* ct = p.C0T + ((size_t)u * 2 + dir) * 8192;
                    *(unsigned*)(ct + e0) = cvt_pk_bf16(c0, c1);
                    if (hasn) p.N0[((size_t)u * 2 + dir) * 64 + tid] = nn;
                    if (slice == 0 && tid == 0) p.M0[u * 2 + dir] = m;
                }
                const float be = bm[0], mc = bm[1];
                const float mn = fmaxf(be + m, mc);
                const float fa = __expf(be + m - mn), fb = __expf(mc - mn);
                c0 = fa * c0 + fb * kv[0]; c1 = fa * c1 + fb * kv[1];
                nn = fa * nn + fb * ksv;
                m = mn;
            }
        }
    }
}

constexpr int MLO_K = 8192, MLO_VT = MLO_K + 16384, MLO_VTS = 272, MLO_C0 = MLO_VT + 128 * MLO_VTS, MLO_HS = 8192;
DI void ph_ml_out(const Params& p, char* ldsc) {
    float* G = (float*)ldsc;
    const int tid = opaque_tid(), lane = tid & 63, wv = tid >> 6, q = lane & 15, g = lane >> 4;
    for (int u = blockIdx.x; u < 1024; u += gridDim.x) {
        const int bh = u >> 6, blk = u & 63, b = bh >> 3, h = bh & 7;
        const int row0 = b * TLB + blk * 128;
        {
            u32x4 rk[2], rv[4], rc[4];
#pragma unroll
            for (int i = 0; i < 2; ++i) { const int pc = tid + i * NTHR; rk[i] = *(const u32x4*)(p.P1 + (size_t)(row0 + (pc >> 3)) * 3072 + 512 + h * 64 + (pc & 7) * 8); }
#pragma unroll
            for (int i = 0; i < 4; ++i) { const int pc = tid + i * NTHR; rv[i] = *(const u32x4*)(p.V1TL + ((size_t)(b * 1024 + h * 128 + (pc >> 4))) * TLB + blk * 128 + (pc & 15) * 8); }
#pragma unroll
            for (int i = 0; i < 4; ++i) { const int pc = tid + i * NTHR; rc[i] = *(const u32x4*)(p.C0T + (size_t)u * 2 * 8192 + (size_t)pc * 8); }
#pragma unroll
            for (int i = 0; i < 2; ++i) { const int pc = tid + i * NTHR; *(u32x4*)(ldsc + MLO_K + lds_byte(pc >> 3, (pc & 7) * 8)) = rk[i]; }
#pragma unroll
            for (int i = 0; i < 4; ++i) { const int pc = tid + i * NTHR; *(u32x4*)(ldsc + MLO_VT + (pc >> 4) * MLO_VTS + (pc & 15) * 16) = rv[i]; }
#pragma unroll
            for (int i = 0; i < 4; ++i) { const int pc = tid + i * NTHR; const int dd = pc >> 10, rr = (pc >> 3) & 127; *(u32x4*)(ldsc + MLO_C0 + dd * 16384 + lds_byte(rr, (pc & 7) * 8)) = rc[i]; }
        }
        float ig, bc, tot; int idx;
        ml_gates(p, G, row0, h, ig, bc, tot, idx);
        const float m0f = p.M0[u * 2 + 0], m0b = p.M0[u * 2 + 1];
        {
            float pm = (tid < 256) ? wave_incl_max(ig - bc, lane) : 0.f;
            if (tid < 256 && lane == 63) G[768 + wv] = pm;
            __syncthreads();
            if (tid < 256) {
                if (wv & 1) pm = fmaxf(pm, G[768 + wv - 1]);
                const int gi = tid >> 7;
                G[512 + gi * 128 + idx] = fmaxf(bc + pm, bc + (gi == 0 ? m0f : m0b));
            }
            __syncthreads();
        }
        const int tl = 16 * wv + q;
        const int trow = row0 + tl;
        bf16x8 qf[2];
#pragma unroll
        for (int ks = 0; ks < 2; ++ks) qf[ks] = *(const bf16x8*)(p.P1 + (size_t)trow * 3072 + h * 64 + 32 * ks + 8 * g);
        f32x4 st_[8];
#pragma unroll
        for (int st = 0; st < 8; ++st) {
            f32x4 s = (f32x4){0.f, 0.f, 0.f, 0.f};
#pragma unroll
            for (int ks = 0; ks < 2; ++ks) s = mfma16(*(const bf16x8*)(ldsc + MLO_K + lds_byte(16 * st + q, 32 * ks + 8 * g)), qf[ks], s);
            st_[st] = s;
        }
        f32x4 hsum[8];
#pragma unroll
        for (int vm = 0; vm < 8; ++vm) hsum[vm] = (f32x4){0.f, 0.f, 0.f, 0.f};
#pragma unroll 1
        for (int dir = 0; dir < 2; ++dir) {
            const float mt = G[512 + dir * 128 + tl];
            const float bt = G[256 + dir * 128 + tl];
            const float m0 = dir == 0 ? m0f : m0b;
            const float iw = __expf(bt + m0 - mt);
            const float* n0 = p.N0 + ((size_t)u * 2 + dir) * 64;
            float qn = 0.f;
#pragma unroll
            for (int ks = 0; ks < 2; ++ks) {
                const u32x4 w = __builtin_bit_cast(u32x4, qf[ks]);
                const f32x4 na = *(const f32x4*)(n0 + 32 * ks + 8 * g), nb = *(const f32x4*)(n0 + 32 * ks + 8 * g + 4);
                qn += bflo(w.x) * na[0] + bfhi(w.x) * na[1] + bflo(w.y) * na[2] + bfhi(w.y) * na[3] + bflo(w.z) * nb[0] + bfhi(w.z) * nb[1] + bflo(w.w) * nb[2] + bfhi(w.w) * nb[3];
            }
            qn += __shfl_xor(qn, 16); qn += __shfl_xor(qn, 32);
            f32x4 acc[8];
            const char* c0s = ldsc + MLO_C0 + dir * 16384;
#pragma unroll
            for (int vm = 0; vm < 8; ++vm) {
                f32x4 a = (f32x4){0.f, 0.f, 0.f, 0.f};
#pragma unroll
                for (int ks = 0; ks < 2; ++ks) a = mfma16(*(const bf16x8*)(c0s + lds_byte(16 * vm + q, 32 * ks + 8 * g)), qf[ks], a);
                acc[vm] = a * iw;
            }
            float rs = 0.f;
#pragma unroll
            for (int uu = 0; uu < 4; ++uu) {
                const bool need = dir == 0 ? (2 * uu <= wv) : (2 * uu + 1 >= wv);
                if (need) {
                    f32x4 pw[2];
#pragma unroll
                    for (int hf = 0; hf < 2; ++hf) {
                        const int st = 2 * uu + hf;
                        const f32x4 bs = *(const f32x4*)(G + 256 + dir * 128 + 16 * st + 4 * g);
                        const f32x4 is = *(const f32x4*)(G + dir * 128 + 16 * st + 4 * g);
                        f32x4 w;
#pragma unroll
                        for (int r = 0; r < 4; ++r) {
                            const int s = 16 * st + 4 * g + r;
                            const bool ok = dir == 0 ? (s <= tl) : (s >= tl);
                            const float dw = ok ? __expf(bt - bs[r] + is[r] - mt) : 0.f;
                            w[r] = st_[st][r] * dw;
                            rs += w[r];
                        }
                        pw[hf] = w;
                    }
                    const bf16x8 pb = pack8(pw[0], pw[1]);
#pragma unroll
                    for (int vm = 0; vm < 8; ++vm) {
                        const char* vr = ldsc + MLO_VT + (16 * vm + q) * MLO_VTS + (32 * uu + 4 * g) * 2;
                        const bf16x8 va = join8(*(const u32x2*)vr, *(const u32x2*)(vr + 32));
                        acc[vm] = mfma16(va, pb, acc[vm]);
                    }
                }
            }
            rs += __shfl_xor(rs, 16); rs += __shfl_xor(rs, 32);
            const float den = rs + iw * qn;
            const float dn = 1.0f / fmaxf(fabsf(den), __expf(-mt));
#pragma unroll
            for (int vm = 0; vm < 8; ++vm) hsum[vm] += acc[vm] * dn;
        }
        __syncthreads();
        float* HS = (float*)(ldsc + MLO_HS);
#pragma unroll
        for (int vm = 0; vm < 8; ++vm) *(f32x4*)(HS + tl * 132 + 16 * vm + 4 * g) = hsum[vm];
        __syncthreads();
        {
            const int t = tid >> 2, vq = (tid & 3) * 4;
            const float* hr = HS + t * 132 + vq;
            f32x4 hv[8];
            float ss = 0.f;
#pragma unroll
            for (int i = 0; i < 8; ++i) { hv[i] = *(const f32x4*)(hr + 16 * i); ss += (hv[i][0] * hv[i][0] + hv[i][1] * hv[i][1]) + (hv[i][2] * hv[i][2] + hv[i][3] * hv[i][3]); }
            ss += __shfl_xor(ss, 1); ss += __shfl_xor(ss, 2);
            const float rn = rsqrtf(ss * (1.0f / 128.0f) + 1e-6f);
            const size_t orow = (size_t)(row0 + t) * 1024 + h * 128 + vq;
#pragma unroll
            for (int i = 0; i < 8; ++i) {
                const f32x4 ng = *(const f32x4*)(p.ml_norm_g + h * 128 + vq + 16 * i);
                const u32x2 ow = *(const u32x2*)(p.P1 + (size_t)(row0 + t) * 3072 + 2048 + h * 128 + vq + 16 * i);
                f32x4 o;
                o[0] = hv[i][0] * rn * ng[0] * sigmoidf_(bflo(ow.x)); o[1] = hv[i][1] * rn * ng[1] * sigmoidf_(bfhi(ow.x));
                o[2] = hv[i][2] * rn * ng[2] * sigmoidf_(bflo(ow.y)); o[3] = hv[i][3] * rn * ng[3] * sigmoidf_(bfhi(ow.y));
                u32x2 w; w.x = cvt_pk_bf16(o[0], o[1]); w.y = cvt_pk_bf16(o[2], o[3]);
                *(u32x2*)(p.MIX + orow + 16 * i) = w;
            }
        }
        __syncthreads();
    }
}


#ifndef PROBE_MODE
#define PROBE_MODE 0
#endif
DI void ph_probe(const Params& p, char* lds) {
#if PROBE_MODE >= 1 && PROBE_MODE <= 4
    const int tid = opaque_tid();
    constexpr int NTN = 26, NTM = 66;
    gemm_stream<4, 2, 4, 4, PtrLoaderF, 4, PROBE_MODE>(lds, NTN * NTM, 16, [&](int u, PtrLoader<4>& al, PtrLoaderF& bl, const int (&nx)[4]) {
        int tm, tn; tile_of(u, NTM, NTN, tm, tn);
#pragma unroll
        for (int i = 0; i < 4; ++i) al.p[i] = (unsigned)((tm * 256 + a_row(tid) + 64 * i) * 1024 + a_c8(tid) * 8);
        al.base = p.Abuf;
        fill_bf(bl, p.ev_w_in, EVC, tn * 128, EVC);
    }, [&](int u, int (&nx)[4], int) {}, [&](int u, int mi, const f32x4 (&a)[4], f32x4 (&o)[4], int r0, int c0) {
#pragma unroll
        for (int ni = 0; ni < 4; ++ni) o[ni] = a[ni];
    }, [&](int u, int r, int c, f32x4 v, f32x4 pv) {
        int tm, tn; tile_of(u, NTM, NTN, tm, tn);
        const int row = tm * 256 + r, col = tn * 128 + c;
        if (tn < 12) {
            bf16_t* dst = (tn < 4 ? p.Q0 + col : (tn < 8 ? p.K0 + (col - 512) : p.V0 + (col - 1024))) + (size_t)row * 512;
            u32x2 w; w.x = cvt_pk_bf16(v[0], v[1]); w.y = cvt_pk_bf16(v[2], v[3]);
            *(u32x2*)dst = w;
        } else if (col < EVC) {
            *(f32x4*)(p.RWP + (size_t)row * RWC + (col - 1536)) = v;
        }
    });
#endif
}
constexpr int NPHASE = 27;
template <int PH>
DI void run_phase(const Params& p, char* lds) {
    if (PH == 0) ph_prologue(p, lds);
    if (PH == 1) ph_modulate0(p);
    if (PH == 2) ph_inproj0(p, lds);
    if (PH == 3) { for (int j = blockIdx.x; j < (TT / 64) * 8; j += gridDim.x) transpose_tile(lds, p.V0, 512, (j >> 3) * 64, (j & 7) * 64, p.VT0L, p.VT0C, 512); ph_rw_prep(p, lds); }
    if (PH == 4) ph_attn_cp<1>(p, lds);
    if (PH == 5) ph_sq(p, lds);
    if (PH == 6) ph_rw_readout(p);
    if (PH == 7) gemm_f32out(lds, p.MIX, TT, p.ev_w_out, 1024, p.YL);
    if (PH == 8) ph_ln1<0>(p);
    if (PH == 9) gemm_router(lds, p.Abuf, TT, p.moe_router, p.LOGITS);
    if (PH == 10) ph_route<0>(p, lds);
    if (PH == 11) ph_scatter<0>(p, lds);
    if (PH == 12) ph_moe1<0>(p, lds);
    if (PH == 13) ph_moe2<0>(p, lds);
    if (PH == 14) ph_combine<0>(p);
    if (PH == 15) ph_inproj1(p, lds);
    if (PH == 17) ph_ml_chunks(p, lds);
    if (PH == 18) ph_ml_scan(p);
    if (PH == 19) ph_ml_out(p, lds);
    if (PH == 20) gemm_f32out(lds, p.MIX, TL, p.od_w_out, 1024, p.YL);
    if (PH == 21) ph_ln1<1>(p);
    if (PH == 22) gemm_router(lds, p.Abuf, TL, p.moe_router + 1024 * 256, p.LOGITS);
    if (PH == 23) ph_route<1>(p, lds);
    if (PH == 24) ph_scatter<1>(p, lds);
    if (PH == 25) ph_moe1<1>(p, lds);
    if (PH == 26) ph_moe2<1>(p, lds);
    if (PH == 27) ph_combine<1>(p);
    if (PH == 28) { if (PROBE_MODE >= 1 && PROBE_MODE <= 4) ph_probe(p, lds); if (PROBE_MODE == 5) ph_attn_cp(p, lds); if (PROBE_MODE == 6) ph_sq(p, lds); if (PROBE_MODE == 7) ph_rw_prep(p, lds); if (PROBE_MODE == 17) ph_rw_prep<1>(p, lds); if (PROBE_MODE == 8) ph_attn_cp<1>(p, lds); if (PROBE_MODE == 9) ph_attn_cp<2>(p, lds); if (PROBE_MODE == 10) ph_route<0>(p, lds); if (PROBE_MODE == 11) ph_scatter<0>(p, lds); if (PROBE_MODE == 12) { ph_prologue(p, lds); } if (PROBE_MODE == 13) ph_rw_readout(p); if (PROBE_MODE == 14) gemm_f32out(lds, p.MIX, TT, p.ev_w_out, 1024, p.YL); if (PROBE_MODE == 15) { ph_ml_chunks(p, lds); } if (PROBE_MODE == 16) ph_ml_out(p, lds); }
}

#if MK_MULTI
template <int PH>
__global__ void __launch_bounds__(NTHR, 2) k_phase(Params p) {
    extern __shared__ __attribute__((aligned(16))) char lds[];
    run_phase<PH>(p, lds);
}
#else
template <int PH> struct PhaseSeq {
    static DI void run(const Params& p, char* lds, const XcdBarrier& bar) {
        PhaseSeq<PH - 1>::run(p, lds, bar);
        if constexpr (PH == 16) return;
        xcd_barrier(bar);
        if constexpr (((PROBE_DUP >> PH) & 1ull) != 0) {
            const int reps = 1 + (int)(__builtin_amdgcn_s_getreg((3 << 11) | 20) < 64u);
#pragma unroll 1
            for (int rep = 0; rep < reps; ++rep) run_phase<PH>(p, lds);
        } else run_phase<PH>(p, lds);
    }
};
template <> struct PhaseSeq<0> {
    static DI void run(const Params& p, char* lds, const XcdBarrier&) { if (PROBE_DUP & 1ull) run_phase<0>(p, lds); run_phase<0>(p, lds); }
};
__global__ void __launch_bounds__(NTHR, 2) k_mega(Params p) {
    extern __shared__ __attribute__((aligned(16))) char lds[];
    LAS unsigned* xb = (LAS unsigned*)(lds + LDS_XB);
    if (threadIdx.x == 0) { xb[0] = 0u; xb[1] = 0u; xb[2] = 0u; xb[3] = 0u; }
    __syncthreads();
    XcdBarrier bar = xcd_barrier_post(p.bar, (volatile LAS unsigned*)xb);
    PhaseSeq<PROBE_MODE ? 28 : 27>::run(p, lds, bar);
}
#endif

#if MK_MULTI
template <int PH> static void launch_all(const Params& p, hipStream_t s) {
    if constexpr (PH > 0) launch_all<PH - 1>(p, s);
    hipFuncSetAttribute((const void*)k_phase<PH>, hipFuncAttributeMaxDynamicSharedMemorySize, LDS_BYTES);
    hipLaunchKernelGGL(k_phase<PH>, dim3(256), dim3(NTHR), LDS_BYTES, s, p);
}
#endif

extern "C" void kernel_launch(void* const* d_in, const int* in_sizes, int n_in, void* d_out, int out_size, void* d_ws, size_t ws_size, hipStream_t stream) {
    Params p{};
    const float** f = (const float**)&p.x;
    for (int i = 0; i < 34; ++i) f[i] = (const float*)d_in[i];
    p.out = (float*)d_out;
    size_t off = 0;
    auto A = [&](size_t bytes) -> char* { char* r = (char*)d_ws + off; off += (bytes + 255) & ~(size_t)255; return r; };
    p.bar = (unsigned*)A(XCD_BAR_WORDS * 4);
    p.ictl = (int*)A(1026 * 4);
    p.mods = (float*)A((size_t)2 * 3 * 6144 * 4);
    p.Abuf = (bf16_t*)A((size_t)TT * 1024 * 2);
    p.CM = (bf16_t*)A((size_t)32 * CK_NCH * 4096 * 2);
    p.CRH = (bf16_t*)A((size_t)32 * CK_NCH * 1024 * 2);
    p.CN = (bf16_t*)A((size_t)32 * CK_NCH * 4096 * 2);
    p.CP3 = (bf16_t*)A((size_t)32 * CK_NCH * 1024 * 2);
    p.HA = (float*)A((size_t)TT * 1024 * 4);
    p.HB = (float*)A((size_t)TT * 1024 * 4);
    p.Q0 = (bf16_t*)A((size_t)TT * 512 * 2);
    p.K0 = (bf16_t*)A((size_t)TT * 512 * 2);
    p.V0 = (bf16_t*)A((size_t)TT * 512 * 2);
    p.VT0L = (bf16_t*)A((size_t)2 * 512 * TLB * 2);
    p.VT0C = (bf16_t*)A((size_t)2 * 512 * TCB * 2);
    p.RWP = (float*)A((size_t)TT * RWC * 4);
    p.MIX = (bf16_t*)A((size_t)TT * 1024 * 2);
    p.YL = (float*)A((size_t)TT * 1024 * 4);
    p.LOGITS = (float*)A((size_t)TT * 256 * 4);
    p.EIDX = (int*)A((size_t)TT * 8 * 4);
    p.EW = (float*)A((size_t)TT * 8 * 4);
    p.APOS = (int*)A((size_t)TT * 8 * 4);
    p.SLOT_TOK = (int*)A((size_t)2 * NSLOT * 4);
    p.SLOT_W = (float*)A((size_t)2 * NSLOT * 4);
    p.HIST = (int*)A((size_t)2 * 256 * 256 * 4);
    p.WF = (unsigned*)A((size_t)8 * 4 * 7 * 64 * 16);
    p.TILE_E = (int*)A((size_t)2 * MAXTILES * 4);
    p.TILE_R0 = (int*)A((size_t)2 * MAXTILES * 4);
    p.HBUF = (bf16_t*)A((size_t)NSLOT * 256 * 2);
    const size_t un0 = off;
    p.YB = (bf16_t*)A((size_t)NSLOT * 1024 * 2);
    const size_t un_end = off;
    off = un0;
    p.SW = (float*)A((size_t)2 * TT * 512 * 4);
    p.SBP = (unsigned*)A((size_t)TT * 512 * 4);
    p.SKP = (unsigned*)A((size_t)TT * 512 * 4);
    p.SNV = (unsigned*)A((size_t)TT * 512 * 4);
    p.SRG = (unsigned*)A((size_t)TT * 512 * 4);
    p.BONUS = (float*)A((size_t)TT * 8 * 4);
    p.YS = (float*)A((size_t)2 * TT * 512 * 4);
    const size_t m0_end = off;
    off = un0;
    p.P1 = (bf16_t*)A((size_t)TT * 3072 * 2);
    p.K1TL = (bf16_t*)A((size_t)2 * 512 * TLB * 2);
    p.K1TC = (bf16_t*)A((size_t)2 * 512 * TCB * 2);
    p.V1TL = (bf16_t*)A((size_t)2 * 1024 * TLB * 2);
    p.V1TC = (bf16_t*)A((size_t)2 * 1024 * TCB * 2);
    p.G1 = (float*)A((size_t)TT * 32 * 4);
    p.KVT = (float*)A((size_t)1056 * 2 * 8192 * 4);
    p.KS = (float*)A((size_t)1056 * 128 * 4);
    p.BEMC = (float*)A((size_t)1056 * 4 * 4);
    p.C0T = (bf16_t*)A((size_t)1056 * 2 * 8192 * 2);
    p.N0 = (float*)A((size_t)1056 * 2 * 64 * 4);
    p.M0 = (float*)A((size_t)1056 * 2 * 4);
    const size_t m1_end = off;
    off = un_end > m0_end ? un_end : m0_end; off = off > m1_end ? off : m1_end;
    if (off > ws_size) return;
    hipMemsetAsync(p.bar, 0, XCD_BAR_WORDS * 4, stream);
#if MK_MULTI
    launch_all<27>(p, stream);
#else
    hipFuncSetAttribute((const void*)k_mega, hipFuncAttributeMaxDynamicSharedMemorySize, LDS_BYTES);
    hipLaunchKernelGGL(k_mega, dim3(256), dim3(NTHR), LDS_BYTES, stream, p);
#endif
}
```

```cpp
#include <hip/hip_runtime.h>
#include <stdint.h>

#ifndef MK_MULTI
#define MK_MULTI 0
#endif

#ifndef PROBE_DUP
#define PROBE_DUP 0ull
#endif
#define DI __device__ __forceinline__
typedef unsigned short bf16_t;
typedef short bf16x8 __attribute__((ext_vector_type(8)));
typedef float f32x4 __attribute__((ext_vector_type(4)));
typedef unsigned u32x4 __attribute__((ext_vector_type(4)));
typedef unsigned u32x2 __attribute__((ext_vector_type(2)));

constexpr int NTHR = 512;
constexpr int TLB = 8192, TCB = 256, TL = 16384, TC = 512, TT = 16896;
constexpr int EVC = 3296, ODC = 3104, RWC = 1760;
constexpr float ALPHA = 1.41421356237f;
constexpr int SH_BASE = 200704;
constexpr int NSLOT = SH_BASE + TT;
constexpr int MAXTILES = 784 + 66;
constexpr int EPI_OFF = 98304, EPI_WAVE_B = 4352;
constexpr int LDS_XB = 153600;
constexpr int LDS_BYTES = LDS_XB + 256;

#define XB_TMO      128
#define XB_XCNT(j)  (256  + 64 * (j))
#define XB_XSUB(j)  (1280 + 64 * (j))
#define XB_XGEN(j)  (2304 + 64 * (j))
#define XB_TOP      3328
#define XB_TOPGEN   3392
#define XCD_BAR_WORDS 3456
#define XB_SPIN_CAP (1u << 18)
#define LAS __attribute__((address_space(3)))

__device__ __forceinline__ unsigned xb_ld(unsigned* p)              { return __hip_atomic_load(p, __ATOMIC_RELAXED, __HIP_MEMORY_SCOPE_AGENT); }
__device__ __forceinline__ unsigned xb_add(unsigned* p, unsigned v) { return __hip_atomic_fetch_add(p, v, __ATOMIC_RELAXED, __HIP_MEMORY_SCOPE_AGENT); }
__device__ __forceinline__ unsigned xb_xcc_id() { return (unsigned)__builtin_amdgcn_s_getreg((3 << 11) | 20) & 0xFu; }
#define XB_SPIN(cond, bar) do { unsigned _sp = 0; while (cond) { __builtin_amdgcn_s_sleep(1); \
    if ((++_sp & 255u) == 0u) { if (xb_ld(&(bar)[XB_TMO])) break; if (_sp > XB_SPIN_CAP) { atomicAdd(&(bar)[XB_TMO], 1u); break; } } } } while (0)

struct XcdBarrier {
    unsigned* bar; unsigned x;
    volatile LAS unsigned* st;
};
__device__ __forceinline__ XcdBarrier xcd_barrier_post(unsigned* bar, volatile LAS unsigned* st) {
    XcdBarrier b; b.bar = bar; b.x = xb_xcc_id(); b.st = st;
    if (threadIdx.x == 0) (void)xb_add(&bar[XB_XCNT(b.x)], 1u);
    return b;
}
__device__ __forceinline__ void xcd_barrier_complete(unsigned* bar, unsigned x, unsigned& nloc, unsigned& nx) {
    const unsigned G = gridDim.x * gridDim.y * gridDim.z;
    unsigned sum, cnt, mine, sp = 0u;
    for (;;) {
        sum = 0u; cnt = 0u; mine = 0u;
#pragma unroll
        for (unsigned j = 0; j < 16; ++j) { const unsigned c = xb_ld(&bar[XB_XCNT(j)]); sum += c; cnt += (c > 0u) ? 1u : 0u; mine = (j == x) ? c : mine; }
        if (sum == G) break;
        __builtin_amdgcn_s_sleep(1);
        if ((++sp & 255u) == 0u) { if (xb_ld(&bar[XB_TMO])) break; if (sp > XB_SPIN_CAP) { atomicAdd(&bar[XB_TMO], 1u); break; } }
    }
    nloc = mine > 0u ? mine : 1u; nx = cnt > 0u ? cnt : 1u;
}
__device__ __forceinline__ void xcd_barrier(const XcdBarrier& b) {
    asm volatile("s_waitcnt vmcnt(0)" ::: "memory");
    __syncthreads();
    if (threadIdx.x == 0) {
        unsigned* bar = b.bar;
        __builtin_amdgcn_s_waitcnt(0);
        unsigned nloc = b.st[0], nx = b.st[1];
        if (nloc == 0u) { xcd_barrier_complete(bar, b.x, nloc, nx); b.st[0] = nloc; b.st[1] = nx; }
        const unsigned old = xb_add(&bar[XB_XSUB(b.x)], 1u);
        const unsigned gen = old / nloc;
        if (old + 1u == (gen + 1u) * nloc) {
            __builtin_amdgcn_fence(__ATOMIC_RELEASE, "agent");
            asm volatile("s_waitcnt vmcnt(0)" ::: "memory");
            const unsigned og = xb_add(&bar[XB_TOP], 1u);
            const unsigned tg = og / nx;
            if (og + 1u == (tg + 1u) * nx) xb_add(&bar[XB_TOPGEN], 1u);
            else XB_SPIN(xb_ld(&bar[XB_TOPGEN]) == tg, bar);
            __builtin_amdgcn_fence(__ATOMIC_ACQUIRE, "agent");
            xb_add(&bar[XB_XGEN(b.x)], 1u);
            asm volatile("s_waitcnt vmcnt(0)" ::: "memory");
        } else {
            XB_SPIN(xb_ld(&bar[XB_XGEN(b.x)]) == gen, bar);
            __builtin_amdgcn_fence(__ATOMIC_ACQUIRE, "agent");
            asm volatile("s_waitcnt vmcnt(0)" ::: "memory");
        }
    }
    __syncthreads();
}

struct Params {
    const float *x, *c, *ctx, *c_ctx, *ada_w, *ada_b, *ln_g, *ln_b, *ev_w_in, *ev_w_out, *na_rpb, *rw_mu, *rw_w0, *rw_w_up, *rw_a0,
        *rw_a_up, *rw_g_up, *rw_k_k, *rw_k_a, *rw_r_k, *rw_gn_g, *rw_gn_b, *od_w_in, *od_w_out, *ml_gate_b, *ml_norm_g, *moe_router,
        *moe_bias, *moe_w_gate, *moe_w_up, *moe_w_down, *sh_w_gate, *sh_w_up, *sh_w_down;
    float* out;
    unsigned* bar;
    int* ictl;
    float* mods;
    bf16_t* Abuf;
    float *HA, *HB;
    bf16_t *Q0, *K0, *V0, *VT0L, *VT0C;
    float* RWP;
    unsigned* WF;
    float *SW, *BONUS, *YS;
    unsigned *SBP, *SKP, *SNV, *SRG;
    bf16_t *CM, *CRH, *CN, *CP3;
    bf16_t* MIX;
    float* YL;
    float* LOGITS;
    int *EIDX, *APOS, *SLOT_TOK, *TILE_E, *TILE_R0, *HIST;
    float *EW, *SLOT_W;
    bf16_t *HBUF, *YB;
    bf16_t *P1, *K1TL, *K1TC, *V1TL, *V1TC, *C0T;
    float *G1, *KVT, *KS, *BEMC, *N0, *M0;
};

DI int opaque_tid() { int t = threadIdx.x; asm volatile("" : "+v"(t)); return t; }
typedef __bf16 bf16x2_t __attribute__((ext_vector_type(2)));
typedef float f32x2_t __attribute__((ext_vector_type(2)));
DI unsigned cvt_pk_bf16_asm(float lo, float hi) { unsigned r; asm volatile("v_cvt_pk_bf16_f32 %0, %1, %2" : "=v"(r) : "v"(lo), "v"(hi)); return r; }
DI unsigned cvt_pk_bf16(float lo, float hi) { const f32x2_t v = {lo, hi}; return __builtin_bit_cast(unsigned, __builtin_convertvector(v, bf16x2_t)); }
DI float bf2f(bf16_t b) { return __uint_as_float(((unsigned)b) << 16); }
DI float bflo(unsigned w) { return __uint_as_float(w << 16); }
DI float bfhi(unsigned w) { return __uint_as_float(w & 0xffff0000u); }
DI float sigmoidf_(float x) { return 1.0f / (1.0f + __expf(-x)); }
DI float siluf_(float x) { return x / (1.0f + __expf(-x)); }
DI float tanhf_(float x) { return 1.0f - 2.0f / (__expf(2.0f * x) + 1.0f); }
DI float softplusf_(float x) { return fmaxf(x, 0.f) + __logf(1.0f + __expf(-fabsf(x))); }
DI float logsigmoidf_(float x) { return -softplusf_(-x); }
DI f32x4 mfma16(bf16x8 a, bf16x8 b, f32x4 c) { return __builtin_amdgcn_mfma_f32_16x16x32_bf16(a, b, c, 0, 0, 0); }
DI bf16x8 pack8(f32x4 a, f32x4 b) {
    u32x4 w; w.x = cvt_pk_bf16(a[0], a[1]); w.y = cvt_pk_bf16(a[2], a[3]); w.z = cvt_pk_bf16(b[0], b[1]); w.w = cvt_pk_bf16(b[2], b[3]);
    return __builtin_bit_cast(bf16x8, w);
}
DI bf16x8 join8(u32x2 lo, u32x2 hi) { u32x4 w; w.x = lo.x; w.y = lo.y; w.z = hi.x; w.w = hi.y; return __builtin_bit_cast(bf16x8, w); }
DI float wave_allsum(float v) {
#pragma unroll
    for (int d = 1; d < 64; d <<= 1) v += __shfl_xor(v, d);
    return v;
}
DI float wave_allmax(float v) {
#pragma unroll
    for (int d = 1; d < 64; d <<= 1) v = fmaxf(v, __shfl_xor(v, d));
    return v;
}
template <int CTRL, int RM> DI float dpp_f(float x) {
    return __builtin_bit_cast(float, __builtin_amdgcn_update_dpp(0, __builtin_bit_cast(int, x), CTRL, RM, 0xF, false));
}
DI float wave_sum63(float x) {
    x += dpp_f<0xB1, 0xF>(x);
    x += dpp_f<0x4E, 0xF>(x);
    x += dpp_f<0x141, 0xF>(x);
    x += dpp_f<0x140, 0xF>(x);
    x += dpp_f<0x142, 0xA>(x);
    x += dpp_f<0x143, 0xC>(x);
    return x;
}
template <int CTRL> DI float dpp_add(float x) { return x + __builtin_bit_cast(float, __builtin_amdgcn_update_dpp(0, __builtin_bit_cast(int, x), CTRL, 0xF, 0xF, false)); }
DI float row16_allsum(float x) { x = dpp_add<0xB1>(x); x = dpp_add<0x4E>(x); x = dpp_add<0x141>(x); x = dpp_add<0x140>(x); return x; }
DI void seq_info(int row, int& t, int& T) { if (row < TL) { t = row & (TLB - 1); T = TLB; } else { t = (row - TL) & (TCB - 1); T = TCB; } }
DI int mods_row(int row) { return row < TL ? (row >> 13) : 2; }

DI int lds_byte(int r, int c) { const int st = (r >> 4) * 2 + (c >> 5), rr = r & 15, cc = c & 31, ob = rr * 64 + cc * 2; return st * 1024 + (ob ^ (((ob >> 9) & 1) << 5)); }

DI int a_row(int tid) { return (tid >> 4) * 2 + ((tid >> 2) & 1); }
DI int a_c8(int tid) { return ((tid >> 3) & 1) * 4 + (tid & 3); }
template <int NP> struct PtrLoader { const bf16_t* base; unsigned p[NP]; };
struct PtrLoaderF { const float* base0; const float* base1; unsigned p[4]; int ld; };
typedef short s16x4 __attribute__((ext_vector_type(4)));
DI int b_img(int k, int seg, int bo) { return 256 * k + 32 * (seg ^ ((k & 3) + 4 * ((k >> 3) & 1))) + bo; }
DI bf16x8 tr_frag(const char* base, int xl, int c, int ks) {
    const char* a = base + (xl ^ (c << 5)) + 8192 * ks;
    const s16x4 lo = __builtin_amdgcn_ds_read_tr16_b64_v4i16((LAS s16x4*)(a));
    const s16x4 hi = __builtin_amdgcn_ds_read_tr16_b64_v4i16((LAS s16x4*)(a + 1024));
    return __builtin_shufflevector(lo, hi, 0, 1, 2, 3, 4, 5, 6, 7);
}

DI void tile_of(int u, int ntm, int ntn, int& tm, int& tn) {
    const int gid = u / (4 * ntn), within = u % (4 * ntn);
    const int gsz = (ntm - gid * 4) < 4 ? (ntm - gid * 4) : 4;
    tm = gid * 4 + within % gsz; tn = within / gsz;
}
DI void fill_bf(PtrLoaderF& bl, const float* W, int ld, int n0, int nvalid) {
    bl.ld = ld; bl.base0 = W; bl.base1 = W;
    const int tz = opaque_tid();
#pragma unroll
    for (int i = 0; i < 4; ++i) { int n = n0 + 32 * i + (tz & 7) * 4; n = n < nvalid ? n : nvalid - 4; bl.p[i] = (unsigned)((tz >> 3) * ld + n); }
}
template <int V> struct IC { static constexpr int value = V; };
template <int WR, int WC, int MT, int NT, class BL, int NTU, int MODE = 0, class MK, class PF, class PRE, class SINK>
DI void gemm_stream(char* lds, int nunits, int nk, MK&& mk, PF&& pf, PRE&& pre, SINK&& sink) {
    constexpr bool BF32 = __is_same(BL, PtrLoaderF);
    constexpr int BM = WR * MT * 16, BN = WC * NT * 16, APC = BM * 8 / NTHR, BPC = BF32 ? 4 : BN * 8 / NTHR;
    constexpr int ABYTES = BM * 128, STAGE = (BM + BN) * 128;
    static_assert(WR * WC == 8, "8 waves");
    static_assert(!BF32 || BN == 128, "f32 B path is written for 128-column tiles");
    const int tid = opaque_tid(), lane = tid & 63, wid = tid >> 6, wr = wid / WC, wc = wid % WC, fr = lane & 15, fq = lane >> 4;
    const int ubase = (blockIdx.x & 7) * 32 + (blockIdx.x >> 3), ustep = (int)gridDim.x;
    if (ubase >= nunits) return;
    int lu = ubase, lkt = 0, cu = ubase, ckt = 0;
    int lun = (lu + ustep < nunits) ? lu + ustep : lu;
    f32x4 acc[MT][NT];
#pragma unroll
    for (int m = 0; m < MT; ++m)
#pragma unroll
        for (int n = 0; n < NT; ++n) acc[m][n] = (f32x4){0.f, 0.f, 0.f, 0.f};
    const int sa0 = lds_byte(a_row(tid), a_c8(tid) * 8);
    const int xl = b_img(8 * fq + ((lane & 15) >> 2), 0, 8 * (lane & 3));
    auto sbo = [&](int i) -> int {
        if constexpr (BF32) { const int k = tid >> 3, n4 = 8 * i + (tid & 7); return ABYTES + b_img(k, n4 >> 2, 8 * (n4 & 3)); }
        else return ABYTES + lds_byte((tid >> 3) + 64 * i, (tid & 7) * 8);
    };
    PtrLoader<APC> al; BL bl;
    int nx[4] = {0, 0, 0, 0};
    pf(lu, nx, 2);
    mk(lu, al, bl, nx);
    pf(lun, nx, 2);
    u32x4 ra[APC], rb[BPC];
    auto issue = [&](auto hc) {
        if constexpr (MODE == 2) return;
#pragma unroll
        for (int i = 0; i < APC; ++i) ra[i] = *(const u32x4*)(al.base + al.p[i] + lkt * 64);
#pragma unroll
        for (int i = 0; i < BPC; ++i) {
            if constexpr (BF32) rb[i] = *(const u32x4*)(((i & 1) ? bl.base1 : bl.base0) + bl.p[i] + (size_t)lkt * 64 * bl.ld);
            else rb[i] = *(const u32x4*)(bl.base + bl.p[i] + lkt * 64);
        }
        const int use[4] = {nx[0], nx[1], nx[2], nx[3]};
        pf(lun, nx, decltype(hc)::value);
        if (++lkt == nk) { lkt = 0; lu = lun; lun = (lu + ustep < nunits) ? lu + ustep : lu; mk(lu, al, bl, use); }
    };
    auto stash = [&](char* st) {
        if constexpr (MODE == 2) return;
#pragma unroll
        for (int i = 0; i < APC; ++i) *(u32x4*)(st + sa0 + 8192 * i) = ra[i];
#pragma unroll
        for (int i = 0; i < BPC; ++i) {
            if constexpr (BF32) {
                u32x2 w; w.x = cvt_pk_bf16_asm(__uint_as_float(rb[i].x), __uint_as_float(rb[i].y)); w.y = cvt_pk_bf16_asm(__uint_as_float(rb[i].z), __uint_as_float(rb[i].w));
                *(u32x2*)(st + sbo(i)) = w;
            } else *(u32x4*)(st + sbo(i)) = rb[i];
        }
    };
    auto compute = [&](const char* st) {
        if constexpr (MODE == 1) return;
#pragma unroll
        for (int ks = 0; ks < 2; ++ks) {
            bf16x8 af[MT], bfr[NT];
#pragma unroll
            for (int m = 0; m < MT; ++m) af[m] = *(const bf16x8*)(st + lds_byte(wr * MT * 16 + m * 16 + fr, ks * 32 + fq * 8));
#pragma unroll
            for (int n = 0; n < NT; ++n) {
                if constexpr (BF32) bfr[n] = tr_frag(st + ABYTES, xl, wc * NT + n, ks);
                else bfr[n] = *(const bf16x8*)(st + ABYTES + lds_byte(wc * NT * 16 + n * 16 + fr, ks * 32 + fq * 8));
            }
#pragma unroll
            for (int m = 0; m < MT; ++m)
#pragma unroll
                for (int n = 0; n < NT; ++n) acc[m][n] = mfma16(bfr[n], af[m], acc[m][n]);
        }
    };
    auto ep = [&](int u, f32x4 (&a)[MT][NT], int, int) {
        float* W = (float*)(lds + EPI_OFF + wid * EPI_WAVE_B);
        constexpr int LPR = NTU * 4, RPI = 64 / LPR, NJ = 16 / RPI;
        const int c4 = lane % LPR, rb = lane / LPR;
#pragma unroll
        for (int mi = 0; mi < MT; ++mi) {
            f32x4 o[NTU];
            pre(u, mi, a[mi], o, wr * MT * 16 + mi * 16 + fr, wc * NT * 16 + 4 * fq);
#pragma unroll
            for (int ni = 0; ni < NTU; ++ni) *(f32x4*)(W + fr * 68 + ni * 16 + 4 * fq) = o[ni];
#pragma unroll
            for (int j = 0; j < NJ; ++j) {
                const f32x4 v = *(const f32x4*)(W + (rb + RPI * j) * 68 + 4 * c4);
                const f32x4 pv = *(const f32x4*)(W + (rb + RPI * j) * 68 + 4 * (c4 ^ 4));
                sink(u, wr * MT * 16 + mi * 16 + rb + RPI * j, wc * NTU * 16 + 4 * c4, v, pv);
            }
        }
    };
    issue(IC<0>{});
    stash(lds);
    if (wid >= 4) issue(IC<1>{});
    __syncthreads();
    bool first = true;
    auto epilogue = [&]() {
        if (ckt == 0 && !first) {
            if constexpr (MODE == 0 || MODE == 4) ep(cu - ustep, acc, wr * MT * 16 + fr, wc * NT * 16 + 4 * fq);
            else { asm volatile("" :: "v"(acc[0][0]), "v"(acc[MT - 1][NT - 1])); }
#pragma unroll
            for (int m = 0; m < MT; ++m)
#pragma unroll
                for (int n = 0; n < NT; ++n) acc[m][n] = (f32x4){0.f, 0.f, 0.f, 0.f};
        }
    };
    while (cu < nunits) {
        if (wid < 4) {
            epilogue(); issue(IC<1>{}); compute(lds); stash(lds + STAGE);
            __syncthreads();
            issue(IC<0>{}); compute(lds + STAGE); stash(lds);
            __syncthreads();
        } else {
            stash(lds + STAGE); epilogue(); issue(IC<0>{}); compute(lds);
            __syncthreads();
            stash(lds); issue(IC<1>{}); compute(lds + STAGE);
            __syncthreads();
        }
        first = false;
        ckt += 2;
        if (ckt == nk) { ckt = 0; cu += ustep; }
    }
    if constexpr (MODE == 0 || MODE == 4) ep(cu - ustep, acc, wr * MT * 16 + fr, wc * NT * 16 + 4 * fq);
    else {
#pragma unroll
        for (int m = 0; m < MT; ++m)
#pragma unroll
            for (int n = 0; n < NT; ++n) asm volatile("" :: "v"(acc[m][n]));
        if constexpr (MODE == 1) { asm volatile("" :: "v"(ra[0]), "v"(rb[0])); }
    }
}

DI void ph_prologue(const Params& p, char* lds) {
    const int tid = opaque_tid(), bid = blockIdx.x, nb = gridDim.x;
    for (int i = bid * NTHR + tid; i < 1026; i += nb * NTHR) p.ictl[i] = 0;
    for (int i = bid * NTHR + tid; i < 2 * NSLOT; i += nb * NTHR) {
        const int s = i % NSLOT;
        p.SLOT_TOK[i] = s >= SH_BASE ? s - SH_BASE : 0;
        p.SLOT_W[i] = s >= SH_BASE ? 1.0f : 0.0f;
    }
    if (bid >= 192) {
        for (int idx = (bid - 192) * NTHR + tid; idx < 8 * 4 * 7 * 64; idx += (nb - 192) * NTHR) {
            const int ln = idx & 63, s = (idx >> 6) % 7, hn = (idx >> 6) / 7;
            const int c = hn * 16 + (ln & 15);
            const float* wc_ = (s < 2 ? p.rw_w_up + s * 32 * 512 : (s < 4 ? p.rw_a_up + (s - 2) * 32 * 512 : p.rw_g_up + (s - 4) * 32 * 512)) + 8 * (ln >> 4) * 512 + c;
            u32x4 w;
            w.x = cvt_pk_bf16(wc_[0], wc_[512]); w.y = cvt_pk_bf16(wc_[1024], wc_[1536]); w.z = cvt_pk_bf16(wc_[2048], wc_[2560]); w.w = cvt_pk_bf16(wc_[3072], wc_[3584]);
            *(u32x4*)(p.WF + (size_t)idx * 4) = w;
        }
    }
    constexpr int J_MODS = 192;
    for (int job = bid; job < J_MODS; job += nb) {
        const int j = job;
        if (j < J_MODS) {
            const int l = j / 96, cb = j % 96;
            float* sc = (float*)lds;
            float* red = sc + 3072;
            for (int idx = tid; idx < 3072; idx += NTHR) {
                const int r = idx >> 10, k = idx & 1023;
                const float cv = r < 2 ? p.c[r * 1024 + k] : p.c_ctx[k];
                sc[idx] = siluf_(cv);
            }
            __syncthreads();
            const int kq = tid >> 6, cl = tid & 63, col = cb * 64 + cl;
            float a0 = 0.f, a1 = 0.f, a2 = 0.f;
            const float* w = p.ada_w + (size_t)l * 1024 * 6144 + col;
            for (int k = kq * 128; k < kq * 128 + 128; ++k) {
                const float wv = w[(size_t)k * 6144];
                a0 += sc[k] * wv; a1 += sc[1024 + k] * wv; a2 += sc[2048 + k] * wv;
            }
            red[(kq * 3 + 0) * 64 + cl] = a0; red[(kq * 3 + 1) * 64 + cl] = a1; red[(kq * 3 + 2) * 64 + cl] = a2;
            __syncthreads();
            if (tid < 192) {
                const int r = tid >> 6, c2 = tid & 63;
                float s = 0.f;
#pragma unroll
                for (int q = 0; q < 8; ++q) s += red[(q * 3 + r) * 64 + c2];
                p.mods[(size_t)(l * 3 + r) * 6144 + cb * 64 + c2] = s + p.ada_b[l * 6144 + cb * 64 + c2];
            }
            __syncthreads();
            continue;
        }
    }
}

DI void ph_modulate0(const Params& p) {
    const int nb = gridDim.x;
#pragma unroll 4
    for (int i = blockIdx.x * NTHR + opaque_tid(); i < TT * 256; i += nb * NTHR) {
        const int row = i >> 8, c = (i & 255) * 4;
        const float* src = row < TL ? p.x + (size_t)row * 1024 : p.ctx + (size_t)(row - TL) * 1024;
        const float* m = p.mods + (size_t)(0 * 3 + mods_row(row)) * 6144;
        const f32x4 v = *(const f32x4*)(src + c), sh = *(const f32x4*)(m + c), scv = *(const f32x4*)(m + 1024 + c);
        const f32x4 a = v * (1.0f + scv) + sh;
        u32x2 w; w.x = cvt_pk_bf16(a[0], a[1]); w.y = cvt_pk_bf16(a[2], a[3]);
        *(u32x2*)(p.Abuf + (size_t)row * 1024 + c) = w;
    }
}

DI void ph_inproj0(const Params& p, char* lds) {
    const int tid = opaque_tid();
    constexpr int NTN = 26, NTM = 66;
    gemm_stream<4, 2, 4, 4, PtrLoaderF, 4>(lds, NTN * NTM, 16, [&](int u, PtrLoader<4>& al, PtrLoaderF& bl, const int (&nx)[4]) {
        int tm, tn; tile_of(u, NTM, NTN, tm, tn);
#pragma unroll
        for (int i = 0; i < 4; ++i) al.p[i] = (unsigned)((tm * 256 + a_row(tid) + 64 * i) * 1024 + a_c8(tid) * 8);
        al.base = p.Abuf;
        fill_bf(bl, p.ev_w_in, EVC, tn * 128, EVC);
    }, [&](int u, int (&nx)[4], int) {}, [&](int u, int mi, const f32x4 (&a)[4], f32x4 (&o)[4], int r0, int c0) {
#pragma unroll
        for (int ni = 0; ni < 4; ++ni) o[ni] = a[ni];
    }, [&](int u, int r, int c, f32x4 v, f32x4 pv) {
        int tm, tn; tile_of(u, NTM, NTN, tm, tn);
        const int row = tm * 256 + r, col = tn * 128 + c;
        if (tn < 12) {
            bf16_t* dst = (tn < 4 ? p.Q0 + col : (tn < 8 ? p.K0 + (col - 512) : p.V0 + (col - 1024))) + (size_t)row * 512;
            u32x2 w; w.x = cvt_pk_bf16(v[0], v[1]); w.y = cvt_pk_bf16(v[2], v[3]);
            *(u32x2*)dst = w;
        } else if (col < EVC) {
            *(f32x4*)(p.RWP + (size_t)row * RWC + (col - 1536)) = v;
        }
    });
}

DI void transpose_tile(char* ldsc, const bf16_t* src, int ld, int row0, int col0, bf16_t* dstL, bf16_t* dstC, int ncols) {
    bf16_t* T = (bf16_t*)ldsc;
    const int tid = opaque_tid();
    {
        const int tok = tid >> 3, d8 = tid & 7;
        *(u32x4*)(T + tok * 72 + d8 * 8) = *(const u32x4*)(src + (size_t)(row0 + tok) * ld + col0 + d8 * 8);
    }
    __syncthreads();
    {
        const int d = tid >> 3, t8 = tid & 7;
        u32x4 w;
        w.x = (unsigned)T[(t8 * 8 + 0) * 72 + d] | ((unsigned)T[(t8 * 8 + 1) * 72 + d] << 16);
        w.y = (unsigned)T[(t8 * 8 + 2) * 72 + d] | ((unsigned)T[(t8 * 8 + 3) * 72 + d] << 16);
        w.z = (unsigned)T[(t8 * 8 + 4) * 72 + d] | ((unsigned)T[(t8 * 8 + 5) * 72 + d] << 16);
        w.w = (unsigned)T[(t8 * 8 + 6) * 72 + d] | ((unsigned)T[(t8 * 8 + 7) * 72 + d] << 16);
        bf16_t* dst;
        if (row0 < TL) dst = dstL + ((size_t)((row0 >> 13) * ncols + col0 + d)) * TLB + (row0 & (TLB - 1));
        else { const int rc = row0 - TL; dst = dstC + ((size_t)((rc >> 8) * ncols + col0 + d)) * TCB + (rc & (TCB - 1)); }
        *(u32x4*)(dst + t8 * 8) = w;
    }
    __syncthreads();
}

template <int NOSTORE = 0>
DI void ph_rw_prep(const Params& p, char* ldsc) {
    constexpr int TG = 16, LRP = 232;
    bf16_t* LR = (bf16_t*)ldsc;
    const int tid = opaque_tid(), lane = tid & 63, hh = tid >> 6, q = lane & 15, g = lane >> 4;
    bf16_t* SH = (bf16_t*)(ldsc + 8192);
    bf16x8 wq[7];
    auto wload = [&](int nt_) {
        unsigned co_ = (unsigned)(((hh * 4 + nt_) * 7 * 64 + lane) * 4); asm volatile("" : "+v"(co_));
#pragma unroll
        for (int s = 0; s < 7; ++s) wq[s] = __builtin_bit_cast(bf16x8, *(const u32x4*)(p.WF + co_ + s * 256));
    };
    wload(0);
    for (int grp = blockIdx.x; grp < TT / TG; grp += gridDim.x) {
        const int row0 = grp * TG;
        int t0, Tseq; seq_info(row0, t0, Tseq);
#pragma unroll 4
        for (int idx = tid; idx < TG * 440; idx += NTHR) {
            const int tk = idx / 440, c4 = (idx % 440) * 4;
            const int t = t0 + tk;
            const float* pr = p.RWP + (size_t)(row0 + tk) * RWC + c4;
            const f32x4 pc = *(const f32x4*)pr;
            const f32x4 pv = t > 0 ? *(const f32x4*)(pr - RWC) : (f32x4){0.f, 0.f, 0.f, 0.f};
            const f32x4 nx = t < Tseq - 1 ? *(const f32x4*)(pr + RWC) : (f32x4){0.f, 0.f, 0.f, 0.f};
            const f32x4 mu = *(const f32x4*)(p.rw_mu + c4);
            f32x4 v = pc + mu * (0.5f * (pv + nx) - pc);
            if (c4 < 1536) {
                u32x2 w; w.x = cvt_pk_bf16(v[0], v[1]); w.y = cvt_pk_bf16(v[2], v[3]);
                *(u32x2*)(SH + tk * 1536 + c4) = w;
            } else {
                const int j = c4 - 1536;
                if (j < 64) { v[0] = tanhf_(v[0]); v[1] = tanhf_(v[1]); v[2] = tanhf_(v[2]); v[3] = tanhf_(v[3]); }
                else if (j >= 128) { v[0] = sigmoidf_(v[0]); v[1] = sigmoidf_(v[1]); v[2] = sigmoidf_(v[2]); v[3] = sigmoidf_(v[3]); }
                u32x2 w; w.x = cvt_pk_bf16(v[0], v[1]); w.y = cvt_pk_bf16(v[2], v[3]);
                *(u32x2*)(LR + tk * LRP + j) = w;
            }
        }
        __syncthreads();
        float nrm[4];
#pragma unroll
        for (int r = 0; r < 4; ++r) {
            float ss = 0.f;
#pragma unroll
            for (int nt = 0; nt < 4; ++nt) {
                const int c = hh * 64 + 16 * nt + q;
                const float kk0 = bf2f(SH[(4 * g + r) * 1536 + 512 + c]) * p.rw_k_k[c];
                ss += kk0 * kk0;
            }
            nrm[r] = 1.0f / fmaxf(sqrtf(row16_allsum(ss)), 1e-12f);
        }
        float bon[4] = {0.f, 0.f, 0.f, 0.f};
        const f32x4 z4 = (f32x4){0.f, 0.f, 0.f, 0.f};
#pragma unroll
        for (int nt = 0; nt < 4; ++nt) {
            const int c = hh * 64 + 16 * nt + q;
            auto afrag = [&](int s) -> bf16x8 { return *(const bf16x8*)(LR + q * LRP + 32 * s + 8 * g); };
            f32x4 wl0, wl1, al0, al1, gl;
            {
                bf16x8 wc[7];
#pragma unroll
                for (int s = 0; s < 7; ++s) wc[s] = wq[s];
                wload((nt + 1) & 3);
                wl0 = mfma16(afrag(0), wc[0], z4); wl1 = mfma16(afrag(1), wc[1], z4); al0 = mfma16(afrag(2), wc[2], z4); al1 = mfma16(afrag(3), wc[3], z4);
                gl = mfma16(afrag(6), wc[6], mfma16(afrag(5), wc[5], mfma16(afrag(4), wc[4], z4)));
            }
            asm volatile("" ::: "memory");
            const float kkw = p.rw_k_k[c], kaw = p.rw_k_a[c], rkw = p.rw_r_k[c];
            const float w00 = p.rw_w0[c], w01 = p.rw_w0[512 + c], a00 = p.rw_a0[c], a01 = p.rw_a0[512 + c];
#pragma unroll
            for (int r = 0; r < 4; ++r) {
                const int row = row0 + 4 * g + r;
                const bf16_t* sh = SH + (4 * g + r) * 1536 + c;
                const float r_ = bf2f(sh[0]), k_ = bf2f(sh[512]), v_ = bf2f(sh[1024]);
                const float kk = k_ * kkw * nrm[r];
                const float wlog0 = -softplusf_(-(w00 + wl0[r])) - 0.5f, wlog1 = -softplusf_(-(w01 + wl1[r])) - 0.5f;
                const float dec0 = __expf(-__expf(wlog0)), dec1 = __expf(-__expf(wlog1));
                const float av0 = sigmoidf_(a00 + al0[r]), av1 = sigmoidf_(a01 + al1[r]);
                const float kd0 = k_ * (1.0f + (av0 - 1.0f) * kaw), kd1 = k_ * (1.0f + (av1 - 1.0f) * kaw);
                bon[r] += r_ * (kd0 + kd1) * rkw;
                const size_t o = (size_t)row * 512 + c;
                if (NOSTORE) { asm volatile("" :: "v"(dec0), "v"(dec1), "v"(kk * av0 + kk * av1 + kd0 + kd1 + v_ + gl[r])); continue; }
                typedef float f32x2s __attribute__((ext_vector_type(2)));
                *(f32x2s*)(p.SW + 2 * o) = (f32x2s){dec0, dec1};
                p.SBP[o] = cvt_pk_bf16(kk * av0, kk * av1); p.SKP[o] = cvt_pk_bf16(kd0, kd1);
                p.SNV[o] = cvt_pk_bf16(-kk, v_); p.SRG[o] = cvt_pk_bf16(r_, gl[r]);
                if (r & 1) asm volatile("" ::: "memory");
            }
        }
#pragma unroll
        for (int r = 0; r < 4; ++r) {
            const float bs = row16_allsum(bon[r]);
            if (q == 0) p.BONUS[(row0 + 4 * g + r) * 8 + hh] = bs;
        }
        __syncthreads();
    }
}

template <bool LAT>
DI void na_unit(const Params& p, int b, int r, int h, int w, int lane) {
    const int q = lane & 15, g = lane >> 4;
    const int j = 16 * w + q;
    const int qtok = LAT ? (b * TLB + r * 64 + j) : (TL + b * TCB + j);
    bf16x8 qf[2];
#pragma unroll
    for (int ks = 0; ks < 2; ++ks) qf[ks] = *(const bf16x8*)(p.Q0 + (size_t)qtok * 512 + h * 64 + 32 * ks + 8 * g);
    const int row_start = LAT ? (r - 4 < 0 ? 0 : (r - 4 > 120 ? 120 : r - 4)) : 0;
    const int c0 = LAT ? (w == 0 ? 0 : (w == 1 ? 8 : (w == 2 ? 24 : 32))) : 0;
    int cs = j - 8; cs = cs < 0 ? 0 : (cs > 48 ? 48 : cs);
    auto score_local = [&](int a, int tt) -> f32x4 {
        const int ktok = b * TLB + (row_start + a) * 64 + c0 + 16 * tt + q;
        f32x4 s = (f32x4){0.f, 0.f, 0.f, 0.f};
#pragma unroll
        for (int ks = 0; ks < 2; ++ks) {
            const bf16x8 kf = *(const bf16x8*)(p.K0 + (size_t)ktok * 512 + h * 64 + 32 * ks + 8 * g);
            s = mfma16(kf, qf[ks], s);
        }
        const int row_off = row_start + a - r + 7;
#pragma unroll
        for (int rr = 0; rr < 4; ++rr) {
            const int cc = c0 + 16 * tt + 4 * g + rr;
            int co = cc - j; co = co < -15 ? -15 : (co > 15 ? 15 : co);
            const bool in = (cc >= cs) && (cc < cs + 16);
            const float bias = p.na_rpb[(h * 15 + row_off) * 31 + co + 15];
            s[rr] = in ? (s[rr] * 0.125f + bias) : -1.0e30f;
        }
        return s;
    };
    auto score_ctx = [&](int ct) -> f32x4 {
        const int ktok = TL + b * TCB + 16 * ct + q;
        f32x4 s = (f32x4){0.f, 0.f, 0.f, 0.f};
#pragma unroll
        for (int ks = 0; ks < 2; ++ks) {
            const bf16x8 kf = *(const bf16x8*)(p.K0 + (size_t)ktok * 512 + h * 64 + 32 * ks + 8 * g);
            s = mfma16(kf, qf[ks], s);
        }
        return s * 0.125f;
    };
    float mx = -3.0e38f;
    if (LAT) {
        for (int a = 0; a < 8; ++a) {
#pragma unroll
            for (int tt = 0; tt < 2; ++tt) { const f32x4 s = score_local(a, tt); mx = fmaxf(mx, fmaxf(fmaxf(s[0], s[1]), fmaxf(s[2], s[3]))); }
        }
    }
    for (int ct = 0; ct < 16; ++ct) { const f32x4 s = score_ctx(ct); mx = fmaxf(mx, fmaxf(fmaxf(s[0], s[1]), fmaxf(s[2], s[3]))); }
    mx = fmaxf(mx, __shfl_xor(mx, 16)); mx = fmaxf(mx, __shfl_xor(mx, 32));
    float sum = 0.f;
    f32x4 o[4];
#pragma unroll
    for (int dm = 0; dm < 4; ++dm) o[dm] = (f32x4){0.f, 0.f, 0.f, 0.f};
    if (LAT) {
        for (int a = 0; a < 8; ++a) {
            f32x4 s0 = score_local(a, 0), s1 = score_local(a, 1);
#pragma unroll
            for (int rr = 0; rr < 4; ++rr) { s0[rr] = __expf(s0[rr] - mx); s1[rr] = __expf(s1[rr] - mx); sum += s0[rr] + s1[rr]; }
            const bf16x8 pb = pack8(s0, s1);
#pragma unroll
            for (int dm = 0; dm < 4; ++dm) {
                const bf16_t* vr = p.VT0L + ((size_t)(b * 512 + h * 64 + 16 * dm + q)) * TLB + (row_start + a) * 64 + c0 + 4 * g;
                const bf16x8 va = join8(*(const u32x2*)vr, *(const u32x2*)(vr + 16));
                o[dm] = mfma16(va, pb, o[dm]);
            }
        }
    }
    for (int u = 0; u < 8; ++u) {
        f32x4 s0 = score_ctx(2 * u), s1 = score_ctx(2 * u + 1);
#pragma unroll
        for (int rr = 0; rr < 4; ++rr) { s0[rr] = __expf(s0[rr] - mx); s1[rr] = __expf(s1[rr] - mx); sum += s0[rr] + s1[rr]; }
        const bf16x8 pb = pack8(s0, s1);
#pragma unroll
        for (int dm = 0; dm < 4; ++dm) {
            const bf16_t* vr = p.VT0C + ((size_t)(b * 512 + h * 64 + 16 * dm + q)) * TCB + 32 * u + 4 * g;
            const bf16x8 va = join8(*(const u32x2*)vr, *(const u32x2*)(vr + 16));
            o[dm] = mfma16(va, pb, o[dm]);
        }
    }
    sum += __shfl_xor(sum, 16); sum += __shfl_xor(sum, 32);
    const float inv = 1.0f / sum;
#pragma unroll
    for (int dm = 0; dm < 4; ++dm) {
        u32x2 wv; wv.x = cvt_pk_bf16(o[dm][0] * inv, o[dm][1] * inv); wv.y = cvt_pk_bf16(o[dm][2] * inv, o[dm][3] * inv);
        *(u32x2*)(p.MIX + (size_t)qtok * 1024 + h * 64 + 16 * dm + 4 * g) = wv;
    }
}

constexpr int CK_NCH = (TCB + TLB) / 16;
constexpr int CPW = 19200;
constexpr int CP_TMU = 0, CP_TMB = 2304, CP_TMK = 4608, CP_TMR = 6912, CP_TRU = 9216, CP_TRB = 11264, CP_TRV = 13312;
constexpr int CP_TT = 15360, CP_ARB = 15872, CP_AUKT = 16384, CP_H = 16896, CP_Q = 17408, CP_AUB = 17920, CP_G = 18944;
constexpr int CP_GT = CP_TMU, CP_WT = CP_TMB;

DI void cp_unit(const Params& p, char* W, int unit, int lane) {
    const int chain = unit / CK_NCH, c = unit % CK_NCH;
    const int b = chain >> 4, h = (chain >> 1) & 7, dir = chain & 1;
    const int q = lane & 15, g = lane >> 4;
    auto step_row = [&](int i) -> int {
        if (i < TCB) return TL + b * TCB + (dir == 0 ? i : TCB - 1 - i);
        const int jj = i - TCB;
        return b * TLB + (dir == 0 ? jj : TLB - 1 - jj);
    };
    {
        const float* SWd = p.SW + 2 * (h * 64 + lane) + dir;
        const unsigned* SBd = p.SBP + h * 64 + lane;
        const unsigned* SKDd = p.SKP + h * 64 + lane;
        const unsigned* SNd = p.SNV + h * 64 + lane;
        const unsigned* SRd = p.SRG + h * 64 + lane;
        float gam = 1.0f;
        unsigned pu[8], pb[8], pv[8];
        float lu = 0.f, lb = 0.f, lv = 0.f;
#pragma unroll
        for (int i4 = 0; i4 < 4; ++i4) {
            float w_[4], n_[4], b_[4], k_[4], r_[4], v_[4];
#pragma unroll
            for (int e = 0; e < 4; ++e) {
                const size_t ro = (size_t)step_row(c * 16 + 4 * i4 + e) * 512;
                w_[e] = SWd[2 * ro];
                { const unsigned nv = SNd[ro], bw = SBd[ro], kw = SKDd[ro], rw = SRd[ro];
                  n_[e] = bflo(nv); v_[e] = bfhi(nv); b_[e] = dir ? bfhi(bw) : bflo(bw); k_[e] = dir ? bfhi(kw) : bflo(kw); r_[e] = bflo(rw); }
            }
#pragma unroll
            for (int e = 0; e < 4; ++e) {
                const int i = 4 * i4 + e;
                const float gp = gam; gam *= w_[e];
                const float ig = 1.0f / gam;
                const float ut = gp * n_[e], bt = b_[e] * ig, kt = k_[e] * ig, rt = gam * r_[e];
                const unsigned wub = cvt_pk_bf16(ut, bt), wkr = cvt_pk_bf16(kt, rt);
                *(bf16_t*)(W + CP_TMU + i * 144 + lane * 2) = (bf16_t)(wub & 0xffff);
                *(bf16_t*)(W + CP_TMB + i * 144 + lane * 2) = (bf16_t)(wub >> 16);
                *(bf16_t*)(W + CP_TMK + i * 144 + lane * 2) = (bf16_t)(wkr & 0xffff);
                *(bf16_t*)(W + CP_TMR + i * 144 + lane * 2) = (bf16_t)(wkr >> 16);
                if (i & 1) { pu[i >> 1] = cvt_pk_bf16(lu, ut); pb[i >> 1] = cvt_pk_bf16(lb, bt); pv[i >> 1] = cvt_pk_bf16(lv, v_[e]); }
                else { lu = ut; lb = bt; lv = v_[e]; }
            }
        }
        *(u32x4*)(W + CP_TRU + lane * 32) = (u32x4){pu[0], pu[1], pu[2], pu[3]}; *(u32x4*)(W + CP_TRU + lane * 32 + 16) = (u32x4){pu[4], pu[5], pu[6], pu[7]};
        *(u32x4*)(W + CP_TRB + lane * 32) = (u32x4){pb[0], pb[1], pb[2], pb[3]}; *(u32x4*)(W + CP_TRB + lane * 32 + 16) = (u32x4){pb[4], pb[5], pb[6], pb[7]};
        *(u32x4*)(W + CP_TRV + lane * 32) = (u32x4){pv[0], pv[1], pv[2], pv[3]}; *(u32x4*)(W + CP_TRV + lane * 32 + 16) = (u32x4){pv[4], pv[5], pv[6], pv[7]};
        *(float*)(W + CP_G + lane * 4) = gam;
    }
    auto fr64 = [&](int off, int ks) -> bf16x8 { return *(const bf16x8*)(W + off + q * 144 + (32 * ks + 8 * g) * 2); };
    auto fr16 = [&](int off, int row) -> bf16x8 {
        u32x4 z = (u32x4){0u, 0u, 0u, 0u};
        if (g < 2) z = *(const u32x4*)(W + off + row * 32 + g * 16);
        return __builtin_bit_cast(bf16x8, z);
    };
    const f32x4 zero4 = (f32x4){0.f, 0.f, 0.f, 0.f};
    asm volatile("" ::: "memory");
    f32x4 arkT;
    {
        const bf16x8 fu0 = fr64(CP_TMU, 0), fu1 = fr64(CP_TMU, 1), fb0 = fr64(CP_TMB, 0), fb1 = fr64(CP_TMB, 1);
        const bf16x8 fk0 = fr64(CP_TMK, 0), fk1 = fr64(CP_TMK, 1), fr0 = fr64(CP_TMR, 0), fr1 = fr64(CP_TMR, 1);
        f32x4 d = mfma16(fb1, fu1, mfma16(fb0, fu0, zero4));
#pragma unroll
        for (int r = 0; r < 4; ++r) d[r] = (4 * g + r < q) ? d[r] : 0.f;
        *(f32x4*)(W + CP_AUB + q * 64 + 16 * g) = d;
        d = mfma16(fb1, fr1, mfma16(fb0, fr0, zero4));
#pragma unroll
        for (int r = 0; r < 4; ++r) d[r] = (4 * g + r <= q) ? d[r] : 0.f;
        { u32x2 w; w.x = cvt_pk_bf16(d[0], d[1]); w.y = cvt_pk_bf16(d[2], d[3]); *(u32x2*)(W + CP_ARB + q * 32 + 8 * g) = w; }
        d = mfma16(fu1, fk1, mfma16(fu0, fk0, zero4));
#pragma unroll
        for (int r = 0; r < 4; ++r) d[r] = (q < 4 * g + r) ? d[r] : 0.f;
        { u32x2 w; w.x = cvt_pk_bf16(d[0], d[1]); w.y = cvt_pk_bf16(d[2], d[3]); *(u32x2*)(W + CP_AUKT + q * 32 + 8 * g) = w; }
        arkT = mfma16(fk1, fr1, mfma16(fk0, fr0, zero4));
#pragma unroll
        for (int r = 0; r < 4; ++r) arkT[r] = (4 * g + r <= q) ? arkT[r] : 0.f;
    }
    asm volatile("" ::: "memory");
    {
        float t[16];
#pragma unroll
        for (int i = 0; i < 16; ++i) t[i] = 0.f;
#pragma unroll
        for (int i = 0; i < 16; ++i) {
            float s = (i == q) ? 1.0f : 0.f;
#pragma unroll
            for (int m4 = 0; m4 < 4; ++m4) {
                if (4 * m4 < i) {
                    const f32x4 a = *(const f32x4*)(W + CP_AUB + i * 64 + 16 * m4);
                    s += (a[0] * t[4 * m4] + a[1] * t[4 * m4 + 1]) + (a[2] * t[4 * m4 + 2] + a[3] * t[4 * m4 + 3]);
                }
            }
            t[i] = s;
        }
        if (g == 0) {
            *(u32x4*)(W + CP_TT + q * 32) = (u32x4){cvt_pk_bf16(t[0], t[1]), cvt_pk_bf16(t[2], t[3]), cvt_pk_bf16(t[4], t[5]), cvt_pk_bf16(t[6], t[7])};
            *(u32x4*)(W + CP_TT + q * 32 + 16) = (u32x4){cvt_pk_bf16(t[8], t[9]), cvt_pk_bf16(t[10], t[11]), cvt_pk_bf16(t[12], t[13]), cvt_pk_bf16(t[14], t[15])};
        }
    }
    asm volatile("" ::: "memory");
    {
        const f32x4 d = mfma16(fr16(CP_TT, q), fr16(CP_ARB, q), zero4);
        u32x2 w; w.x = cvt_pk_bf16(d[0], d[1]); w.y = cvt_pk_bf16(d[2], d[3]); *(u32x2*)(W + CP_H + q * 32 + 8 * g) = w;
    }
    asm volatile("" ::: "memory");
    {
        const f32x4 d = mfma16(fr16(CP_AUKT, q), fr16(CP_H, q), arkT);
        u32x2 w; w.x = cvt_pk_bf16(d[0], d[1]); w.y = cvt_pk_bf16(d[2], d[3]); *(u32x2*)(W + CP_Q + q * 32 + 8 * g) = w;
    }
    asm volatile("" ::: "memory");
    {
        const bf16x8 ft = fr16(CP_TT, q);
#pragma unroll
        for (int nt = 0; nt < 4; ++nt) {
            const f32x4 d = mfma16(ft, fr16(CP_TRB, 16 * nt + q), zero4);
            u32x2 w; w.x = cvt_pk_bf16(d[0], d[1]); w.y = cvt_pk_bf16(d[2], d[3]); *(u32x2*)(W + CP_GT + (16 * nt + q) * 32 + 8 * g) = w;
        }
    }
    asm volatile("" ::: "memory");
    {
        const bf16x8 fa = fr16(CP_AUKT, q);
#pragma unroll
        for (int nt = 0; nt < 4; ++nt) {
            f32x4 kt;
#pragma unroll
            for (int r = 0; r < 4; ++r) kt[r] = bf2f(*(const bf16_t*)(W + CP_TMK + (4 * g + r) * 144 + (16 * nt + q) * 2));
            const f32x4 d = mfma16(fa, fr16(CP_GT, 16 * nt + q), kt);
            u32x2 w; w.x = cvt_pk_bf16(d[0], d[1]); w.y = cvt_pk_bf16(d[2], d[3]); *(u32x2*)(W + CP_WT + (16 * nt + q) * 32 + 8 * g) = w;
        }
    }
    asm volatile("" ::: "memory");
    {
        const bf16x8 fh = fr16(CP_H, q), fq = fr16(CP_Q, q);
        bf16_t* RHg = p.CRH + (size_t)unit * 1024;
        bf16_t* P3g = p.CP3 + (size_t)unit * 1024;
        bf16_t* Mg = p.CM + (size_t)unit * 4096;
        bf16_t* Ng = p.CN + (size_t)unit * 4096;
#pragma unroll
        for (int mt = 0; mt < 4; ++mt) {
            const u32x2 rw = *(const u32x2*)(W + CP_TMR + q * 144 + (16 * mt + 4 * g) * 2);
            const f32x4 rt = (f32x4){bflo(rw.x), bfhi(rw.x), bflo(rw.y), bfhi(rw.y)};
            const f32x4 d = mfma16(fr16(CP_TRU, 16 * mt + q), fh, rt);
            u32x2 w; w.x = cvt_pk_bf16(d[0], d[1]); w.y = cvt_pk_bf16(d[2], d[3]);
            *(u32x2*)(RHg + (((mt >> 1) * 64 + lane) * 8 + (mt & 1) * 4)) = w;
        }
#pragma unroll
        for (int vs = 0; vs < 4; ++vs) {
            const f32x4 d = mfma16(fq, fr16(CP_TRV, 16 * vs + q), zero4);
            { u32x2 w; w.x = cvt_pk_bf16(d[0], d[1]); w.y = cvt_pk_bf16(d[2], d[3]); *(u32x2*)(P3g + (vs * 64 + lane) * 4) = w; }
        }
#pragma unroll
        for (int nt = 0; nt < 4; ++nt) {
            const bf16x8 fg = fr16(CP_GT, 16 * nt + q);
            const float gc = *(const float*)(W + CP_G + (16 * nt + q) * 4);
#pragma unroll
            for (int mt = 0; mt < 4; ++mt) {
                f32x4 d = mfma16(fr16(CP_TRU, 16 * mt + q), fg, zero4);
#pragma unroll
                for (int r = 0; r < 4; ++r) d[r] = gc * (d[r] + ((16 * mt + 4 * g + r == 16 * nt + q) ? 1.0f : 0.f));
                u32x2 w; w.x = cvt_pk_bf16(d[0], d[1]); w.y = cvt_pk_bf16(d[2], d[3]);
                *(u32x2*)(Mg + (((nt * 2 + (mt >> 1)) * 64 + lane) * 8 + (mt & 1) * 4)) = w;
            }
        }
#pragma unroll
        for (int mt = 0; mt < 4; ++mt) {
            const bf16x8 fw = fr16(CP_WT, 16 * mt + q);
            const f32x4 gc = *(const f32x4*)(W + CP_G + (16 * mt + 4 * g) * 4);
#pragma unroll
            for (int vs = 0; vs < 4; ++vs) {
                const f32x4 d = mfma16(fw, fr16(CP_TRV, 16 * vs + q), zero4) * gc;
                { u32x2 w; w.x = cvt_pk_bf16(d[0], d[1]); w.y = cvt_pk_bf16(d[2], d[3]); *(u32x2*)(Ng + ((vs * 4 + mt) * 64 + lane) * 4) = w; }
            }
        }
    }
    asm volatile("" ::: "memory");
}

DI void sq_wave(const Params& p, int chain, int vs, int lane) {
    const int b = chain >> 4, h = (chain >> 1) & 7, dir = chain & 1;
    const int q = lane & 15, g = lane >> 4;
    auto step_row = [&](int i) -> int {
        if (i < TCB) return TL + b * TCB + (dir == 0 ? i : TCB - 1 - i);
        const int jj = i - TCB;
        return b * TLB + (dir == 0 ? jj : TLB - 1 - jj);
    };
    float* YCd = p.YS + ((size_t)chain * CK_NCH * 4 + vs) * 256 + lane * 4;
    f32x4 st[4];
#pragma unroll
    for (int mt = 0; mt < 4; ++mt) st[mt] = (f32x4){0.f, 0.f, 0.f, 0.f};
    struct Ops { u32x4 m[4][2]; u32x4 r[2]; u32x2 n[4]; u32x2 p3; };
    auto load = [&](Ops& o, int c) {
        const size_t unit = (size_t)chain * CK_NCH + c;
        const bf16_t* Mg = p.CM + unit * 4096; const bf16_t* RHg = p.CRH + unit * 1024;
        const bf16_t* Ng = p.CN + unit * 4096 + (size_t)vs * 1024; const bf16_t* P3g = p.CP3 + unit * 1024 + vs * 256;
#pragma unroll
        for (int mt = 0; mt < 4; ++mt)
#pragma unroll
            for (int s = 0; s < 2; ++s) o.m[mt][s] = *(const u32x4*)(Mg + ((mt * 2 + s) * 64 + lane) * 8);
#pragma unroll
        for (int s = 0; s < 2; ++s) o.r[s] = *(const u32x4*)(RHg + (s * 64 + lane) * 8);
#pragma unroll
        for (int mt = 0; mt < 4; ++mt) o.n[mt] = *(const u32x2*)(Ng + (mt * 64 + lane) * 4);
        o.p3 = *(const u32x2*)(P3g + lane * 4);
    };
    auto stepc = [&](const Ops& o, int c) {
        const bf16x8 sb0 = pack8(st[0], st[1]), sb1 = pack8(st[2], st[3]);
        f32x4 y = mfma16(__builtin_bit_cast(bf16x8, o.r[0]), sb0, (f32x4){bflo(o.p3.x), bfhi(o.p3.x), bflo(o.p3.y), bfhi(o.p3.y)});
        y = mfma16(__builtin_bit_cast(bf16x8, o.r[1]), sb1, y);
#pragma unroll
        for (int mt = 0; mt < 4; ++mt) {
            f32x4 a = mfma16(__builtin_bit_cast(bf16x8, o.m[mt][0]), sb0, (f32x4){bflo(o.n[mt].x), bfhi(o.n[mt].x), bflo(o.n[mt].y), bfhi(o.n[mt].y)});
            st[mt] = mfma16(__builtin_bit_cast(bf16x8, o.m[mt][1]), sb1, a);
        }
        *(f32x4*)(YCd + ((size_t)c * 4) * 256) = y;
    };
    Ops oa, ob, oc;
    load(oa, 0); load(ob, 1); load(oc, 2);
    for (int c = 0; c < CK_NCH; c += 3) {
        stepc(oa, c);     __builtin_amdgcn_sched_barrier(0); load(oa, (c + 3 < CK_NCH) ? c + 3 : CK_NCH - 1); __builtin_amdgcn_sched_barrier(0);
        stepc(ob, c + 1); __builtin_amdgcn_sched_barrier(0); load(ob, (c + 4 < CK_NCH) ? c + 4 : CK_NCH - 1); __builtin_amdgcn_sched_barrier(0);
        stepc(oc, c + 2); __builtin_amdgcn_sched_barrier(0); load(oc, (c + 5 < CK_NCH) ? c + 5 : CK_NCH - 1); __builtin_amdgcn_sched_barrier(0);
    }
}

DI void na_block_unit(const Params& p, char* lds, int U) {
    const int tid = opaque_tid(), lane = tid & 63, wv = tid >> 6, q = lane & 15, g = lane >> 4;
    const bool lat = U < 1024;
    int b, r, hp, qb;
    if (lat) { hp = U & 3; r = (U >> 2) & 127; b = U >> 9; qb = 0; } else { const int V = U - 1024; qb = V & 3; hp = (V >> 2) & 3; b = V >> 4; r = 0; }
    const int hh = wv >> 2, w = wv & 3, h = 2 * hp + hh;
    const int j = 16 * w + q;
    const int qtok = lat ? (b * TLB + r * 64 + j) : (TL + b * TCB + 64 * qb + j);
    const int row_start = lat ? (r - 4 < 0 ? 0 : (r - 4 > 120 ? 120 : r - 4)) : 0;
    const int c0 = (w == 0 ? 0 : (w == 1 ? 8 : (w == 2 ? 24 : 32)));
    int cs = j - 8; cs = cs < 0 ? 0 : (cs > 48 ? 48 : cs);
    const int nch = lat ? 12 : 4, first_ctx = lat ? 8 : 0;
    bf16x8 qf[2];
#pragma unroll
    for (int ks = 0; ks < 2; ++ks) qf[ks] = *(const bf16x8*)(p.Q0 + (size_t)qtok * 512 + h * 64 + 32 * ks + 8 * g);
    u32x4 rk[2], rv[2];
    auto issue = [&](int ci) {
        const bool isctx = ci >= first_ctx;
        const int cc = ci - first_ctx;
#pragma unroll
        for (int i = 0; i < 2; ++i) {
            const int pc = tid + NTHR * i;
            const int key = pc >> 4, c16 = pc & 15;
            const int tok = isctx ? (TL + b * TCB + cc * 64 + key) : (b * TLB + (row_start + ci) * 64 + key);
            rk[i] = *(const u32x4*)(p.K0 + (size_t)tok * 512 + hp * 128 + c16 * 8);
            const int row = pc >> 3, k8 = pc & 7;
            const bf16_t* vsrc = isctx ? (p.VT0C + ((size_t)(b * 512 + hp * 128 + row)) * TCB + cc * 64 + k8 * 8)
                                       : (p.VT0L + ((size_t)(b * 512 + hp * 128 + row)) * TLB + (row_start + ci) * 64 + k8 * 8);
            rv[i] = *(const u32x4*)vsrc;
        }
    };
    auto stash = [&](char* st) {
#pragma unroll
        for (int i = 0; i < 2; ++i) {
            const int pc = tid + NTHR * i;
            const int key = pc >> 4, c16 = pc & 15;
            *(u32x4*)(st + (c16 >> 3) * 8192 + lds_byte(key, (c16 & 7) * 8)) = rk[i];
            const int row = pc >> 3, k8 = pc & 7;
            *(u32x4*)(st + 16384 + (row >> 6) * 8192 + lds_byte(row & 63, k8 * 8)) = rv[i];
        }
    };
    float m = -3.0e38f, sum = 0.f;
    f32x4 o[4];
#pragma unroll
    for (int dm = 0; dm < 4; ++dm) o[dm] = (f32x4){0.f, 0.f, 0.f, 0.f};
    auto qk = [&](const char* kimg, int kc0, f32x4 (&s)[2]) {
#pragma unroll
        for (int hf = 0; hf < 2; ++hf) {
            const int key = kc0 + 8 * (q >> 2) + 4 * hf + (q & 3);
            f32x4 a = (f32x4){0.f, 0.f, 0.f, 0.f};
#pragma unroll
            for (int ks = 0; ks < 2; ++ks) a = mfma16(*(const bf16x8*)(kimg + lds_byte(key, 32 * ks + 8 * g)), qf[ks], a);
            s[hf] = a;
        }
    };
    auto pv = [&](const char* vimg, int kc0, const f32x4 (&s)[2]) {
        const bf16x8 pb = pack8(s[0], s[1]);
#pragma unroll
        for (int dm = 0; dm < 4; ++dm) o[dm] = mfma16(*(const bf16x8*)(vimg + lds_byte(16 * dm + q, kc0 + 8 * g)), pb, o[dm]);
    };
    issue(0);
    stash(lds);
    __syncthreads();
    for (int ci = 0; ci < nch; ++ci) {
        const bool more = ci + 1 < nch;
        if (more) issue(ci + 1);
        const char* st = lds + (ci & 1) * 32768;
        const char* kimg = st + hh * 8192;
        const char* vimg = st + 16384 + hh * 8192;
        if (ci < first_ctx) {
            f32x4 s[2];
            qk(kimg, c0, s);
            const int row_off = row_start + ci - r + 7;
            float cmax = -3.0e38f;
#pragma unroll
            for (int hf = 0; hf < 2; ++hf)
#pragma unroll
                for (int rr = 0; rr < 4; ++rr) {
                    const int cc_ = c0 + 8 * g + 4 * hf + rr;
                    int co = cc_ - j; co = co < -15 ? -15 : (co > 15 ? 15 : co);
                    const bool in = (cc_ >= cs) && (cc_ < cs + 16);
                    const float bias = p.na_rpb[(h * 15 + row_off) * 31 + co + 15];
                    const float sv = in ? (s[hf][rr] * 0.125f + bias) : -1.0e30f;
                    s[hf][rr] = sv; cmax = fmaxf(cmax, sv);
                }
            cmax = fmaxf(cmax, __shfl_xor(cmax, 16)); cmax = fmaxf(cmax, __shfl_xor(cmax, 32));
            const float mn = fmaxf(m, cmax), al = __expf(m - mn);
            m = mn; sum *= al;
#pragma unroll
            for (int dm = 0; dm < 4; ++dm) o[dm] = o[dm] * al;
#pragma unroll
            for (int hf = 0; hf < 2; ++hf)
#pragma unroll
                for (int rr = 0; rr < 4; ++rr) { s[hf][rr] = __expf(s[hf][rr] - mn); sum += s[hf][rr]; }
            pv(vimg, c0, s);
        } else {
            f32x4 s0[2], s1[2];
            qk(kimg, 0, s0); qk(kimg, 32, s1);
            float cmax = -3.0e38f;
#pragma unroll
            for (int hf = 0; hf < 2; ++hf)
#pragma unroll
                for (int rr = 0; rr < 4; ++rr) { s0[hf][rr] *= 0.125f; s1[hf][rr] *= 0.125f; cmax = fmaxf(cmax, fmaxf(s0[hf][rr], s1[hf][rr])); }
            cmax = fmaxf(cmax, __shfl_xor(cmax, 16)); cmax = fmaxf(cmax, __shfl_xor(cmax, 32));
            const float mn = fmaxf(m, cmax), al = __expf(m - mn);
            m = mn; sum *= al;
#pragma unroll
            for (int dm = 0; dm < 4; ++dm) o[dm] = o[dm] * al;
#pragma unroll
            for (int hf = 0; hf < 2; ++hf)
#pragma unroll
                for (int rr = 0; rr < 4; ++rr) { s0[hf][rr] = __expf(s0[hf][rr] - mn); s1[hf][rr] = __expf(s1[hf][rr] - mn); sum += s0[hf][rr] + s1[hf][rr]; }
            pv(vimg, 0, s0); pv(vimg, 32, s1);
        }
        if (more) stash(lds + ((ci + 1) & 1) * 32768);
        __syncthreads();
    }
    sum += __shfl_xor(sum, 16); sum += __shfl_xor(sum, 32);
    const float inv = 1.0f / sum;
#pragma unroll
    for (int dm = 0; dm < 4; ++dm) {
        u32x2 wv_; wv_.x = cvt_pk_bf16(o[dm][0] * inv, o[dm][1] * inv); wv_.y = cvt_pk_bf16(o[dm][2] * inv, o[dm][3] * inv);
        *(u32x2*)(p.MIX + (size_t)qtok * 1024 + h * 64 + 16 * dm + 4 * g) = wv_;
    }
}

template <int PARTS = 3>
DI void ph_attn_cp(const Params& p, char* lds) {
    const int tz_ = opaque_tid(), lane = tz_ & 63, wv = tz_ >> 6;
    char* W = lds + wv * CPW;
    const int gw = blockIdx.x * 8 + wv, nw = (int)gridDim.x * 8;
    constexpr int NCP = 32 * CK_NCH;
    if (PARTS & 1) for (int U = gw; U < NCP; U += nw) cp_unit(p, W, U, lane);
    if (PARTS & 2) {
        __syncthreads();
        for (int U = blockIdx.x; U < 1024 + 32; U += gridDim.x) na_block_unit(p, lds, U);
    }
}
DI void ph_sq(const Params& p, char* lds) {
    const int tz_ = opaque_tid(), lane = tz_ & 63, wv = tz_ >> 6;
    const int nsq = gridDim.x >= 256 ? 128 : 0;
    if ((int)blockIdx.x < nsq) { if (wv == 0) sq_wave(p, blockIdx.x >> 2, blockIdx.x & 3, lane); return; }
    if (nsq == 0) { if (wv == 0) for (int u = blockIdx.x; u < 128; u += gridDim.x) sq_wave(p, u >> 2, u & 3, lane); __syncthreads(); }
    for (int U = (int)blockIdx.x - nsq; U < 1024 + 32; U += (int)gridDim.x - nsq) na_block_unit(p, lds, U);
}

DI void ph_rw_readout(const Params& p) {
    const int c = opaque_tid(), hh = c >> 6;
    const float gg = p.rw_gn_g[c], gb = p.rw_gn_b[c];
    for (int row = blockIdx.x; row < TT; row += gridDim.x) {
        const size_t o = (size_t)row * 512 + c;
        float y;
        {
            const bool lat = row < TL;
            const int bb = lat ? (row >> 13) : ((row - TL) >> 8), t = lat ? (row & (TLB - 1)) : ((row - TL) & (TCB - 1));
            const int pf = lat ? TCB + t : t, pb = lat ? TCB + (TLB - 1 - t) : (TCB - 1 - t);
            const int vs = (c >> 4) & 3, q = c & 15;
            const size_t cf = (size_t)((bb * 8 + hh) * 2 + 0) * CK_NCH + (pf >> 4), cb = (size_t)((bb * 8 + hh) * 2 + 1) * CK_NCH + (pb >> 4);
            y = p.YS[(cf * 4 + vs) * 256 + (16 * ((pf & 15) >> 2) + q) * 4 + (pf & 3)] + p.YS[(cb * 4 + vs) * 256 + (16 * ((pb & 15) >> 2) + q) * 4 + (pb & 3)];
        }
        const float mu = wave_allsum(y) * (1.0f / 64.0f);
        const float d = y - mu;
        const float var = wave_allsum(d * d) * (1.0f / 64.0f);
        const float yn = d * rsqrtf(var + 64e-5f) * gg + gb;
        const float outv = (yn + p.BONUS[row * 8 + hh] * bfhi(p.SNV[o])) * bfhi(p.SRG[o]);
        p.MIX[(size_t)row * 1024 + 512 + c] = (bf16_t)(cvt_pk_bf16(outv, 0.f) & 0xffff);
    }
}

DI void gemm_f32out(char* lds, const bf16_t* A, int M, const float* W, int N, float* C) {
    const int tid = opaque_tid();
    const int ntn = N / 128, ntm = M / 256;
    gemm_stream<4, 2, 4, 4, PtrLoaderF, 4>(lds, ntn * ntm, 16, [&](int u, PtrLoader<4>& al, PtrLoaderF& bl, const int (&nx)[4]) {
        int tm, tn; tile_of(u, ntm, ntn, tm, tn);
#pragma unroll
        for (int i = 0; i < 4; ++i) al.p[i] = (unsigned)((tm * 256 + a_row(tid) + 64 * i) * 1024 + a_c8(tid) * 8);
        al.base = A;
        fill_bf(bl, W, N, tn * 128, N);
    }, [&](int u, int (&nx)[4], int) {}, [&](int u, int mi, const f32x4 (&a)[4], f32x4 (&o)[4], int r0, int c0) {
#pragma unroll
        for (int ni = 0; ni < 4; ++ni) o[ni] = a[ni];
    }, [&](int u, int r, int c, f32x4 v, f32x4 pv) {
        int tm, tn; tile_of(u, ntm, ntn, tm, tn);
        *(f32x4*)(C + (size_t)(tm * 256 + r) * N + tn * 128 + c) = v;
    });
}

DI void ln_row(f32x4 (&v)[4], const float* g, const float* bta, int lane) {
    float s = 0.f;
#pragma unroll
    for (int i = 0; i < 4; ++i) s += (v[i][0] + v[i][1]) + (v[i][2] + v[i][3]);
    const float mu = wave_allsum(s) * (1.0f / 1024.0f);
    float q = 0.f;
#pragma unroll
    for (int i = 0; i < 4; ++i) { v[i] = v[i] - mu; q += (v[i][0] * v[i][0] + v[i][1] * v[i][1]) + (v[i][2] * v[i][2] + v[i][3] * v[i][3]); }
    const float rstd = rsqrtf(wave_allsum(q) * (1.0f / 1024.0f) + 1e-5f);
#pragma unroll
    for (int i = 0; i < 4; ++i) {
        const int c = 4 * lane + 256 * i;
        v[i] = v[i] * rstd * (*(const f32x4*)(g + c)) + (*(const f32x4*)(bta + c));
    }
}

template <int L>
DI void ph_ln1(const Params& p) {
    const int tz_ = opaque_tid(), lane = tz_ & 63, wv = tz_ >> 6;
    const int nrows = (L == 0) ? TT : TL;
    for (int row = blockIdx.x * 8 + wv; row < nrows; row += gridDim.x * 8) {
        const float* hin = (L == 0) ? (row < TL ? p.x + (size_t)row * 1024 : p.ctx + (size_t)(row - TL) * 1024) : p.HB + (size_t)row * 1024;
        const float* m = p.mods + (size_t)(L * 3 + mods_row(row)) * 6144;
        f32x4 v[4];
#pragma unroll
        for (int i = 0; i < 4; ++i) {
            const int c = 4 * lane + 256 * i;
            v[i] = ALPHA * (*(const f32x4*)(hin + c)) + (*(const f32x4*)(m + 2048 + c)) * (*(const f32x4*)(p.YL + (size_t)row * 1024 + c));
        }
        ln_row(v, p.ln_g + (L * 2 + 0) * 1024, p.ln_b + (L * 2 + 0) * 1024, lane);
#pragma unroll
        for (int i = 0; i < 4; ++i) {
            const int c = 4 * lane + 256 * i;
            *(f32x4*)(p.HA + (size_t)row * 1024 + c) = v[i];
            const f32x4 f = v[i] * (1.0f + *(const f32x4*)(m + 4096 + c)) + *(const f32x4*)(m + 3072 + c);
            u32x2 w; w.x = cvt_pk_bf16(f[0], f[1]); w.y = cvt_pk_bf16(f[2], f[3]);
            *(u32x2*)(p.Abuf + (size_t)row * 1024 + c) = w;
        }
    }
}

template <int CTRL, int RM> DI float dpp_keep(float x) {
    return __builtin_bit_cast(float, __builtin_amdgcn_update_dpp(__builtin_bit_cast(int, x), __builtin_bit_cast(int, x), CTRL, RM, 0xF, false));
}
DI float wave_max_uniform(float x) {
    x = fmaxf(x, dpp_keep<0xB1, 0xF>(x)); x = fmaxf(x, dpp_keep<0x4E, 0xF>(x));
    x = fmaxf(x, dpp_keep<0x141, 0xF>(x)); x = fmaxf(x, dpp_keep<0x140, 0xF>(x));
    x = fmaxf(x, dpp_keep<0x142, 0xA>(x)); x = fmaxf(x, dpp_keep<0x143, 0xC>(x));
    return __builtin_bit_cast(float, __builtin_amdgcn_readlane(__builtin_bit_cast(int, x), 63));
}
template <int L>
DI void ph_route(const Params& p, char* ldsc) {
    const int tz_ = opaque_tid(), lane = tz_ & 63, wv = tz_ >> 6;
    const int nrows = (L == 0) ? TT : TL;
    int* hist = (int*)ldsc;
    if (tz_ < 256) hist[tz_] = 0;
    __syncthreads();
    const f32x4 bias = *(const f32x4*)(p.moe_bias + L * 256 + 4 * lane);
    for (int row = blockIdx.x * 8 + wv; row < nrows; row += gridDim.x * 8) {
        const f32x4 lg = *(const f32x4*)(p.LOGITS + (size_t)row * 256 + 4 * lane);
        const float s0 = sigmoidf_(lg[0]), s1 = sigmoidf_(lg[1]), s2 = sigmoidf_(lg[2]), s3 = sigmoidf_(lg[3]);
        float v0 = s0 + bias[0], v1 = s1 + bias[1], v2 = s2 + bias[2], v3 = s3 + bias[3];
        float m1 = fmaxf(v0, v1), m2 = fminf(v0, v1);
        { const float a = fmaxf(v2, v3), bq = fminf(v2, v3); const float n1 = fmaxf(m1, a); const float n2 = fmaxf(fminf(m1, a), fmaxf(m2, bq)); m1 = n1; m2 = n2; }
        { const float o1 = dpp_keep<0xB1, 0xF>(m1), o2 = dpp_keep<0xB1, 0xF>(m2); const float n1 = fmaxf(m1, o1), n2 = fmaxf(fminf(m1, o1), fmaxf(m2, o2)); m1 = n1; m2 = n2; }
        { const float o1 = dpp_keep<0x4E, 0xF>(m1), o2 = dpp_keep<0x4E, 0xF>(m2); const float n1 = fmaxf(m1, o1), n2 = fmaxf(fminf(m1, o1), fmaxf(m2, o2)); m1 = n1; m2 = n2; }
        { const float o1 = dpp_keep<0x141, 0xF>(m1), o2 = dpp_keep<0x141, 0xF>(m2); const float n1 = fmaxf(m1, o1), n2 = fmaxf(fminf(m1, o1), fmaxf(m2, o2)); m1 = n1; m2 = n2; }
        const float gs = m1 + m2;
        const int myg = lane >> 3;
        int rank = 0;
#pragma unroll
        for (int gg = 0; gg < 8; ++gg) {
            const float og = __builtin_bit_cast(float, __builtin_amdgcn_readlane(__builtin_bit_cast(int, gs), gg * 8));
            rank += ((og > gs) || (og == gs && gg < myg)) ? 1 : 0;
        }
        if (rank >= 4) { v0 = -1.0e30f; v1 = -1.0e30f; v2 = -1.0e30f; v3 = -1.0e30f; }
        int sel_e = 0; float sel_s = 0.f, ssum = 0.f;
#pragma unroll
        for (int rd = 0; rd < 8; ++rd) {
            float bv = v0; int bi = 0; float bs = s0;
            if (v1 > bv) { bv = v1; bi = 1; bs = s1; }
            if (v2 > bv) { bv = v2; bi = 2; bs = s2; }
            if (v3 > bv) { bv = v3; bi = 3; bs = s3; }
            const float mx = wave_max_uniform(bv);
            const unsigned long long bal = __ballot(bv == mx);
            const int ol = __builtin_amdgcn_readfirstlane((int)__builtin_ctzll(bal));
            const int oi = __builtin_amdgcn_readlane(bi, ol);
            const float sv = __builtin_bit_cast(float, __builtin_amdgcn_readlane(__builtin_bit_cast(int, bs), ol));
            if (lane == ol) { if (oi == 0) v0 = -3.0e30f; else if (oi == 1) v1 = -3.0e30f; else if (oi == 2) v2 = -3.0e30f; else v3 = -3.0e30f; }
            ssum += sv;
            if (lane == rd) { sel_e = 4 * ol + oi; sel_s = sv; }
        }
        if (lane < 8) {
            p.EIDX[(size_t)row * 8 + lane] = sel_e;
            p.EW[(size_t)row * 8 + lane] = sel_s / ssum * 2.5f;
            atomicAdd(&hist[sel_e], 1);
        }
    }
    __syncthreads();
    if (tz_ < 256) p.HIST[((size_t)L * 256 + blockIdx.x) * 256 + tz_] = hist[tz_];
    __syncthreads();
}

template <int L>
DI void ph_scatter(const Params& p, char* ldsc) {
    int* sbase = (int*)ldsc;
    int* cursor = sbase + 320;
    const int tid = opaque_tid(), lane = tid & 63, wv = tid >> 6;
    const int nrows = (L == 0) ? TT : TL;
    int mypre = 0;
    if (tid < 256) {
        const int* hcol = p.HIST + (size_t)L * 256 * 256 + tid;
        int tot = 0;
#pragma unroll 16
        for (int bq = 0; bq < (int)gridDim.x; ++bq) { const int hv = hcol[bq * 256]; tot += hv; mypre += (bq < (int)blockIdx.x) ? hv : 0; }
        sbase[tid] = (tot + 255) & ~255;
    }
    __syncthreads();
    {
        int pd = 0, inc = 0;
        if (tid < 256) {
            pd = sbase[tid]; inc = pd;
#pragma unroll
            for (int d = 1; d < 64; d <<= 1) { const int t = __shfl_up(inc, d); if (lane >= d) inc += t; }
            if (lane == 63) sbase[288 + wv] = inc;
        }
        __syncthreads();
        if (tid < 256) {
            int off = 0;
#pragma unroll
            for (int w = 0; w < 3; ++w) off += (w < wv) ? sbase[288 + w] : 0;
            const int excl = inc - pd + off;
            sbase[tid] = excl;
            if (tid == 255) sbase[256] = excl + pd;
        }
    }
    __syncthreads();
    if (tid < 256) cursor[tid] = sbase[tid] + mypre;
    if (blockIdx.x == 0) {
        int* te = p.TILE_E + L * MAXTILES; int* tr = p.TILE_R0 + L * MAXTILES;
        if (tid < 256) { const int b0 = sbase[tid], b1 = sbase[tid + 1]; for (int r = b0; r < b1; r += 256) { te[r >> 8] = tid; tr[r >> 8] = r; } }
        const int nt = sbase[256] >> 8, nsh = nrows / 256;
        for (int i = tid; i < nsh; i += NTHR) { te[nt + i] = 256; tr[nt + i] = SH_BASE + 256 * i; }
        if (tid == 0) p.ictl[1024 + L] = nt + nsh;
    }
    __syncthreads();
    int* stok = p.SLOT_TOK + (size_t)L * NSLOT; float* sw = p.SLOT_W + (size_t)L * NSLOT;
    for (int row = blockIdx.x * 8 + wv; row < nrows; row += gridDim.x * 8) {
        if (lane < 8) {
            const int a = row * 8 + lane;
            const int e = p.EIDX[a];
            const int pos = atomicAdd(&cursor[e], 1);
            stok[pos] = row; sw[pos] = p.EW[a]; p.APOS[a] = pos;
        }
    }
    __syncthreads();
}

template <int L>
DI void ph_moe1(const Params& p, char* lds) {
    const int tid = opaque_tid();
    const int ntiles = p.ictl[1024 + L];
    const int* te = p.TILE_E + L * MAXTILES; const int* tr = p.TILE_R0 + L * MAXTILES;
    const int* stok = p.SLOT_TOK + (size_t)L * NSLOT;
    gemm_stream<4, 2, 4, 4, PtrLoaderF, 2>(lds, ntiles * 4, 16, [&](int u, PtrLoader<4>& al, PtrLoaderF& bl, const int (&nx)[4]) {
        const int ti = u >> 2, tn = u & 3;
        const int e = te[ti];
#pragma unroll
        for (int i = 0; i < 4; ++i) al.p[i] = (unsigned)(nx[i] * 1024 + a_c8(tid) * 8);
        al.base = p.Abuf;
        const float* gsrc = e < 256 ? p.moe_w_gate + ((size_t)(L * 256 + e)) * 1024 * 256 : p.sh_w_gate + (size_t)L * 1024 * 256;
        const float* usrc = e < 256 ? p.moe_w_up + ((size_t)(L * 256 + e)) * 1024 * 256 : p.sh_w_up + (size_t)L * 1024 * 256;
        bl.ld = 256; bl.base0 = gsrc; bl.base1 = usrc;
#pragma unroll
        for (int i = 0; i < 4; ++i) bl.p[i] = (unsigned)((tid >> 3) * 256 + 32 * (2 * tn + (i >> 1)) + (tid & 7) * 4);
    }, [&](int u, int (&nx)[4], int half) {
        const int row0 = tr[u >> 2];
#pragma unroll
        for (int i = 0; i < 4; ++i) if (half == 2 || (i >> 1) == half) nx[i] = stok[row0 + a_row(tid) + 64 * i];
    }, [&](int u, int mi, const f32x4 (&a)[4], f32x4 (&o)[2], int r0, int c0) {
#pragma unroll
        for (int ni = 0; ni < 2; ++ni)
#pragma unroll
            for (int j = 0; j < 4; ++j) o[ni][j] = siluf_(a[ni][j]) * a[ni + 2][j];
    }, [&](int u, int r, int c, f32x4 v, f32x4 pv) {
        const int ti = u >> 2, tn = u & 3;
        u32x2 w; w.x = cvt_pk_bf16(v[0], v[1]); w.y = cvt_pk_bf16(v[2], v[3]);
        *(u32x2*)(p.HBUF + (size_t)(tr[ti] + r) * 256 + tn * 64 + c) = w;
    });
}
template <int L>
DI void ph_moe2(const Params& p, char* lds) {
    const int tid = opaque_tid();
    const int ntiles = p.ictl[1024 + L];
    const int* te = p.TILE_E + L * MAXTILES; const int* tr = p.TILE_R0 + L * MAXTILES;
    const float* sw = p.SLOT_W + (size_t)L * NSLOT;
    float sc4[4] = {0.f, 0.f, 0.f, 0.f};
    gemm_stream<4, 2, 4, 4, PtrLoaderF, 4>(lds, ntiles * 8, 4, [&](int u, PtrLoader<4>& al, PtrLoaderF& bl, const int (&nx)[4]) {
        const int ti = u >> 3, tn = u & 7;
        const int e = te[ti], row0 = tr[ti];
#pragma unroll
        for (int i = 0; i < 4; ++i) al.p[i] = (unsigned)((row0 + a_row(tid) + 64 * i) * 256 + a_c8(tid) * 8);
        al.base = p.HBUF;
        const float* dsrc = e < 256 ? p.moe_w_down + ((size_t)(L * 256 + e)) * 256 * 1024 : p.sh_w_down + (size_t)L * 256 * 1024;
        fill_bf(bl, dsrc, 1024, tn * 128, 1024);
    }, [&](int u, int (&nx)[4], int) {}, [&](int u, int mi, const f32x4 (&a)[4], f32x4 (&o)[4], int r0, int c0) {
        if (mi == 0) {
            const float* s_ = sw + tr[u >> 3] + r0;
#pragma unroll
            for (int m = 0; m < 4; ++m) sc4[m] = s_[16 * m];
        }
#pragma unroll
        for (int ni = 0; ni < 4; ++ni) o[ni] = a[ni] * sc4[mi];
    }, [&](int u, int r, int c, f32x4 v, f32x4 pv) {
        const int ti = u >> 3, tn = u & 7;
        const int row = tr[ti] + r;
        u32x2 w; w.x = cvt_pk_bf16(v[0], v[1]); w.y = cvt_pk_bf16(v[2], v[3]);
        *(u32x2*)(p.YB + (size_t)row * 1024 + tn * 128 + c) = w;
    });
}

template <int L>
DI void ph_combine(const Params& p) {
    const int tz_ = opaque_tid(), lane = tz_ & 63, wv = tz_ >> 6;
    const int nrows = (L == 0) ? TT : TL;
    for (int row = blockIdx.x * 8 + wv; row < nrows; row += gridDim.x * 8) {
        int rr[9];
#pragma unroll
        for (int k = 0; k < 8; ++k) rr[k] = p.APOS[(size_t)row * 8 + k];
        rr[8] = SH_BASE + row;
        const float* m = p.mods + (size_t)(L * 3 + mods_row(row)) * 6144;
        f32x4 v[4];
#pragma unroll
        for (int i = 0; i < 4; ++i) {
            const int c = 4 * lane + 256 * i;
            f32x4 ff = (f32x4){0.f, 0.f, 0.f, 0.f};
#pragma unroll
            for (int k = 0; k < 9; ++k) {
                const u32x2 w = *(const u32x2*)(p.YB + (size_t)rr[k] * 1024 + c);
                ff[0] += bflo(w.x); ff[1] += bfhi(w.x); ff[2] += bflo(w.y); ff[3] += bfhi(w.y);
            }
            v[i] = ALPHA * (*(const f32x4*)(p.HA + (size_t)row * 1024 + c)) + (*(const f32x4*)(m + 5120 + c)) * ff;
        }
        ln_row(v, p.ln_g + (L * 2 + 1) * 1024, p.ln_b + (L * 2 + 1) * 1024, lane);
        if (L == 0) {
            const float* m1 = p.mods + (size_t)(1 * 3 + mods_row(row)) * 6144;
#pragma unroll
            for (int i = 0; i < 4; ++i) {
                const int c = 4 * lane + 256 * i;
                *(f32x4*)(p.HB + (size_t)row * 1024 + c) = v[i];
                const f32x4 a = v[i] * (1.0f + *(const f32x4*)(m1 + 1024 + c)) + *(const f32x4*)(m1 + c);
                u32x2 w; w.x = cvt_pk_bf16(a[0], a[1]); w.y = cvt_pk_bf16(a[2], a[3]);
                *(u32x2*)(p.Abuf + (size_t)row * 1024 + c) = w;
            }
        } else {
#pragma unroll
            for (int i = 0; i < 4; ++i) *(f32x4*)(p.out + (size_t)row * 1024 + 4 * lane + 256 * i) = v[i];
        }
    }
}

DI void gemm_router(char* lds, const bf16_t* A, int M, const float* W, float* C) {
    const int tid = opaque_tid();
    const int ntn = 2, ntm = M / 128;
    gemm_stream<2, 4, 4, 2, PtrLoaderF, 2>(lds, ntn * ntm, 16, [&](int u, PtrLoader<2>& al, PtrLoaderF& bl, const int (&nx)[4]) {
        int tm, tn; tile_of(u, ntm, ntn, tm, tn);
#pragma unroll
        for (int i = 0; i < 2; ++i) al.p[i] = (unsigned)((tm * 128 + a_row(tid) + 64 * i) * 1024 + a_c8(tid) * 8);
        al.base = A;
        fill_bf(bl, W, 256, tn * 128, 256);
    }, [&](int u, int (&nx)[4], int) {}, [&](int u, int mi, const f32x4 (&a)[2], f32x4 (&o)[2], int r0, int c0) {
#pragma unroll
        for (int ni = 0; ni < 2; ++ni) o[ni] = a[ni];
    }, [&](int u, int r, int c, f32x4 v, f32x4 pv) {
        int tm, tn; tile_of(u, ntm, ntn, tm, tn);
        *(f32x4*)(C + (size_t)(tm * 128 + r) * 256 + tn * 128 + c) = v;
    });
}

DI void ph_inproj1(const Params& p, char* lds) {
    const int tid = opaque_tid();
    constexpr int NTN = 25, NTM = 66;
    gemm_stream<4, 2, 4, 4, PtrLoaderF, 4>(lds, NTN * NTM, 16, [&](int u, PtrLoader<4>& al, PtrLoaderF& bl, const int (&nx)[4]) {
        int tm, tn; tile_of(u, NTM, NTN, tm, tn);
#pragma unroll
        for (int i = 0; i < 4; ++i) al.p[i] = (unsigned)((tm * 256 + a_row(tid) + 64 * i) * 1024 + a_c8(tid) * 8);
        al.base = p.Abuf;
        fill_bf(bl, p.od_w_in, ODC, tn * 128, ODC);
    }, [&](int u, int (&nx)[4], int) {}, [&](int u, int mi, const f32x4 (&a)[4], f32x4 (&o)[4], int r0, int c0) {
#pragma unroll
        for (int ni = 0; ni < 4; ++ni) o[ni] = a[ni];
    }, [&](int u, int r, int c, f32x4 v, f32x4 pv) {
        int tm, tn; tile_of(u, NTM, NTN, tm, tn);
        const int row = tm * 256 + r, col = tn * 128 + c;
        if (tn < 8 && row < TL) {
            const int t = row & (TLB - 1);
            const float pos = (c & 32) ? (float)(t & 63) : (float)(t >> 6);
            const float sgn = (c & 16) ? 1.0f : -1.0f;
#pragma unroll
            for (int j = 0; j < 4; ++j) {
                const float ang = pos * exp2f(-(float)((c & 15) + j) * (13.287712379549449f / 16.0f));
                v[j] = v[j] * __cosf(ang) + sgn * pv[j] * __sinf(ang);
            }
            if (tn < 4) v = v * 0.125f;
        }
        if (tn < 24) {
            u32x2 w; w.x = cvt_pk_bf16(v[0], v[1]); w.y = cvt_pk_bf16(v[2], v[3]);
            *(u32x2*)(p.P1 + (size_t)row * 3072 + col) = w;
        } else if (col < ODC) *(f32x4*)(p.G1 + (size_t)row * 32 + (col - 3072)) = v;
    });
}

DI float wave_incl_sum(float v, int lane) {
#pragma unroll
    for (int d = 1; d < 64; d <<= 1) { const float t = __shfl_up(v, d); if (lane >= d) v += t; }
    return v;
}
DI float wave_incl_max(float v, int lane) {
#pragma unroll
    for (int d = 1; d < 64; d <<= 1) { const float t = __shfl_up(v, d); if (lane >= d) v = fmaxf(v, t); }
    return v;
}
DI void ml_gates(const Params& p, float* G, int row0, int h, float& ig, float& bc, float& tot, int& idx) {
    const int tid = opaque_tid(), lane = tid & 63, wv = tid >> 6;
    const int gi = (tid >> 7) & 1, e = tid & 127;
    idx = gi == 0 ? e : 127 - e;
    float c = 0.f; ig = 0.f;
    if (tid < 256) {
        const float* g = p.G1 + (size_t)(row0 + idx) * 32;
        ig = g[8 * gi + h] + p.ml_gate_b[8 * gi + h];
        const float lf = logsigmoidf_(g[16 + 8 * gi + h] + p.ml_gate_b[16 + 8 * gi + h]);
        c = wave_incl_sum(lf, lane);
        if (lane == 63) G[768 + wv] = c;
    }
    __syncthreads();
    if (tid < 256) {
        if (wv & 1) c += G[768 + wv - 1];
        G[gi * 128 + idx] = ig; G[256 + gi * 128 + idx] = c;
        if (e == 127) G[776 + gi] = c;
    }
    __syncthreads();
    bc = c; tot = G[776 + gi];
}

constexpr int MLC_T = 4096, MLC_TS = 392;
DI void ph_ml_chunks(const Params& p, char* ldsc) {
    float* G = (float*)ldsc;
    const int tid = opaque_tid(), lane = tid & 63, wv = tid >> 6, fr = lane & 15, fq = lane >> 4;
    for (int u = blockIdx.x; u < 1056; u += gridDim.x) {
        const bool lat = u < 1024;
        const int bh = lat ? (u >> 6) : ((u - 1024) >> 1), blk = lat ? (u & 63) : ((u - 1024) & 1);
        const int b = bh >> 3, h = bh & 7;
        const int Tseq = lat ? TLB : TCB;
        const int row0 = (lat ? b * TLB : TL + b * TCB) + blk * 128;
        {
            u32x4 rr[6];
#pragma unroll
            for (int i = 0; i < 6; ++i) {
                const int qd = tid + NTHR * i, row = qd / 24, cc = qd % 24;
                rr[i] = *(const u32x4*)(p.P1 + (size_t)(row0 + row) * 3072 + (cc < 8 ? 512 + h * 64 + cc * 8 : 1024 + h * 128 + (cc - 8) * 8));
            }
#pragma unroll
            for (int i = 0; i < 6; ++i) {
                const int qd = tid + NTHR * i, row = qd / 24, cc = qd % 24;
                char* d = ldsc + MLC_T + row * MLC_TS + cc * 16;
                *(u32x2*)d = (u32x2){rr[i].x, rr[i].y}; *(u32x2*)(d + 8) = (u32x2){rr[i].z, rr[i].w};
            }
        }
        float ig, bc, tot; int idx;
        ml_gates(p, G, row0, h, ig, bc, tot, idx);
        const float gl = tot - bc + ig;
        float mw = (tid < 256) ? wave_allmax(gl) : 0.f;
        if (tid < 256 && lane == 0) G[784 + wv] = mw;
        __syncthreads();
        if (tid < 256) {
            const int gi = tid >> 7;
            const float mc = fmaxf(G[784 + 2 * gi], G[784 + 2 * gi + 1]);
            G[512 + gi * 128 + idx] = __expf(gl - mc);
            if ((tid & 127) == 0) { p.BEMC[u * 4 + gi * 2 + 0] = tot; p.BEMC[u * 4 + gi * 2 + 1] = mc; }
        }
        __syncthreads();
        auto col8 = [&](int col, int l0) -> u32x4 {
            const char* s_ = ldsc + MLC_T + l0 * MLC_TS + col * 2;
            u32x4 w;
            w.x = (unsigned)*(const unsigned short*)(s_) | ((unsigned)*(const unsigned short*)(s_ + MLC_TS) << 16);
            w.y = (unsigned)*(const unsigned short*)(s_ + 2 * MLC_TS) | ((unsigned)*(const unsigned short*)(s_ + 3 * MLC_TS) << 16);
            w.z = (unsigned)*(const unsigned short*)(s_ + 4 * MLC_TS) | ((unsigned)*(const unsigned short*)(s_ + 5 * MLC_TS) << 16);
            w.w = (unsigned)*(const unsigned short*)(s_ + 6 * MLC_TS) | ((unsigned)*(const unsigned short*)(s_ + 7 * MLC_TS) << 16);
            return w;
        };
        f32x4 accf[4], accb[4];
#pragma unroll
        for (int n = 0; n < 4; ++n) { accf[n] = (f32x4){0.f, 0.f, 0.f, 0.f}; accb[n] = accf[n]; }
#pragma unroll
        for (int ks = 0; ks < 4; ++ks) {
            const int l0 = 32 * ks + 8 * fq;
            const bf16x8 va = __builtin_bit_cast(bf16x8, col8(64 + 16 * wv + fr, l0));
            const f32x4 wfa = *(const f32x4*)(G + 512 + l0), wfb = *(const f32x4*)(G + 512 + l0 + 4);
            const f32x4 wba = *(const f32x4*)(G + 640 + l0), wbb = *(const f32x4*)(G + 640 + l0 + 4);
#pragma unroll
            for (int n = 0; n < 4; ++n) {
                const u32x4 kr = col8(16 * n + fr, l0);
                const float k0 = bflo(kr.x), k1 = bfhi(kr.x), k2 = bflo(kr.y), k3 = bfhi(kr.y), k4 = bflo(kr.z), k5 = bfhi(kr.z), k6 = bflo(kr.w), k7 = bfhi(kr.w);
                u32x4 kf, kb;
                kf.x = cvt_pk_bf16(k0 * wfa[0], k1 * wfa[1]); kf.y = cvt_pk_bf16(k2 * wfa[2], k3 * wfa[3]);
                kf.z = cvt_pk_bf16(k4 * wfb[0], k5 * wfb[1]); kf.w = cvt_pk_bf16(k6 * wfb[2], k7 * wfb[3]);
                kb.x = cvt_pk_bf16(k0 * wba[0], k1 * wba[1]); kb.y = cvt_pk_bf16(k2 * wba[2], k3 * wba[3]);
                kb.z = cvt_pk_bf16(k4 * wbb[0], k5 * wbb[1]); kb.w = cvt_pk_bf16(k6 * wbb[2], k7 * wbb[3]);
                accf[n] = mfma16(va, __builtin_bit_cast(bf16x8, kf), accf[n]);
                accb[n] = mfma16(va, __builtin_bit_cast(bf16x8, kb), accb[n]);
            }
        }
        float* kvt = p.KVT + (size_t)u * 2 * 8192;
#pragma unroll
        for (int n = 0; n < 4; ++n)
#pragma unroll
            for (int j = 0; j < 4; ++j) {
                kvt[(16 * wv + 4 * fq + j) * 64 + 16 * n + fr] = accf[n][j];
                kvt[8192 + (16 * wv + 4 * fq + j) * 64 + 16 * n + fr] = accb[n][j];
            }
        if (tid < 128) {
            const int d = tid >> 6, k = tid & 63;
            float s = 0.f;
#pragma unroll 4
            for (int l = 0; l < 128; l += 8) {
                const u32x4 kq = col8(k, l);
                const f32x4 wa = *(const f32x4*)(G + 512 + d * 128 + l), wb = *(const f32x4*)(G + 512 + d * 128 + l + 4);
                s += bflo(kq.x) * wa[0] + bfhi(kq.x) * wa[1] + bflo(kq.y) * wa[2] + bfhi(kq.y) * wa[3]
                   + bflo(kq.z) * wb[0] + bfhi(kq.z) * wb[1] + bflo(kq.w) * wb[2] + bfhi(kq.w) * wb[3];
            }
            p.KS[(size_t)u * 128 + d * 64 + k] = s;
        }
        if (lat) {
            const int v = tid >> 2, part = tid & 3;
            bf16_t* dst = p.V1TL + ((size_t)(b * 1024 + h * 128 + v)) * TLB + blk * 128;
#pragma unroll
            for (int i = 0; i < 4; ++i) {
                const int tg = part + 4 * i;
                *(u32x4*)(dst + 8 * tg) = col8(64 + v, 8 * tg);
            }
        }
        __syncthreads();
    }
}

DI void ph_ml_scan(const Params& p) {
    const int tid = opaque_tid();
    for (int w = blockIdx.x; w < 256; w += gridDim.x) {
        const int chain = w & 31, slice = w >> 5;
        const int bh = chain >> 1, dir = chain & 1;
        const int e0 = slice * 1024 + tid * 2;
        float c0 = 0.f, c1 = 0.f, nn = 0.f, m = 0.f;
        const bool hasn = (slice == 0 && tid < 64);
        auto unit_of = [&](int s) -> int {
            if (s < 2) return 1024 + bh * 2 + (dir == 0 ? s : 1 - s);
            const int jj = s - 2; return bh * 64 + (dir == 0 ? jj : 63 - jj);
        };
        typedef float f32x2 __attribute__((ext_vector_type(2)));
        constexpr int DP = 6;
        f32x2 kvq[DP], bmq[DP]; float ksq[DP];
        const int nl = tid & 63;
#pragma unroll
        for (int j = 0; j < DP; ++j) {
            const int un = unit_of(j);
            kvq[j] = *(const f32x2*)(p.KVT + ((size_t)un * 2 + dir) * 8192 + e0);
            bmq[j] = *(const f32x2*)(p.BEMC + un * 4 + dir * 2);
            ksq[j] = p.KS[(size_t)un * 128 + dir * 64 + nl];
        }
#pragma unroll 1
        for (int s0 = 0; s0 < 66; s0 += DP) {
#pragma unroll
            for (int j = 0; j < DP; ++j) {
                const int s = s0 + j;
                const int u = unit_of(s);
                const f32x2 kv = kvq[j], bm = bmq[j]; const float ksv = ksq[j];
                {
                    const int sn = s + DP < 66 ? s + DP : 65;
                    const int un = unit_of(sn);
                    kvq[j] = *(const f32x2*)(p.KVT + ((size_t)un * 2 + dir) * 8192 + e0);
                    bmq[j] = *(const f32x2*)(p.BEMC + un * 4 + dir * 2);
                    ksq[j] = p.KS[(size_t)un * 128 + dir * 64 + nl];
                }
                {
                    bf16_t* ct = p.C0T + ((size_t)u * 2 + dir) * 8192;
                    *(unsigned*)(ct + e0) = cvt_pk_bf16(c0, c1);
                    if (hasn) p.N0[((size_t)u * 2 + dir) * 64 + tid] = nn;
                    if (slice == 0 && tid == 0) p.M0[u * 2 + dir] = m;
                }
                const float be = bm[0], mc = bm[1];
                const float mn = fmaxf(be + m, mc);
                const float fa = __expf(be + m - mn), fb = __expf(mc - mn);
                c0 = fa * c0 + fb * kv[0]; c1 = fa * c1 + fb * kv[1];
                nn = fa * nn + fb * ksv;
                m = mn;
            }
        }
    }
}

constexpr int MLO_K = 8192, MLO_VT = MLO_K + 16384, MLO_VTS = 272, MLO_C0 = MLO_VT + 128 * MLO_VTS, MLO_HS = 8192;
DI void ph_ml_out(const Params& p, char* ldsc) {
    float* G = (float*)ldsc;
    const int tid = opaque_tid(), lane = tid & 63, wv = tid >> 6, q = lane & 15, g = lane >> 4;
    for (int u = blockIdx.x; u < 1024; u += gridDim.x) {
        const int bh = u >> 6, blk = u & 63, b = bh >> 3, h = bh & 7;
        const int row0 = b * TLB + blk * 128;
        {
            u32x4 rk[2], rv[4], rc[4];
#pragma unroll
            for (int i = 0; i < 2; ++i) { const int pc = tid + i * NTHR; rk[i] = *(const u32x4*)(p.P1 + (size_t)(row0 + (pc >> 3)) * 3072 + 512 + h * 64 + (pc & 7) * 8); }
#pragma unroll
            for (int i = 0; i < 4; ++i) { const int pc = tid + i * NTHR; rv[i] = *(const u32x4*)(p.V1TL + ((size_t)(b * 1024 + h * 128 + (pc >> 4))) * TLB + blk * 128 + (pc & 15) * 8); }
#pragma unroll
            for (int i = 0; i < 4; ++i) { const int pc = tid + i * NTHR; rc[i] = *(const u32x4*)(p.C0T + (size_t)u * 2 * 8192 + (size_t)pc * 8); }
#pragma unroll
            for (int i = 0; i < 2; ++i) { const int pc = tid + i * NTHR; *(u32x4*)(ldsc + MLO_K + lds_byte(pc >> 3, (pc & 7) * 8)) = rk[i]; }
#pragma unroll
            for (int i = 0; i < 4; ++i) { const int pc = tid + i * NTHR; *(u32x4*)(ldsc + MLO_VT + (pc >> 4) * MLO_VTS + (pc & 15) * 16) = rv[i]; }
#pragma unroll
            for (int i = 0; i < 4; ++i) { const int pc = tid + i * NTHR; const int dd = pc >> 10, rr = (pc >> 3) & 127; *(u32x4*)(ldsc + MLO_C0 + dd * 16384 + lds_byte(rr, (pc & 7) * 8)) = rc[i]; }
        }
        float ig, bc, tot; int idx;
        ml_gates(p, G, row0, h, ig, bc, tot, idx);
        const float m0f = p.M0[u * 2 + 0], m0b = p.M0[u * 2 + 1];
        {
            float pm = (tid < 256) ? wave_incl_max(ig - bc, lane) : 0.f;
            if (tid < 256 && lane == 63) G[768 + wv] = pm;
            __syncthreads();
            if (tid < 256) {
                if (wv & 1) pm = fmaxf(pm, G[768 + wv - 1]);
                const int gi = tid >> 7;
                G[512 + gi * 128 + idx] = fmaxf(bc + pm, bc + (gi == 0 ? m0f : m0b));
            }
            __syncthreads();
        }
        const int tl = 16 * wv + q;
        const int trow = row0 + tl;
        bf16x8 qf[2];
#pragma unroll
        for (int ks = 0; ks < 2; ++ks) qf[ks] = *(const bf16x8*)(p.P1 + (size_t)trow * 3072 + h * 64 + 32 * ks + 8 * g);
        f32x4 st_[8];
#pragma unroll
        for (int st = 0; st < 8; ++st) {
            f32x4 s = (f32x4){0.f, 0.f, 0.f, 0.f};
#pragma unroll
            for (int ks = 0; ks < 2; ++ks) s = mfma16(*(const bf16x8*)(ldsc + MLO_K + lds_byte(16 * st + q, 32 * ks + 8 * g)), qf[ks], s);
            st_[st] = s;
        }
        f32x4 hsum[8];
#pragma unroll
        for (int vm = 0; vm < 8; ++vm) hsum[vm] = (f32x4){0.f, 0.f, 0.f, 0.f};
#pragma unroll 1
        for (int dir = 0; dir < 2; ++dir) {
            const float mt = G[512 + dir * 128 + tl];
            const float bt = G[256 + dir * 128 + tl];
            const float m0 = dir == 0 ? m0f : m0b;
            const float iw = __expf(bt + m0 - mt);
            const float* n0 = p.N0 + ((size_t)u * 2 + dir) * 64;
            float qn = 0.f;
#pragma unroll
            for (int ks = 0; ks < 2; ++ks) {
                const u32x4 w = __builtin_bit_cast(u32x4, qf[ks]);
                const f32x4 na = *(const f32x4*)(n0 + 32 * ks + 8 * g), nb = *(const f32x4*)(n0 + 32 * ks + 8 * g + 4);
                qn += bflo(w.x) * na[0] + bfhi(w.x) * na[1] + bflo(w.y) * na[2] + bfhi(w.y) * na[3] + bflo(w.z) * nb[0] + bfhi(w.z) * nb[1] + bflo(w.w) * nb[2] + bfhi(w.w) * nb[3];
            }
            qn += __shfl_xor(qn, 16); qn += __shfl_xor(qn, 32);
            f32x4 acc[8];
            const char* c0s = ldsc + MLO_C0 + dir * 16384;
#pragma unroll
            for (int vm = 0; vm < 8; ++vm) {
                f32x4 a = (f32x4){0.f, 0.f, 0.f, 0.f};
#pragma unroll
                for (int ks = 0; ks < 2; ++ks) a = mfma16(*(const bf16x8*)(c0s + lds_byte(16 * vm + q, 32 * ks + 8 * g)), qf[ks], a);
                acc[vm] = a * iw;
            }
            float rs = 0.f;
#pragma unroll
            for (int uu = 0; uu < 4; ++uu) {
                const bool need = dir == 0 ? (2 * uu <= wv) : (2 * uu + 1 >= wv);
                if (need) {
                    f32x4 pw[2];
#pragma unroll
                    for (int hf = 0; hf < 2; ++hf) {
                        const int st = 2 * uu + hf;
                        const f32x4 bs = *(const f32x4*)(G + 256 + dir * 128 + 16 * st + 4 * g);
                        const f32x4 is = *(const f32x4*)(G + dir * 128 + 16 * st + 4 * g);
                        f32x4 w;
#pragma unroll
                        for (int r = 0; r < 4; ++r) {
                            const int s = 16 * st + 4 * g + r;
                            const bool ok = dir == 0 ? (s <= tl) : (s >= tl);
                            const float dw = ok ? __expf(bt - bs[r] + is[r] - mt) : 0.f;
                            w[r] = st_[st][r] * dw;
                            rs += w[r];
                        }
                        pw[hf] = w;
                    }
                    const bf16x8 pb = pack8(pw[0], pw[1]);
#pragma unroll
                    for (int vm = 0; vm < 8; ++vm) {
                        const char* vr = ldsc + MLO_VT + (16 * vm + q) * MLO_VTS + (32 * uu + 4 * g) * 2;
                        const bf16x8 va = join8(*(const u32x2*)vr, *(const u32x2*)(vr + 32));
                        acc[vm] = mfma16(va, pb, acc[vm]);
                    }
                }
            }
            rs += __shfl_xor(rs, 16); rs += __shfl_xor(rs, 32);
            const float den = rs + iw * qn;
            const float dn = 1.0f / fmaxf(fabsf(den), __expf(-mt));
#pragma unroll
            for (int vm = 0; vm < 8; ++vm) hsum[vm] += acc[vm] * dn;
        }
        __syncthreads();
        float* HS = (float*)(ldsc + MLO_HS);
#pragma unroll
        for (int vm = 0; vm < 8; ++vm) *(f32x4*)(HS + tl * 132 + 16 * vm + 4 * g) = hsum[vm];
        __syncthreads();
        {
            const int t = tid >> 2, vq = (tid & 3) * 4;
            const float* hr = HS + t * 132 + vq;
            f32x4 hv[8];
            float ss = 0.f;
#pragma unroll
            for (int i = 0; i < 8; ++i) { hv[i] = *(const f32x4*)(hr + 16 * i); ss += (hv[i][0] * hv[i][0] + hv[i][1] * hv[i][1]) + (hv[i][2] * hv[i][2] + hv[i][3] * hv[i][3]); }
            ss += __shfl_xor(ss, 1); ss += __shfl_xor(ss, 2);
            const float rn = rsqrtf(ss * (1.0f / 128.0f) + 1e-6f);
            const size_t orow = (size_t)(row0 + t) * 1024 + h * 128 + vq;
#pragma unroll
            for (int i = 0; i < 8; ++i) {
                const f32x4 ng = *(const f32x4*)(p.ml_norm_g + h * 128 + vq + 16 * i);
                const u32x2 ow = *(const u32x2*)(p.P1 + (size_t)(row0 + t) * 3072 + 2048 + h * 128 + vq + 16 * i);
                f32x4 o;
                o[0] = hv[i][0] * rn * ng[0] * sigmoidf_(bflo(ow.x)); o[1] = hv[i][1] * rn * ng[1] * sigmoidf_(bfhi(ow.x));
                o[2] = hv[i][2] * rn * ng[2] * sigmoidf_(bflo(ow.y)); o[3] = hv[i][3] * rn * ng[3] * sigmoidf_(bfhi(ow.y));
                u32x2 w; w.x = cvt_pk_bf16(o[0], o[1]); w.y = cvt_pk_bf16(o[2], o[3]);
                *(u32x2*)(p.MIX + orow + 16 * i) = w;
            }
        }
        __syncthreads();
    }
}


#ifndef PROBE_MODE
#define PROBE_MODE 0
#endif
DI void ph_probe(const Params& p, char* lds) {
#if PROBE_MODE >= 1 && PROBE_MODE <= 4
    const int tid = opaque_tid();
    constexpr int NTN = 26, NTM = 66;
    gemm_stream<4, 2, 4, 4, PtrLoaderF, 4, PROBE_MODE>(lds, NTN * NTM, 16, [&](int u, PtrLoader<4>& al, PtrLoaderF& bl, const int (&nx)[4]) {
        int tm, tn; tile_of(u, NTM, NTN, tm, tn);
#pragma unroll
        for (int i = 0; i < 4; ++i) al.p[i] = (unsigned)((tm * 256 + a_row(tid) + 64 * i) * 1024 + a_c8(tid) * 8);
        al.base = p.Abuf;
        fill_bf(bl, p.ev_w_in, EVC, tn * 128, EVC);
    }, [&](int u, int (&nx)[4], int) {}, [&](int u, int mi, const f32x4 (&a)[4], f32x4 (&o)[4], int r0, int c0) {
#pragma unroll
        for (int ni = 0; ni < 4; ++ni) o[ni] = a[ni];
    }, [&](int u, int r, int c, f32x4 v, f32x4 pv) {
        int tm, tn; tile_of(u, NTM, NTN, tm, tn);
        const int row = tm * 256 + r, col = tn * 128 + c;
        if (tn < 12) {
            bf16_t* dst = (tn < 4 ? p.Q0 + col : (tn < 8 ? p.K0 + (col - 512) : p.V0 + (col - 1024))) + (size_t)row * 512;
            u32x2 w; w.x = cvt_pk_bf16(v[0], v[1]); w.y = cvt_pk_bf16(v[2], v[3]);
            *(u32x2*)dst = w;
        } else if (col < EVC) {
            *(f32x4*)(p.RWP + (size_t)row * RWC + (col - 1536)) = v;
        }
    });
#endif
}
constexpr int NPHASE = 27;
template <int PH>
DI void run_phase(const Params& p, char* lds) {
    if (PH == 0) ph_prologue(p, lds);
    if (PH == 1) ph_modulate0(p);
    if (PH == 2) ph_inproj0(p, lds);
    if (PH == 3) { for (int j = blockIdx.x; j < (TT / 64) * 8; j += gridDim.x) transpose_tile(lds, p.V0, 512, (j >> 3) * 64, (j & 7) * 64, p.VT0L, p.VT0C, 512); ph_rw_prep(p, lds); }
    if (PH == 4) ph_attn_cp<1>(p, lds);
    if (PH == 5) ph_sq(p, lds);
    if (PH == 6) ph_rw_readout(p);
    if (PH == 7) gemm_f32out(lds, p.MIX, TT, p.ev_w_out, 1024, p.YL);
    if (PH == 8) ph_ln1<0>(p);
    if (PH == 9) gemm_router(lds, p.Abuf, TT, p.moe_router, p.LOGITS);
    if (PH == 10) ph_route<0>(p, lds);
    if (PH == 11) ph_scatter<0>(p, lds);
    if (PH == 12) ph_moe1<0>(p, lds);
    if (PH == 13) ph_moe2<0>(p, lds);
    if (PH == 14) ph_combine<0>(p);
    if (PH == 15) ph_inproj1(p, lds);
    if (PH == 17) ph_ml_chunks(p, lds);
    if (PH == 18) ph_ml_scan(p);
    if (PH == 19) ph_ml_out(p, lds);
    if (PH == 20) gemm_f32out(lds, p.MIX, TL, p.od_w_out, 1024, p.YL);
    if (PH == 21) ph_ln1<1>(p);
    if (PH == 22) gemm_router(lds, p.Abuf, TL, p.moe_router + 1024 * 256, p.LOGITS);
    if (PH == 23) ph_route<1>(p, lds);
    if (PH == 24) ph_scatter<1>(p, lds);
    if (PH == 25) ph_moe1<1>(p, lds);
    if (PH == 26) ph_moe2<1>(p, lds);
    if (PH == 27) ph_combine<1>(p);
    if (PH == 28) { if (PROBE_MODE >= 1 && PROBE_MODE <= 4) ph_probe(p, lds); if (PROBE_MODE == 5) ph_attn_cp(p, lds); if (PROBE_MODE == 6) ph_sq(p, lds); if (PROBE_MODE == 7) ph_rw_prep(p, lds); if (PROBE_MODE == 17) ph_rw_prep<1>(p, lds); if (PROBE_MODE == 8) ph_attn_cp<1>(p, lds); if (PROBE_MODE == 9) ph_attn_cp<2>(p, lds); if (PROBE_MODE == 10) ph_route<0>(p, lds); if (PROBE_MODE == 11) ph_scatter<0>(p, lds); if (PROBE_MODE == 12) { ph_prologue(p, lds); } if (PROBE_MODE == 13) ph_rw_readout(p); if (PROBE_MODE == 14) gemm_f32out(lds, p.MIX, TT, p.ev_w_out, 1024, p.YL); if (PROBE_MODE == 15) { ph_ml_chunks(p, lds); } if (PROBE_MODE == 16) ph_ml_out(p, lds); }
}

#if MK_MULTI
template <int PH>
__global__ void __launch_bounds__(NTHR, 2) k_phase(Params p) {
    extern __shared__ __attribute__((aligned(16))) char lds[];
    run_phase<PH>(p, lds);
}
#else
template <int PH> struct PhaseSeq {
    static DI void run(const Params& p, char* lds, const XcdBarrier& bar) {
        PhaseSeq<PH - 1>::run(p, lds, bar);
        if constexpr (PH == 16) return;
        xcd_barrier(bar);
        if constexpr (((PROBE_DUP >> PH) & 1ull) != 0) {
            const int reps = 1 + (int)(__builtin_amdgcn_s_getreg((3 << 11) | 20) < 64u);
#pragma unroll 1
            for (int rep = 0; rep < reps; ++rep) run_phase<PH>(p, lds);
        } else run_phase<PH>(p, lds);
    }
};
template <> struct PhaseSeq<0> {
    static DI void run(const Params& p, char* lds, const XcdBarrier&) { if (PROBE_DUP & 1ull) run_phase<0>(p, lds); run_phase<0>(p, lds); }
};
__global__ void __launch_bounds__(NTHR, 2) k_mega(Params p) {
    extern __shared__ __attribute__((aligned(16))) char lds[];
    LAS unsigned* xb = (LAS unsigned*)(lds + LDS_XB);
    if (threadIdx.x == 0) { xb[0] = 0u; xb[1] = 0u; xb[2] = 0u; xb[3] = 0u; }
    __syncthreads();
    XcdBarrier bar = xcd_barrier_post(p.bar, (volatile LAS unsigned*)xb);
    PhaseSeq<PROBE_MODE ? 28 : 27>::run(p, lds, bar);
}
#endif

#if MK_MULTI
template <int PH> static void launch_all(const Params& p, hipStream_t s) {
    if constexpr (PH > 0) launch_all<PH - 1>(p, s);
    hipFuncSetAttribute((const void*)k_phase<PH>, hipFuncAttributeMaxDynamicSharedMemorySize, LDS_BYTES);
    hipLaunchKernelGGL(k_phase<PH>, dim3(256), dim3(NTHR), LDS_BYTES, s, p);
}
#endif

extern "C" void kernel_launch(void* const* d_in, const int* in_sizes, int n_in, void* d_out, int out_size, void* d_ws, size_t ws_size, hipStream_t stream) {
    Params p{};
    const float** f = (const float**)&p.x;
    for (int i = 0; i < 34; ++i) f[i] = (const float*)d_in[i];
    p.out = (float*)d_out;
    size_t off = 0;
    auto A = [&](size_t bytes) -> char* { char* r = (char*)d_ws + off; off += (bytes + 255) & ~(size_t)255; return r; };
    p.bar = (unsigned*)A(XCD_BAR_WORDS * 4);
    p.ictl = (int*)A(1026 * 4);
    p.mods = (float*)A((size_t)2 * 3 * 6144 * 4);
    p.Abuf = (bf16_t*)A((size_t)TT * 1024 * 2);
    p.CM = (bf16_t*)A((size_t)32 * CK_NCH * 4096 * 2);
    p.CRH = (bf16_t*)A((size_t)32 * CK_NCH * 1024 * 2);
    p.CN = (bf16_t*)A((size_t)32 * CK_NCH * 4096 * 2);
    p.CP3 = (bf16_t*)A((size_t)32 * CK_NCH * 1024 * 2);
    p.HA = (float*)A((size_t)TT * 1024 * 4);
    p.HB = (float*)A((size_t)TT * 1024 * 4);
    p.Q0 = (bf16_t*)A((size_t)TT * 512 * 2);
    p.K0 = (bf16_t*)A((size_t)TT * 512 * 2);
    p.V0 = (bf16_t*)A((size_t)TT * 512 * 2);
    p.VT0L = (bf16_t*)A((size_t)2 * 512 * TLB * 2);
    p.VT0C = (bf16_t*)A((size_t)2 * 512 * TCB * 2);
    p.RWP = (float*)A((size_t)TT * RWC * 4);
    p.MIX = (bf16_t*)A((size_t)TT * 1024 * 2);
    p.YL = (float*)A((size_t)TT * 1024 * 4);
    p.LOGITS = (float*)A((size_t)TT * 256 * 4);
    p.EIDX = (int*)A((size_t)TT * 8 * 4);
    p.EW = (float*)A((size_t)TT * 8 * 4);
    p.APOS = (int*)A((size_t)TT * 8 * 4);
    p.SLOT_TOK = (int*)A((size_t)2 * NSLOT * 4);
    p.SLOT_W = (float*)A((size_t)2 * NSLOT * 4);
    p.HIST = (int*)A((size_t)2 * 256 * 256 * 4);
    p.WF = (unsigned*)A((size_t)8 * 4 * 7 * 64 * 16);
    p.TILE_E = (int*)A((size_t)2 * MAXTILES * 4);
    p.TILE_R0 = (int*)A((size_t)2 * MAXTILES * 4);
    p.HBUF = (bf16_t*)A((size_t)NSLOT * 256 * 2);
    const size_t un0 = off;
    p.YB = (bf16_t*)A((size_t)NSLOT * 1024 * 2);
    const size_t un_end = off;
    off = un0;
    p.SW = (float*)A((size_t)2 * TT * 512 * 4);
    p.SBP = (unsigned*)A((size_t)TT * 512 * 4);
    p.SKP = (unsigned*)A((size_t)TT * 512 * 4);
    p.SNV = (unsigned*)A((size_t)TT * 512 * 4);
    p.SRG = (unsigned*)A((size_t)TT * 512 * 4);
    p.BONUS = (float*)A((size_t)TT * 8 * 4);
    p.YS = (float*)A((size_t)2 * TT * 512 * 4);
    const size_t m0_end = off;
    off = un0;
    p.P1 = (bf16_t*)A((size_t)TT * 3072 * 2);
    p.K1TL = (bf16_t*)A((size_t)2 * 512 * TLB * 2);
    p.K1TC = (bf16_t*)A((size_t)2 * 512 * TCB * 2);
    p.V1TL = (bf16_t*)A((size_t)2 * 1024 * TLB * 2);
    p.V1TC = (bf16_t*)A((size_t)2 * 1024 * TCB * 2);
    p.G1 = (float*)A((size_t)TT * 32 * 4);
    p.KVT = (float*)A((size_t)1056 * 2 * 8192 * 4);
    p.KS = (float*)A((size_t)1056 * 128 * 4);
    p.BEMC = (float*)A((size_t)1056 * 4 * 4);
    p.C0T = (bf16_t*)A((size_t)1056 * 2 * 8192 * 2);
    p.N0 = (float*)A((size_t)1056 * 2 * 64 * 4);
    p.M0 = (float*)A((size_t)1056 * 2 * 4);
    const size_t m1_end = off;
    off = un_end > m0_end ? un_end : m0_end; off = off > m1_end ? off : m1_end;
    if (off > ws_size) return;
    hipMemsetAsync(p.bar, 0, XCD_BAR_WORDS * 4, stream);
#if MK_MULTI
    launch_all<27>(p, stream);
#else
    hipFuncSetAttribute((const void*)k_mega, hipFuncAttributeMaxDynamicSharedMemorySize, LDS_BYTES);
    hipLaunchKernelGGL(k_mega, dim3(256), dim3(NTHR), LDS_BYTES, stream, p);
#endif
}
```

```cpp
#include <hip/hip_runtime.h>
#include <stdint.h>

#ifndef MK_MULTI
#define MK_MULTI 0
#endif

#ifndef PROBE_DUP
#define PROBE_DUP 0ull
#endif
#define DI __device__ __forceinline__
typedef unsigned short bf16_t;
typedef short bf16x8 __attribute__((ext_vector_type(8)));
typedef float f32x4 __attribute__((ext_vector_type(4)));
typedef unsigned u32x4 __attribute__((ext_vector_type(4)));
typedef unsigned u32x2 __attribute__((ext_vector_type(2)));

constexpr int NTHR = 512;
constexpr int TLB = 8192, TCB = 256, TL = 16384, TC = 512, TT = 16896;
constexpr int EVC = 3296, ODC = 3104, RWC = 1760;
constexpr float ALPHA = 1.41421356237f;
constexpr int SH_BASE = 200704;
constexpr int NSLOT = SH_BASE + TT;
constexpr int MAXTILES = 784 + 66;
constexpr int EPI_OFF = 98304, EPI_WAVE_B = 4352;
constexpr int LDS_XB = 153600;
constexpr int LDS_BYTES = LDS_XB + 256;

#define XB_TMO      128
#define XB_XCNT(j)  (256  + 64 * (j))
#define XB_XSUB(j)  (1280 + 64 * (j))
#define XB_XGEN(j)  (2304 + 64 * (j))
#define XB_TOP      3328
#define XB_TOPGEN   3392
#define XCD_BAR_WORDS 3456
#define XB_SPIN_CAP (1u << 18)
#define LAS __attribute__((address_space(3)))

__device__ __forceinline__ unsigned xb_ld(unsigned* p)              { return __hip_atomic_load(p, __ATOMIC_RELAXED, __HIP_MEMORY_SCOPE_AGENT); }
__device__ __forceinline__ unsigned xb_add(unsigned* p, unsigned v) { return __hip_atomic_fetch_add(p, v, __ATOMIC_RELAXED, __HIP_MEMORY_SCOPE_AGENT); }
__device__ __forceinline__ unsigned xb_xcc_id() { return (unsigned)__builtin_amdgcn_s_getreg((3 << 11) | 20) & 0xFu; }
#define XB_SPIN(cond, bar) do { unsigned _sp = 0; while (cond) { __builtin_amdgcn_s_sleep(1); \
    if ((++_sp & 255u) == 0u) { if (xb_ld(&(bar)[XB_TMO])) break; if (_sp > XB_SPIN_CAP) { atomicAdd(&(bar)[XB_TMO], 1u); break; } } } } while (0)

struct XcdBarrier {
    unsigned* bar; unsigned x;
    volatile LAS unsigned* st;
};
__device__ __forceinline__ XcdBarrier xcd_barrier_post(unsigned* bar, volatile LAS unsigned* st) {
    XcdBarrier b; b.bar = bar; b.x = xb_xcc_id(); b.st = st;
    if (threadIdx.x == 0) (void)xb_add(&bar[XB_XCNT(b.x)], 1u);
    return b;
}
__device__ __forceinline__ void xcd_barrier_complete(unsigned* bar, unsigned x, unsigned& nloc, unsigned& nx) {
    const unsigned G = gridDim.x * gridDim.y * gridDim.z;
    unsigned sum, cnt, mine, sp = 0u;
    for (;;) {
        sum = 0u; cnt = 0u; mine = 0u;
#pragma unroll
        for (unsigned j = 0; j < 16; ++j) { const unsigned c = xb_ld(&bar[XB_XCNT(j)]); sum += c; cnt += (c > 0u) ? 1u : 0u; mine = (j == x) ? c : mine; }
        if (sum == G) break;
        __builtin_amdgcn_s_sleep(1);
        if ((++sp & 255u) == 0u) { if (xb_ld(&bar[XB_TMO])) break; if (sp > XB_SPIN_CAP) { atomicAdd(&bar[XB_TMO], 1u); break; } }
    }
    nloc = mine > 0u ? mine : 1u; nx = cnt > 0u ? cnt : 1u;
}
__device__ __forceinline__ void xcd_barrier(const XcdBarrier& b) {
    asm volatile("s_waitcnt vmcnt(0)" ::: "memory");
    __syncthreads();
    if (threadIdx.x == 0) {
        unsigned* bar = b.bar;
        __builtin_amdgcn_s_waitcnt(0);
        unsigned nloc = b.st[0], nx = b.st[1];
        if (nloc == 0u) { xcd_barrier_complete(bar, b.x, nloc, nx); b.st[0] = nloc; b.st[1] = nx; }
        const unsigned old = xb_add(&bar[XB_XSUB(b.x)], 1u);
        const unsigned gen = old / nloc;
        if (old + 1u == (gen + 1u) * nloc) {
            __builtin_amdgcn_fence(__ATOMIC_RELEASE, "agent");
            asm volatile("s_waitcnt vmcnt(0)" ::: "memory");
            const unsigned og = xb_add(&bar[XB_TOP], 1u);
            const unsigned tg = og / nx;
            if (og + 1u == (tg + 1u) * nx) xb_add(&bar[XB_TOPGEN], 1u);
            else XB_SPIN(xb_ld(&bar[XB_TOPGEN]) == tg, bar);
            __builtin_amdgcn_fence(__ATOMIC_ACQUIRE, "agent");
            xb_add(&bar[XB_XGEN(b.x)], 1u);
            asm volatile("s_waitcnt vmcnt(0)" ::: "memory");
        } else {
            XB_SPIN(xb_ld(&bar[XB_XGEN(b.x)]) == gen, bar);
            __builtin_amdgcn_fence(__ATOMIC_ACQUIRE, "agent");
            asm volatile("s_waitcnt vmcnt(0)" ::: "memory");
        }
    }
    __syncthreads();
}

struct Params {
    const float *x, *c, *ctx, *c_ctx, *ada_w, *ada_b, *ln_g, *ln_b, *ev_w_in, *ev_w_out, *na_rpb, *rw_mu, *rw_w0, *rw_w_up, *rw_a0,
        *rw_a_up, *rw_g_up, *rw_k_k, *rw_k_a, *rw_r_k, *rw_gn_g, *rw_gn_b, *od_w_in, *od_w_out, *ml_gate_b, *ml_norm_g, *moe_router,
        *moe_bias, *moe_w_gate, *moe_w_up, *moe_w_down, *sh_w_gate, *sh_w_up, *sh_w_down;
    float* out;
    unsigned* bar;
    int* ictl;
    float* mods;
    bf16_t* Abuf;
    float *HA, *HB;
    bf16_t *Q0, *K0, *V0, *VT0L, *VT0C;
    float* RWP;
    unsigned* WF;
    float *SW, *BONUS, *YS;
    unsigned *SBP, *SKP, *SNV, *SRG;
    bf16_t *CM, *CRH, *CN, *CP3;
    bf16_t* MIX;
    float* YL;
    float* LOGITS;
    int *EIDX, *APOS, *SLOT_TOK, *TILE_E, *TILE_R0, *HIST;
    float *EW, *SLOT_W;
    bf16_t *HBUF, *YB;
    bf16_t *P1, *K1TL, *K1TC, *V1TL, *V1TC, *C0T;
    float *G1, *KVT, *KS, *BEMC, *N0, *M0;
};

DI int opaque_tid() { int t = threadIdx.x; asm volatile("" : "+v"(t)); return t; }
typedef __bf16 bf16x2_t __attribute__((ext_vector_type(2)));
typedef float f32x2_t __attribute__((ext_vector_type(2)));
DI unsigned cvt_pk_bf16_asm(float lo, float hi) { unsigned r; asm volatile("v_cvt_pk_bf16_f32 %0, %1, %2" : "=v"(r) : "v"(lo), "v"(hi)); return r; }
DI unsigned cvt_pk_bf16(float lo, float hi) { const f32x2_t v = {lo, hi}; return __builtin_bit_cast(unsigned, __builtin_convertvector(v, bf16x2_t)); }
DI float bf2f(bf16_t b) { return __uint_as_float(((unsigned)b) << 16); }
DI float bflo(unsigned w) { return __uint_as_float(w << 16); }
DI float bfhi(unsigned w) { return __uint_as_float(w & 0xffff0000u); }
DI float sigmoidf_(float x) { return 1.0f / (1.0f + __expf(-x)); }
DI float siluf_(float x) { return x / (1.0f + __expf(-x)); }
DI float tanhf_(float x) { return 1.0f - 2.0f / (__expf(2.0f * x) + 1.0f); }
DI float softplusf_(float x) { return fmaxf(x, 0.f) + __logf(1.0f + __expf(-fabsf(x))); }
DI float logsigmoidf_(float x) { return -softplusf_(-x); }
DI f32x4 mfma16(bf16x8 a, bf16x8 b, f32x4 c) { return __builtin_amdgcn_mfma_f32_16x16x32_bf16(a, b, c, 0, 0, 0); }
DI bf16x8 pack8(f32x4 a, f32x4 b) {
    u32x4 w; w.x = cvt_pk_bf16(a[0], a[1]); w.y = cvt_pk_bf16(a[2], a[3]); w.z = cvt_pk_bf16(b[0], b[1]); w.w = cvt_pk_bf16(b[2], b[3]);
    return __builtin_bit_cast(bf16x8, w);
}
DI bf16x8 join8(u32x2 lo, u32x2 hi) { u32x4 w; w.x = lo.x; w.y = lo.y; w.z = hi.x; w.w = hi.y; return __builtin_bit_cast(bf16x8, w); }
DI float wave_allsum(float v) {
#pragma unroll
    for (int d = 1; d < 64; d <<= 1) v += __shfl_xor(v, d);
    return v;
}
DI float wave_allmax(float v) {
#pragma unroll
    for (int d = 1; d < 64; d <<= 1) v = fmaxf(v, __shfl_xor(v, d));
    return v;
}
template <int CTRL, int RM> DI float dpp_f(float x) {
    return __builtin_bit_cast(float, __builtin_amdgcn_update_dpp(0, __builtin_bit_cast(int, x), CTRL, RM, 0xF, false));
}
DI float wave_sum63(float x) {
    x += dpp_f<0xB1, 0xF>(x);
    x += dpp_f<0x4E, 0xF>(x);
    x += dpp_f<0x141, 0xF>(x);
    x += dpp_f<0x140, 0xF>(x);
    x += dpp_f<0x142, 0xA>(x);
    x += dpp_f<0x143, 0xC>(x);
    return x;
}
template <int CTRL> DI float dpp_add(float x) { return x + __builtin_bit_cast(float, __builtin_amdgcn_update_dpp(0, __builtin_bit_cast(int, x), CTRL, 0xF, 0xF, false)); }
DI float row16_allsum(float x) { x = dpp_add<0xB1>(x); x = dpp_add<0x4E>(x); x = dpp_add<0x141>(x); x = dpp_add<0x140>(x); return x; }
DI void seq_info(int row, int& t, int& T) { if (row < TL) { t = row & (TLB - 1); T = TLB; } else { t = (row - TL) & (TCB - 1); T = TCB; } }
DI int mods_row(int row) { return row < TL ? (row >> 13) : 2; }

DI int lds_byte(int r, int c) { const int st = (r >> 4) * 2 + (c >> 5), rr = r & 15, cc = c & 31, ob = rr * 64 + cc * 2; return st * 1024 + (ob ^ (((ob >> 9) & 1) << 5)); }

DI int a_row(int tid) { return (tid >> 4) * 2 + ((tid >> 2) & 1); }
DI int a_c8(int tid) { return ((tid >> 3) & 1) * 4 + (tid & 3); }
template <int NP> struct PtrLoader { const bf16_t* base; unsigned p[NP]; };
struct PtrLoaderF { const float* base0; const float* base1; unsigned p[4]; int ld; };
typedef short s16x4 __attribute__((ext_vector_type(4)));
DI int b_img(int k, int seg, int bo) { return 256 * k + 32 * (seg ^ ((k & 3) + 4 * ((k >> 3) & 1))) + bo; }
DI bf16x8 tr_frag(const char* base, int xl, int c, int ks) {
    const char* a = base + (xl ^ (c << 5)) + 8192 * ks;
    const s16x4 lo = __builtin_amdgcn_ds_read_tr16_b64_v4i16((LAS s16x4*)(a));
    const s16x4 hi = __builtin_amdgcn_ds_read_tr16_b64_v4i16((LAS s16x4*)(a + 1024));
    return __builtin_shufflevector(lo, hi, 0, 1, 2, 3, 4, 5, 6, 7);
}

DI void tile_of(int u, int ntm, int ntn, int& tm, int& tn) {
    const int gid = u / (4 * ntn), within = u % (4 * ntn);
    const int gsz = (ntm - gid * 4) < 4 ? (ntm - gid * 4) : 4;
    tm = gid * 4 + within % gsz; tn = within / gsz;
}
DI void fill_bf(PtrLoaderF& bl, const float* W, int ld, int n0, int nvalid) {
    bl.ld = ld; bl.base0 = W; bl.base1 = W;
    const int tz = opaque_tid();
#pragma unroll
    for (int i = 0; i < 4; ++i) { int n = n0 + 32 * i + (tz & 7) * 4; n = n < nvalid ? n : nvalid - 4; bl.p[i] = (unsigned)((tz >> 3) * ld + n); }
}
template <int V> struct IC { static constexpr int value = V; };
template <int WR, int WC, int MT, int NT, class BL, int NTU, int MODE = 0, class MK, class PF, class PRE, class SINK>
DI void gemm_stream(char* lds, int nunits, int nk, MK&& mk, PF&& pf, PRE&& pre, SINK&& sink) {
    constexpr bool BF32 = __is_same(BL, PtrLoaderF);
    constexpr int BM = WR * MT * 16, BN = WC * NT * 16, APC = BM * 8 / NTHR, BPC = BF32 ? 4 : BN * 8 / NTHR;
    constexpr int ABYTES = BM * 128, STAGE = (BM + BN) * 128;
    static_assert(WR * WC == 8, "8 waves");
    static_assert(!BF32 || BN == 128, "f32 B path is written for 128-column tiles");
    const int tid = opaque_tid(), lane = tid & 63, wid = tid >> 6, wr = wid / WC, wc = wid % WC, fr = lane & 15, fq = lane >> 4;
    const int ubase = (blockIdx.x & 7) * 32 + (blockIdx.x >> 3), ustep = (int)gridDim.x;
    if (ubase >= nunits) return;
    int lu = ubase, lkt = 0, cu = ubase, ckt = 0;
    int lun = (lu + ustep < nunits) ? lu + ustep : lu;
    f32x4 acc[MT][NT];
#pragma unroll
    for (int m = 0; m < MT; ++m)
#pragma unroll
        for (int n = 0; n < NT; ++n) acc[m][n] = (f32x4){0.f, 0.f, 0.f, 0.f};
    const int sa0 = lds_byte(a_row(tid), a_c8(tid) * 8);
    const int xl = b_img(8 * fq + ((lane & 15) >> 2), 0, 8 * (lane & 3));
    auto sbo = [&](int i) -> int {
        if constexpr (BF32) { const int k = tid >> 3, n4 = 8 * i + (tid & 7); return ABYTES + b_img(k, n4 >> 2, 8 * (n4 & 3)); }
        else return ABYTES + lds_byte((tid >> 3) + 64 * i, (tid & 7) * 8);
    };
    PtrLoader<APC> al; BL bl;
    int nx[4] = {0, 0, 0, 0};
    pf(lu, nx, 2);
    mk(lu, al, bl, nx);
    pf(lun, nx, 2);
    u32x4 ra[APC], rb[BPC];
    auto issue = [&](auto hc) {
        if constexpr (MODE == 2) return;
#pragma unroll
        for (int i = 0; i < APC; ++i) ra[i] = *(const u32x4*)(al.base + al.p[i] + lkt * 64);
#pragma unroll
        for (int i = 0; i < BPC; ++i) {
            if constexpr (BF32) rb[i] = *(const u32x4*)(((i & 1) ? bl.base1 : bl.base0) + bl.p[i] + (size_t)lkt * 64 * bl.ld);
            else rb[i] = *(const u32x4*)(bl.base + bl.p[i] + lkt * 64);
        }
        const int use[4] = {nx[0], nx[1], nx[2], nx[3]};
        pf(lun, nx, decltype(hc)::value);
        if (++lkt == nk) { lkt = 0; lu = lun; lun = (lu + ustep < nunits) ? lu + ustep : lu; mk(lu, al, bl, use); }
    };
    auto stash = [&](char* st) {
        if constexpr (MODE == 2) return;
#pragma unroll
        for (int i = 0; i < APC; ++i) *(u32x4*)(st + sa0 + 8192 * i) = ra[i];
#pragma unroll
        for (int i = 0; i < BPC; ++i) {
            if constexpr (BF32) {
                u32x2 w; w.x = cvt_pk_bf16_asm(__uint_as_float(rb[i].x), __uint_as_float(rb[i].y)); w.y = cvt_pk_bf16_asm(__uint_as_float(rb[i].z), __uint_as_float(rb[i].w));
                *(u32x2*)(st + sbo(i)) = w;
            } else *(u32x4*)(st + sbo(i)) = rb[i];
        }
    };
    auto compute = [&](const char* st) {
        if constexpr (MODE == 1) return;
#pragma unroll
        for (int ks = 0; ks < 2; ++ks) {
            bf16x8 af[MT], bfr[NT];
#pragma unroll
            for (int m = 0; m < MT; ++m) af[m] = *(const bf16x8*)(st + lds_byte(wr * MT * 16 + m * 16 + fr, ks * 32 + fq * 8));
#pragma unroll
            for (int n = 0; n < NT; ++n) {
                if constexpr (BF32) bfr[n] = tr_frag(st + ABYTES, xl, wc * NT + n, ks);
                else bfr[n] = *(const bf16x8*)(st + ABYTES + lds_byte(wc * NT * 16 + n * 16 + fr, ks * 32 + fq * 8));
            }
#pragma unroll
            for (int m = 0; m < MT; ++m)
#pragma unroll
                for (int n = 0; n < NT; ++n) acc[m][n] = mfma16(bfr[n], af[m], acc[m][n]);
        }
    };
    auto ep = [&](int u, f32x4 (&a)[MT][NT], int, int) {
        float* W = (float*)(lds + EPI_OFF + wid * EPI_WAVE_B);
        constexpr int LPR = NTU * 4, RPI = 64 / LPR, NJ = 16 / RPI;
        const int c4 = lane % LPR, rb = lane / LPR;
#pragma unroll
        for (int mi = 0; mi < MT; ++mi) {
            f32x4 o[NTU];
            pre(u, mi, a[mi], o, wr * MT * 16 + mi * 16 + fr, wc * NT * 16 + 4 * fq);
#pragma unroll
            for (int ni = 0; ni < NTU; ++ni) *(f32x4*)(W + fr * 68 + ni * 16 + 4 * fq) = o[ni];
#pragma unroll
            for (int j = 0; j < NJ; ++j) {
                const f32x4 v = *(const f32x4*)(W + (rb + RPI * j) * 68 + 4 * c4);
                const f32x4 pv = *(const f32x4*)(W + (rb + RPI * j) * 68 + 4 * (c4 ^ 4));
                sink(u, wr * MT * 16 + mi * 16 + rb + RPI * j, wc * NTU * 16 + 4 * c4, v, pv);
            }
        }
    };
    issue(IC<0>{});
    stash(lds);
    if (wid >= 4) issue(IC<1>{});
    __syncthreads();
    bool first = true;
    auto epilogue = [&]() {
        if (ckt == 0 && !first) {
            if constexpr (MODE == 0 || MODE == 4) ep(cu - ustep, acc, wr * MT * 16 + fr, wc * NT * 16 + 4 * fq);
            else { asm volatile("" :: "v"(acc[0][0]), "v"(acc[MT - 1][NT - 1])); }
#pragma unroll
            for (int m = 0; m < MT; ++m)
#pragma unroll
                for (int n = 0; n < NT; ++n) acc[m][n] = (f32x4){0.f, 0.f, 0.f, 0.f};
        }
    };
    while (cu < nunits) {
        if (wid < 4) {
            epilogue(); issue(IC<1>{}); compute(lds); stash(lds + STAGE);
            __syncthreads();
            issue(IC<0>{}); compute(lds + STAGE); stash(lds);
            __syncthreads();
        } else {
            stash(lds + STAGE); epilogue(); issue(IC<0>{}); compute(lds);
            __syncthreads();
            stash(lds); issue(IC<1>{}); compute(lds + STAGE);
            __syncthreads();
        }
        first = false;
        ckt += 2;
        if (ckt == nk) { ckt = 0; cu += ustep; }
    }
    if constexpr (MODE == 0 || MODE == 4) ep(cu - ustep, acc, wr * MT * 16 + fr, wc * NT * 16 + 4 * fq);
    else {
#pragma unroll
        for (int m = 0; m < MT; ++m)
#pragma unroll
            for (int n = 0; n < NT; ++n) asm volatile("" :: "v"(acc[m][n]));
        if constexpr (MODE == 1) { asm volatile("" :: "v"(ra[0]), "v"(rb[0])); }
    }
}

DI void ph_prologue(const Params& p, char* lds) {
    const int tid = opaque_tid(), bid = blockIdx.x, nb = gridDim.x;
    for (int i = bid * NTHR + tid; i < 1026; i += nb * NTHR) p.ictl[i] = 0;
    for (int i = bid * NTHR + tid; i < 2 * NSLOT; i += nb * NTHR) {
        const int s = i % NSLOT;
        p.SLOT_TOK[i] = s >= SH_BASE ? s - SH_BASE : 0;
        p.SLOT_W[i] = s >= SH_BASE ? 1.0f : 0.0f;
    }
    if (bid >= 192) {
        for (int idx = (bid - 192) * NTHR + tid; idx < 8 * 4 * 7 * 64; idx += (nb - 192) * NTHR) {
            const int ln = idx & 63, s = (idx >> 6) % 7, hn = (idx >> 6) / 7;
            const int c = hn * 16 + (ln & 15);
            const float* wc_ = (s < 2 ? p.rw_w_up + s * 32 * 512 : (s < 4 ? p.rw_a_up + (s - 2) * 32 * 512 : p.rw_g_up + (s - 4) * 32 * 512)) + 8 * (ln >> 4) * 512 + c;
            u32x4 w;
            w.x = cvt_pk_bf16(wc_[0], wc_[512]); w.y = cvt_pk_bf16(wc_[1024], wc_[1536]); w.z = cvt_pk_bf16(wc_[2048], wc_[2560]); w.w = cvt_pk_bf16(wc_[3072], wc_[3584]);
            *(u32x4*)(p.WF + (size_t)idx * 4) = w;
        }
    }
    constexpr int J_MODS = 192;
    for (int job = bid; job < J_MODS; job += nb) {
        const int j = job;
        if (j < J_MODS) {
            const int l = j / 96, cb = j % 96;
            float* sc = (float*)lds;
            float* red = sc + 3072;
            for (int idx = tid; idx < 3072; idx += NTHR) {
                const int r = idx >> 10, k = idx & 1023;
                const float cv = r < 2 ? p.c[r * 1024 + k] : p.c_ctx[k];
                sc[idx] = siluf_(cv);
            }
            __syncthreads();
            const int kq = tid >> 6, cl = tid & 63, col = cb * 64 + cl;
            float a0 = 0.f, a1 = 0.f, a2 = 0.f;
            const float* w = p.ada_w + (size_t)l * 1024 * 6144 + col;
            for (int k = kq * 128; k < kq * 128 + 128; ++k) {
                const float wv = w[(size_t)k * 6144];
                a0 += sc[k] * wv; a1 += sc[1024 + k] * wv; a2 += sc[2048 + k] * wv;
            }
            red[(kq * 3 + 0) * 64 + cl] = a0; red[(kq * 3 + 1) * 64 + cl] = a1; red[(kq * 3 + 2) * 64 + cl] = a2;
            __syncthreads();
            if (tid < 192) {
                const int r = tid >> 6, c2 = tid & 63;
                float s = 0.f;
#pragma unroll
                for (int q = 0; q < 8; ++q) s += red[(q * 3 + r) * 64 + c2];
                p.mods[(size_t)(l * 3 + r) * 6144 + cb * 64 + c2] = s + p.ada_b[l * 6144 + cb * 64 + c2];
            }
            __syncthreads();
            continue;
        }
    }
}

DI void ph_modulate0(const Params& p) {
    const int nb = gridDim.x;
#pragma unroll 4
    for (int i = blockIdx.x * NTHR + opaque_tid(); i < TT * 256; i += nb * NTHR) {
        const int row = i >> 8, c = (i & 255) * 4;
        const float* src = row < TL ? p.x + (size_t)row * 1024 : p.ctx + (size_t)(row - TL) * 1024;
        const float* m = p.mods + (size_t)(0 * 3 + mods_row(row)) * 6144;
        const f32x4 v = *(const f32x4*)(src + c), sh = *(const f32x4*)(m + c), scv = *(const f32x4*)(m + 1024 + c);
        const f32x4 a = v * (1.0f + scv) + sh;
        u32x2 w; w.x = cvt_pk_bf16(a[0], a[1]); w.y = cvt_pk_bf16(a[2], a[3]);
        *(u32x2*)(p.Abuf + (size_t)row * 1024 + c) = w;
    }
}

DI void ph_inproj0(const Params& p, char* lds) {
    const int tid = opaque_tid();
    constexpr int NTN = 26, NTM = 66;
    gemm_stream<4, 2, 4, 4, PtrLoaderF, 4>(lds, NTN * NTM, 16, [&](int u, PtrLoader<4>& al, PtrLoaderF& bl, const int (&nx)[4]) {
        int tm, tn; tile_of(u, NTM, NTN, tm, tn);
#pragma unroll
        for (int i = 0; i < 4; ++i) al.p[i] = (unsigned)((tm * 256 + a_row(tid) + 64 * i) * 1024 + a_c8(tid) * 8);
        al.base = p.Abuf;
        fill_bf(bl, p.ev_w_in, EVC, tn * 128, EVC);
    }, [&](int u, int (&nx)[4], int) {}, [&](int u, int mi, const f32x4 (&a)[4], f32x4 (&o)[4], int r0, int c0) {
#pragma unroll
        for (int ni = 0; ni < 4; ++ni) o[ni] = a[ni];
    }, [&](int u, int r, int c, f32x4 v, f32x4 pv) {
        int tm, tn; tile_of(u, NTM, NTN, tm, tn);
        const int row = tm * 256 + r, col = tn * 128 + c;
        if (tn < 12) {
            bf16_t* dst = (tn < 4 ? p.Q0 + col : (tn < 8 ? p.K0 + (col - 512) : p.V0 + (col - 1024))) + (size_t)row * 512;
            u32x2 w; w.x = cvt_pk_bf16(v[0], v[1]); w.y = cvt_pk_bf16(v[2], v[3]);
            *(u32x2*)dst = w;
        } else if (col < EVC) {
            *(f32x4*)(p.RWP + (size_t)row * RWC + (col - 1536)) = v;
        }
    });
}

DI void transpose_tile(char* ldsc, const bf16_t* src, int ld, int row0, int col0, bf16_t* dstL, bf16_t* dstC, int ncols) {
    bf16_t* T = (bf16_t*)ldsc;
    const int tid = opaque_tid();
    {
        const int tok = tid >> 3, d8 = tid & 7;
        *(u32x4*)(T + tok * 72 + d8 * 8) = *(const u32x4*)(src + (size_t)(row0 + tok) * ld + col0 + d8 * 8);
    }
    __syncthreads();
    {
        const int d = tid >> 3, t8 = tid & 7;
        u32x4 w;
        w.x = (unsigned)T[(t8 * 8 + 0) * 72 + d] | ((unsigned)T[(t8 * 8 + 1) * 72 + d] << 16);
        w.y = (unsigned)T[(t8 * 8 + 2) * 72 + d] | ((unsigned)T[(t8 * 8 + 3) * 72 + d] << 16);
        w.z = (unsigned)T[(t8 * 8 + 4) * 72 + d] | ((unsigned)T[(t8 * 8 + 5) * 72 + d] << 16);
        w.w = (unsigned)T[(t8 * 8 + 6) * 72 + d] | ((unsigned)T[(t8 * 8 + 7) * 72 + d] << 16);
        bf16_t* dst;
        if (row0 < TL) dst = dstL + ((size_t)((row0 >> 13) * ncols + col0 + d)) * TLB + (row0 & (TLB - 1));
        else { const int rc = row0 - TL; dst = dstC + ((size_t)((rc >> 8) * ncols + col0 + d)) * TCB + (rc & (TCB - 1)); }
        *(u32x4*)(dst + t8 * 8) = w;
    }
    __syncthreads();
}

template <int NOSTORE = 0>
DI void ph_rw_prep(const Params& p, char* ldsc) {
    constexpr int TG = 16, LRP = 232;
    bf16_t* LR = (bf16_t*)ldsc;
    const int tid = opaque_tid(), lane = tid & 63, hh = tid >> 6, q = lane & 15, g = lane >> 4;
    bf16_t* SH = (bf16_t*)(ldsc + 8192);
    bf16x8 wq[7];
    auto wload = [&](int nt_) {
        unsigned co_ = (unsigned)(((hh * 4 + nt_) * 7 * 64 + lane) * 4); asm volatile("" : "+v"(co_));
#pragma unroll
        for (int s = 0; s < 7; ++s) wq[s] = __builtin_bit_cast(bf16x8, *(const u32x4*)(p.WF + co_ + s * 256));
    };
    wload(0);
    for (int grp = blockIdx.x; grp < TT / TG; grp += gridDim.x) {
        const int row0 = grp * TG;
        int t0, Tseq; seq_info(row0, t0, Tseq);
#pragma unroll 4
        for (int idx = tid; idx < TG * 440; idx += NTHR) {
            const int tk = idx / 440, c4 = (idx % 440) * 4;
            const int t = t0 + tk;
            const float* pr = p.RWP + (size_t)(row0 + tk) * RWC + c4;
            const f32x4 pc = *(const f32x4*)pr;
            const f32x4 pv = t > 0 ? *(const f32x4*)(pr - RWC) : (f32x4){0.f, 0.f, 0.f, 0.f};
            const f32x4 nx = t < Tseq - 1 ? *(const f32x4*)(pr + RWC) : (f32x4){0.f, 0.f, 0.f, 0.f};
            const f32x4 mu = *(const f32x4*)(p.rw_mu + c4);
            f32x4 v = pc + mu * (0.5f * (pv + nx) - pc);
            if (c4 < 1536) {
                u32x2 w; w.x = cvt_pk_bf16(v[0], v[1]); w.y = cvt_pk_bf16(v[2], v[3]);
                *(u32x2*)(SH + tk * 1536 + c4) = w;
            } else {
                const int j = c4 - 1536;
                if (j < 64) { v[0] = tanhf_(v[0]); v[1] = tanhf_(v[1]); v[2] = tanhf_(v[2]); v[3] = tanhf_(v[3]); }
                else if (j >= 128) { v[0] = sigmoidf_(v[0]); v[1] = sigmoidf_(v[1]); v[2] = sigmoidf_(v[2]); v[3] = sigmoidf_(v[3]); }
                u32x2 w; w.x = cvt_pk_bf16(v[0], v[1]); w.y = cvt_pk_bf16(v[2], v[3]);
                *(u32x2*)(LR + tk * LRP + j) = w;
            }
        }
        __syncthreads();
        float nrm[4];
#pragma unroll
        for (int r = 0; r < 4; ++r) {
            float ss = 0.f;
#pragma unroll
            for (int nt = 0; nt < 4; ++nt) {
                const int c = hh * 64 + 16 * nt + q;
                const float kk0 = bf2f(SH[(4 * g + r) * 1536 + 512 + c]) * p.rw_k_k[c];
                ss += kk0 * kk0;
            }
            nrm[r] = 1.0f / fmaxf(sqrtf(row16_allsum(ss)), 1e-12f);
        }
        float bon[4] = {0.f, 0.f, 0.f, 0.f};
        const f32x4 z4 = (f32x4){0.f, 0.f, 0.f, 0.f};
#pragma unroll
        for (int nt = 0; nt < 4; ++nt) {
            const int c = hh * 64 + 16 * nt + q;
            auto afrag = [&](int s) -> bf16x8 { return *(const bf16x8*)(LR + q * LRP + 32 * s + 8 * g); };
            f32x4 wl0, wl1, al0, al1, gl;
            {
                bf16x8 wc[7];
#pragma unroll
                for (int s = 0; s < 7; ++s) wc[s] = wq[s];
                wload((nt + 1) & 3);
                wl0 = mfma16(afrag(0), wc[0], z4); wl1 = mfma16(afrag(1), wc[1], z4); al0 = mfma16(afrag(2), wc[2], z4); al1 = mfma16(afrag(3), wc[3], z4);
                gl = mfma16(afrag(6), wc[6], mfma16(afrag(5), wc[5], mfma16(afrag(4), wc[4], z4)));
            }
            asm volatile("" ::: "memory");
            const float kkw = p.rw_k_k[c], kaw = p.rw_k_a[c], rkw = p.rw_r_k[c];
            const float w00 = p.rw_w0[c], w01 = p.rw_w0[512 + c], a00 = p.rw_a0[c], a01 = p.rw_a0[512 + c];
#pragma unroll
            for (int r = 0; r < 4; ++r) {
                const int row = row0 + 4 * g + r;
                const bf16_t* sh = SH + (4 * g + r) * 1536 + c;
                const float r_ = bf2f(sh[0]), k_ = bf2f(sh[512]), v_ = bf2f(sh[1024]);
                const float kk = k_ * kkw * nrm[r];
                const float wlog0 = -softplusf_(-(w00 + wl0[r])) - 0.5f, wlog1 = -softplusf_(-(w01 + wl1[r])) - 0.5f;
                const float dec0 = __expf(-__expf(wlog0)), dec1 = __expf(-__expf(wlog1));
                const float av0 = sigmoidf_(a00 + al0[r]), av1 = sigmoidf_(a01 + al1[r]);
                const float kd0 = k_ * (1.0f + (av0 - 1.0f) * kaw), kd1 = k_ * (1.0f + (av1 - 1.0f) * kaw);
                bon[r] += r_ * (kd0 + kd1) * rkw;
                const size_t o = (size_t)row * 512 + c;
                if (NOSTORE) { asm volatile("" :: "v"(dec0), "v"(dec1), "v"(kk * av0 + kk * av1 + kd0 + kd1 + v_ + gl[r])); continue; }
                typedef float f32x2s __attribute__((ext_vector_type(2)));
                *(f32x2s*)(p.SW + 2 * o) = (f32x2s){dec0, dec1};
                p.SBP[o] = cvt_pk_bf16(kk * av0, kk * av1); p.SKP[o] = cvt_pk_bf16(kd0, kd1);
                p.SNV[o] = cvt_pk_bf16(-kk, v_); p.SRG[o] = cvt_pk_bf16(r_, gl[r]);
                if (r & 1) asm volatile("" ::: "memory");
            }
        }
#pragma unroll
        for (int r = 0; r < 4; ++r) {
            const float bs = row16_allsum(bon[r]);
            if (q == 0) p.BONUS[(row0 + 4 * g + r) * 8 + hh] = bs;
        }
        __syncthreads();
    }
}

template <bool LAT>
DI void na_unit(const Params& p, int b, int r, int h, int w, int lane) {
    const int q = lane & 15, g = lane >> 4;
    const int j = 16 * w + q;
    const int qtok = LAT ? (b * TLB + r * 64 + j) : (TL + b * TCB + j);
    bf16x8 qf[2];
#pragma unroll
    for (int ks = 0; ks < 2; ++ks) qf[ks] = *(const bf16x8*)(p.Q0 + (size_t)qtok * 512 + h * 64 + 32 * ks + 8 * g);
    const int row_start = LAT ? (r - 4 < 0 ? 0 : (r - 4 > 120 ? 120 : r - 4)) : 0;
    const int c0 = LAT ? (w == 0 ? 0 : (w == 1 ? 8 : (w == 2 ? 24 : 32))) : 0;
    int cs = j - 8; cs = cs < 0 ? 0 : (cs > 48 ? 48 : cs);
    auto score_local = [&](int a, int tt) -> f32x4 {
        const int ktok = b * TLB + (row_start + a) * 64 + c0 + 16 * tt + q;
        f32x4 s = (f32x4){0.f, 0.f, 0.f, 0.f};
#pragma unroll
        for (int ks = 0; ks < 2; ++ks) {
            const bf16x8 kf = *(const bf16x8*)(p.K0 + (size_t)ktok * 512 + h * 64 + 32 * ks + 8 * g);
            s = mfma16(kf, qf[ks], s);
        }
        const int row_off = row_start + a - r + 7;
#pragma unroll
        for (int rr = 0; rr < 4; ++rr) {
            const int cc = c0 + 16 * tt + 4 * g + rr;
            int co = cc - j; co = co < -15 ? -15 : (co > 15 ? 15 : co);
            const bool in = (cc >= cs) && (cc < cs + 16);
            const float bias = p.na_rpb[(h * 15 + row_off) * 31 + co + 15];
            s[rr] = in ? (s[rr] * 0.125f + bias) : -1.0e30f;
        }
        return s;
    };
    auto score_ctx = [&](int ct) -> f32x4 {
        const int ktok = TL + b * TCB + 16 * ct + q;
        f32x4 s = (f32x4){0.f, 0.f, 0.f, 0.f};
#pragma unroll
        for (int ks = 0; ks < 2; ++ks) {
            const bf16x8 kf = *(const bf16x8*)(p.K0 + (size_t)ktok * 512 + h * 64 + 32 * ks + 8 * g);
            s = mfma16(kf, qf[ks], s);
        }
        return s * 0.125f;
    };
    float mx = -3.0e38f;
    if (LAT) {
        for (int a = 0; a < 8; ++a) {
#pragma unroll
            for (int tt = 0; tt < 2; ++tt) { const f32x4 s = score_local(a, tt); mx = fmaxf(mx, fmaxf(fmaxf(s[0], s[1]), fmaxf(s[2], s[3]))); }
        }
    }
    for (int ct = 0; ct < 16; ++ct) { const f32x4 s = score_ctx(ct); mx = fmaxf(mx, fmaxf(fmaxf(s[0], s[1]), fmaxf(s[2], s[3]))); }
    mx = fmaxf(mx, __shfl_xor(mx, 16)); mx = fmaxf(mx, __shfl_xor(mx, 32));
    float sum = 0.f;
    f32x4 o[4];
#pragma unroll
    for (int dm = 0; dm < 4; ++dm) o[dm] = (f32x4){0.f, 0.f, 0.f, 0.f};
    if (LAT) {
        for (int a = 0; a < 8; ++a) {
            f32x4 s0 = score_local(a, 0), s1 = score_local(a, 1);
#pragma unroll
            for (int rr = 0; rr < 4; ++rr) { s0[rr] = __expf(s0[rr] - mx); s1[rr] = __expf(s1[rr] - mx); sum += s0[rr] + s1[rr]; }
            const bf16x8 pb = pack8(s0, s1);
#pragma unroll
            for (int dm = 0; dm < 4; ++dm) {
                const bf16_t* vr = p.VT0L + ((size_t)(b * 512 + h * 64 + 16 * dm + q)) * TLB + (row_start + a) * 64 + c0 + 4 * g;
                const bf16x8 va = join8(*(const u32x2*)vr, *(const u32x2*)(vr + 16));
                o[dm] = mfma16(va, pb, o[dm]);
            }
        }
    }
    for (int u = 0; u < 8; ++u) {
        f32x4 s0 = score_ctx(2 * u), s1 = score_ctx(2 * u + 1);
#pragma unroll
        for (int rr = 0; rr < 4; ++rr) { s0[rr] = __expf(s0[rr] - mx); s1[rr] = __expf(s1[rr] - mx); sum += s0[rr] + s1[rr]; }
        const bf16x8 pb = pack8(s0, s1);
#pragma unroll
        for (int dm = 0; dm < 4; ++dm) {
            const bf16_t* vr = p.VT0C + ((size_t)(b * 512 + h * 64 + 16 * dm + q)) * TCB + 32 * u + 4 * g;
            const bf16x8 va = join8(*(const u32x2*)vr, *(const u32x2*)(vr + 16));
            o[dm] = mfma16(va, pb, o[dm]);
        }
    }
    sum += __shfl_xor(sum, 16); sum += __shfl_xor(sum, 32);
    const float inv = 1.0f / sum;
#pragma unroll
    for (int dm = 0; dm < 4; ++dm) {
        u32x2 wv; wv.x = cvt_pk_bf16(o[dm][0] * inv, o[dm][1] * inv); wv.y = cvt_pk_bf16(o[dm][2] * inv, o[dm][3] * inv);
        *(u32x2*)(p.MIX + (size_t)qtok * 1024 + h * 64 + 16 * dm + 4 * g) = wv;
    }
}

constexpr int CK_NCH = (TCB + TLB) / 16;
constexpr int CPW = 19200;
constexpr int CP_TMU = 0, CP_TMB = 2304, CP_TMK = 4608, CP_TMR = 6912, CP_TRU = 9216, CP_TRB = 11264, CP_TRV = 13312;
constexpr int CP_TT = 15360, CP_ARB = 15872, CP_AUKT = 16384, CP_H = 16896, CP_Q = 17408, CP_AUB = 17920, CP_G = 18944;
constexpr int CP_GT = CP_TMU, CP_WT = CP_TMB;

DI void cp_unit(const Params& p, char* W, int unit, int lane) {
    const int chain = unit / CK_NCH, c = unit % CK_NCH;
    const int b = chain >> 4, h = (chain >> 1) & 7, dir = chain & 1;
    const int q = lane & 15, g = lane >> 4;
    auto step_row = [&](int i) -> int {
        if (i < TCB) return TL + b * TCB + (dir == 0 ? i : TCB - 1 - i);
        const int jj = i - TCB;
        return b * TLB + (dir == 0 ? jj : TLB - 1 - jj);
    };
    {
        const float* SWd = p.SW + 2 * (h * 64 + lane) + dir;
        const unsigned* SBd = p.SBP + h * 64 + lane;
        const unsigned* SKDd = p.SKP + h * 64 + lane;
        const unsigned* SNd = p.SNV + h * 64 + lane;
        const unsigned* SRd = p.SRG + h * 64 + lane;
        float gam = 1.0f;
        unsigned pu[8], pb[8], pv[8];
        float lu = 0.f, lb = 0.f, lv = 0.f;
#pragma unroll
        for (int i4 = 0; i4 < 4; ++i4) {
            float w_[4], n_[4], b_[4], k_[4], r_[4], v_[4];
#pragma unroll
            for (int e = 0; e < 4; ++e) {
                const size_t ro = (size_t)step_row(c * 16 + 4 * i4 + e) * 512;
                w_[e] = SWd[2 * ro];
                { const unsigned nv = SNd[ro], bw = SBd[ro], kw = SKDd[ro], rw = SRd[ro];
                  n_[e] = bflo(nv); v_[e] = bfhi(nv); b_[e] = dir ? bfhi(bw) : bflo(bw); k_[e] = dir ? bfhi(kw) : bflo(kw); r_[e] = bflo(rw); }
            }
#pragma unroll
            for (int e = 0; e < 4; ++e) {
                const int i = 4 * i4 + e;
                const float gp = gam; gam *= w_[e];
                const float ig = 1.0f / gam;
                const float ut = gp * n_[e], bt = b_[e] * ig, kt = k_[e] * ig, rt = gam * r_[e];
                const unsigned wub = cvt_pk_bf16(ut, bt), wkr = cvt_pk_bf16(kt, rt);
                *(bf16_t*)(W + CP_TMU + i * 144 + lane * 2) = (bf16_t)(wub & 0xffff);
                *(bf16_t*)(W + CP_TMB + i * 144 + lane * 2) = (bf16_t)(wub >> 16);
                *(bf16_t*)(W + CP_TMK + i * 144 + lane * 2) = (bf16_t)(wkr & 0xffff);
                *(bf16_t*)(W + CP_TMR + i * 144 + lane * 2) = (bf16_t)(wkr >> 16);
                if (i & 1) { pu[i >> 1] = cvt_pk_bf16(lu, ut); pb[i >> 1] = cvt_pk_bf16(lb, bt); pv[i >> 1] = cvt_pk_bf16(lv, v_[e]); }
                else { lu = ut; lb = bt; lv = v_[e]; }
            }
        }
        *(u32x4*)(W + CP_TRU + lane * 32) = (u32x4){pu[0], pu[1], pu[2], pu[3]}; *(u32x4*)(W + CP_TRU + lane * 32 + 16) = (u32x4){pu[4], pu[5], pu[6], pu[7]};
        *(u32x4*)(W + CP_TRB + lane * 32) = (u32x4){pb[0], pb[1], pb[2], pb[3]}; *(u32x4*)(W + CP_TRB + lane * 32 + 16) = (u32x4){pb[4], pb[5], pb[6], pb[7]};
        *(u32x4*)(W + CP_TRV + lane * 32) = (u32x4){pv[0], pv[1], pv[2], pv[3]}; *(u32x4*)(W + CP_TRV + lane * 32 + 16) = (u32x4){pv[4], pv[5], pv[6], pv[7]};
        *(float*)(W + CP_G + lane * 4) = gam;
    }
    auto fr64 = [&](int off, int ks) -> bf16x8 { return *(const bf16x8*)(W + off + q * 144 + (32 * ks + 8 * g) * 2); };
    auto fr16 = [&](int off, int row) -> bf16x8 {
        u32x4 z = (u32x4){0u, 0u, 0u, 0u};
        if (g < 2) z = *(const u32x4*)(W + off + row * 32 + g * 16);
        return __builtin_bit_cast(bf16x8, z);
    };
    const f32x4 zero4 = (f32x4){0.f, 0.f, 0.f, 0.f};
    asm volatile("" ::: "memory");
    f32x4 arkT;
    {
        const bf16x8 fu0 = fr64(CP_TMU, 0), fu1 = fr64(CP_TMU, 1), fb0 = fr64(CP_TMB, 0), fb1 = fr64(CP_TMB, 1);
        const bf16x8 fk0 = fr64(CP_TMK, 0), fk1 = fr64(CP_TMK, 1), fr0 = fr64(CP_TMR, 0), fr1 = fr64(CP_TMR, 1);
        f32x4 d = mfma16(fb1, fu1, mfma16(fb0, fu0, zero4));
#pragma unroll
        for (int r = 0; r < 4; ++r) d[r] = (4 * g + r < q) ? d[r] : 0.f;
        *(f32x4*)(W + CP_AUB + q * 64 + 16 * g) = d;
        d = mfma16(fb1, fr1, mfma16(fb0, fr0, zero4));
#pragma unroll
        for (int r = 0; r < 4; ++r) d[r] = (4 * g + r <= q) ? d[r] : 0.f;
        { u32x2 w; w.x = cvt_pk_bf16(d[0], d[1]); w.y = cvt_pk_bf16(d[2], d[3]); *(u32x2*)(W + CP_ARB + q * 32 + 8 * g) = w; }
        d = mfma16(fu1, fk1, mfma16(fu0, fk0, zero4));
#pragma unroll
        for (int r = 0; r < 4; ++r) d[r] = (q < 4 * g + r) ? d[r] : 0.f;
        { u32x2 w; w.x = cvt_pk_bf16(d[0], d[1]); w.y = cvt_pk_bf16(d[2], d[3]); *(u32x2*)(W + CP_AUKT + q * 32 + 8 * g) = w; }
        arkT = mfma16(fk1, fr1, mfma16(fk0, fr0, zero4));
#pragma unroll
        for (int r = 0; r < 4; ++r) arkT[r] = (4 * g + r <= q) ? arkT[r] : 0.f;
    }
    asm volatile("" ::: "memory");
    {
        float t[16];
#pragma unroll
        for (int i = 0; i < 16; ++i) t[i] = 0.f;
#pragma unroll
        for (int i = 0; i < 16; ++i) {
            float s = (i == q) ? 1.0f : 0.f;
#pragma unroll
            for (int m4 = 0; m4 < 4; ++m4) {
                if (4 * m4 < i) {
                    const f32x4 a = *(const f32x4*)(W + CP_AUB + i * 64 + 16 * m4);
                    s += (a[0] * t[4 * m4] + a[1] * t[4 * m4 + 1]) + (a[2] * t[4 * m4 + 2] + a[3] * t[4 * m4 + 3]);
                }
            }
            t[i] = s;
        }
        if (g == 0) {
            *(u32x4*)(W + CP_TT + q * 32) = (u32x4){cvt_pk_bf16(t[0], t[1]), cvt_pk_bf16(t[2], t[3]), cvt_pk_bf16(t[4], t[5]), cvt_pk_bf16(t[6], t[7])};
            *(u32x4*)(W + CP_TT + q * 32 + 16) = (u32x4){cvt_pk_bf16(t[8], t[9]), cvt_pk_bf16(t[10], t[11]), cvt_pk_bf16(t[12], t[13]), cvt_pk_bf16(t[14], t[15])};
        }
    }
    asm volatile("" ::: "memory");
    {
        const f32x4 d = mfma16(fr16(CP_TT, q), fr16(CP_ARB, q), zero4);
        u32x2 w; w.x = cvt_pk_bf16(d[0], d[1]); w.y = cvt_pk_bf16(d[2], d[3]); *(u32x2*)(W + CP_H + q * 32 + 8 * g) = w;
    }
    asm volatile("" ::: "memory");
    {
        const f32x4 d = mfma16(fr16(CP_AUKT, q), fr16(CP_H, q), arkT);
        u32x2 w; w.x = cvt_pk_bf16(d[0], d[1]); w.y = cvt_pk_bf16(d[2], d[3]); *(u32x2*)(W + CP_Q + q * 32 + 8 * g) = w;
    }
    asm volatile("" ::: "memory");
    {
        const bf16x8 ft = fr16(CP_TT, q);
#pragma unroll
        for (int nt = 0; nt < 4; ++nt) {
            const f32x4 d = mfma16(ft, fr16(CP_TRB, 16 * nt + q), zero4);
            u32x2 w; w.x = cvt_pk_bf16(d[0], d[1]); w.y = cvt_pk_bf16(d[2], d[3]); *(u32x2*)(W + CP_GT + (16 * nt + q) * 32 + 8 * g) = w;
        }
    }
    asm volatile("" ::: "memory");
    {
        const bf16x8 fa = fr16(CP_AUKT, q);
#pragma unroll
        for (int nt = 0; nt < 4; ++nt) {
            f32x4 kt;
#pragma unroll
            for (int r = 0; r < 4; ++r) kt[r] = bf2f(*(const bf16_t*)(W + CP_TMK + (4 * g + r) * 144 + (16 * nt + q) * 2));
            const f32x4 d = mfma16(fa, fr16(CP_GT, 16 * nt + q), kt);
            u32x2 w; w.x = cvt_pk_bf16(d[0], d[1]); w.y = cvt_pk_bf16(d[2], d[3]); *(u32x2*)(W + CP_WT + (16 * nt + q) * 32 + 8 * g) = w;
        }
    }
    asm volatile("" ::: "memory");
    {
        const bf16x8 fh = fr16(CP_H, q), fq = fr16(CP_Q, q);
        bf16_t* RHg = p.CRH + (size_t)unit * 1024;
        bf16_t* P3g = p.CP3 + (size_t)unit * 1024;
        bf16_t* Mg = p.CM + (size_t)unit * 4096;
        bf16_t* Ng = p.CN + (size_t)unit * 4096;
#pragma unroll
        for (int mt = 0; mt < 4; ++mt) {
            const u32x2 rw = *(const u32x2*)(W + CP_TMR + q * 144 + (16 * mt + 4 * g) * 2);
            const f32x4 rt = (f32x4){bflo(rw.x), bfhi(rw.x), bflo(rw.y), bfhi(rw.y)};
            const f32x4 d = mfma16(fr16(CP_TRU, 16 * mt + q), fh, rt);
            u32x2 w; w.x = cvt_pk_bf16(d[0], d[1]); w.y = cvt_pk_bf16(d[2], d[3]);
            *(u32x2*)(RHg + (((mt >> 1) * 64 + lane) * 8 + (mt & 1) * 4)) = w;
        }
#pragma unroll
        for (int vs = 0; vs < 4; ++vs) {
            const f32x4 d = mfma16(fq, fr16(CP_TRV, 16 * vs + q), zero4);
            { u32x2 w; w.x = cvt_pk_bf16(d[0], d[1]); w.y = cvt_pk_bf16(d[2], d[3]); *(u32x2*)(P3g + (vs * 64 + lane) * 4) = w; }
        }
#pragma unroll
        for (int nt = 0; nt < 4; ++nt) {
            const bf16x8 fg = fr16(CP_GT, 16 * nt + q);
            const float gc = *(const float*)(W + CP_G + (16 * nt + q) * 4);
#pragma unroll
            for (int mt = 0; mt < 4; ++mt) {
                f32x4 d = mfma16(fr16(CP_TRU, 16 * mt + q), fg, zero4);
#pragma unroll
                for (int r = 0; r < 4; ++r) d[r] = gc * (d[r] + ((16 * mt + 4 * g + r == 16 * nt + q) ? 1.0f : 0.f));
                u32x2 w; w.x = cvt_pk_bf16(d[0], d[1]); w.y = cvt_pk_bf16(d[2], d[3]);
                *(u32x2*)(Mg + (((nt * 2 + (mt >> 1)) * 64 + lane) * 8 + (mt & 1) * 4)) = w;
            }
        }
#pragma unroll
        for (int mt = 0; mt < 4; ++mt) {
            const bf16x8 fw = fr16(CP_WT, 16 * mt + q);
            const f32x4 gc = *(const f32x4*)(W + CP_G + (16 * mt + 4 * g) * 4);
#pragma unroll
            for (int vs = 0; vs < 4; ++vs) {
                const f32x4 d = mfma16(fw, fr16(CP_TRV, 16 * vs + q), zero4) * gc;
                { u32x2 w; w.x = cvt_pk_bf16(d[0], d[1]); w.y = cvt_pk_bf16(d[2], d[3]); *(u32x2*)(Ng + ((vs * 4 + mt) * 64 + lane) * 4) = w; }
            }
        }
    }
    asm volatile("" ::: "memory");
}

DI void sq_wave(const Params& p, int chain, int vs, int lane) {
    const int b = chain >> 4, h = (chain >> 1) & 7, dir = chain & 1;
    const int q = lane & 15, g = lane >> 4;
    auto step_row = [&](int i) -> int {
        if (i < TCB) return TL + b * TCB + (dir == 0 ? i : TCB - 1 - i);
        const int jj = i - TCB;
        return b * TLB + (dir == 0 ? jj : TLB - 1 - jj);
    };
    float* YCd = p.YS + ((size_t)chain * CK_NCH * 4 + vs) * 256 + lane * 4;
    f32x4 st[4];
#pragma unroll
    for (int mt = 0; mt < 4; ++mt) st[mt] = (f32x4){0.f, 0.f, 0.f, 0.f};
    struct Ops { u32x4 m[4][2]; u32x4 r[2]; u32x2 n[4]; u32x2 p3; };
    auto load = [&](Ops& o, int c) {
        const size_t unit = (size_t)chain * CK_NCH + c;
        const bf16_t* Mg = p.CM + unit * 4096; const bf16_t* RHg = p.CRH + unit * 1024;
        const bf16_t* Ng = p.CN + unit * 4096 + (size_t)vs * 1024; const bf16_t* P3g = p.CP3 + unit * 1024 + vs * 256;
#pragma unroll
        for (int mt = 0; mt < 4; ++mt)
#pragma unroll
            for (int s = 0; s < 2; ++s) o.m[mt][s] = *(const u32x4*)(Mg + ((mt * 2 + s) * 64 + lane) * 8);
#pragma unroll
        for (int s = 0; s < 2; ++s) o.r[s] = *(const u32x4*)(RHg + (s * 64 + lane) * 8);
#pragma unroll
        for (int mt = 0; mt < 4; ++mt) o.n[mt] = *(const u32x2*)(Ng + (mt * 64 + lane) * 4);
        o.p3 = *(const u32x2*)(P3g + lane * 4);
    };
    auto stepc = [&](const Ops& o, int c) {
        const bf16x8 sb0 = pack8(st[0], st[1]), sb1 = pack8(st[2], st[3]);
        f32x4 y = mfma16(__builtin_bit_cast(bf16x8, o.r[0]), sb0, (f32x4){bflo(o.p3.x), bfhi(o.p3.x), bflo(o.p3.y), bfhi(o.p3.y)});
        y = mfma16(__builtin_bit_cast(bf16x8, o.r[1]), sb1, y);
#pragma unroll
        for (int mt = 0; mt < 4; ++mt) {
            f32x4 a = mfma16(__builtin_bit_cast(bf16x8, o.m[mt][0]), sb0, (f32x4){bflo(o.n[mt].x), bfhi(o.n[mt].x), bflo(o.n[mt].y), bfhi(o.n[mt].y)});
            st[mt] = mfma16(__builtin_bit_cast(bf16x8, o.m[mt][1]), sb1, a);
        }
        *(f32x4*)(YCd + ((size_t)c * 4) * 256) = y;
    };
    Ops oa, ob, oc;
    load(oa, 0); load(ob, 1); load(oc, 2);
    for (int c = 0; c < CK_NCH; c += 3) {
        stepc(oa, c);     __builtin_amdgcn_sched_barrier(0); load(oa, (c + 3 < CK_NCH) ? c + 3 : CK_NCH - 1); __builtin_amdgcn_sched_barrier(0);
        stepc(ob, c + 1); __builtin_amdgcn_sched_barrier(0); load(ob, (c + 4 < CK_NCH) ? c + 4 : CK_NCH - 1); __builtin_amdgcn_sched_barrier(0);
        stepc(oc, c + 2); __builtin_amdgcn_sched_barrier(0); load(oc, (c + 5 < CK_NCH) ? c + 5 : CK_NCH - 1); __builtin_amdgcn_sched_barrier(0);
    }
}

DI void na_block_unit(const Params& p, char* lds, int U) {
    const int tid = opaque_tid(), lane = tid & 63, wv = tid >> 6, q = lane & 15, g = lane >> 4;
    const bool lat = U < 1024;
    int b, r, hp, qb;
    if (lat) { hp = U & 3; r = (U >> 2) & 127; b = U >> 9; qb = 0; } else { const int V = U - 1024; qb = V & 3; hp = (V >> 2) & 3; b = V >> 4; r = 0; }
    const int hh = wv >> 2, w = wv & 3, h = 2 * hp + hh;
    const int j = 16 * w + q;
    const int qtok = lat ? (b * TLB + r * 64 + j) : (TL + b * TCB + 64 * qb + j);
    const int row_start = lat ? (r - 4 < 0 ? 0 : (r - 4 > 120 ? 120 : r - 4)) : 0;
    const int c0 = (w == 0 ? 0 : (w == 1 ? 8 : (w == 2 ? 24 : 32)));
    int cs = j - 8; cs = cs < 0 ? 0 : (cs > 48 ? 48 : cs);
    const int nch = lat ? 12 : 4, first_ctx = lat ? 8 : 0;
    bf16x8 qf[2];
#pragma unroll
    for (int ks = 0; ks < 2; ++ks) qf[ks] = *(const bf16x8*)(p.Q0 + (size_t)qtok * 512 + h * 64 + 32 * ks + 8 * g);
    u32x4 rk[2], rv[2];
    auto issue = [&](int ci) {
        const bool isctx = ci >= first_ctx;
        const int cc = ci - first_ctx;
#pragma unroll
        for (int i = 0; i < 2; ++i) {
            const int pc = tid + NTHR * i;
            const int key = pc >> 4, c16 = pc & 15;
            const int tok = isctx ? (TL + b * TCB + cc * 64 + key) : (b * TLB + (row_start + ci) * 64 + key);
            rk[i] = *(const u32x4*)(p.K0 + (size_t)tok * 512 + hp * 128 + c16 * 8);
            const int row = pc >> 3, k8 = pc & 7;
            const bf16_t* vsrc = isctx ? (p.VT0C + ((size_t)(b * 512 + hp * 128 + row)) * TCB + cc * 64 + k8 * 8)
                                       : (p.VT0L + ((size_t)(b * 512 + hp * 128 + row)) * TLB + (row_start + ci) * 64 + k8 * 8);
            rv[i] = *(const u32x4*)vsrc;
        }
    };
    auto stash = [&](char* st) {
#pragma unroll
        for (int i = 0; i < 2; ++i) {
            const int pc = tid + NTHR * i;
            const int key = pc >> 4, c16 = pc & 15;
            *(u32x4*)(st + (c16 >> 3) * 8192 + lds_byte(key, (c16 & 7) * 8)) = rk[i];
            const int row = pc >> 3, k8 = pc & 7;
            *(u32x4*)(st + 16384 + (row >> 6) * 8192 + lds_byte(row & 63, k8 * 8)) = rv[i];
        }
    };
    float m = -3.0e38f, sum = 0.f;
    f32x4 o[4];
#pragma unroll
    for (int dm = 0; dm < 4; ++dm) o[dm] = (f32x4){0.f, 0.f, 0.f, 0.f};
    auto qk = [&](const char* kimg, int kc0, f32x4 (&s)[2]) {
#pragma unroll
        for (int hf = 0; hf < 2; ++hf) {
            const int key = kc0 + 8 * (q >> 2) + 4 * hf + (q & 3);
            f32x4 a = (f32x4){0.f, 0.f, 0.f, 0.f};
#pragma unroll
            for (int ks = 0; ks < 2; ++ks) a = mfma16(*(const bf16x8*)(kimg + lds_byte(key, 32 * ks + 8 * g)), qf[ks], a);
            s[hf] = a;
        }
    };
    auto pv = [&](const char* vimg, int kc0, const f32x4 (&s)[2]) {
        const bf16x8 pb = pack8(s[0], s[1]);
#pragma unroll
        for (int dm = 0; dm < 4; ++dm) o[dm] = mfma16(*(const bf16x8*)(vimg + lds_byte(16 * dm + q, kc0 + 8 * g)), pb, o[dm]);
    };
    issue(0);
    stash(lds);
    __syncthreads();
    for (int ci = 0; ci < nch; ++ci) {
        const bool more = ci + 1 < nch;
        if (more) issue(ci + 1);
        const char* st = lds + (ci & 1) * 32768;
        const char* kimg = st + hh * 8192;
        const char* vimg = st + 16384 + hh * 8192;
        if (ci < first_ctx) {
            f32x4 s[2];
            qk(kimg, c0, s);
            const int row_off = row_start + ci - r + 7;
            float cmax = -3.0e38f;
#pragma unroll
            for (int hf = 0; hf < 2; ++hf)
#pragma unroll
                for (int rr = 0; rr < 4; ++rr) {
                    const int cc_ = c0 + 8 * g + 4 * hf + rr;
                    int co = cc_ - j; co = co < -15 ? -15 : (co > 15 ? 15 : co);
                    const bool in = (cc_ >= cs) && (cc_ < cs + 16);
                    const float bias = p.na_rpb[(h * 15 + row_off) * 31 + co + 15];
                    const float sv = in ? (s[hf][rr] * 0.125f + bias) : -1.0e30f;
                    s[hf][rr] = sv; cmax = fmaxf(cmax, sv);
                }
            cmax = fmaxf(cmax, __shfl_xor(cmax, 16)); cmax = fmaxf(cmax, __shfl_xor(cmax, 32));
            const float mn = fmaxf(m, cmax), al = __expf(m - mn);
            m = mn; sum *= al;
#pragma unroll
            for (int dm = 0; dm < 4; ++dm) o[dm] = o[dm] * al;
#pragma unroll
            for (int hf = 0; hf < 2; ++hf)
#pragma unroll
                for (int rr = 0; rr < 4; ++rr) { s[hf][rr] = __expf(s[hf][rr] - mn); sum += s[hf][rr]; }
            pv(vimg, c0, s);
        } else {
            f32x4 s0[2], s1[2];
            qk(kimg, 0, s0); qk(kimg, 32, s1);
            float cmax = -3.0e38f;
#pragma unroll
            for (int hf = 0; hf < 2; ++hf)
#pragma unroll
                for (int rr = 0; rr < 4; ++rr) { s0[hf][rr] *= 0.125f; s1[hf][rr] *= 0.125f; cmax = fmaxf(cmax, fmaxf(s0[hf][rr], s1[hf][rr])); }
            cmax = fmaxf(cmax, __shfl_xor(cmax, 16)); cmax = fmaxf(cmax, __shfl_xor(cmax, 32));
            const float mn = fmaxf(m, cmax), al = __expf(m - mn);
            m = mn; sum *= al;
#pragma unroll
            for (int dm = 0; dm < 4; ++dm) o[dm] = o[dm] * al;
#pragma unroll
            for (int hf = 0; hf < 2; ++hf)
#pragma unroll
                for (int rr = 0; rr < 4; ++rr) { s0[hf][rr] = __expf(s0[hf][rr] - mn); s1[hf][rr] = __expf(s1[hf][rr] - mn); sum += s0[hf][rr] + s1[hf][rr]; }
            pv(vimg, 0, s0); pv(vimg, 32, s1);
        }
        if (more) stash(lds + ((ci + 1) & 1) * 32768);
        __syncthreads();
    }
    sum += __shfl_xor(sum, 16); sum += __shfl_xor(sum, 32);
    const float inv = 1.0f / sum;
#pragma unroll
    for (int dm = 0; dm < 4; ++dm) {
        u32x2 wv_; wv_.x = cvt_pk_bf16(o[dm][0] * inv, o[dm][1] * inv); wv_.y = cvt_pk_bf16(o[dm][2] * inv, o[dm][3] * inv);
        *(u32x2*)(p.MIX + (size_t)qtok * 1024 + h * 64 + 16 * dm + 4 * g) = wv_;
    }
}

template <int PARTS = 3>
DI void ph_attn_cp(const Params& p, char* lds) {
    const int tz_ = opaque_tid(), lane = tz_ & 63, wv = tz_ >> 6;
    char* W = lds + wv * CPW;
    const int gw = blockIdx.x * 8 + wv, nw = (int)gridDim.x * 8;
    constexpr int NCP = 32 * CK_NCH;
    if (PARTS & 1) for (int U = gw; U < NCP; U += nw) cp_unit(p, W, U, lane);
    if (PARTS & 2) {
        __syncthreads();
        for (int U = blockIdx.x; U < 1024 + 32; U += gridDim.x) na_block_unit(p, lds, U);
    }
}
DI void ph_sq(const Params& p, char* lds) {
    const int tz_ = opaque_tid(), lane = tz_ & 63, wv = tz_ >> 6;
    const int nsq = gridDim.x >= 256 ? 128 : 0;
    if ((int)blockIdx.x < nsq) { if (wv == 0) sq_wave(p, blockIdx.x >> 2, blockIdx.x & 3, lane); return; }
    if (nsq == 0) { if (wv == 0) for (int u = blockIdx.x; u < 128; u += gridDim.x) sq_wave(p, u >> 2, u & 3, lane); __syncthreads(); }
    for (int U = (int)blockIdx.x - nsq; U < 1024 + 32; U += (int)gridDim.x - nsq) na_block_unit(p, lds, U);
}

DI void ph_rw_readout(const Params& p) {
    const int c = opaque_tid(), hh = c >> 6;
    const float gg = p.rw_gn_g[c], gb = p.rw_gn_b[c];
    for (int row = blockIdx.x; row < TT; row += gridDim.x) {
        const size_t o = (size_t)row * 512 + c;
        float y;
        {
            const bool lat = row < TL;
            const int bb = lat ? (row >> 13) : ((row - TL) >> 8), t = lat ? (row & (TLB - 1)) : ((row - TL) & (TCB - 1));
            const int pf = lat ? TCB + t : t, pb = lat ? TCB + (TLB - 1 - t) : (TCB - 1 - t);
            const int vs = (c >> 4) & 3, q = c & 15;
            const size_t cf = (size_t)((bb * 8 + hh) * 2 + 0) * CK_NCH + (pf >> 4), cb = (size_t)((bb * 8 + hh) * 2 + 1) * CK_NCH + (pb >> 4);
            y = p.YS[(cf * 4 + vs) * 256 + (16 * ((pf & 15) >> 2) + q) * 4 + (pf & 3)] + p.YS[(cb * 4 + vs) * 256 + (16 * ((pb & 15) >> 2) + q) * 4 + (pb & 3)];
        }
        const float mu = wave_allsum(y) * (1.0f / 64.0f);
        const float d = y - mu;
        const float var = wave_allsum(d * d) * (1.0f / 64.0f);
        const float yn = d * rsqrtf(var + 64e-5f) * gg + gb;
        const float outv = (yn + p.BONUS[row * 8 + hh] * bfhi(p.SNV[o])) * bfhi(p.SRG[o]);
        p.MIX[(size_t)row * 1024 + 512 + c] = (bf16_t)(cvt_pk_bf16(outv, 0.f) & 0xffff);
    }
}

DI void gemm_f32out(char* lds, const bf16_t* A, int M, const float* W, int N, float* C) {
    const int tid = opaque_tid();
    const int ntn = N / 128, ntm = M / 256;
    gemm_stream<4, 2, 4, 4, PtrLoaderF, 4>(lds, ntn * ntm, 16, [&](int u, PtrLoader<4>& al, PtrLoaderF& bl, const int (&nx)[4]) {
        int tm, tn; tile_of(u, ntm, ntn, tm, tn);
#pragma unroll
        for (int i = 0; i < 4; ++i) al.p[i] = (unsigned)((tm * 256 + a_row(tid) + 64 * i) * 1024 + a_c8(tid) * 8);
        al.base = A;
        fill_bf(bl, W, N, tn * 128, N);
    }, [&](int u, int (&nx)[4], int) {}, [&](int u, int mi, const f32x4 (&a)[4], f32x4 (&o)[4], int r0, int c0) {
#pragma unroll
        for (int ni = 0; ni < 4; ++ni) o[ni] = a[ni];
    }, [&](int u, int r, int c, f32x4 v, f32x4 pv) {
        int tm, tn; tile_of(u, ntm, ntn, tm, tn);
        *(f32x4*)(C + (size_t)(tm * 256 + r) * N + tn * 128 + c) = v;
    });
}

DI void ln_row(f32x4 (&v)[4], const float* g, const float* bta, int lane) {
    float s = 0.f;
#pragma unroll
    for (int i = 0; i < 4; ++i) s += (v[i][0] + v[i][1]) + (v[i][2] + v[i][3]);
    const float mu = wave_allsum(s) * (1.0f / 1024.0f);
    float q = 0.f;
#pragma unroll
    for (int i = 0; i < 4; ++i) { v[i] = v[i] - mu; q += (v[i][0] * v[i][0] + v[i][1] * v[i][1]) + (v[i][2] * v[i][2] + v[i][3] * v[i][3]); }
    const float rstd = rsqrtf(wave_allsum(q) * (1.0f / 1024.0f) + 1e-5f);
#pragma unroll
    for (int i = 0; i < 4; ++i) {
        const int c = 4 * lane + 256 * i;
        v[i] = v[i] * rstd * (*(const f32x4*)(g + c)) + (*(const f32x4*)(bta + c));
    }
}

template <int L>
DI void ph_ln1(const Params& p) {
    const int tz_ = opaque_tid(), lane = tz_ & 63, wv = tz_ >> 6;
    const int nrows = (L == 0) ? TT : TL;
    for (int row = blockIdx.x * 8 + wv; row < nrows; row += gridDim.x * 8) {
        const float* hin = (L == 0) ? (row < TL ? p.x + (size_t)row * 1024 : p.ctx + (size_t)(row - TL) * 1024) : p.HB + (size_t)row * 1024;
        const float* m = p.mods + (size_t)(L * 3 + mods_row(row)) * 6144;
        f32x4 v[4];
#pragma unroll
        for (int i = 0; i < 4; ++i) {
            const int c = 4 * lane + 256 * i;
            v[i] = ALPHA * (*(const f32x4*)(hin + c)) + (*(const f32x4*)(m + 2048 + c)) * (*(const f32x4*)(p.YL + (size_t)row * 1024 + c));
        }
        ln_row(v, p.ln_g + (L * 2 + 0) * 1024, p.ln_b + (L * 2 + 0) * 1024, lane);
#pragma unroll
        for (int i = 0; i < 4; ++i) {
            const int c = 4 * lane + 256 * i;
            *(f32x4*)(p.HA + (size_t)row * 1024 + c) = v[i];
            const f32x4 f = v[i] * (1.0f + *(const f32x4*)(m + 4096 + c)) + *(const f32x4*)(m + 3072 + c);
            u32x2 w; w.x = cvt_pk_bf16(f[0], f[1]); w.y = cvt_pk_bf16(f[2], f[3]);
            *(u32x2*)(p.Abuf + (size_t)row * 1024 + c) = w;
        }
    }
}

template <int CTRL, int RM> DI float dpp_keep(float x) {
    return __builtin_bit_cast(float, __builtin_amdgcn_update_dpp(__builtin_bit_cast(int, x), __builtin_bit_cast(int, x), CTRL, RM, 0xF, false));
}
DI float wave_max_uniform(float x) {
    x = fmaxf(x, dpp_keep<0xB1, 0xF>(x)); x = fmaxf(x, dpp_keep<0x4E, 0xF>(x));
    x = fmaxf(x, dpp_keep<0x141, 0xF>(x)); x = fmaxf(x, dpp_keep<0x140, 0xF>(x));
    x = fmaxf(x, dpp_keep<0x142, 0xA>(x)); x = fmaxf(x, dpp_keep<0x143, 0xC>(x));
    return __builtin_bit_cast(float, __builtin_amdgcn_readlane(__builtin_bit_cast(int, x), 63));
}
template <int L>
DI void ph_route(const Params& p, char* ldsc) {
    const int tz_ = opaque_tid(), lane = tz_ & 63, wv = tz_ >> 6;
    const int nrows = (L == 0) ? TT : TL;
    int* hist = (int*)ldsc;
    if (tz_ < 256) hist[tz_] = 0;
    __syncthreads();
    const f32x4 bias = *(const f32x4*)(p.moe_bias + L * 256 + 4 * lane);
    for (int row = blockIdx.x * 8 + wv; row < nrows; row += gridDim.x * 8) {
        const f32x4 lg = *(const f32x4*)(p.LOGITS + (size_t)row * 256 + 4 * lane);
        const float s0 = sigmoidf_(lg[0]), s1 = sigmoidf_(lg[1]), s2 = sigmoidf_(lg[2]), s3 = sigmoidf_(lg[3]);
        float v0 = s0 + bias[0], v1 = s1 + bias[1], v2 = s2 + bias[2], v3 = s3 + bias[3];
        float m1 = fmaxf(v0, v1), m2 = fminf(v0, v1);
        { const float a = fmaxf(v2, v3), bq = fminf(v2, v3); const float n1 = fmaxf(m1, a); const float n2 = fmaxf(fminf(m1, a), fmaxf(m2, bq)); m1 = n1; m2 = n2; }
        { const float o1 = dpp_keep<0xB1, 0xF>(m1), o2 = dpp_keep<0xB1, 0xF>(m2); const float n1 = fmaxf(m1, o1), n2 = fmaxf(fminf(m1, o1), fmaxf(m2, o2)); m1 = n1; m2 = n2; }
        { const float o1 = dpp_keep<0x4E, 0xF>(m1), o2 = dpp_keep<0x4E, 0xF>(m2); const float n1 = fmaxf(m1, o1), n2 = fmaxf(fminf(m1, o1), fmaxf(m2, o2)); m1 = n1; m2 = n2; }
        { const float o1 = dpp_keep<0x141, 0xF>(m1), o2 = dpp_keep<0x141, 0xF>(m2); const float n1 = fmaxf(m1, o1), n2 = fmaxf(fminf(m1, o1), fmaxf(m2, o2)); m1 = n1; m2 = n2; }
        const float gs = m1 + m2;
        const int myg = lane >> 3;
        int rank = 0;
#pragma unroll
        for (int gg = 0; gg < 8; ++gg) {
            const float og = __builtin_bit_cast(float, __builtin_amdgcn_readlane(__builtin_bit_cast(int, gs), gg * 8));
            rank += ((og > gs) || (og == gs && gg < myg)) ? 1 : 0;
        }
        if (rank >= 4) { v0 = -1.0e30f; v1 = -1.0e30f; v2 = -1.0e30f; v3 = -1.0e30f; }
        int sel_e = 0; float sel_s = 0.f, ssum = 0.f;
#pragma unroll
        for (int rd = 0; rd < 8; ++rd) {
            float bv = v0; int bi = 0; float bs = s0;
            if (v1 > bv) { bv = v1; bi = 1; bs = s1; }
            if (v2 > bv) { bv = v2; bi = 2; bs = s2; }
            if (v3 > bv) { bv = v3; bi = 3; bs = s3; }
            const float mx = wave_max_uniform(bv);
            const unsigned long long bal = __ballot(bv == mx);
            const int ol = __builtin_amdgcn_readfirstlane((int)__builtin_ctzll(bal));
            const int oi = __builtin_amdgcn_readlane(bi, ol);
            const float sv = __builtin_bit_cast(float, __builtin_amdgcn_readlane(__builtin_bit_cast(int, bs), ol));
            if (lane == ol) { if (oi == 0) v0 = -3.0e30f; else if (oi == 1) v1 = -3.0e30f; else if (oi == 2) v2 = -3.0e30f; else v3 = -3.0e30f; }
            ssum += sv;
            if (lane == rd) { sel_e = 4 * ol + oi; sel_s = sv; }
        }
        if (lane < 8) {
            p.EIDX[(size_t)row * 8 + lane] = sel_e;
            p.EW[(size_t)row * 8 + lane] = sel_s / ssum * 2.5f;
            atomicAdd(&hist[sel_e], 1);
        }
    }
    __syncthreads();
    if (tz_ < 256) p.HIST[((size_t)L * 256 + blockIdx.x) * 256 + tz_] = hist[tz_];
    __syncthreads();
}

template <int L>
DI void ph_scatter(const Params& p, char* ldsc) {
    int* sbase = (int*)ldsc;
    int* cursor = sbase + 320;
    const int tid = opaque_tid(), lane = tid & 63, wv = tid >> 6;
    const int nrows = (L == 0) ? TT : TL;
    int mypre = 0;
    {
        int* part = sbase + 640;
        const int e = tid & 255, half = tid >> 8, nbh = ((int)gridDim.x + 1) >> 1;
        const int* hcol = p.HIST + (size_t)L * 256 * 256 + e;
        int tot = 0, pre = 0;
#pragma unroll 16
        for (int i = 0; i < nbh; ++i) {
            const int bq = half * nbh + i;
            const int hv = bq < (int)gridDim.x ? hcol[bq * 256] : 0;
            tot += hv; pre += (bq < (int)blockIdx.x) ? hv : 0;
        }
        part[half * 512 + e] = tot; part[half * 512 + 256 + e] = pre;
        __syncthreads();
        if (tid < 256) {
            tot = part[tid] + part[512 + tid]; mypre = part[256 + tid] + part[768 + tid];
            sbase[tid] = (tot + 255) & ~255;
        }
    }
    __syncthreads();
    {
        int pd = 0, inc = 0;
        if (tid < 256) {
            pd = sbase[tid]; inc = pd;
#pragma unroll
            for (int d = 1; d < 64; d <<= 1) { const int t = __shfl_up(inc, d); if (lane >= d) inc += t; }
            if (lane == 63) sbase[288 + wv] = inc;
        }
        __syncthreads();
        if (tid < 256) {
            int off = 0;
#pragma unroll
            for (int w = 0; w < 3; ++w) off += (w < wv) ? sbase[288 + w] : 0;
            const int excl = inc - pd + off;
            sbase[tid] = excl;
            if (tid == 255) sbase[256] = excl + pd;
        }
    }
    __syncthreads();
    if (tid < 256) cursor[tid] = sbase[tid] + mypre;
    if (blockIdx.x == 0) {
        int* te = p.TILE_E + L * MAXTILES; int* tr = p.TILE_R0 + L * MAXTILES;
        if (tid < 256) { const int b0 = sbase[tid], b1 = sbase[tid + 1]; for (int r = b0; r < b1; r += 256) { te[r >> 8] = tid; tr[r >> 8] = r; } }
        const int nt = sbase[256] >> 8, nsh = nrows / 256;
        for (int i = tid; i < nsh; i += NTHR) { te[nt + i] = 256; tr[nt + i] = SH_BASE + 256 * i; }
        if (tid == 0) p.ictl[1024 + L] = nt + nsh;
    }
    __syncthreads();
    int* stok = p.SLOT_TOK + (size_t)L * NSLOT; float* sw = p.SLOT_W + (size_t)L * NSLOT;
    for (int row = blockIdx.x * 8 + wv; row < nrows; row += gridDim.x * 8) {
        if (lane < 8) {
            const int a = row * 8 + lane;
            const int e = p.EIDX[a];
            const int pos = atomicAdd(&cursor[e], 1);
            stok[pos] = row; sw[pos] = p.EW[a]; p.APOS[a] = pos;
        }
    }
    __syncthreads();
}

template <int L>
DI void ph_moe1(const Params& p, char* lds) {
    const int tid = opaque_tid();
    const int ntiles = p.ictl[1024 + L];
    const int* te = p.TILE_E + L * MAXTILES; const int* tr = p.TILE_R0 + L * MAXTILES;
    const int* stok = p.SLOT_TOK + (size_t)L * NSLOT;
    gemm_stream<4, 2, 4, 4, PtrLoaderF, 2>(lds, ntiles * 4, 16, [&](int u, PtrLoader<4>& al, PtrLoaderF& bl, const int (&nx)[4]) {
        const int ti = u >> 2, tn = u & 3;
        const int e = te[ti];
#pragma unroll
        for (int i = 0; i < 4; ++i) al.p[i] = (unsigned)(nx[i] * 1024 + a_c8(tid) * 8);
        al.base = p.Abuf;
        const float* gsrc = e < 256 ? p.moe_w_gate + ((size_t)(L * 256 + e)) * 1024 * 256 : p.sh_w_gate + (size_t)L * 1024 * 256;
        const float* usrc = e < 256 ? p.moe_w_up + ((size_t)(L * 256 + e)) * 1024 * 256 : p.sh_w_up + (size_t)L * 1024 * 256;
        bl.ld = 256; bl.base0 = gsrc; bl.base1 = usrc;
#pragma unroll
        for (int i = 0; i < 4; ++i) bl.p[i] = (unsigned)((tid >> 3) * 256 + 32 * (2 * tn + (i >> 1)) + (tid & 7) * 4);
    }, [&](int u, int (&nx)[4], int half) {
        const int row0 = tr[u >> 2];
#pragma unroll
        for (int i = 0; i < 4; ++i) if (half == 2 || (i >> 1) == half) nx[i] = stok[row0 + a_row(tid) + 64 * i];
    }, [&](int u, int mi, const f32x4 (&a)[4], f32x4 (&o)[2], int r0, int c0) {
#pragma unroll
        for (int ni = 0; ni < 2; ++ni)
#pragma unroll
            for (int j = 0; j < 4; ++j) o[ni][j] = siluf_(a[ni][j]) * a[ni + 2][j];
    }, [&](int u, int r, int c, f32x4 v, f32x4 pv) {
        const int ti = u >> 2, tn = u & 3;
        u32x2 w; w.x = cvt_pk_bf16(v[0], v[1]); w.y = cvt_pk_bf16(v[2], v[3]);
        *(u32x2*)(p.HBUF + (size_t)(tr[ti] + r) * 256 + tn * 64 + c) = w;
    });
}
template <int L>
DI void ph_moe2(const Params& p, char* lds) {
    const int tid = opaque_tid();
    const int ntiles = p.ictl[1024 + L];
    const int* te = p.TILE_E + L * MAXTILES; const int* tr = p.TILE_R0 + L * MAXTILES;
    const float* sw = p.SLOT_W + (size_t)L * NSLOT;
    float sc4[4] = {0.f, 0.f, 0.f, 0.f};
    gemm_stream<4, 2, 4, 4, PtrLoaderF, 4>(lds, ntiles * 8, 4, [&](int u, PtrLoader<4>& al, PtrLoaderF& bl, const int (&nx)[4]) {
        const int ti = u >> 3, tn = u & 7;
        const int e = te[ti], row0 = tr[ti];
#pragma unroll
        for (int i = 0; i < 4; ++i) al.p[i] = (unsigned)((row0 + a_row(tid) + 64 * i) * 256 + a_c8(tid) * 8);
        al.base = p.HBUF;
        const float* dsrc = e < 256 ? p.moe_w_down + ((size_t)(L * 256 + e)) * 256 * 1024 : p.sh_w_down + (size_t)L * 256 * 1024;
        fill_bf(bl, dsrc, 1024, tn * 128, 1024);
    }, [&](int u, int (&nx)[4], int) {}, [&](int u, int mi, const f32x4 (&a)[4], f32x4 (&o)[4], int r0, int c0) {
        if (mi == 0) {
            const float* s_ = sw + tr[u >> 3] + r0;
#pragma unroll
            for (int m = 0; m < 4; ++m) sc4[m] = s_[16 * m];
        }
#pragma unroll
        for (int ni = 0; ni < 4; ++ni) o[ni] = a[ni] * sc4[mi];
    }, [&](int u, int r, int c, f32x4 v, f32x4 pv) {
        const int ti = u >> 3, tn = u & 7;
        const int row = tr[ti] + r;
        u32x2 w; w.x = cvt_pk_bf16(v[0], v[1]); w.y = cvt_pk_bf16(v[2], v[3]);
        *(u32x2*)(p.YB + (size_t)row * 1024 + tn * 128 + c) = w;
    });
}

template <int L>
DI void ph_combine(const Params& p) {
    const int tz_ = opaque_tid(), lane = tz_ & 63, wv = tz_ >> 6;
    const int nrows = (L == 0) ? TT : TL;
    for (int row = blockIdx.x * 8 + wv; row < nrows; row += gridDim.x * 8) {
        int rr[9];
#pragma unroll
        for (int k = 0; k < 8; ++k) rr[k] = p.APOS[(size_t)row * 8 + k];
        rr[8] = SH_BASE + row;
        const float* m = p.mods + (size_t)(L * 3 + mods_row(row)) * 6144;
        f32x4 v[4];
#pragma unroll
        for (int i = 0; i < 4; ++i) {
            const int c = 4 * lane + 256 * i;
            f32x4 ff = (f32x4){0.f, 0.f, 0.f, 0.f};
#pragma unroll
            for (int k = 0; k < 9; ++k) {
                const u32x2 w = *(const u32x2*)(p.YB + (size_t)rr[k] * 1024 + c);
                ff[0] += bflo(w.x); ff[1] += bfhi(w.x); ff[2] += bflo(w.y); ff[3] += bfhi(w.y);
            }
            v[i] = ALPHA * (*(const f32x4*)(p.HA + (size_t)row * 1024 + c)) + (*(const f32x4*)(m + 5120 + c)) * ff;
        }
        ln_row(v, p.ln_g + (L * 2 + 1) * 1024, p.ln_b + (L * 2 + 1) * 1024, lane);
        if (L == 0) {
            const float* m1 = p.mods + (size_t)(1 * 3 + mods_row(row)) * 6144;
#pragma unroll
            for (int i = 0; i < 4; ++i) {
                const int c = 4 * lane + 256 * i;
                *(f32x4*)(p.HB + (size_t)row * 1024 + c) = v[i];
                const f32x4 a = v[i] * (1.0f + *(const f32x4*)(m1 + 1024 + c)) + *(const f32x4*)(m1 + c);
                u32x2 w; w.x = cvt_pk_bf16(a[0], a[1]); w.y = cvt_pk_bf16(a[2], a[3]);
                *(u32x2*)(p.Abuf + (size_t)row * 1024 + c) = w;
            }
        } else {
#pragma unroll
            for (int i = 0; i < 4; ++i) *(f32x4*)(p.out + (size_t)row * 1024 + 4 * lane + 256 * i) = v[i];
        }
    }
}

DI void gemm_router(char* lds, const bf16_t* A, int M, const float* W, float* C) {
    const int tid = opaque_tid();
    const int ntn = 2, ntm = M / 128;
    gemm_stream<2, 4, 4, 2, PtrLoaderF, 2>(lds, ntn * ntm, 16, [&](int u, PtrLoader<2>& al, PtrLoaderF& bl, const int (&nx)[4]) {
        int tm, tn; tile_of(u, ntm, ntn, tm, tn);
#pragma unroll
        for (int i = 0; i < 2; ++i) al.p[i] = (unsigned)((tm * 128 + a_row(tid) + 64 * i) * 1024 + a_c8(tid) * 8);
        al.base = A;
        fill_bf(bl, W, 256, tn * 128, 256);
    }, [&](int u, int (&nx)[4], int) {}, [&](int u, int mi, const f32x4 (&a)[2], f32x4 (&o)[2], int r0, int c0) {
#pragma unroll
        for (int ni = 0; ni < 2; ++ni) o[ni] = a[ni];
    }, [&](int u, int r, int c, f32x4 v, f32x4 pv) {
        int tm, tn; tile_of(u, ntm, ntn, tm, tn);
        *(f32x4*)(C + (size_t)(tm * 128 + r) * 256 + tn * 128 + c) = v;
    });
}

DI void ph_inproj1(const Params& p, char* lds) {
    const int tid = opaque_tid();
    constexpr int NTN = 25, NTM = 66;
    gemm_stream<4, 2, 4, 4, PtrLoaderF, 4>(lds, NTN * NTM, 16, [&](int u, PtrLoader<4>& al, PtrLoaderF& bl, const int (&nx)[4]) {
        int tm, tn; tile_of(u, NTM, NTN, tm, tn);
#pragma unroll
        for (int i = 0; i < 4; ++i) al.p[i] = (unsigned)((tm * 256 + a_row(tid) + 64 * i) * 1024 + a_c8(tid) * 8);
        al.base = p.Abuf;
        fill_bf(bl, p.od_w_in, ODC, tn * 128, ODC);
    }, [&](int u, int (&nx)[4], int) {}, [&](int u, int mi, const f32x4 (&a)[4], f32x4 (&o)[4], int r0, int c0) {
#pragma unroll
        for (int ni = 0; ni < 4; ++ni) o[ni] = a[ni];
    }, [&](int u, int r, int c, f32x4 v, f32x4 pv) {
        int tm, tn; tile_of(u, NTM, NTN, tm, tn);
        const int row = tm * 256 + r, col = tn * 128 + c;
        if (tn < 8 && row < TL) {
            const int t = row & (TLB - 1);
            const float pos = (c & 32) ? (float)(t & 63) : (float)(t >> 6);
            const float sgn = (c & 16) ? 1.0f : -1.0f;
#pragma unroll
            for (int j = 0; j < 4; ++j) {
                const float ang = pos * exp2f(-(float)((c & 15) + j) * (13.287712379549449f / 16.0f));
                v[j] = v[j] * __cosf(ang) + sgn * pv[j] * __sinf(ang);
            }
            if (tn < 4) v = v * 0.125f;
        }
        if (tn < 24) {
            u32x2 w; w.x = cvt_pk_bf16(v[0], v[1]); w.y = cvt_pk_bf16(v[2], v[3]);
            *(u32x2*)(p.P1 + (size_t)row * 3072 + col) = w;
        } else if (col < ODC) *(f32x4*)(p.G1 + (size_t)row * 32 + (col - 3072)) = v;
    });
}

DI float wave_incl_sum(float v, int lane) {
#pragma unroll
    for (int d = 1; d < 64; d <<= 1) { const float t = __shfl_up(v, d); if (lane >= d) v += t; }
    return v;
}
DI float wave_incl_max(float v, int lane) {
#pragma unroll
    for (int d = 1; d < 64; d <<= 1) { const float t = __shfl_up(v, d); if (lane >= d) v = fmaxf(v, t); }
    return v;
}
DI void ml_gates(const Params& p, float* G, int row0, int h, float& ig, float& bc, float& tot, int& idx) {
    const int tid = opaque_tid(), lane = tid & 63, wv = tid >> 6;
    const int gi = (tid >> 7) & 1, e = tid & 127;
    idx = gi == 0 ? e : 127 - e;
    float c = 0.f; ig = 0.f;
    if (tid < 256) {
        const float* g = p.G1 + (size_t)(row0 + idx) * 32;
        ig = g[8 * gi + h] + p.ml_gate_b[8 * gi + h];
        const float lf = logsigmoidf_(g[16 + 8 * gi + h] + p.ml_gate_b[16 + 8 * gi + h]);
        c = wave_incl_sum(lf, lane);
        if (lane == 63) G[768 + wv] = c;
    }
    __syncthreads();
    if (tid < 256) {
        if (wv & 1) c += G[768 + wv - 1];
        G[gi * 128 + idx] = ig; G[256 + gi * 128 + idx] = c;
        if (e == 127) G[776 + gi] = c;
    }
    __syncthreads();
    bc = c; tot = G[776 + gi];
}

constexpr int MLC_T = 4096, MLC_TS = 392;
DI void ph_ml_chunks(const Params& p, char* ldsc) {
    float* G = (float*)ldsc;
    const int tid = opaque_tid(), lane = tid & 63, wv = tid >> 6, fr = lane & 15, fq = lane >> 4;
    for (int u = blockIdx.x; u < 1056; u += gridDim.x) {
        const bool lat = u < 1024;
        const int bh = lat ? (u >> 6) : ((u - 1024) >> 1), blk = lat ? (u & 63) : ((u - 1024) & 1);
        const int b = bh >> 3, h = bh & 7;
        const int Tseq = lat ? TLB : TCB;
        const int row0 = (lat ? b * TLB : TL + b * TCB) + blk * 128;
        {
            u32x4 rr[6];
#pragma unroll
            for (int i = 0; i < 6; ++i) {
                const int qd = tid + NTHR * i, row = qd / 24, cc = qd % 24;
                rr[i] = *(const u32x4*)(p.P1 + (size_t)(row0 + row) * 3072 + (cc < 8 ? 512 + h * 64 + cc * 8 : 1024 + h * 128 + (cc - 8) * 8));
            }
#pragma unroll
            for (int i = 0; i < 6; ++i) {
                const int qd = tid + NTHR * i, row = qd / 24, cc = qd % 24;
                char* d = ldsc + MLC_T + row * MLC_TS + cc * 16;
                *(u32x2*)d = (u32x2){rr[i].x, rr[i].y}; *(u32x2*)(d + 8) = (u32x2){rr[i].z, rr[i].w};
            }
        }
        float ig, bc, tot; int idx;
        ml_gates(p, G, row0, h, ig, bc, tot, idx);
        const float gl = tot - bc + ig;
        float mw = (tid < 256) ? wave_allmax(gl) : 0.f;
        if (tid < 256 && lane == 0) G[784 + wv] = mw;
        __syncthreads();
        if (tid < 256) {
            const int gi = tid >> 7;
            const float mc = fmaxf(G[784 + 2 * gi], G[784 + 2 * gi + 1]);
            G[512 + gi * 128 + idx] = __expf(gl - mc);
            if ((tid & 127) == 0) { p.BEMC[u * 4 + gi * 2 + 0] = tot; p.BEMC[u * 4 + gi * 2 + 1] = mc; }
        }
        __syncthreads();
        auto col8 = [&](int col, int l0) -> u32x4 {
            const char* s_ = ldsc + MLC_T + l0 * MLC_TS + col * 2;
            u32x4 w;
            w.x = (unsigned)*(const unsigned short*)(s_) | ((unsigned)*(const unsigned short*)(s_ + MLC_TS) << 16);
            w.y = (unsigned)*(const unsigned short*)(s_ + 2 * MLC_TS) | ((unsigned)*(const unsigned short*)(s_ + 3 * MLC_TS) << 16);
            w.z = (unsigned)*(const unsigned short*)(s_ + 4 * MLC_TS) | ((unsigned)*(const unsigned short*)(s_ + 5 * MLC_TS) << 16);
            w.w = (unsigned)*(const unsigned short*)(s_ + 6 * MLC_TS) | ((unsigned)*(const unsigned short*)(s_ + 7 * MLC_TS) << 16);
            return w;
        };
        f32x4 accf[4], accb[4];
#pragma unroll
        for (int n = 0; n < 4; ++n) { accf[n] = (f32x4){0.f, 0.f, 0.f, 0.f}; accb[n] = accf[n]; }
#pragma unroll
        for (int ks = 0; ks < 4; ++ks) {
            const int l0 = 32 * ks + 8 * fq;
            const bf16x8 va = __builtin_bit_cast(bf16x8, col8(64 + 16 * wv + fr, l0));
            const f32x4 wfa = *(const f32x4*)(G + 512 + l0), wfb = *(const f32x4*)(G + 512 + l0 + 4);
            const f32x4 wba = *(const f32x4*)(G + 640 + l0), wbb = *(const f32x4*)(G + 640 + l0 + 4);
#pragma unroll
            for (int n = 0; n < 4; ++n) {
                const u32x4 kr = col8(16 * n + fr, l0);
                const float k0 = bflo(kr.x), k1 = bfhi(kr.x), k2 = bflo(kr.y), k3 = bfhi(kr.y), k4 = bflo(kr.z), k5 = bfhi(kr.z), k6 = bflo(kr.w), k7 = bfhi(kr.w);
                u32x4 kf, kb;
                kf.x = cvt_pk_bf16(k0 * wfa[0], k1 * wfa[1]); kf.y = cvt_pk_bf16(k2 * wfa[2], k3 * wfa[3]);
                kf.z = cvt_pk_bf16(k4 * wfb[0], k5 * wfb[1]); kf.w = cvt_pk_bf16(k6 * wfb[2], k7 * wfb[3]);
                kb.x = cvt_pk_bf16(k0 * wba[0], k1 * wba[1]); kb.y = cvt_pk_bf16(k2 * wba[2], k3 * wba[3]);
                kb.z = cvt_pk_bf16(k4 * wbb[0], k5 * wbb[1]); kb.w = cvt_pk_bf16(k6 * wbb[2], k7 * wbb[3]);
                accf[n] = mfma16(va, __builtin_bit_cast(bf16x8, kf), accf[n]);
                accb[n] = mfma16(va, __builtin_bit_cast(bf16x8, kb), accb[n]);
            }
        }
        float* kvt = p.KVT + (size_t)u * 2 * 8192;
#pragma unroll
        for (int n = 0; n < 4; ++n)
#pragma unroll
            for (int j = 0; j < 4; ++j) {
                kvt[(16 * wv + 4 * fq + j) * 64 + 16 * n + fr] = accf[n][j];
                kvt[8192 + (16 * wv + 4 * fq + j) * 64 + 16 * n + fr] = accb[n][j];
            }
        if (tid < 128) {
            const int d = tid >> 6, k = tid & 63;
            float s = 0.f;
#pragma unroll 4
            for (int l = 0; l < 128; l += 8) {
                const u32x4 kq = col8(k, l);
                const f32x4 wa = *(const f32x4*)(G + 512 + d * 128 + l), wb = *(const f32x4*)(G + 512 + d * 128 + l + 4);
                s += bflo(kq.x) * wa[0] + bfhi(kq.x) * wa[1] + bflo(kq.y) * wa[2] + bfhi(kq.y) * wa[3]
                   + bflo(kq.z) * wb[0] + bfhi(kq.z) * wb[1] + bflo(kq.w) * wb[2] + bfhi(kq.w) * wb[3];
            }
            p.KS[(size_t)u * 128 + d * 64 + k] = s;
        }
        if (lat) {
            const int v = tid >> 2, part = tid & 3;
            bf16_t* dst = p.V1TL + ((size_t)(b * 1024 + h * 128 + v)) * TLB + blk * 128;
#pragma unroll
            for (int i = 0; i < 4; ++i) {
                const int tg = part + 4 * i;
                *(u32x4*)(dst + 8 * tg) = col8(64 + v, 8 * tg);
            }
        }
        __syncthreads();
    }
}

DI void ph_ml_scan(const Params& p) {
    const int tid = opaque_tid();
    for (int w = blockIdx.x; w < 256; w += gridDim.x) {
        const int chain = w & 31, slice = w >> 5;
        const int bh = chain >> 1, dir = chain & 1;
        const int e0 = slice * 1024 + tid * 2;
        float c0 = 0.f, c1 = 0.f, nn = 0.f, m = 0.f;
        const bool hasn = (slice == 0 && tid < 64);
        auto unit_of = [&](int s) -> int {
            if (s < 2) return 1024 + bh * 2 + (dir == 0 ? s : 1 - s);
            const int jj = s - 2; return bh * 64 + (dir == 0 ? jj : 63 - jj);
        };
        typedef float f32x2 __attribute__((ext_vector_type(2)));
        constexpr int DP = 6;
        f32x2 kvq[DP], bmq[DP]; float ksq[DP];
        const int nl = tid & 63;
#pragma unroll
        for (int j = 0; j < DP; ++j) {
            const int un = unit_of(j);
            kvq[j] = *(const f32x2*)(p.KVT + ((size_t)un * 2 + dir) * 8192 + e0);
            bmq[j] = *(const f32x2*)(p.BEMC + un * 4 + dir * 2);
            ksq[j] = p.KS[(size_t)un * 128 + dir * 64 + nl];
        }
#pragma unroll 1
        for (int s0 = 0; s0 < 66; s0 += DP) {
#pragma unroll
            for (int j = 0; j < DP; ++j) {
                const int s = s0 + j;
                const int u = unit_of(s);
                const f32x2 kv = kvq[j], bm = bmq[j]; const float ksv = ksq[j];
                {
                    const int sn = s + DP < 66 ? s + DP : 65;
                    const int un = unit_of(sn);
                    kvq[j] = *(const f32x2*)(p.KVT + ((size_t)un * 2 + dir) * 8192 + e0);
                    bmq[j] = *(const f32x2*)(p.BEMC + un * 4 + dir * 2);
                    ksq[j] = p.KS[(size_t)un * 128 + dir * 64 + nl];
                }
                {
                    bf16_t* ct = p.C0T + ((size_t)u * 2 + dir) * 8192;
                    *(unsigned*)(ct + e0) = cvt_pk_bf16(c0, c1);
                    if (hasn) p.N0[((size_t)u * 2 + dir) * 64 + tid] = nn;
                    if (slice == 0 && tid == 0) p.M0[u * 2 + dir] = m;
                }
                const float be = bm[0], mc = bm[1];
                const float mn = fmaxf(be + m, mc);
                const float fa = __expf(be + m - mn), fb = __expf(mc - mn);
                c0 = fa * c0 + fb * kv[0]; c1 = fa * c1 + fb * kv[1];
                nn = fa * nn + fb * ksv;
                m = mn;
            }
        }
    }
}

constexpr int MLO_K = 8192, MLO_VT = MLO_K + 16384, MLO_VTS = 272, MLO_C0 = MLO_VT + 128 * MLO_VTS, MLO_HS = 8192;
DI void ph_ml_out(const Params& p, char* ldsc) {
    float* G = (float*)ldsc;
    const int tid = opaque_tid(), lane = tid & 63, wv = tid >> 6, q = lane & 15, g = lane >> 4;
    for (int u = blockIdx.x; u < 1024; u += gridDim.x) {
        const int bh = u >> 6, blk = u & 63, b = bh >> 3, h = bh & 7;
        const int row0 = b * TLB + blk * 128;
        {
            u32x4 rk[2], rv[4], rc[4];
#pragma unroll
            for (int i = 0; i < 2; ++i) { const int pc = tid + i * NTHR; rk[i] = *(const u32x4*)(p.P1 + (size_t)(row0 + (pc >> 3)) * 3072 + 512 + h * 64 + (pc & 7) * 8); }
#pragma unroll
            for (int i = 0; i < 4; ++i) { const int pc = tid + i * NTHR; rv[i] = *(const u32x4*)(p.V1TL + ((size_t)(b * 1024 + h * 128 + (pc >> 4))) * TLB + blk * 128 + (pc & 15) * 8); }
#pragma unroll
            for (int i = 0; i < 4; ++i) { const int pc = tid + i * NTHR; rc[i] = *(const u32x4*)(p.C0T + (size_t)u * 2 * 8192 + (size_t)pc * 8); }
#pragma unroll
            for (int i = 0; i < 2; ++i) { const int pc = tid + i * NTHR; *(u32x4*)(ldsc + MLO_K + lds_byte(pc >> 3, (pc & 7) * 8)) = rk[i]; }
#pragma unroll
            for (int i = 0; i < 4; ++i) { const int pc = tid + i * NTHR; *(u32x4*)(ldsc + MLO_VT + (pc >> 4) * MLO_VTS + (pc & 15) * 16) = rv[i]; }
#pragma unroll
            for (int i = 0; i < 4; ++i) { const int pc = tid + i * NTHR; const int dd = pc >> 10, rr = (pc >> 3) & 127; *(u32x4*)(ldsc + MLO_C0 + dd * 16384 + lds_byte(rr, (pc & 7) * 8)) = rc[i]; }
        }
        float ig, bc, tot; int idx;
        ml_gates(p, G, row0, h, ig, bc, tot, idx);
        const float m0f = p.M0[u * 2 + 0], m0b = p.M0[u * 2 + 1];
        {
            float pm = (tid < 256) ? wave_incl_max(ig - bc, lane) : 0.f;
            if (tid < 256 && lane == 63) G[768 + wv] = pm;
            __syncthreads();
            if (tid < 256) {
                if (wv & 1) pm = fmaxf(pm, G[768 + wv - 1]);
                const int gi = tid >> 7;
                G[512 + gi * 128 + idx] = fmaxf(bc + pm, bc + (gi == 0 ? m0f : m0b));
            }
            __syncthreads();
        }
        const int tl = 16 * wv + q;
        const int trow = row0 + tl;
        bf16x8 qf[2];
#pragma unroll
        for (int ks = 0; ks < 2; ++ks) qf[ks] = *(const bf16x8*)(p.P1 + (size_t)trow * 3072 + h * 64 + 32 * ks + 8 * g);
        f32x4 st_[8];
#pragma unroll
        for (int st = 0; st < 8; ++st) {
            f32x4 s = (f32x4){0.f, 0.f, 0.f, 0.f};
#pragma unroll
            for (int ks = 0; ks < 2; ++ks) s = mfma16(*(const bf16x8*)(ldsc + MLO_K + lds_byte(16 * st + q, 32 * ks + 8 * g)), qf[ks], s);
            st_[st] = s;
        }
        f32x4 hsum[8];
#pragma unroll
        for (int vm = 0; vm < 8; ++vm) hsum[vm] = (f32x4){0.f, 0.f, 0.f, 0.f};
#pragma unroll 1
        for (int dir = 0; dir < 2; ++dir) {
            const float mt = G[512 + dir * 128 + tl];
            const float bt = G[256 + dir * 128 + tl];
            const float m0 = dir == 0 ? m0f : m0b;
            const float iw = __expf(bt + m0 - mt);
            const float* n0 = p.N0 + ((size_t)u * 2 + dir) * 64;
            float qn = 0.f;
#pragma unroll
            for (int ks = 0; ks < 2; ++ks) {
                const u32x4 w = __builtin_bit_cast(u32x4, qf[ks]);
                const f32x4 na = *(const f32x4*)(n0 + 32 * ks + 8 * g), nb = *(const f32x4*)(n0 + 32 * ks + 8 * g + 4);
                qn += bflo(w.x) * na[0] + bfhi(w.x) * na[1] + bflo(w.y) * na[2] + bfhi(w.y) * na[3] + bflo(w.z) * nb[0] + bfhi(w.z) * nb[1] + bflo(w.w) * nb[2] + bfhi(w.w) * nb[3];
            }
            qn += __shfl_xor(qn, 16); qn += __shfl_xor(qn, 32);
            f32x4 acc[8];
            const char* c0s = ldsc + MLO_C0 + dir * 16384;
#pragma unroll
            for (int vm = 0; vm < 8; ++vm) {
                f32x4 a = (f32x4){0.f, 0.f, 0.f, 0.f};
#pragma unroll
                for (int ks = 0; ks < 2; ++ks) a = mfma16(*(const bf16x8*)(c0s + lds_byte(16 * vm + q, 32 * ks + 8 * g)), qf[ks], a);
                acc[vm] = a * iw;
            }
            float rs = 0.f;
#pragma unroll
            for (int uu = 0; uu < 4; ++uu) {
                const bool need = dir == 0 ? (2 * uu <= wv) : (2 * uu + 1 >= wv);
                if (need) {
                    f32x4 pw[2];
#pragma unroll
                    for (int hf = 0; hf < 2; ++hf) {
                        const int st = 2 * uu + hf;
                        const f32x4 bs = *(const f32x4*)(G + 256 + dir * 128 + 16 * st + 4 * g);
                        const f32x4 is = *(const f32x4*)(G + dir * 128 + 16 * st + 4 * g);
                        f32x4 w;
#pragma unroll
                        for (int r = 0; r < 4; ++r) {
                            const int s = 16 * st + 4 * g + r;
                            const bool ok = dir == 0 ? (s <= tl) : (s >= tl);
                            const float dw = ok ? __expf(bt - bs[r] + is[r] - mt) : 0.f;
                            w[r] = st_[st][r] * dw;
                            rs += w[r];
                        }
                        pw[hf] = w;
                    }
                    const bf16x8 pb = pack8(pw[0], pw[1]);
#pragma unroll
                    for (int vm = 0; vm < 8; ++vm) {
                        const char* vr = ldsc + MLO_VT + (16 * vm + q) * MLO_VTS + (32 * uu + 4 * g) * 2;
                        const bf16x8 va = join8(*(const u32x2*)vr, *(const u32x2*)(vr + 32));
                        acc[vm] = mfma16(va, pb, acc[vm]);
                    }
                }
            }
            rs += __shfl_xor(rs, 16); rs += __shfl_xor(rs, 32);
            const float den = rs + iw * qn;
            const float dn = 1.0f / fmaxf(fabsf(den), __expf(-mt));
#pragma unroll
            for (int vm = 0; vm < 8; ++vm) hsum[vm] += acc[vm] * dn;
        }
        __syncthreads();
        float* HS = (float*)(ldsc + MLO_HS);
#pragma unroll
        for (int vm = 0; vm < 8; ++vm) *(f32x4*)(HS + tl * 132 + 16 * vm + 4 * g) = hsum[vm];
        __syncthreads();
        {
            const int t = tid >> 2, vq = (tid & 3) * 4;
            const float* hr = HS + t * 132 + vq;
            f32x4 hv[8];
            float ss = 0.f;
#pragma unroll
            for (int i = 0; i < 8; ++i) { hv[i] = *(const f32x4*)(hr + 16 * i); ss += (hv[i][0] * hv[i][0] + hv[i][1] * hv[i][1]) + (hv[i][2] * hv[i][2] + hv[i][3] * hv[i][3]); }
            ss += __shfl_xor(ss, 1); ss += __shfl_xor(ss, 2);
            const float rn = rsqrtf(ss * (1.0f / 128.0f) + 1e-6f);
            const size_t orow = (size_t)(row0 + t) * 1024 + h * 128 + vq;
#pragma unroll
            for (int i = 0; i < 8; ++i) {
                const f32x4 ng = *(const f32x4*)(p.ml_norm_g + h * 128 + vq + 16 * i);
                const u32x2 ow = *(const u32x2*)(p.P1 + (size_t)(row0 + t) * 3072 + 2048 + h * 128 + vq + 16 * i);
                f32x4 o;
                o[0] = hv[i][0] * rn * ng[0] * sigmoidf_(bflo(ow.x)); o[1] = hv[i][1] * rn * ng[1] * sigmoidf_(bfhi(ow.x));
                o[2] = hv[i][2] * rn * ng[2] * sigmoidf_(bflo(ow.y)); o[3] = hv[i][3] * rn * ng[3] * sigmoidf_(bfhi(ow.y));
                u32x2 w; w.x = cvt_pk_bf16(o[0], o[1]); w.y = cvt_pk_bf16(o[2], o[3]);
                *(u32x2*)(p.MIX + orow + 16 * i) = w;
            }
        }
        __syncthreads();
    }
}


#ifndef PROBE_MODE
#define PROBE_MODE 0
#endif
DI void ph_probe(const Params& p, char* lds) {
#if PROBE_MODE >= 1 && PROBE_MODE <= 4
    const int tid = opaque_tid();
    constexpr int NTN = 26, NTM = 66;
    gemm_stream<4, 2, 4, 4, PtrLoaderF, 4, PROBE_MODE>(lds, NTN * NTM, 16, [&](int u, PtrLoader<4>& al, PtrLoaderF& bl, const int (&nx)[4]) {
        int tm, tn; tile_of(u, NTM, NTN, tm, tn);
#pragma unroll
        for (int i = 0; i < 4; ++i) al.p[i] = (unsigned)((tm * 256 + a_row(tid) + 64 * i) * 1024 + a_c8(tid) * 8);
        al.base = p.Abuf;
        fill_bf(bl, p.ev_w_in, EVC, tn * 128, EVC);
    }, [&](int u, int (&nx)[4], int) {}, [&](int u, int mi, const f32x4 (&a)[4], f32x4 (&o)[4], int r0, int c0) {
#pragma unroll
        for (int ni = 0; ni < 4; ++ni) o[ni] = a[ni];
    }, [&](int u, int r, int c, f32x4 v, f32x4 pv) {
        int tm, tn; tile_of(u, NTM, NTN, tm, tn);
        const int row = tm * 256 + r, col = tn * 128 + c;
        if (tn < 12) {
            bf16_t* dst = (tn < 4 ? p.Q0 + col : (tn < 8 ? p.K0 + (col - 512) : p.V0 + (col - 1024))) + (size_t)row * 512;
            u32x2 w; w.x = cvt_pk_bf16(v[0], v[1]); w.y = cvt_pk_bf16(v[2], v[3]);
            *(u32x2*)dst = w;
        } else if (col < EVC) {
            *(f32x4*)(p.RWP + (size_t)row * RWC + (col - 1536)) = v;
        }
    });
#endif
}
constexpr int NPHASE = 27;
template <int PH>
DI void run_phase(const Params& p, char* lds) {
    if (PH == 0) ph_prologue(p, lds);
    if (PH == 1) ph_modulate0(p);
    if (PH == 2) ph_inproj0(p, lds);
    if (PH == 3) { for (int j = blockIdx.x; j < (TT / 64) * 8; j += gridDim.x) transpose_tile(lds, p.V0, 512, (j >> 3) * 64, (j & 7) * 64, p.VT0L, p.VT0C, 512); ph_rw_prep(p, lds); }
    if (PH == 4) ph_attn_cp<1>(p, lds);
    if (PH == 5) ph_sq(p, lds);
    if (PH == 6) ph_rw_readout(p);
    if (PH == 7) gemm_f32out(lds, p.MIX, TT, p.ev_w_out, 1024, p.YL);
    if (PH == 8) ph_ln1<0>(p);
    if (PH == 9) gemm_router(lds, p.Abuf, TT, p.moe_router, p.LOGITS);
    if (PH == 10) ph_route<0>(p, lds);
    if (PH == 11) ph_scatter<0>(p, lds);
    if (PH == 12) ph_moe1<0>(p, lds);
    if (PH == 13) ph_moe2<0>(p, lds);
    if (PH == 14) ph_combine<0>(p);
    if (PH == 15) ph_inproj1(p, lds);
    if (PH == 17) ph_ml_chunks(p, lds);
    if (PH == 18) ph_ml_scan(p);
    if (PH == 19) ph_ml_out(p, lds);
    if (PH == 20) gemm_f32out(lds, p.MIX, TL, p.od_w_out, 1024, p.YL);
    if (PH == 21) ph_ln1<1>(p);
    if (PH == 22) gemm_router(lds, p.Abuf, TL, p.moe_router + 1024 * 256, p.LOGITS);
    if (PH == 23) ph_route<1>(p, lds);
    if (PH == 24) ph_scatter<1>(p, lds);
    if (PH == 25) ph_moe1<1>(p, lds);
    if (PH == 26) ph_moe2<1>(p, lds);
    if (PH == 27) ph_combine<1>(p);
    if (PH == 28) { if (PROBE_MODE >= 1 && PROBE_MODE <= 4) ph_probe(p, lds); if (PROBE_MODE == 5) ph_attn_cp(p, lds); if (PROBE_MODE == 6) ph_sq(p, lds); if (PROBE_MODE == 7) ph_rw_prep(p, lds); if (PROBE_MODE == 17) ph_rw_prep<1>(p, lds); if (PROBE_MODE == 8) ph_attn_cp<1>(p, lds); if (PROBE_MODE == 9) ph_attn_cp<2>(p, lds); if (PROBE_MODE == 10) ph_route<0>(p, lds); if (PROBE_MODE == 11) ph_scatter<0>(p, lds); if (PROBE_MODE == 12) { ph_prologue(p, lds); } if (PROBE_MODE == 13) ph_rw_readout(p); if (PROBE_MODE == 14) gemm_f32out(lds, p.MIX, TT, p.ev_w_out, 1024, p.YL); if (PROBE_MODE == 15) { ph_ml_chunks(p, lds); } if (PROBE_MODE == 16) ph_ml_out(p, lds); }
}

#if MK_MULTI
template <int PH>
__global__ void __launch_bounds__(NTHR, 2) k_phase(Params p) {
    extern __shared__ __attribute__((aligned(16))) char lds[];
    run_phase<PH>(p, lds);
}
#else
template <int PH> struct PhaseSeq {
    static DI void run(const Params& p, char* lds, const XcdBarrier& bar) {
        PhaseSeq<PH - 1>::run(p, lds, bar);
        if constexpr (PH == 16) return;
        xcd_barrier(bar);
        if constexpr (((PROBE_DUP >> PH) & 1ull) != 0) {
            const int reps = 1 + (int)(__builtin_amdgcn_s_getreg((3 << 11) | 20) < 64u);
#pragma unroll 1
            for (int rep = 0; rep < reps; ++rep) run_phase<PH>(p, lds);
        } else run_phase<PH>(p, lds);
    }
};
template <> struct PhaseSeq<0> {
    static DI void run(const Params& p, char* lds, const XcdBarrier&) { if (PROBE_DUP & 1ull) run_phase<0>(p, lds); run_phase<0>(p, lds); }
};
__global__ void __launch_bounds__(NTHR, 2) k_mega(Params p) {
    extern __shared__ __attribute__((aligned(16))) char lds[];
    LAS unsigned* xb = (LAS unsigned*)(lds + LDS_XB);
    if (threadIdx.x == 0) { xb[0] = 0u; xb[1] = 0u; xb[2] = 0u; xb[3] = 0u; }
    __syncthreads();
    XcdBarrier bar = xcd_barrier_post(p.bar, (volatile LAS unsigned*)xb);
    PhaseSeq<PROBE_MODE ? 28 : 27>::run(p, lds, bar);
}
#endif

#if MK_MULTI
template <int PH> static void launch_all(const Params& p, hipStream_t s) {
    if constexpr (PH > 0) launch_all<PH - 1>(p, s);
    hipFuncSetAttribute((const void*)k_phase<PH>, hipFuncAttributeMaxDynamicSharedMemorySize, LDS_BYTES);
    hipLaunchKernelGGL(k_phase<PH>, dim3(256), dim3(NTHR), LDS_BYTES, s, p);
}
#endif

extern "C" void kernel_launch(void* const* d_in, const int* in_sizes, int n_in, void* d_out, int out_size, void* d_ws, size_t ws_size, hipStream_t stream) {
    Params p{};
    const float** f = (const float**)&p.x;
    for (int i = 0; i < 34; ++i) f[i] = (const float*)d_in[i];
    p.out = (float*)d_out;
    size_t off = 0;
    auto A = [&](size_t bytes) -> char* { char* r = (char*)d_ws + off; off += (bytes + 255) & ~(size_t)255; return r; };
    p.bar = (unsigned*)A(XCD_BAR_WORDS * 4);
    p.ictl = (int*)A(1026 * 4);
    p.mods = (float*)A((size_t)2 * 3 * 6144 * 4);
    p.Abuf = (bf16_t*)A((size_t)TT * 1024 * 2);
    p.CM = (bf16_t*)A((size_t)32 * CK_NCH * 4096 * 2);
    p.CRH = (bf16_t*)A((size_t)32 * CK_NCH * 1024 * 2);
    p.CN = (bf16_t*)A((size_t)32 * CK_NCH * 4096 * 2);
    p.CP3 = (bf16_t*)A((size_t)32 * CK_NCH * 1024 * 2);
    p.HA = (float*)A((size_t)TT * 1024 * 4);
    p.HB = (float*)A((size_t)TT * 1024 * 4);
    p.Q0 = (bf16_t*)A((size_t)TT * 512 * 2);
    p.K0 = (bf16_t*)A((size_t)TT * 512 * 2);
    p.V0 = (bf16_t*)A((size_t)TT * 512 * 2);
    p.VT0L = (bf16_t*)A((size_t)2 * 512 * TLB * 2);
    p.VT0C = (bf16_t*)A((size_t)2 * 512 * TCB * 2);
    p.RWP = (float*)A((size_t)TT * RWC * 4);
    p.MIX = (bf16_t*)A((size_t)TT * 1024 * 2);
    p.YL = (float*)A((size_t)TT * 1024 * 4);
    p.LOGITS = (float*)A((size_t)TT * 256 * 4);
    p.EIDX = (int*)A((size_t)TT * 8 * 4);
    p.EW = (float*)A((size_t)TT * 8 * 4);
    p.APOS = (int*)A((size_t)TT * 8 * 4);
    p.SLOT_TOK = (int*)A((size_t)2 * NSLOT * 4);
    p.SLOT_W = (float*)A((size_t)2 * NSLOT * 4);
    p.HIST = (int*)A((size_t)2 * 256 * 256 * 4);
    p.WF = (unsigned*)A((size_t)8 * 4 * 7 * 64 * 16);
    p.TILE_E = (int*)A((size_t)2 * MAXTILES * 4);
    p.TILE_R0 = (int*)A((size_t)2 * MAXTILES * 4);
    p.HBUF = (bf16_t*)A((size_t)NSLOT * 256 * 2);
    const size_t un0 = off;
    p.YB = (bf16_t*)A((size_t)NSLOT * 1024 * 2);
    const size_t un_end = off;
    off = un0;
    p.SW = (float*)A((size_t)2 * TT * 512 * 4);
    p.SBP = (unsigned*)A((size_t)TT * 512 * 4);
    p.SKP = (unsigned*)A((size_t)TT * 512 * 4);
    p.SNV = (unsigned*)A((size_t)TT * 512 * 4);
    p.SRG = (unsigned*)A((size_t)TT * 512 * 4);
    p.BONUS = (float*)A((size_t)TT * 8 * 4);
    p.YS = (float*)A((size_t)2 * TT * 512 * 4);
    const size_t m0_end = off;
    off = un0;
    p.P1 = (bf16_t*)A((size_t)TT * 3072 * 2);
    p.K1TL = (bf16_t*)A((size_t)2 * 512 * TLB * 2);
    p.K1TC = (bf16_t*)A((size_t)2 * 512 * TCB * 2);
    p.V1TL = (bf16_t*)A((size_t)2 * 1024 * TLB * 2);
    p.V1TC = (bf16_t*)A((size_t)2 * 1024 * TCB * 2);
    p.G1 = (float*)A((size_t)TT * 32 * 4);
    p.KVT = (float*)A((size_t)1056 * 2 * 8192 * 4);
    p.KS = (float*)A((size_t)1056 * 128 * 4);
    p.BEMC = (float*)A((size_t)1056 * 4 * 4);
    p.C0T = (bf16_t*)A((size_t)1056 * 2 * 8192 * 2);
    p.N0 = (float*)A((size_t)1056 * 2 * 64 * 4);
    p.M0 = (float*)A((size_t)1056 * 2 * 4);
    const size_t m1_end = off;
    off = un_end > m0_end ? un_end : m0_end; off = off > m1_end ? off : m1_end;
    if (off > ws_size) return;
    hipMemsetAsync(p.bar, 0, XCD_BAR_WORDS * 4, stream);
#if MK_MULTI
    launch_all<27>(p, stream);
#else
    hipFuncSetAttribute((const void*)k_mega, hipFuncAttributeMaxDynamicSharedMemorySize, LDS_BYTES);
    hipLaunchKernelGGL(k_mega, dim3(256), dim3(NTHR), LDS_BYTES, stream, p);
#endif
}
```

```cpp
#include <hip/hip_runtime.h>
#include <stdint.h>

#ifndef MK_MULTI
#define MK_MULTI 0
#endif

#ifndef PROBE_DUP
#define PROBE_DUP 0ull
#endif
#define DI __device__ __forceinline__
typedef unsigned short bf16_t;
typedef short bf16x8 __attribute__((ext_vector_type(8)));
typedef float f32x4 __attribute__((ext_vector_type(4)));
typedef unsigned u32x4 __attribute__((ext_vector_type(4)));
typedef unsigned u32x2 __attribute__((ext_vector_type(2)));

constexpr int NTHR = 512;
constexpr int TLB = 8192, TCB = 256, TL = 16384, TC = 512, TT = 16896;
constexpr int EVC = 3296, ODC = 3104, RWC = 1760;
constexpr float ALPHA = 1.41421356237f;
constexpr int SH_BASE = 200704;
constexpr int NSLOT = SH_BASE + TT;
constexpr int MAXTILES = 784 + 66;
constexpr int EPI_OFF = 98304, EPI_WAVE_B = 4352;
constexpr int LDS_XB = 153600;
constexpr int LDS_BYTES = LDS_XB + 256;

#define XB_TMO      128
#define XB_XCNT(j)  (256  + 64 * (j))
#define XB_XSUB(j)  (1280 + 64 * (j))
#define XB_XGEN(j)  (2304 + 64 * (j))
#define XB_TOP      3328
#define XB_TOPGEN   3392
#define XCD_BAR_WORDS 3456
#define XB_SPIN_CAP (1u << 18)
#define LAS __attribute__((address_space(3)))

__device__ __forceinline__ unsigned xb_ld(unsigned* p)              { return __hip_atomic_load(p, __ATOMIC_RELAXED, __HIP_MEMORY_SCOPE_AGENT); }
__device__ __forceinline__ unsigned xb_add(unsigned* p, unsigned v) { return __hip_atomic_fetch_add(p, v, __ATOMIC_RELAXED, __HIP_MEMORY_SCOPE_AGENT); }
__device__ __forceinline__ unsigned xb_xcc_id() { return (unsigned)__builtin_amdgcn_s_getreg((3 << 11) | 20) & 0xFu; }
#define XB_SPIN(cond, bar) do { unsigned _sp = 0; while (cond) { __builtin_amdgcn_s_sleep(1); \
    if ((++_sp & 255u) == 0u) { if (xb_ld(&(bar)[XB_TMO])) break; if (_sp > XB_SPIN_CAP) { atomicAdd(&(bar)[XB_TMO], 1u); break; } } } } while (0)

struct XcdBarrier {
    unsigned* bar; unsigned x;
    volatile LAS unsigned* st;
};
__device__ __forceinline__ XcdBarrier xcd_barrier_post(unsigned* bar, volatile LAS unsigned* st) {
    XcdBarrier b; b.bar = bar; b.x = xb_xcc_id(); b.st = st;
    if (threadIdx.x == 0) (void)xb_add(&bar[XB_XCNT(b.x)], 1u);
    return b;
}
__device__ __forceinline__ void xcd_barrier_complete(unsigned* bar, unsigned x, unsigned& nloc, unsigned& nx) {
    const unsigned G = gridDim.x * gridDim.y * gridDim.z;
    unsigned sum, cnt, mine, sp = 0u;
    for (;;) {
        sum = 0u; cnt = 0u; mine = 0u;
#pragma unroll
        for (unsigned j = 0; j < 16; ++j) { const unsigned c = xb_ld(&bar[XB_XCNT(j)]); sum += c; cnt += (c > 0u) ? 1u : 0u; mine = (j == x) ? c : mine; }
        if (sum == G) break;
        __builtin_amdgcn_s_sleep(1);
        if ((++sp & 255u) == 0u) { if (xb_ld(&bar[XB_TMO])) break; if (sp > XB_SPIN_CAP) { atomicAdd(&bar[XB_TMO], 1u); break; } }
    }
    nloc = mine > 0u ? mine : 1u; nx = cnt > 0u ? cnt : 1u;
}
__device__ __forceinline__ void xcd_barrier(const XcdBarrier& b) {
    asm volatile("s_waitcnt vmcnt(0)" ::: "memory");
    __syncthreads();
    if (threadIdx.x == 0) {
        unsigned* bar = b.bar;
        __builtin_amdgcn_s_waitcnt(0);
        unsigned nloc = b.st[0], nx = b.st[1];
        if (nloc == 0u) { xcd_barrier_complete(bar, b.x, nloc, nx); b.st[0] = nloc; b.st[1] = nx; }
        const unsigned old = xb_add(&bar[XB_XSUB(b.x)], 1u);
        const unsigned gen = old / nloc;
        if (old + 1u == (gen + 1u) * nloc) {
            __builtin_amdgcn_fence(__ATOMIC_RELEASE, "agent");
            asm volatile("s_waitcnt vmcnt(0)" ::: "memory");
            const unsigned og = xb_add(&bar[XB_TOP], 1u);
            const unsigned tg = og / nx;
            if (og + 1u == (tg + 1u) * nx) xb_add(&bar[XB_TOPGEN], 1u);
            else XB_SPIN(xb_ld(&bar[XB_TOPGEN]) == tg, bar);
            __builtin_amdgcn_fence(__ATOMIC_ACQUIRE, "agent");
            xb_add(&bar[XB_XGEN(b.x)], 1u);
            asm volatile("s_waitcnt vmcnt(0)" ::: "memory");
        } else {
            XB_SPIN(xb_ld(&bar[XB_XGEN(b.x)]) == gen, bar);
            __builtin_amdgcn_fence(__ATOMIC_ACQUIRE, "agent");
            asm volatile("s_waitcnt vmcnt(0)" ::: "memory");
        }
    }
    __syncthreads();
}

struct Params {
    const float *x, *c, *ctx, *c_ctx, *ada_w, *ada_b, *ln_g, *ln_b, *ev_w_in, *ev_w_out, *na_rpb, *rw_mu, *rw_w0, *rw_w_up, *rw_a0,
        *rw_a_up, *rw_g_up, *rw_k_k, *rw_k_a, *rw_r_k, *rw_gn_g, *rw_gn_b, *od_w_in, *od_w_out, *ml_gate_b, *ml_norm_g, *moe_router,
        *moe_bias, *moe_w_gate, *moe_w_up, *moe_w_down, *sh_w_gate, *sh_w_up, *sh_w_down;
    float* out;
    unsigned* bar;
    int* ictl;
    float* mods;
    bf16_t* Abuf;
    float *HA, *HB;
    bf16_t *Q0, *K0, *V0, *VT0L, *VT0C;
    float* RWP;
    unsigned* WF;
    float *SW, *BONUS, *YS;
    unsigned *SBP, *SKP, *SNV, *SRG;
    bf16_t *CM, *CRH, *CN, *CP3;
    bf16_t* MIX;
    float* YL;
    float* LOGITS;
    int *EIDX, *APOS, *SLOT_TOK, *TILE_E, *TILE_R0, *HIST;
    float *EW, *SLOT_W;
    bf16_t *HBUF, *YB;
    bf16_t *P1, *K1TL, *K1TC, *V1TL, *V1TC, *C0T;
    float *G1, *KVT, *KS, *BEMC, *N0, *M0;
};

DI int opaque_tid() { int t = threadIdx.x; asm volatile("" : "+v"(t)); return t; }
typedef __bf16 bf16x2_t __attribute__((ext_vector_type(2)));
typedef float f32x2_t __attribute__((ext_vector_type(2)));
DI unsigned cvt_pk_bf16_asm(float lo, float hi) { unsigned r; asm volatile("v_cvt_pk_bf16_f32 %0, %1, %2" : "=v"(r) : "v"(lo), "v"(hi)); return r; }
DI unsigned cvt_pk_bf16(float lo, float hi) { const f32x2_t v = {lo, hi}; return __builtin_bit_cast(unsigned, __builtin_convertvector(v, bf16x2_t)); }
DI float bf2f(bf16_t b) { return __uint_as_float(((unsigned)b) << 16); }
DI float bflo(unsigned w) { return __uint_as_float(w << 16); }
DI float bfhi(unsigned w) { return __uint_as_float(w & 0xffff0000u); }
DI float sigmoidf_(float x) { return 1.0f / (1.0f + __expf(-x)); }
DI float siluf_(float x) { return x / (1.0f + __expf(-x)); }
DI float tanhf_(float x) { return 1.0f - 2.0f / (__expf(2.0f * x) + 1.0f); }
DI float softplusf_(float x) { return fmaxf(x, 0.f) + __logf(1.0f + __expf(-fabsf(x))); }
DI float logsigmoidf_(float x) { return -softplusf_(-x); }
DI f32x4 mfma16(bf16x8 a, bf16x8 b, f32x4 c) { return __builtin_amdgcn_mfma_f32_16x16x32_bf16(a, b, c, 0, 0, 0); }
DI bf16x8 pack8(f32x4 a, f32x4 b) {
    u32x4 w; w.x = cvt_pk_bf16(a[0], a[1]); w.y = cvt_pk_bf16(a[2], a[3]); w.z = cvt_pk_bf16(b[0], b[1]); w.w = cvt_pk_bf16(b[2], b[3]);
    return __builtin_bit_cast(bf16x8, w);
}
DI bf16x8 join8(u32x2 lo, u32x2 hi) { u32x4 w; w.x = lo.x; w.y = lo.y; w.z = hi.x; w.w = hi.y; return __builtin_bit_cast(bf16x8, w); }
DI float wave_allsum(float v) {
#pragma unroll
    for (int d = 1; d < 64; d <<= 1) v += __shfl_xor(v, d);
    return v;
}
DI float wave_allmax(float v) {
#pragma unroll
    for (int d = 1; d < 64; d <<= 1) v = fmaxf(v, __shfl_xor(v, d));
    return v;
}
template <int CTRL, int RM> DI float dpp_f(float x) {
    return __builtin_bit_cast(float, __builtin_amdgcn_update_dpp(0, __builtin_bit_cast(int, x), CTRL, RM, 0xF, false));
}
DI float wave_sum63(float x) {
    x += dpp_f<0xB1, 0xF>(x);
    x += dpp_f<0x4E, 0xF>(x);
    x += dpp_f<0x141, 0xF>(x);
    x += dpp_f<0x140, 0xF>(x);
    x += dpp_f<0x142, 0xA>(x);
    x += dpp_f<0x143, 0xC>(x);
    return x;
}
template <int CTRL> DI float dpp_add(float x) { return x + __builtin_bit_cast(float, __builtin_amdgcn_update_dpp(0, __builtin_bit_cast(int, x), CTRL, 0xF, 0xF, false)); }
DI float row16_allsum(float x) { x = dpp_add<0xB1>(x); x = dpp_add<0x4E>(x); x = dpp_add<0x141>(x); x = dpp_add<0x140>(x); return x; }
DI void seq_info(int row, int& t, int& T) { if (row < TL) { t = row & (TLB - 1); T = TLB; } else { t = (row - TL) & (TCB - 1); T = TCB; } }
DI int mods_row(int row) { return row < TL ? (row >> 13) : 2; }

DI int lds_byte(int r, int c) { const int st = (r >> 4) * 2 + (c >> 5), rr = r & 15, cc = c & 31, ob = rr * 64 + cc * 2; return st * 1024 + (ob ^ (((ob >> 9) & 1) << 5)); }

DI int a_row(int tid) { return (tid >> 4) * 2 + ((tid >> 2) & 1); }
DI int a_c8(int tid) { return ((tid >> 3) & 1) * 4 + (tid & 3); }
template <int NP> struct PtrLoader { const bf16_t* base; unsigned p[NP]; };
struct PtrLoaderF { const float* base0; const float* base1; unsigned p[4]; int ld; };
typedef short s16x4 __attribute__((ext_vector_type(4)));
DI int b_img(int k, int seg, int bo) { return 256 * k + 32 * (seg ^ ((k & 3) + 4 * ((k >> 3) & 1))) + bo; }
DI bf16x8 tr_frag(const char* base, int xl, int c, int ks) {
    const char* a = base + (xl ^ (c << 5)) + 8192 * ks;
    const s16x4 lo = __builtin_amdgcn_ds_read_tr16_b64_v4i16((LAS s16x4*)(a));
    const s16x4 hi = __builtin_amdgcn_ds_read_tr16_b64_v4i16((LAS s16x4*)(a + 1024));
    return __builtin_shufflevector(lo, hi, 0, 1, 2, 3, 4, 5, 6, 7);
}

DI void tile_of(int u, int ntm, int ntn, int& tm, int& tn) {
    const int gid = u / (4 * ntn), within = u % (4 * ntn);
    const int gsz = (ntm - gid * 4) < 4 ? (ntm - gid * 4) : 4;
    tm = gid * 4 + within % gsz; tn = within / gsz;
}
DI void fill_bf(PtrLoaderF& bl, const float* W, int ld, int n0, int nvalid) {
    bl.ld = ld; bl.base0 = W; bl.base1 = W;
    const int tz = opaque_tid();
#pragma unroll
    for (int i = 0; i < 4; ++i) { int n = n0 + 32 * i + (tz & 7) * 4; n = n < nvalid ? n : nvalid - 4; bl.p[i] = (unsigned)((tz >> 3) * ld + n); }
}
template <int V> struct IC { static constexpr int value = V; };
template <int WR, int WC, int MT, int NT, class BL, int NTU, int MODE = 0, class MK, class PF, class PRE, class SINK>
DI void gemm_stream(char* lds, int nunits, int nk, MK&& mk, PF&& pf, PRE&& pre, SINK&& sink) {
    constexpr bool BF32 = __is_same(BL, PtrLoaderF);
    constexpr int BM = WR * MT * 16, BN = WC * NT * 16, APC = BM * 8 / NTHR, BPC = BF32 ? 4 : BN * 8 / NTHR;
    constexpr int ABYTES = BM * 128, STAGE = (BM + BN) * 128;
    static_assert(WR * WC == 8, "8 waves");
    static_assert(!BF32 || BN == 128, "f32 B path is written for 128-column tiles");
    const int tid = opaque_tid(), lane = tid & 63, wid = tid >> 6, wr = wid / WC, wc = wid % WC, fr = lane & 15, fq = lane >> 4;
    const int ubase = (blockIdx.x & 7) * 32 + (blockIdx.x >> 3), ustep = (int)gridDim.x;
    if (ubase >= nunits) return;
    int lu = ubase, lkt = 0, cu = ubase, ckt = 0;
    int lun = (lu + ustep < nunits) ? lu + ustep : lu;
    f32x4 acc[MT][NT];
#pragma unroll
    for (int m = 0; m < MT; ++m)
#pragma unroll
        for (int n = 0; n < NT; ++n) acc[m][n] = (f32x4){0.f, 0.f, 0.f, 0.f};
    const int sa0 = lds_byte(a_row(tid), a_c8(tid) * 8);
    const int xl = b_img(8 * fq + ((lane & 15) >> 2), 0, 8 * (lane & 3));
    auto sbo = [&](int i) -> int {
        if constexpr (BF32) { const int k = tid >> 3, n4 = 8 * i + (tid & 7); return ABYTES + b_img(k, n4 >> 2, 8 * (n4 & 3)); }
        else return ABYTES + lds_byte((tid >> 3) + 64 * i, (tid & 7) * 8);
    };
    PtrLoader<APC> al; BL bl;
    int nx[4] = {0, 0, 0, 0};
    pf(lu, nx, 2);
    mk(lu, al, bl, nx);
    pf(lun, nx, 2);
    u32x4 ra[APC], rb[BPC];
    auto issue = [&](auto hc) {
        if constexpr (MODE == 2) return;
#pragma unroll
        for (int i = 0; i < APC; ++i) ra[i] = *(const u32x4*)(al.base + al.p[i] + lkt * 64);
#pragma unroll
        for (int i = 0; i < BPC; ++i) {
            if constexpr (BF32) rb[i] = *(const u32x4*)(((i & 1) ? bl.base1 : bl.base0) + bl.p[i] + (size_t)lkt * 64 * bl.ld);
            else rb[i] = *(const u32x4*)(bl.base + bl.p[i] + lkt * 64);
        }
        const int use[4] = {nx[0], nx[1], nx[2], nx[3]};
        pf(lun, nx, 4 + (lkt & 3));
        if (++lkt == nk) { lkt = 0; lu = lun; lun = (lu + ustep < nunits) ? lu + ustep : lu; mk(lu, al, bl, use); }
    };
    auto stash = [&](char* st) {
        if constexpr (MODE == 2) return;
#pragma unroll
        for (int i = 0; i < APC; ++i) *(u32x4*)(st + sa0 + 8192 * i) = ra[i];
#pragma unroll
        for (int i = 0; i < BPC; ++i) {
            if constexpr (BF32) {
                u32x2 w; w.x = cvt_pk_bf16_asm(__uint_as_float(rb[i].x), __uint_as_float(rb[i].y)); w.y = cvt_pk_bf16_asm(__uint_as_float(rb[i].z), __uint_as_float(rb[i].w));
                *(u32x2*)(st + sbo(i)) = w;
            } else *(u32x4*)(st + sbo(i)) = rb[i];
        }
    };
    auto compute = [&](const char* st) {
        if constexpr (MODE == 1) return;
#pragma unroll
        for (int ks = 0; ks < 2; ++ks) {
            bf16x8 af[MT], bfr[NT];
#pragma unroll
            for (int m = 0; m < MT; ++m) af[m] = *(const bf16x8*)(st + lds_byte(wr * MT * 16 + m * 16 + fr, ks * 32 + fq * 8));
#pragma unroll
            for (int n = 0; n < NT; ++n) {
                if constexpr (BF32) bfr[n] = tr_frag(st + ABYTES, xl, wc * NT + n, ks);
                else bfr[n] = *(const bf16x8*)(st + ABYTES + lds_byte(wc * NT * 16 + n * 16 + fr, ks * 32 + fq * 8));
            }
#pragma unroll
            for (int m = 0; m < MT; ++m)
#pragma unroll
                for (int n = 0; n < NT; ++n) acc[m][n] = mfma16(bfr[n], af[m], acc[m][n]);
        }
    };
    auto ep = [&](int u, f32x4 (&a)[MT][NT], int, int) {
        float* W = (float*)(lds + EPI_OFF + wid * EPI_WAVE_B);
        constexpr int LPR = NTU * 4, RPI = 64 / LPR, NJ = 16 / RPI;
        const int c4 = lane % LPR, rb = lane / LPR;
#pragma unroll
        for (int mi = 0; mi < MT; ++mi) {
            f32x4 o[NTU];
            pre(u, mi, a[mi], o, wr * MT * 16 + mi * 16 + fr, wc * NT * 16 + 4 * fq);
#pragma unroll
            for (int ni = 0; ni < NTU; ++ni) *(f32x4*)(W + fr * 68 + ni * 16 + 4 * fq) = o[ni];
#pragma unroll
            for (int j = 0; j < NJ; ++j) {
                const f32x4 v = *(const f32x4*)(W + (rb + RPI * j) * 68 + 4 * c4);
                const f32x4 pv = *(const f32x4*)(W + (rb + RPI * j) * 68 + 4 * (c4 ^ 4));
                sink(u, wr * MT * 16 + mi * 16 + rb + RPI * j, wc * NTU * 16 + 4 * c4, v, pv);
            }
        }
    };
    issue(IC<0>{});
    stash(lds);
    if (wid >= 4) issue(IC<1>{});
    __syncthreads();
    bool first = true;
    auto epilogue = [&]() {
        if (ckt == 0 && !first) {
            if constexpr (MODE == 0 || MODE == 4) ep(cu - ustep, acc, wr * MT * 16 + fr, wc * NT * 16 + 4 * fq);
            else { asm volatile("" :: "v"(acc[0][0]), "v"(acc[MT - 1][NT - 1])); }
#pragma unroll
            for (int m = 0; m < MT; ++m)
#pragma unroll
                for (int n = 0; n < NT; ++n) acc[m][n] = (f32x4){0.f, 0.f, 0.f, 0.f};
        }
    };
    while (cu < nunits) {
        if (wid < 4) {
            epilogue(); issue(IC<1>{}); compute(lds); stash(lds + STAGE);
            __syncthreads();
            issue(IC<0>{}); compute(lds + STAGE); stash(lds);
            __syncthreads();
        } else {
            stash(lds + STAGE); epilogue(); issue(IC<0>{}); compute(lds);
            __syncthreads();
            stash(lds); issue(IC<1>{}); compute(lds + STAGE);
            __syncthreads();
        }
        first = false;
        ckt += 2;
        if (ckt == nk) { ckt = 0; cu += ustep; }
    }
    if constexpr (MODE == 0 || MODE == 4) ep(cu - ustep, acc, wr * MT * 16 + fr, wc * NT * 16 + 4 * fq);
    else {
#pragma unroll
        for (int m = 0; m < MT; ++m)
#pragma unroll
            for (int n = 0; n < NT; ++n) asm volatile("" :: "v"(acc[m][n]));
        if constexpr (MODE == 1) { asm volatile("" :: "v"(ra[0]), "v"(rb[0])); }
    }
}

DI void ph_prologue(const Params& p, char* lds) {
    const int tid = opaque_tid(), bid = blockIdx.x, nb = gridDim.x;
    for (int i = bid * NTHR + tid; i < 1026; i += nb * NTHR) p.ictl[i] = 0;
    for (int i = bid * NTHR + tid; i < 2 * NSLOT; i += nb * NTHR) {
        const int s = i % NSLOT;
        p.SLOT_TOK[i] = s >= SH_BASE ? s - SH_BASE : 0;
        p.SLOT_W[i] = s >= SH_BASE ? 1.0f : 0.0f;
    }
    if (bid >= 192) {
        for (int idx = (bid - 192) * NTHR + tid; idx < 8 * 4 * 7 * 64; idx += (nb - 192) * NTHR) {
            const int ln = idx & 63, s = (idx >> 6) % 7, hn = (idx >> 6) / 7;
            const int c = hn * 16 + (ln & 15);
            const float* wc_ = (s < 2 ? p.rw_w_up + s * 32 * 512 : (s < 4 ? p.rw_a_up + (s - 2) * 32 * 512 : p.rw_g_up + (s - 4) * 32 * 512)) + 8 * (ln >> 4) * 512 + c;
            u32x4 w;
            w.x = cvt_pk_bf16(wc_[0], wc_[512]); w.y = cvt_pk_bf16(wc_[1024], wc_[1536]); w.z = cvt_pk_bf16(wc_[2048], wc_[2560]); w.w = cvt_pk_bf16(wc_[3072], wc_[3584]);
            *(u32x4*)(p.WF + (size_t)idx * 4) = w;
        }
    }
    constexpr int J_MODS = 192;
    for (int job = bid; job < J_MODS; job += nb) {
        const int j = job;
        if (j < J_MODS) {
            const int l = j / 96, cb = j % 96;
            float* sc = (float*)lds;
            float* red = sc + 3072;
            for (int idx = tid; idx < 3072; idx += NTHR) {
                const int r = idx >> 10, k = idx & 1023;
                const float cv = r < 2 ? p.c[r * 1024 + k] : p.c_ctx[k];
                sc[idx] = siluf_(cv);
            }
            __syncthreads();
            const int kq = tid >> 6, cl = tid & 63, col = cb * 64 + cl;
            float a0 = 0.f, a1 = 0.f, a2 = 0.f;
            const float* w = p.ada_w + (size_t)l * 1024 * 6144 + col;
            for (int k = kq * 128; k < kq * 128 + 128; ++k) {
                const float wv = w[(size_t)k * 6144];
                a0 += sc[k] * wv; a1 += sc[1024 + k] * wv; a2 += sc[2048 + k] * wv;
            }
            red[(kq * 3 + 0) * 64 + cl] = a0; red[(kq * 3 + 1) * 64 + cl] = a1; red[(kq * 3 + 2) * 64 + cl] = a2;
            __syncthreads();
            if (tid < 192) {
                const int r = tid >> 6, c2 = tid & 63;
                float s = 0.f;
#pragma unroll
                for (int q = 0; q < 8; ++q) s += red[(q * 3 + r) * 64 + c2];
                p.mods[(size_t)(l * 3 + r) * 6144 + cb * 64 + c2] = s + p.ada_b[l * 6144 + cb * 64 + c2];
            }
            __syncthreads();
            continue;
        }
    }
}

DI void ph_modulate0(const Params& p) {
    const int nb = gridDim.x;
#pragma unroll 4
    for (int i = blockIdx.x * NTHR + opaque_tid(); i < TT * 256; i += nb * NTHR) {
        const int row = i >> 8, c = (i & 255) * 4;
        const float* src = row < TL ? p.x + (size_t)row * 1024 : p.ctx + (size_t)(row - TL) * 1024;
        const float* m = p.mods + (size_t)(0 * 3 + mods_row(row)) * 6144;
        const f32x4 v = *(const f32x4*)(src + c), sh = *(const f32x4*)(m + c), scv = *(const f32x4*)(m + 1024 + c);
        const f32x4 a = v * (1.0f + scv) + sh;
        u32x2 w; w.x = cvt_pk_bf16(a[0], a[1]); w.y = cvt_pk_bf16(a[2], a[3]);
        *(u32x2*)(p.Abuf + (size_t)row * 1024 + c) = w;
    }
}

DI void ph_inproj0(const Params& p, char* lds) {
    const int tid = opaque_tid();
    constexpr int NTN = 26, NTM = 66;
    gemm_stream<4, 2, 4, 4, PtrLoaderF, 4>(lds, NTN * NTM, 16, [&](int u, PtrLoader<4>& al, PtrLoaderF& bl, const int (&nx)[4]) {
        int tm, tn; tile_of(u, NTM, NTN, tm, tn);
#pragma unroll
        for (int i = 0; i < 4; ++i) al.p[i] = (unsigned)((tm * 256 + a_row(tid) + 64 * i) * 1024 + a_c8(tid) * 8);
        al.base = p.Abuf;
        fill_bf(bl, p.ev_w_in, EVC, tn * 128, EVC);
    }, [&](int u, int (&nx)[4], int) {}, [&](int u, int mi, const f32x4 (&a)[4], f32x4 (&o)[4], int r0, int c0) {
#pragma unroll
        for (int ni = 0; ni < 4; ++ni) o[ni] = a[ni];
    }, [&](int u, int r, int c, f32x4 v, f32x4 pv) {
        int tm, tn; tile_of(u, NTM, NTN, tm, tn);
        const int row = tm * 256 + r, col = tn * 128 + c;
        if (tn < 12) {
            bf16_t* dst = (tn < 4 ? p.Q0 + col : (tn < 8 ? p.K0 + (col - 512) : p.V0 + (col - 1024))) + (size_t)row * 512;
            u32x2 w; w.x = cvt_pk_bf16(v[0], v[1]); w.y = cvt_pk_bf16(v[2], v[3]);
            *(u32x2*)dst = w;
        } else if (col < EVC) {
            *(f32x4*)(p.RWP + (size_t)row * RWC + (col - 1536)) = v;
        }
    });
}

DI void transpose_tile(char* ldsc, const bf16_t* src, int ld, int row0, int col0, bf16_t* dstL, bf16_t* dstC, int ncols) {
    bf16_t* T = (bf16_t*)ldsc;
    const int tid = opaque_tid();
    {
        const int tok = tid >> 3, d8 = tid & 7;
        *(u32x4*)(T + tok * 72 + d8 * 8) = *(const u32x4*)(src + (size_t)(row0 + tok) * ld + col0 + d8 * 8);
    }
    __syncthreads();
    {
        const int d = tid >> 3, t8 = tid & 7;
        u32x4 w;
        w.x = (unsigned)T[(t8 * 8 + 0) * 72 + d] | ((unsigned)T[(t8 * 8 + 1) * 72 + d] << 16);
        w.y = (unsigned)T[(t8 * 8 + 2) * 72 + d] | ((unsigned)T[(t8 * 8 + 3) * 72 + d] << 16);
        w.z = (unsigned)T[(t8 * 8 + 4) * 72 + d] | ((unsigned)T[(t8 * 8 + 5) * 72 + d] << 16);
        w.w = (unsigned)T[(t8 * 8 + 6) * 72 + d] | ((unsigned)T[(t8 * 8 + 7) * 72 + d] << 16);
        bf16_t* dst;
        if (row0 < TL) dst = dstL + ((size_t)((row0 >> 13) * ncols + col0 + d)) * TLB + (row0 & (TLB - 1));
        else { const int rc = row0 - TL; dst = dstC + ((size_t)((rc >> 8) * ncols + col0 + d)) * TCB + (rc & (TCB - 1)); }
        *(u32x4*)(dst + t8 * 8) = w;
    }
    __syncthreads();
}

template <int NOSTORE = 0>
DI void ph_rw_prep(const Params& p, char* ldsc) {
    constexpr int TG = 16, LRP = 232;
    bf16_t* LR = (bf16_t*)ldsc;
    const int tid = opaque_tid(), lane = tid & 63, hh = tid >> 6, q = lane & 15, g = lane >> 4;
    bf16_t* SH = (bf16_t*)(ldsc + 8192);
    bf16x8 wq[7];
    auto wload = [&](int nt_) {
        unsigned co_ = (unsigned)(((hh * 4 + nt_) * 7 * 64 + lane) * 4); asm volatile("" : "+v"(co_));
#pragma unroll
        for (int s = 0; s < 7; ++s) wq[s] = __builtin_bit_cast(bf16x8, *(const u32x4*)(p.WF + co_ + s * 256));
    };
    wload(0);
    for (int grp = blockIdx.x; grp < TT / TG; grp += gridDim.x) {
        const int row0 = grp * TG;
        int t0, Tseq; seq_info(row0, t0, Tseq);
#pragma unroll 4
        for (int idx = tid; idx < TG * 440; idx += NTHR) {
            const int tk = idx / 440, c4 = (idx % 440) * 4;
            const int t = t0 + tk;
            const float* pr = p.RWP + (size_t)(row0 + tk) * RWC + c4;
            const f32x4 pc = *(const f32x4*)pr;
            const f32x4 pv = t > 0 ? *(const f32x4*)(pr - RWC) : (f32x4){0.f, 0.f, 0.f, 0.f};
            const f32x4 nx = t < Tseq - 1 ? *(const f32x4*)(pr + RWC) : (f32x4){0.f, 0.f, 0.f, 0.f};
            const f32x4 mu = *(const f32x4*)(p.rw_mu + c4);
            f32x4 v = pc + mu * (0.5f * (pv + nx) - pc);
            if (c4 < 1536) {
                u32x2 w; w.x = cvt_pk_bf16(v[0], v[1]); w.y = cvt_pk_bf16(v[2], v[3]);
                *(u32x2*)(SH + tk * 1536 + c4) = w;
            } else {
                const int j = c4 - 1536;
                if (j < 64) { v[0] = tanhf_(v[0]); v[1] = tanhf_(v[1]); v[2] = tanhf_(v[2]); v[3] = tanhf_(v[3]); }
                else if (j >= 128) { v[0] = sigmoidf_(v[0]); v[1] = sigmoidf_(v[1]); v[2] = sigmoidf_(v[2]); v[3] = sigmoidf_(v[3]); }
                u32x2 w; w.x = cvt_pk_bf16(v[0], v[1]); w.y = cvt_pk_bf16(v[2], v[3]);
                *(u32x2*)(LR + tk * LRP + j) = w;
            }
        }
        __syncthreads();
        float nrm[4];
#pragma unroll
        for (int r = 0; r < 4; ++r) {
            float ss = 0.f;
#pragma unroll
            for (int nt = 0; nt < 4; ++nt) {
                const int c = hh * 64 + 16 * nt + q;
                const float kk0 = bf2f(SH[(4 * g + r) * 1536 + 512 + c]) * p.rw_k_k[c];
                ss += kk0 * kk0;
            }
            nrm[r] = 1.0f / fmaxf(sqrtf(row16_allsum(ss)), 1e-12f);
        }
        float bon[4] = {0.f, 0.f, 0.f, 0.f};
        const f32x4 z4 = (f32x4){0.f, 0.f, 0.f, 0.f};
#pragma unroll
        for (int nt = 0; nt < 4; ++nt) {
            const int c = hh * 64 + 16 * nt + q;
            auto afrag = [&](int s) -> bf16x8 { return *(const bf16x8*)(LR + q * LRP + 32 * s + 8 * g); };
            f32x4 wl0, wl1, al0, al1, gl;
            {
                bf16x8 wc[7];
#pragma unroll
                for (int s = 0; s < 7; ++s) wc[s] = wq[s];
                wload((nt + 1) & 3);
                wl0 = mfma16(afrag(0), wc[0], z4); wl1 = mfma16(afrag(1), wc[1], z4); al0 = mfma16(afrag(2), wc[2], z4); al1 = mfma16(afrag(3), wc[3], z4);
                gl = mfma16(afrag(6), wc[6], mfma16(afrag(5), wc[5], mfma16(afrag(4), wc[4], z4)));
            }
            asm volatile("" ::: "memory");
            const float kkw = p.rw_k_k[c], kaw = p.rw_k_a[c], rkw = p.rw_r_k[c];
            const float w00 = p.rw_w0[c], w01 = p.rw_w0[512 + c], a00 = p.rw_a0[c], a01 = p.rw_a0[512 + c];
#pragma unroll
            for (int r = 0; r < 4; ++r) {
                const int row = row0 + 4 * g + r;
                const bf16_t* sh = SH + (4 * g + r) * 1536 + c;
                const float r_ = bf2f(sh[0]), k_ = bf2f(sh[512]), v_ = bf2f(sh[1024]);
                const float kk = k_ * kkw * nrm[r];
                const float wlog0 = -softplusf_(-(w00 + wl0[r])) - 0.5f, wlog1 = -softplusf_(-(w01 + wl1[r])) - 0.5f;
                const float dec0 = __expf(-__expf(wlog0)), dec1 = __expf(-__expf(wlog1));
                const float av0 = sigmoidf_(a00 + al0[r]), av1 = sigmoidf_(a01 + al1[r]);
                const float kd0 = k_ * (1.0f + (av0 - 1.0f) * kaw), kd1 = k_ * (1.0f + (av1 - 1.0f) * kaw);
                bon[r] += r_ * (kd0 + kd1) * rkw;
                const size_t o = (size_t)row * 512 + c;
                if (NOSTORE) { asm volatile("" :: "v"(dec0), "v"(dec1), "v"(kk * av0 + kk * av1 + kd0 + kd1 + v_ + gl[r])); continue; }
                typedef float f32x2s __attribute__((ext_vector_type(2)));
                *(f32x2s*)(p.SW + 2 * o) = (f32x2s){dec0, dec1};
                p.SBP[o] = cvt_pk_bf16(kk * av0, kk * av1); p.SKP[o] = cvt_pk_bf16(kd0, kd1);
                p.SNV[o] = cvt_pk_bf16(-kk, v_); p.SRG[o] = cvt_pk_bf16(r_, gl[r]);
                if (r & 1) asm volatile("" ::: "memory");
            }
        }
#pragma unroll
        for (int r = 0; r < 4; ++r) {
            const float bs = row16_allsum(bon[r]);
            if (q == 0) p.BONUS[(row0 + 4 * g + r) * 8 + hh] = bs;
        }
        __syncthreads();
    }
}

template <bool LAT>
DI void na_unit(const Params& p, int b, int r, int h, int w, int lane) {
    const int q = lane & 15, g = lane >> 4;
    const int j = 16 * w + q;
    const int qtok = LAT ? (b * TLB + r * 64 + j) : (TL + b * TCB + j);
    bf16x8 qf[2];
#pragma unroll
    for (int ks = 0; ks < 2; ++ks) qf[ks] = *(const bf16x8*)(p.Q0 + (size_t)qtok * 512 + h * 64 + 32 * ks + 8 * g);
    const int row_start = LAT ? (r - 4 < 0 ? 0 : (r - 4 > 120 ? 120 : r - 4)) : 0;
    const int c0 = LAT ? (w == 0 ? 0 : (w == 1 ? 8 : (w == 2 ? 24 : 32))) : 0;
    int cs = j - 8; cs = cs < 0 ? 0 : (cs > 48 ? 48 : cs);
    auto score_local = [&](int a, int tt) -> f32x4 {
        const int ktok = b * TLB + (row_start + a) * 64 + c0 + 16 * tt + q;
        f32x4 s = (f32x4){0.f, 0.f, 0.f, 0.f};
#pragma unroll
        for (int ks = 0; ks < 2; ++ks) {
            const bf16x8 kf = *(const bf16x8*)(p.K0 + (size_t)ktok * 512 + h * 64 + 32 * ks + 8 * g);
            s = mfma16(kf, qf[ks], s);
        }
        const int row_off = row_start + a - r + 7;
#pragma unroll
        for (int rr = 0; rr < 4; ++rr) {
            const int cc = c0 + 16 * tt + 4 * g + rr;
            int co = cc - j; co = co < -15 ? -15 : (co > 15 ? 15 : co);
            const bool in = (cc >= cs) && (cc < cs + 16);
            const float bias = p.na_rpb[(h * 15 + row_off) * 31 + co + 15];
            s[rr] = in ? (s[rr] * 0.125f + bias) : -1.0e30f;
        }
        return s;
    };
    auto score_ctx = [&](int ct) -> f32x4 {
        const int ktok = TL + b * TCB + 16 * ct + q;
        f32x4 s = (f32x4){0.f, 0.f, 0.f, 0.f};
#pragma unroll
        for (int ks = 0; ks < 2; ++ks) {
            const bf16x8 kf = *(const bf16x8*)(p.K0 + (size_t)ktok * 512 + h * 64 + 32 * ks + 8 * g);
            s = mfma16(kf, qf[ks], s);
        }
        return s * 0.125f;
    };
    float mx = -3.0e38f;
    if (LAT) {
        for (int a = 0; a < 8; ++a) {
#pragma unroll
            for (int tt = 0; tt < 2; ++tt) { const f32x4 s = score_local(a, tt); mx = fmaxf(mx, fmaxf(fmaxf(s[0], s[1]), fmaxf(s[2], s[3]))); }
        }
    }
    for (int ct = 0; ct < 16; ++ct) { const f32x4 s = score_ctx(ct); mx = fmaxf(mx, fmaxf(fmaxf(s[0], s[1]), fmaxf(s[2], s[3]))); }
    mx = fmaxf(mx, __shfl_xor(mx, 16)); mx = fmaxf(mx, __shfl_xor(mx, 32));
    float sum = 0.f;
    f32x4 o[4];
#pragma unroll
    for (int dm = 0; dm < 4; ++dm) o[dm] = (f32x4){0.f, 0.f, 0.f, 0.f};
    if (LAT) {
        for (int a = 0; a < 8; ++a) {
            f32x4 s0 = score_local(a, 0), s1 = score_local(a, 1);
#pragma unroll
            for (int rr = 0; rr < 4; ++rr) { s0[rr] = __expf(s0[rr] - mx); s1[rr] = __expf(s1[rr] - mx); sum += s0[rr] + s1[rr]; }
            const bf16x8 pb = pack8(s0, s1);
#pragma unroll
            for (int dm = 0; dm < 4; ++dm) {
                const bf16_t* vr = p.VT0L + ((size_t)(b * 512 + h * 64 + 16 * dm + q)) * TLB + (row_start + a) * 64 + c0 + 4 * g;
                const bf16x8 va = join8(*(const u32x2*)vr, *(const u32x2*)(vr + 16));
                o[dm] = mfma16(va, pb, o[dm]);
            }
        }
    }
    for (int u = 0; u < 8; ++u) {
        f32x4 s0 = score_ctx(2 * u), s1 = score_ctx(2 * u + 1);
#pragma unroll
        for (int rr = 0; rr < 4; ++rr) { s0[rr] = __expf(s0[rr] - mx); s1[rr] = __expf(s1[rr] - mx); sum += s0[rr] + s1[rr]; }
        const bf16x8 pb = pack8(s0, s1);
#pragma unroll
        for (int dm = 0; dm < 4; ++dm) {
            const bf16_t* vr = p.VT0C + ((size_t)(b * 512 + h * 64 + 16 * dm + q)) * TCB + 32 * u + 4 * g;
            const bf16x8 va = join8(*(const u32x2*)vr, *(const u32x2*)(vr + 16));
            o[dm] = mfma16(va, pb, o[dm]);
        }
    }
    sum += __shfl_xor(sum, 16); sum += __shfl_xor(sum, 32);
    const float inv = 1.0f / sum;
#pragma unroll
    for (int dm = 0; dm < 4; ++dm) {
        u32x2 wv; wv.x = cvt_pk_bf16(o[dm][0] * inv, o[dm][1] * inv); wv.y = cvt_pk_bf16(o[dm][2] * inv, o[dm][3] * inv);
        *(u32x2*)(p.MIX + (size_t)qtok * 1024 + h * 64 + 16 * dm + 4 * g) = wv;
    }
}

constexpr int CK_NCH = (TCB + TLB) / 16;
constexpr int CPW = 19200;
constexpr int CP_TMU = 0, CP_TMB = 2304, CP_TMK = 4608, CP_TMR = 6912, CP_TRU = 9216, CP_TRB = 11264, CP_TRV = 13312;
constexpr int CP_TT = 15360, CP_ARB = 15872, CP_AUKT = 16384, CP_H = 16896, CP_Q = 17408, CP_AUB = 17920, CP_G = 18944;
constexpr int CP_GT = CP_TMU, CP_WT = CP_TMB;

DI void cp_unit(const Params& p, char* W, int unit, int lane) {
    const int chain = unit / CK_NCH, c = unit % CK_NCH;
    const int b = chain >> 4, h = (chain >> 1) & 7, dir = chain & 1;
    const int q = lane & 15, g = lane >> 4;
    auto step_row = [&](int i) -> int {
        if (i < TCB) return TL + b * TCB + (dir == 0 ? i : TCB - 1 - i);
        const int jj = i - TCB;
        return b * TLB + (dir == 0 ? jj : TLB - 1 - jj);
    };
    {
        const float* SWd = p.SW + 2 * (h * 64 + lane) + dir;
        const unsigned* SBd = p.SBP + h * 64 + lane;
        const unsigned* SKDd = p.SKP + h * 64 + lane;
        const unsigned* SNd = p.SNV + h * 64 + lane;
        const unsigned* SRd = p.SRG + h * 64 + lane;
        float gam = 1.0f;
        unsigned pu[8], pb[8], pv[8];
        float lu = 0.f, lb = 0.f, lv = 0.f;
#pragma unroll
        for (int i4 = 0; i4 < 4; ++i4) {
            float w_[4], n_[4], b_[4], k_[4], r_[4], v_[4];
#pragma unroll
            for (int e = 0; e < 4; ++e) {
                const size_t ro = (size_t)step_row(c * 16 + 4 * i4 + e) * 512;
                w_[e] = SWd[2 * ro];
                { const unsigned nv = SNd[ro], bw = SBd[ro], kw = SKDd[ro], rw = SRd[ro];
                  n_[e] = bflo(nv); v_[e] = bfhi(nv); b_[e] = dir ? bfhi(bw) : bflo(bw); k_[e] = dir ? bfhi(kw) : bflo(kw); r_[e] = bflo(rw); }
            }
#pragma unroll
            for (int e = 0; e < 4; ++e) {
                const int i = 4 * i4 + e;
                const float gp = gam; gam *= w_[e];
                const float ig = 1.0f / gam;
                const float ut = gp * n_[e], bt = b_[e] * ig, kt = k_[e] * ig, rt = gam * r_[e];
                const unsigned wub = cvt_pk_bf16(ut, bt), wkr = cvt_pk_bf16(kt, rt);
                *(bf16_t*)(W + CP_TMU + i * 144 + lane * 2) = (bf16_t)(wub & 0xffff);
                *(bf16_t*)(W + CP_TMB + i * 144 + lane * 2) = (bf16_t)(wub >> 16);
                *(bf16_t*)(W + CP_TMK + i * 144 + lane * 2) = (bf16_t)(wkr & 0xffff);
                *(bf16_t*)(W + CP_TMR + i * 144 + lane * 2) = (bf16_t)(wkr >> 16);
                if (i & 1) { pu[i >> 1] = cvt_pk_bf16(lu, ut); pb[i >> 1] = cvt_pk_bf16(lb, bt); pv[i >> 1] = cvt_pk_bf16(lv, v_[e]); }
                else { lu = ut; lb = bt; lv = v_[e]; }
            }
        }
        *(u32x4*)(W + CP_TRU + lane * 32) = (u32x4){pu[0], pu[1], pu[2], pu[3]}; *(u32x4*)(W + CP_TRU + lane * 32 + 16) = (u32x4){pu[4], pu[5], pu[6], pu[7]};
        *(u32x4*)(W + CP_TRB + lane * 32) = (u32x4){pb[0], pb[1], pb[2], pb[3]}; *(u32x4*)(W + CP_TRB + lane * 32 + 16) = (u32x4){pb[4], pb[5], pb[6], pb[7]};
        *(u32x4*)(W + CP_TRV + lane * 32) = (u32x4){pv[0], pv[1], pv[2], pv[3]}; *(u32x4*)(W + CP_TRV + lane * 32 + 16) = (u32x4){pv[4], pv[5], pv[6], pv[7]};
        *(float*)(W + CP_G + lane * 4) = gam;
    }
    auto fr64 = [&](int off, int ks) -> bf16x8 { return *(const bf16x8*)(W + off + q * 144 + (32 * ks + 8 * g) * 2); };
    auto fr16 = [&](int off, int row) -> bf16x8 {
        u32x4 z = (u32x4){0u, 0u, 0u, 0u};
        if (g < 2) z = *(const u32x4*)(W + off + row * 32 + g * 16);
        return __builtin_bit_cast(bf16x8, z);
    };
    const f32x4 zero4 = (f32x4){0.f, 0.f, 0.f, 0.f};
    asm volatile("" ::: "memory");
    f32x4 arkT;
    {
        const bf16x8 fu0 = fr64(CP_TMU, 0), fu1 = fr64(CP_TMU, 1), fb0 = fr64(CP_TMB, 0), fb1 = fr64(CP_TMB, 1);
        const bf16x8 fk0 = fr64(CP_TMK, 0), fk1 = fr64(CP_TMK, 1), fr0 = fr64(CP_TMR, 0), fr1 = fr64(CP_TMR, 1);
        f32x4 d = mfma16(fb1, fu1, mfma16(fb0, fu0, zero4));
#pragma unroll
        for (int r = 0; r < 4; ++r) d[r] = (4 * g + r < q) ? d[r] : 0.f;
        *(f32x4*)(W + CP_AUB + q * 64 + 16 * g) = d;
        d = mfma16(fb1, fr1, mfma16(fb0, fr0, zero4));
#pragma unroll
        for (int r = 0; r < 4; ++r) d[r] = (4 * g + r <= q) ? d[r] : 0.f;
        { u32x2 w; w.x = cvt_pk_bf16(d[0], d[1]); w.y = cvt_pk_bf16(d[2], d[3]); *(u32x2*)(W + CP_ARB + q * 32 + 8 * g) = w; }
        d = mfma16(fu1, fk1, mfma16(fu0, fk0, zero4));
#pragma unroll
        for (int r = 0; r < 4; ++r) d[r] = (q < 4 * g + r) ? d[r] : 0.f;
        { u32x2 w; w.x = cvt_pk_bf16(d[0], d[1]); w.y = cvt_pk_bf16(d[2], d[3]); *(u32x2*)(W + CP_AUKT + q * 32 + 8 * g) = w; }
        arkT = mfma16(fk1, fr1, mfma16(fk0, fr0, zero4));
#pragma unroll
        for (int r = 0; r < 4; ++r) arkT[r] = (4 * g + r <= q) ? arkT[r] : 0.f;
    }
    asm volatile("" ::: "memory");
    {
        float t[16];
#pragma unroll
        for (int i = 0; i < 16; ++i) t[i] = 0.f;
#pragma unroll
        for (int i = 0; i < 16; ++i) {
            float s = (i == q) ? 1.0f : 0.f;
#pragma unroll
            for (int m4 = 0; m4 < 4; ++m4) {
                if (4 * m4 < i) {
                    const f32x4 a = *(const f32x4*)(W + CP_AUB + i * 64 + 16 * m4);
                    s += (a[0] * t[4 * m4] + a[1] * t[4 * m4 + 1]) + (a[2] * t[4 * m4 + 2] + a[3] * t[4 * m4 + 3]);
                }
            }
            t[i] = s;
        }
        if (g == 0) {
            *(u32x4*)(W + CP_TT + q * 32) = (u32x4){cvt_pk_bf16(t[0], t[1]), cvt_pk_bf16(t[2], t[3]), cvt_pk_bf16(t[4], t[5]), cvt_pk_bf16(t[6], t[7])};
            *(u32x4*)(W + CP_TT + q * 32 + 16) = (u32x4){cvt_pk_bf16(t[8], t[9]), cvt_pk_bf16(t[10], t[11]), cvt_pk_bf16(t[12], t[13]), cvt_pk_bf16(t[14], t[15])};
        }
    }
    asm volatile("" ::: "memory");
    {
        const f32x4 d = mfma16(fr16(CP_TT, q), fr16(CP_ARB, q), zero4);
        u32x2 w; w.x = cvt_pk_bf16(d[0], d[1]); w.y = cvt_pk_bf16(d[2], d[3]); *(u32x2*)(W + CP_H + q * 32 + 8 * g) = w;
    }
    asm volatile("" ::: "memory");
    {
        const f32x4 d = mfma16(fr16(CP_AUKT, q), fr16(CP_H, q), arkT);
        u32x2 w; w.x = cvt_pk_bf16(d[0], d[1]); w.y = cvt_pk_bf16(d[2], d[3]); *(u32x2*)(W + CP_Q + q * 32 + 8 * g) = w;
    }
    asm volatile("" ::: "memory");
    {
        const bf16x8 ft = fr16(CP_TT, q);
#pragma unroll
        for (int nt = 0; nt < 4; ++nt) {
            const f32x4 d = mfma16(ft, fr16(CP_TRB, 16 * nt + q), zero4);
            u32x2 w; w.x = cvt_pk_bf16(d[0], d[1]); w.y = cvt_pk_bf16(d[2], d[3]); *(u32x2*)(W + CP_GT + (16 * nt + q) * 32 + 8 * g) = w;
        }
    }
    asm volatile("" ::: "memory");
    {
        const bf16x8 fa = fr16(CP_AUKT, q);
#pragma unroll
        for (int nt = 0; nt < 4; ++nt) {
            f32x4 kt;
#pragma unroll
            for (int r = 0; r < 4; ++r) kt[r] = bf2f(*(const bf16_t*)(W + CP_TMK + (4 * g + r) * 144 + (16 * nt + q) * 2));
            const f32x4 d = mfma16(fa, fr16(CP_GT, 16 * nt + q), kt);
            u32x2 w; w.x = cvt_pk_bf16(d[0], d[1]); w.y = cvt_pk_bf16(d[2], d[3]); *(u32x2*)(W + CP_WT + (16 * nt + q) * 32 + 8 * g) = w;
        }
    }
    asm volatile("" ::: "memory");
    {
        const bf16x8 fh = fr16(CP_H, q), fq = fr16(CP_Q, q);
        bf16_t* RHg = p.CRH + (size_t)unit * 1024;
        bf16_t* P3g = p.CP3 + (size_t)unit * 1024;
        bf16_t* Mg = p.CM + (size_t)unit * 4096;
        bf16_t* Ng = p.CN + (size_t)unit * 4096;
#pragma unroll
        for (int mt = 0; mt < 4; ++mt) {
            const u32x2 rw = *(const u32x2*)(W + CP_TMR + q * 144 + (16 * mt + 4 * g) * 2);
            const f32x4 rt = (f32x4){bflo(rw.x), bfhi(rw.x), bflo(rw.y), bfhi(rw.y)};
            const f32x4 d = mfma16(fr16(CP_TRU, 16 * mt + q), fh, rt);
            u32x2 w; w.x = cvt_pk_bf16(d[0], d[1]); w.y = cvt_pk_bf16(d[2], d[3]);
            *(u32x2*)(RHg + (((mt >> 1) * 64 + lane) * 8 + (mt & 1) * 4)) = w;
        }
#pragma unroll
        for (int vs = 0; vs < 4; ++vs) {
            const f32x4 d = mfma16(fq, fr16(CP_TRV, 16 * vs + q), zero4);
            { u32x2 w; w.x = cvt_pk_bf16(d[0], d[1]); w.y = cvt_pk_bf16(d[2], d[3]); *(u32x2*)(P3g + (vs * 64 + lane) * 4) = w; }
        }
#pragma unroll
        for (int nt = 0; nt < 4; ++nt) {
            const bf16x8 fg = fr16(CP_GT, 16 * nt + q);
            const float gc = *(const float*)(W + CP_G + (16 * nt + q) * 4);
#pragma unroll
            for (int mt = 0; mt < 4; ++mt) {
                f32x4 d = mfma16(fr16(CP_TRU, 16 * mt + q), fg, zero4);
#pragma unroll
                for (int r = 0; r < 4; ++r) d[r] = gc * (d[r] + ((16 * mt + 4 * g + r == 16 * nt + q) ? 1.0f : 0.f));
                u32x2 w; w.x = cvt_pk_bf16(d[0], d[1]); w.y = cvt_pk_bf16(d[2], d[3]);
                *(u32x2*)(Mg + (((nt * 2 + (mt >> 1)) * 64 + lane) * 8 + (mt & 1) * 4)) = w;
            }
        }
#pragma unroll
        for (int mt = 0; mt < 4; ++mt) {
            const bf16x8 fw = fr16(CP_WT, 16 * mt + q);
            const f32x4 gc = *(const f32x4*)(W + CP_G + (16 * mt + 4 * g) * 4);
#pragma unroll
            for (int vs = 0; vs < 4; ++vs) {
                const f32x4 d = mfma16(fw, fr16(CP_TRV, 16 * vs + q), zero4) * gc;
                { u32x2 w; w.x = cvt_pk_bf16(d[0], d[1]); w.y = cvt_pk_bf16(d[2], d[3]); *(u32x2*)(Ng + ((vs * 4 + mt) * 64 + lane) * 4) = w; }
            }
        }
    }
    asm volatile("" ::: "memory");
}

DI void sq_wave(const Params& p, int chain, int vs, int lane) {
    const int b = chain >> 4, h = (chain >> 1) & 7, dir = chain & 1;
    const int q = lane & 15, g = lane >> 4;
    auto step_row = [&](int i) -> int {
        if (i < TCB) return TL + b * TCB + (dir == 0 ? i : TCB - 1 - i);
        const int jj = i - TCB;
        return b * TLB + (dir == 0 ? jj : TLB - 1 - jj);
    };
    float* YCd = p.YS + ((size_t)chain * CK_NCH * 4 + vs) * 256 + lane * 4;
    f32x4 st[4];
#pragma unroll
    for (int mt = 0; mt < 4; ++mt) st[mt] = (f32x4){0.f, 0.f, 0.f, 0.f};
    struct Ops { u32x4 m[4][2]; u32x4 r[2]; u32x2 n[4]; u32x2 p3; };
    auto load = [&](Ops& o, int c) {
        const size_t unit = (size_t)chain * CK_NCH + c;
        const bf16_t* Mg = p.CM + unit * 4096; const bf16_t* RHg = p.CRH + unit * 1024;
        const bf16_t* Ng = p.CN + unit * 4096 + (size_t)vs * 1024; const bf16_t* P3g = p.CP3 + unit * 1024 + vs * 256;
#pragma unroll
        for (int mt = 0; mt < 4; ++mt)
#pragma unroll
            for (int s = 0; s < 2; ++s) o.m[mt][s] = *(const u32x4*)(Mg + ((mt * 2 + s) * 64 + lane) * 8);
#pragma unroll
        for (int s = 0; s < 2; ++s) o.r[s] = *(const u32x4*)(RHg + (s * 64 + lane) * 8);
#pragma unroll
        for (int mt = 0; mt < 4; ++mt) o.n[mt] = *(const u32x2*)(Ng + (mt * 64 + lane) * 4);
        o.p3 = *(const u32x2*)(P3g + lane * 4);
    };
    auto stepc = [&](const Ops& o, int c) {
        const bf16x8 sb0 = pack8(st[0], st[1]), sb1 = pack8(st[2], st[3]);
        f32x4 y = mfma16(__builtin_bit_cast(bf16x8, o.r[0]), sb0, (f32x4){bflo(o.p3.x), bfhi(o.p3.x), bflo(o.p3.y), bfhi(o.p3.y)});
        y = mfma16(__builtin_bit_cast(bf16x8, o.r[1]), sb1, y);
#pragma unroll
        for (int mt = 0; mt < 4; ++mt) {
            f32x4 a = mfma16(__builtin_bit_cast(bf16x8, o.m[mt][0]), sb0, (f32x4){bflo(o.n[mt].x), bfhi(o.n[mt].x), bflo(o.n[mt].y), bfhi(o.n[mt].y)});
            st[mt] = mfma16(__builtin_bit_cast(bf16x8, o.m[mt][1]), sb1, a);
        }
        *(f32x4*)(YCd + ((size_t)c * 4) * 256) = y;
    };
    Ops oa, ob, oc;
    load(oa, 0); load(ob, 1); load(oc, 2);
    for (int c = 0; c < CK_NCH; c += 3) {
        stepc(oa, c);     __builtin_amdgcn_sched_barrier(0); load(oa, (c + 3 < CK_NCH) ? c + 3 : CK_NCH - 1); __builtin_amdgcn_sched_barrier(0);
        stepc(ob, c + 1); __builtin_amdgcn_sched_barrier(0); load(ob, (c + 4 < CK_NCH) ? c + 4 : CK_NCH - 1); __builtin_amdgcn_sched_barrier(0);
        stepc(oc, c + 2); __builtin_amdgcn_sched_barrier(0); load(oc, (c + 5 < CK_NCH) ? c + 5 : CK_NCH - 1); __builtin_amdgcn_sched_barrier(0);
    }
}

DI void na_block_unit(const Params& p, char* lds, int U) {
    const int tid = opaque_tid(), lane = tid & 63, wv = tid >> 6, q = lane & 15, g = lane >> 4;
    const bool lat = U < 1024;
    int b, r, hp, qb;
    if (lat) { hp = U & 3; r = (U >> 2) & 127; b = U >> 9; qb = 0; } else { const int V = U - 1024; qb = V & 3; hp = (V >> 2) & 3; b = V >> 4; r = 0; }
    const int hh = wv >> 2, w = wv & 3, h = 2 * hp + hh;
    const int j = 16 * w + q;
    const int qtok = lat ? (b * TLB + r * 64 + j) : (TL + b * TCB + 64 * qb + j);
    const int row_start = lat ? (r - 4 < 0 ? 0 : (r - 4 > 120 ? 120 : r - 4)) : 0;
    const int c0 = (w == 0 ? 0 : (w == 1 ? 8 : (w == 2 ? 24 : 32)));
    int cs = j - 8; cs = cs < 0 ? 0 : (cs > 48 ? 48 : cs);
    const int nch = lat ? 12 : 4, first_ctx = lat ? 8 : 0;
    bf16x8 qf[2];
#pragma unroll
    for (int ks = 0; ks < 2; ++ks) qf[ks] = *(const bf16x8*)(p.Q0 + (size_t)qtok * 512 + h * 64 + 32 * ks + 8 * g);
    u32x4 rk[2], rv[2];
    auto issue = [&](int ci) {
        const bool isctx = ci >= first_ctx;
        const int cc = ci - first_ctx;
#pragma unroll
        for (int i = 0; i < 2; ++i) {
            const int pc = tid + NTHR * i;
            const int key = pc >> 4, c16 = pc & 15;
            const int tok = isctx ? (TL + b * TCB + cc * 64 + key) : (b * TLB + (row_start + ci) * 64 + key);
            rk[i] = *(const u32x4*)(p.K0 + (size_t)tok * 512 + hp * 128 + c16 * 8);
            const int row = pc >> 3, k8 = pc & 7;
            const bf16_t* vsrc = isctx ? (p.VT0C + ((size_t)(b * 512 + hp * 128 + row)) * TCB + cc * 64 + k8 * 8)
                                       : (p.VT0L + ((size_t)(b * 512 + hp * 128 + row)) * TLB + (row_start + ci) * 64 + k8 * 8);
            rv[i] = *(const u32x4*)vsrc;
        }
    };
    auto stash = [&](char* st) {
#pragma unroll
        for (int i = 0; i < 2; ++i) {
            const int pc = tid + NTHR * i;
            const int key = pc >> 4, c16 = pc & 15;
            *(u32x4*)(st + (c16 >> 3) * 8192 + lds_byte(key, (c16 & 7) * 8)) = rk[i];
            const int row = pc >> 3, k8 = pc & 7;
            *(u32x4*)(st + 16384 + (row >> 6) * 8192 + lds_byte(row & 63, k8 * 8)) = rv[i];
        }
    };
    float m = -3.0e38f, sum = 0.f;
    f32x4 o[4];
#pragma unroll
    for (int dm = 0; dm < 4; ++dm) o[dm] = (f32x4){0.f, 0.f, 0.f, 0.f};
    auto qk = [&](const char* kimg, int kc0, f32x4 (&s)[2]) {
#pragma unroll
        for (int hf = 0; hf < 2; ++hf) {
            const int key = kc0 + 8 * (q >> 2) + 4 * hf + (q & 3);
            f32x4 a = (f32x4){0.f, 0.f, 0.f, 0.f};
#pragma unroll
            for (int ks = 0; ks < 2; ++ks) a = mfma16(*(const bf16x8*)(kimg + lds_byte(key, 32 * ks + 8 * g)), qf[ks], a);
            s[hf] = a;
        }
    };
    auto pv = [&](const char* vimg, int kc0, const f32x4 (&s)[2]) {
        const bf16x8 pb = pack8(s[0], s[1]);
#pragma unroll
        for (int dm = 0; dm < 4; ++dm) o[dm] = mfma16(*(const bf16x8*)(vimg + lds_byte(16 * dm + q, kc0 + 8 * g)), pb, o[dm]);
    };
    issue(0);
    stash(lds);
    __syncthreads();
    for (int ci = 0; ci < nch; ++ci) {
        const bool more = ci + 1 < nch;
        if (more) issue(ci + 1);
        const char* st = lds + (ci & 1) * 32768;
        const char* kimg = st + hh * 8192;
        const char* vimg = st + 16384 + hh * 8192;
        if (ci < first_ctx) {
            f32x4 s[2];
            qk(kimg, c0, s);
            const int row_off = row_start + ci - r + 7;
            float cmax = -3.0e38f;
#pragma unroll
            for (int hf = 0; hf < 2; ++hf)
#pragma unroll
                for (int rr = 0; rr < 4; ++rr) {
                    const int cc_ = c0 + 8 * g + 4 * hf + rr;
                    int co = cc_ - j; co = co < -15 ? -15 : (co > 15 ? 15 : co);
                    const bool in = (cc_ >= cs) && (cc_ < cs + 16);
                    const float bias = p.na_rpb[(h * 15 + row_off) * 31 + co + 15];
                    const float sv = in ? (s[hf][rr] * 0.125f + bias) : -1.0e30f;
                    s[hf][rr] = sv; cmax = fmaxf(cmax, sv);
                }
            cmax = fmaxf(cmax, __shfl_xor(cmax, 16)); cmax = fmaxf(cmax, __shfl_xor(cmax, 32));
            const float mn = fmaxf(m, cmax), al = __expf(m - mn);
            m = mn; sum *= al;
#pragma unroll
            for (int dm = 0; dm < 4; ++dm) o[dm] = o[dm] * al;
#pragma unroll
            for (int hf = 0; hf < 2; ++hf)
#pragma unroll
                for (int rr = 0; rr < 4; ++rr) { s[hf][rr] = __expf(s[hf][rr] - mn); sum += s[hf][rr]; }
            pv(vimg, c0, s);
        } else {
            f32x4 s0[2], s1[2];
            qk(kimg, 0, s0); qk(kimg, 32, s1);
            float cmax = -3.0e38f;
#pragma unroll
            for (int hf = 0; hf < 2; ++hf)
#pragma unroll
                for (int rr = 0; rr < 4; ++rr) { s0[hf][rr] *= 0.125f; s1[hf][rr] *= 0.125f; cmax = fmaxf(cmax, fmaxf(s0[hf][rr], s1[hf][rr])); }
            cmax = fmaxf(cmax, __shfl_xor(cmax, 16)); cmax = fmaxf(cmax, __shfl_xor(cmax, 32));
            const float mn = fmaxf(m, cmax), al = __expf(m - mn);
            m = mn; sum *= al;
#pragma unroll
            for (int dm = 0; dm < 4; ++dm) o[dm] = o[dm] * al;
#pragma unroll
            for (int hf = 0; hf < 2; ++hf)
#pragma unroll
                for (int rr = 0; rr < 4; ++rr) { s0[hf][rr] = __expf(s0[hf][rr] - mn); s1[hf][rr] = __expf(s1[hf][rr] - mn); sum += s0[hf][rr] + s1[hf][rr]; }
            pv(vimg, 0, s0); pv(vimg, 32, s1);
        }
        if (more) stash(lds + ((ci + 1) & 1) * 32768);
        __syncthreads();
    }
    sum += __shfl_xor(sum, 16); sum += __shfl_xor(sum, 32);
    const float inv = 1.0f / sum;
#pragma unroll
    for (int dm = 0; dm < 4; ++dm) {
        u32x2 wv_; wv_.x = cvt_pk_bf16(o[dm][0] * inv, o[dm][1] * inv); wv_.y = cvt_pk_bf16(o[dm][2] * inv, o[dm][3] * inv);
        *(u32x2*)(p.MIX + (size_t)qtok * 1024 + h * 64 + 16 * dm + 4 * g) = wv_;
    }
}

template <int PARTS = 3>
DI void ph_attn_cp(const Params& p, char* lds) {
    const int tz_ = opaque_tid(), lane = tz_ & 63, wv = tz_ >> 6;
    char* W = lds + wv * CPW;
    const int gw = blockIdx.x * 8 + wv, nw = (int)gridDim.x * 8;
    constexpr int NCP = 32 * CK_NCH;
    if (PARTS & 1) for (int U = gw; U < NCP; U += nw) cp_unit(p, W, U, lane);
    if (PARTS & 2) {
        __syncthreads();
        for (int U = blockIdx.x; U < 1024 + 32; U += gridDim.x) na_block_unit(p, lds, U);
    }
}
DI void ph_sq(const Params& p, char* lds) {
    const int tz_ = opaque_tid(), lane = tz_ & 63, wv = tz_ >> 6;
    const int nsq = gridDim.x >= 256 ? 128 : 0;
    if ((int)blockIdx.x < nsq) { if (wv == 0) sq_wave(p, blockIdx.x >> 2, blockIdx.x & 3, lane); return; }
    if (nsq == 0) { if (wv == 0) for (int u = blockIdx.x; u < 128; u += gridDim.x) sq_wave(p, u >> 2, u & 3, lane); __syncthreads(); }
    for (int U = (int)blockIdx.x - nsq; U < 1024 + 32; U += (int)gridDim.x - nsq) na_block_unit(p, lds, U);
}

DI void ph_rw_readout(const Params& p) {
    const int c = opaque_tid(), hh = c >> 6;
    const float gg = p.rw_gn_g[c], gb = p.rw_gn_b[c];
    for (int row = blockIdx.x; row < TT; row += gridDim.x) {
        const size_t o = (size_t)row * 512 + c;
        float y;
        {
            const bool lat = row < TL;
            const int bb = lat ? (row >> 13) : ((row - TL) >> 8), t = lat ? (row & (TLB - 1)) : ((row - TL) & (TCB - 1));
            const int pf = lat ? TCB + t : t, pb = lat ? TCB + (TLB - 1 - t) : (TCB - 1 - t);
            const int vs = (c >> 4) & 3, q = c & 15;
            const size_t cf = (size_t)((bb * 8 + hh) * 2 + 0) * CK_NCH + (pf >> 4), cb = (size_t)((bb * 8 + hh) * 2 + 1) * CK_NCH + (pb >> 4);
            y = p.YS[(cf * 4 + vs) * 256 + (16 * ((pf & 15) >> 2) + q) * 4 + (pf & 3)] + p.YS[(cb * 4 + vs) * 256 + (16 * ((pb & 15) >> 2) + q) * 4 + (pb & 3)];
        }
        const float mu = wave_allsum(y) * (1.0f / 64.0f);
        const float d = y - mu;
        const float var = wave_allsum(d * d) * (1.0f / 64.0f);
        const float yn = d * rsqrtf(var + 64e-5f) * gg + gb;
        const float outv = (yn + p.BONUS[row * 8 + hh] * bfhi(p.SNV[o])) * bfhi(p.SRG[o]);
        p.MIX[(size_t)row * 1024 + 512 + c] = (bf16_t)(cvt_pk_bf16(outv, 0.f) & 0xffff);
    }
}

DI void gemm_f32out(char* lds, const bf16_t* A, int M, const float* W, int N, float* C) {
    const int tid = opaque_tid();
    const int ntn = N / 128, ntm = M / 256;
    gemm_stream<4, 2, 4, 4, PtrLoaderF, 4>(lds, ntn * ntm, 16, [&](int u, PtrLoader<4>& al, PtrLoaderF& bl, const int (&nx)[4]) {
        int tm, tn; tile_of(u, ntm, ntn, tm, tn);
#pragma unroll
        for (int i = 0; i < 4; ++i) al.p[i] = (unsigned)((tm * 256 + a_row(tid) + 64 * i) * 1024 + a_c8(tid) * 8);
        al.base = A;
        fill_bf(bl, W, N, tn * 128, N);
    }, [&](int u, int (&nx)[4], int) {}, [&](int u, int mi, const f32x4 (&a)[4], f32x4 (&o)[4], int r0, int c0) {
#pragma unroll
        for (int ni = 0; ni < 4; ++ni) o[ni] = a[ni];
    }, [&](int u, int r, int c, f32x4 v, f32x4 pv) {
        int tm, tn; tile_of(u, ntm, ntn, tm, tn);
        *(f32x4*)(C + (size_t)(tm * 256 + r) * N + tn * 128 + c) = v;
    });
}

DI void ln_row(f32x4 (&v)[4], const float* g, const float* bta, int lane) {
    float s = 0.f;
#pragma unroll
    for (int i = 0; i < 4; ++i) s += (v[i][0] + v[i][1]) + (v[i][2] + v[i][3]);
    const float mu = wave_allsum(s) * (1.0f / 1024.0f);
    float q = 0.f;
#pragma unroll
    for (int i = 0; i < 4; ++i) { v[i] = v[i] - mu; q += (v[i][0] * v[i][0] + v[i][1] * v[i][1]) + (v[i][2] * v[i][2] + v[i][3] * v[i][3]); }
    const float rstd = rsqrtf(wave_allsum(q) * (1.0f / 1024.0f) + 1e-5f);
#pragma unroll
    for (int i = 0; i < 4; ++i) {
        const int c = 4 * lane + 256 * i;
        v[i] = v[i] * rstd * (*(const f32x4*)(g + c)) + (*(const f32x4*)(bta + c));
    }
}

template <int L>
DI void ph_ln1(const Params& p) {
    const int tz_ = opaque_tid(), lane = tz_ & 63, wv = tz_ >> 6;
    const int nrows = (L == 0) ? TT : TL;
    for (int row = blockIdx.x * 8 + wv; row < nrows; row += gridDim.x * 8) {
        const float* hin = (L == 0) ? (row < TL ? p.x + (size_t)row * 1024 : p.ctx + (size_t)(row - TL) * 1024) : p.HB + (size_t)row * 1024;
        const float* m = p.mods + (size_t)(L * 3 + mods_row(row)) * 6144;
        f32x4 v[4];
#pragma unroll
        for (int i = 0; i < 4; ++i) {
            const int c = 4 * lane + 256 * i;
            v[i] = ALPHA * (*(const f32x4*)(hin + c)) + (*(const f32x4*)(m + 2048 + c)) * (*(const f32x4*)(p.YL + (size_t)row * 1024 + c));
        }
        ln_row(v, p.ln_g + (L * 2 + 0) * 1024, p.ln_b + (L * 2 + 0) * 1024, lane);
#pragma unroll
        for (int i = 0; i < 4; ++i) {
            const int c = 4 * lane + 256 * i;
            *(f32x4*)(p.HA + (size_t)row * 1024 + c) = v[i];
            const f32x4 f = v[i] * (1.0f + *(const f32x4*)(m + 4096 + c)) + *(const f32x4*)(m + 3072 + c);
            u32x2 w; w.x = cvt_pk_bf16(f[0], f[1]); w.y = cvt_pk_bf16(f[2], f[3]);
            *(u32x2*)(p.Abuf + (size_t)row * 1024 + c) = w;
        }
    }
}

template <int CTRL, int RM> DI float dpp_keep(float x) {
    return __builtin_bit_cast(float, __builtin_amdgcn_update_dpp(__builtin_bit_cast(int, x), __builtin_bit_cast(int, x), CTRL, RM, 0xF, false));
}
DI float wave_max_uniform(float x) {
    x = fmaxf(x, dpp_keep<0xB1, 0xF>(x)); x = fmaxf(x, dpp_keep<0x4E, 0xF>(x));
    x = fmaxf(x, dpp_keep<0x141, 0xF>(x)); x = fmaxf(x, dpp_keep<0x140, 0xF>(x));
    x = fmaxf(x, dpp_keep<0x142, 0xA>(x)); x = fmaxf(x, dpp_keep<0x143, 0xC>(x));
    return __builtin_bit_cast(float, __builtin_amdgcn_readlane(__builtin_bit_cast(int, x), 63));
}
template <int L>
DI void ph_route(const Params& p, char* ldsc) {
    const int tz_ = opaque_tid(), lane = tz_ & 63, wv = tz_ >> 6;
    const int nrows = (L == 0) ? TT : TL;
    int* hist = (int*)ldsc;
    if (tz_ < 256) hist[tz_] = 0;
    __syncthreads();
    const f32x4 bias = *(const f32x4*)(p.moe_bias + L * 256 + 4 * lane);
    for (int row = blockIdx.x * 8 + wv; row < nrows; row += gridDim.x * 8) {
        const f32x4 lg = *(const f32x4*)(p.LOGITS + (size_t)row * 256 + 4 * lane);
        const float s0 = sigmoidf_(lg[0]), s1 = sigmoidf_(lg[1]), s2 = sigmoidf_(lg[2]), s3 = sigmoidf_(lg[3]);
        float v0 = s0 + bias[0], v1 = s1 + bias[1], v2 = s2 + bias[2], v3 = s3 + bias[3];
        float m1 = fmaxf(v0, v1), m2 = fminf(v0, v1);
        { const float a = fmaxf(v2, v3), bq = fminf(v2, v3); const float n1 = fmaxf(m1, a); const float n2 = fmaxf(fminf(m1, a), fmaxf(m2, bq)); m1 = n1; m2 = n2; }
        { const float o1 = dpp_keep<0xB1, 0xF>(m1), o2 = dpp_keep<0xB1, 0xF>(m2); const float n1 = fmaxf(m1, o1), n2 = fmaxf(fminf(m1, o1), fmaxf(m2, o2)); m1 = n1; m2 = n2; }
        { const float o1 = dpp_keep<0x4E, 0xF>(m1), o2 = dpp_keep<0x4E, 0xF>(m2); const float n1 = fmaxf(m1, o1), n2 = fmaxf(fminf(m1, o1), fmaxf(m2, o2)); m1 = n1; m2 = n2; }
        { const float o1 = dpp_keep<0x141, 0xF>(m1), o2 = dpp_keep<0x141, 0xF>(m2); const float n1 = fmaxf(m1, o1), n2 = fmaxf(fminf(m1, o1), fmaxf(m2, o2)); m1 = n1; m2 = n2; }
        const float gs = m1 + m2;
        const int myg = lane >> 3;
        int rank = 0;
#pragma unroll
        for (int gg = 0; gg < 8; ++gg) {
            const float og = __builtin_bit_cast(float, __builtin_amdgcn_readlane(__builtin_bit_cast(int, gs), gg * 8));
            rank += ((og > gs) || (og == gs && gg < myg)) ? 1 : 0;
        }
        if (rank >= 4) { v0 = -1.0e30f; v1 = -1.0e30f; v2 = -1.0e30f; v3 = -1.0e30f; }
        int sel_e = 0; float sel_s = 0.f, ssum = 0.f;
#pragma unroll
        for (int rd = 0; rd < 8; ++rd) {
            float bv = v0; int bi = 0; float bs = s0;
            if (v1 > bv) { bv = v1; bi = 1; bs = s1; }
            if (v2 > bv) { bv = v2; bi = 2; bs = s2; }
            if (v3 > bv) { bv = v3; bi = 3; bs = s3; }
            const float mx = wave_max_uniform(bv);
            const unsigned long long bal = __ballot(bv == mx);
            const int ol = __builtin_amdgcn_readfirstlane((int)__builtin_ctzll(bal));
            const int oi = __builtin_amdgcn_readlane(bi, ol);
            const float sv = __builtin_bit_cast(float, __builtin_amdgcn_readlane(__builtin_bit_cast(int, bs), ol));
            if (lane == ol) { if (oi == 0) v0 = -3.0e30f; else if (oi == 1) v1 = -3.0e30f; else if (oi == 2) v2 = -3.0e30f; else v3 = -3.0e30f; }
            ssum += sv;
            if (lane == rd) { sel_e = 4 * ol + oi; sel_s = sv; }
        }
        if (lane < 8) {
            p.EIDX[(size_t)row * 8 + lane] = sel_e;
            p.EW[(size_t)row * 8 + lane] = sel_s / ssum * 2.5f;
            atomicAdd(&hist[sel_e], 1);
        }
    }
    __syncthreads();
    if (tz_ < 256) p.HIST[((size_t)L * 256 + blockIdx.x) * 256 + tz_] = hist[tz_];
    __syncthreads();
}

template <int L>
DI void ph_scatter(const Params& p, char* ldsc) {
    int* sbase = (int*)ldsc;
    int* cursor = sbase + 320;
    const int tid = opaque_tid(), lane = tid & 63, wv = tid >> 6;
    const int nrows = (L == 0) ? TT : TL;
    int mypre = 0;
    {
        int* part = sbase + 640;
        const int e = tid & 255, half = tid >> 8, nbh = ((int)gridDim.x + 1) >> 1;
        const int* hcol = p.HIST + (size_t)L * 256 * 256 + e;
        int tot = 0, pre = 0;
#pragma unroll 16
        for (int i = 0; i < nbh; ++i) {
            const int bq = half * nbh + i;
            const int hv = bq < (int)gridDim.x ? hcol[bq * 256] : 0;
            tot += hv; pre += (bq < (int)blockIdx.x) ? hv : 0;
        }
        part[half * 512 + e] = tot; part[half * 512 + 256 + e] = pre;
        __syncthreads();
        if (tid < 256) {
            tot = part[tid] + part[512 + tid]; mypre = part[256 + tid] + part[768 + tid];
            sbase[tid] = (tot + 255) & ~255;
        }
    }
    __syncthreads();
    {
        int pd = 0, inc = 0;
        if (tid < 256) {
            pd = sbase[tid]; inc = pd;
#pragma unroll
            for (int d = 1; d < 64; d <<= 1) { const int t = __shfl_up(inc, d); if (lane >= d) inc += t; }
            if (lane == 63) sbase[288 + wv] = inc;
        }
        __syncthreads();
        if (tid < 256) {
            int off = 0;
#pragma unroll
            for (int w = 0; w < 3; ++w) off += (w < wv) ? sbase[288 + w] : 0;
            const int excl = inc - pd + off;
            sbase[tid] = excl;
            if (tid == 255) sbase[256] = excl + pd;
        }
    }
    __syncthreads();
    if (tid < 256) cursor[tid] = sbase[tid] + mypre;
    if (blockIdx.x == 0) {
        int* te = p.TILE_E + L * MAXTILES; int* tr = p.TILE_R0 + L * MAXTILES;
        if (tid < 256) { const int b0 = sbase[tid], b1 = sbase[tid + 1]; for (int r = b0; r < b1; r += 256) { te[r >> 8] = tid; tr[r >> 8] = r; } }
        const int nt = sbase[256] >> 8, nsh = nrows / 256;
        for (int i = tid; i < nsh; i += NTHR) { te[nt + i] = 256; tr[nt + i] = SH_BASE + 256 * i; }
        if (tid == 0) p.ictl[1024 + L] = nt + nsh;
    }
    __syncthreads();
    int* stok = p.SLOT_TOK + (size_t)L * NSLOT; float* sw = p.SLOT_W + (size_t)L * NSLOT;
    for (int row = blockIdx.x * 8 + wv; row < nrows; row += gridDim.x * 8) {
        if (lane < 8) {
            const int a = row * 8 + lane;
            const int e = p.EIDX[a];
            const int pos = atomicAdd(&cursor[e], 1);
            stok[pos] = row; sw[pos] = p.EW[a]; p.APOS[a] = pos;
        }
    }
    __syncthreads();
}

template <int L>
DI void ph_moe1(const Params& p, char* lds) {
    const int tid = opaque_tid();
    const int ntiles = p.ictl[1024 + L];
    const int* te = p.TILE_E + L * MAXTILES; const int* tr = p.TILE_R0 + L * MAXTILES;
    const int* stok = p.SLOT_TOK + (size_t)L * NSLOT;
    int pend = 0, pendq = -1;
    gemm_stream<4, 2, 4, 4, PtrLoaderF, 2>(lds, ntiles * 4, 16, [&](int u, PtrLoader<4>& al, PtrLoaderF& bl, const int (&nx)[4]) {
        const int ti = u >> 2, tn = u & 3;
        const int e = te[ti];
#pragma unroll
        for (int i = 0; i < 4; ++i) al.p[i] = (unsigned)(nx[i] * 1024 + a_c8(tid) * 8);
        al.base = p.Abuf;
        const float* gsrc = e < 256 ? p.moe_w_gate + ((size_t)(L * 256 + e)) * 1024 * 256 : p.sh_w_gate + (size_t)L * 1024 * 256;
        const float* usrc = e < 256 ? p.moe_w_up + ((size_t)(L * 256 + e)) * 1024 * 256 : p.sh_w_up + (size_t)L * 1024 * 256;
        bl.ld = 256; bl.base0 = gsrc; bl.base1 = usrc;
#pragma unroll
        for (int i = 0; i < 4; ++i) bl.p[i] = (unsigned)((tid >> 3) * 256 + 32 * (2 * tn + (i >> 1)) + (tid & 7) * 4);
    }, [&](int u, int (&nx)[4], int sel) {
        const int row0 = tr[u >> 2];
        if (sel == 2) {
#pragma unroll
            for (int i = 0; i < 4; ++i) nx[i] = stok[row0 + a_row(tid) + 64 * i];
        } else {
#pragma unroll
            for (int i = 0; i < 4; ++i) nx[i] = (pendq == i) ? pend : nx[i];
            pendq = sel - 4;
            pend = stok[row0 + a_row(tid) + 64 * pendq];
        }
    }, [&](int u, int mi, const f32x4 (&a)[4], f32x4 (&o)[2], int r0, int c0) {
#pragma unroll
        for (int ni = 0; ni < 2; ++ni)
#pragma unroll
            for (int j = 0; j < 4; ++j) o[ni][j] = siluf_(a[ni][j]) * a[ni + 2][j];
    }, [&](int u, int r, int c, f32x4 v, f32x4 pv) {
        const int ti = u >> 2, tn = u & 3;
        u32x2 w; w.x = cvt_pk_bf16(v[0], v[1]); w.y = cvt_pk_bf16(v[2], v[3]);
        *(u32x2*)(p.HBUF + (size_t)(tr[ti] + r) * 256 + tn * 64 + c) = w;
    });
}
template <int L>
DI void ph_moe2(const Params& p, char* lds) {
    const int tid = opaque_tid();
    const int ntiles = p.ictl[1024 + L];
    const int* te = p.TILE_E + L * MAXTILES; const int* tr = p.TILE_R0 + L * MAXTILES;
    const float* sw = p.SLOT_W + (size_t)L * NSLOT;
    float sc4[4] = {0.f, 0.f, 0.f, 0.f};
    gemm_stream<4, 2, 4, 4, PtrLoaderF, 4>(lds, ntiles * 8, 4, [&](int u, PtrLoader<4>& al, PtrLoaderF& bl, const int (&nx)[4]) {
        const int ti = u >> 3, tn = u & 7;
        const int e = te[ti], row0 = tr[ti];
#pragma unroll
        for (int i = 0; i < 4; ++i) al.p[i] = (unsigned)((row0 + a_row(tid) + 64 * i) * 256 + a_c8(tid) * 8);
        al.base = p.HBUF;
        const float* dsrc = e < 256 ? p.moe_w_down + ((size_t)(L * 256 + e)) * 256 * 1024 : p.sh_w_down + (size_t)L * 256 * 1024;
        fill_bf(bl, dsrc, 1024, tn * 128, 1024);
    }, [&](int u, int (&nx)[4], int) {}, [&](int u, int mi, const f32x4 (&a)[4], f32x4 (&o)[4], int r0, int c0) {
        if (mi == 0) {
            const float* s_ = sw + tr[u >> 3] + r0;
#pragma unroll
            for (int m = 0; m < 4; ++m) sc4[m] = s_[16 * m];
        }
#pragma unroll
        for (int ni = 0; ni < 4; ++ni) o[ni] = a[ni] * sc4[mi];
    }, [&](int u, int r, int c, f32x4 v, f32x4 pv) {
        const int ti = u >> 3, tn = u & 7;
        const int row = tr[ti] + r;
        u32x2 w; w.x = cvt_pk_bf16(v[0], v[1]); w.y = cvt_pk_bf16(v[2], v[3]);
        *(u32x2*)(p.YB + (size_t)row * 1024 + tn * 128 + c) = w;
    });
}

template <int L>
DI void ph_combine(const Params& p) {
    const int tz_ = opaque_tid(), lane = tz_ & 63, wv = tz_ >> 6;
    const int nrows = (L == 0) ? TT : TL;
    for (int row = blockIdx.x * 8 + wv; row < nrows; row += gridDim.x * 8) {
        int rr[9];
#pragma unroll
        for (int k = 0; k < 8; ++k) rr[k] = p.APOS[(size_t)row * 8 + k];
        rr[8] = SH_BASE + row;
        const float* m = p.mods + (size_t)(L * 3 + mods_row(row)) * 6144;
        f32x4 v[4];
#pragma unroll
        for (int i = 0; i < 4; ++i) {
            const int c = 4 * lane + 256 * i;
            f32x4 ff = (f32x4){0.f, 0.f, 0.f, 0.f};
#pragma unroll
            for (int k = 0; k < 9; ++k) {
                const u32x2 w = *(const u32x2*)(p.YB + (size_t)rr[k] * 1024 + c);
                ff[0] += bflo(w.x); ff[1] += bfhi(w.x); ff[2] += bflo(w.y); ff[3] += bfhi(w.y);
            }
            v[i] = ALPHA * (*(const f32x4*)(p.HA + (size_t)row * 1024 + c)) + (*(const f32x4*)(m + 5120 + c)) * ff;
        }
        ln_row(v, p.ln_g + (L * 2 + 1) * 1024, p.ln_b + (L * 2 + 1) * 1024, lane);
        if (L == 0) {
            const float* m1 = p.mods + (size_t)(1 * 3 + mods_row(row)) * 6144;
#pragma unroll
            for (int i = 0; i < 4; ++i) {
                const int c = 4 * lane + 256 * i;
                *(f32x4*)(p.HB + (size_t)row * 1024 + c) = v[i];
                const f32x4 a = v[i] * (1.0f + *(const f32x4*)(m1 + 1024 + c)) + *(const f32x4*)(m1 + c);
                u32x2 w; w.x = cvt_pk_bf16(a[0], a[1]); w.y = cvt_pk_bf16(a[2], a[3]);
                *(u32x2*)(p.Abuf + (size_t)row * 1024 + c) = w;
            }
        } else {
#pragma unroll
            for (int i = 0; i < 4; ++i) *(f32x4*)(p.out + (size_t)row * 1024 + 4 * lane + 256 * i) = v[i];
        }
    }
}

DI void gemm_router(char* lds, const bf16_t* A, int M, const float* W, float* C) {
    const int tid = opaque_tid();
    const int ntn = 2, ntm = M / 128;
    gemm_stream<2, 4, 4, 2, PtrLoaderF, 2>(lds, ntn * ntm, 16, [&](int u, PtrLoader<2>& al, PtrLoaderF& bl, const int (&nx)[4]) {
        int tm, tn; tile_of(u, ntm, ntn, tm, tn);
#pragma unroll
        for (int i = 0; i < 2; ++i) al.p[i] = (unsigned)((tm * 128 + a_row(tid) + 64 * i) * 1024 + a_c8(tid) * 8);
        al.base = A;
        fill_bf(bl, W, 256, tn * 128, 256);
    }, [&](int u, int (&nx)[4], int) {}, [&](int u, int mi, const f32x4 (&a)[2], f32x4 (&o)[2], int r0, int c0) {
#pragma unroll
        for (int ni = 0; ni < 2; ++ni) o[ni] = a[ni];
    }, [&](int u, int r, int c, f32x4 v, f32x4 pv) {
        int tm, tn; tile_of(u, ntm, ntn, tm, tn);
        *(f32x4*)(C + (size_t)(tm * 128 + r) * 256 + tn * 128 + c) = v;
    });
}

DI void ph_inproj1(const Params& p, char* lds) {
    const int tid = opaque_tid();
    constexpr int NTN = 25, NTM = 66;
    gemm_stream<4, 2, 4, 4, PtrLoaderF, 4>(lds, NTN * NTM, 16, [&](int u, PtrLoader<4>& al, PtrLoaderF& bl, const int (&nx)[4]) {
        int tm, tn; tile_of(u, NTM, NTN, tm, tn);
#pragma unroll
        for (int i = 0; i < 4; ++i) al.p[i] = (unsigned)((tm * 256 + a_row(tid) + 64 * i) * 1024 + a_c8(tid) * 8);
        al.base = p.Abuf;
        fill_bf(bl, p.od_w_in, ODC, tn * 128, ODC);
    }, [&](int u, int (&nx)[4], int) {}, [&](int u, int mi, const f32x4 (&a)[4], f32x4 (&o)[4], int r0, int c0) {
#pragma unroll
        for (int ni = 0; ni < 4; ++ni) o[ni] = a[ni];
    }, [&](int u, int r, int c, f32x4 v, f32x4 pv) {
        int tm, tn; tile_of(u, NTM, NTN, tm, tn);
        const int row = tm * 256 + r, col = tn * 128 + c;
        if (tn < 8 && row < TL) {
            const int t = row & (TLB - 1);
            const float pos = (c & 32) ? (float)(t & 63) : (float)(t >> 6);
            const float sgn = (c & 16) ? 1.0f : -1.0f;
#pragma unroll
            for (int j = 0; j < 4; ++j) {
                const float ang = pos * exp2f(-(float)((c & 15) + j) * (13.287712379549449f / 16.0f));
                v[j] = v[j] * __cosf(ang) + sgn * pv[j] * __sinf(ang);
            }
            if (tn < 4) v = v * 0.125f;
        }
        if (tn < 24) {
            u32x2 w; w.x = cvt_pk_bf16(v[0], v[1]); w.y = cvt_pk_bf16(v[2], v[3]);
            *(u32x2*)(p.P1 + (size_t)row * 3072 + col) = w;
        } else if (col < ODC) *(f32x4*)(p.G1 + (size_t)row * 32 + (col - 3072)) = v;
    });
}

DI float wave_incl_sum(float v, int lane) {
#pragma unroll
    for (int d = 1; d < 64; d <<= 1) { const float t = __shfl_up(v, d); if (lane >= d) v += t; }
    return v;
}
DI float wave_incl_max(float v, int lane) {
#pragma unroll
    for (int d = 1; d < 64; d <<= 1) { const float t = __shfl_up(v, d); if (lane >= d) v = fmaxf(v, t); }
    return v;
}
DI void ml_gates(const Params& p, float* G, int row0, int h, float& ig, float& bc, float& tot, int& idx) {
    const int tid = opaque_tid(), lane = tid & 63, wv = tid >> 6;
    const int gi = (tid >> 7) & 1, e = tid & 127;
    idx = gi == 0 ? e : 127 - e;
    float c = 0.f; ig = 0.f;
    if (tid < 256) {
        const float* g = p.G1 + (size_t)(row0 + idx) * 32;
        ig = g[8 * gi + h] + p.ml_gate_b[8 * gi + h];
        const float lf = logsigmoidf_(g[16 + 8 * gi + h] + p.ml_gate_b[16 + 8 * gi + h]);
        c = wave_incl_sum(lf, lane);
        if (lane == 63) G[768 + wv] = c;
    }
    __syncthreads();
    if (tid < 256) {
        if (wv & 1) c += G[768 + wv - 1];
        G[gi * 128 + idx] = ig; G[256 + gi * 128 + idx] = c;
        if (e == 127) G[776 + gi] = c;
    }
    __syncthreads();
    bc = c; tot = G[776 + gi];
}

constexpr int MLC_T = 4096, MLC_TS = 392;
DI void ph_ml_chunks(const Params& p, char* ldsc) {
    float* G = (float*)ldsc;
    const int tid = opaque_tid(), lane = tid & 63, wv = tid >> 6, fr = lane & 15, fq = lane >> 4;
    for (int u = blockIdx.x; u < 1056; u += gridDim.x) {
        const bool lat = u < 1024;
        const int bh = lat ? (u >> 6) : ((u - 1024) >> 1), blk = lat ? (u & 63) : ((u - 1024) & 1);
        const int b = bh >> 3, h = bh & 7;
        const int Tseq = lat ? TLB : TCB;
        const int row0 = (lat ? b * TLB : TL + b * TCB) + blk * 128;
        {
            u32x4 rr[6];
#pragma unroll
            for (int i = 0; i < 6; ++i) {
                const int qd = tid + NTHR * i, row = qd / 24, cc = qd % 24;
                rr[i] = *(const u32x4*)(p.P1 + (size_t)(row0 + row) * 3072 + (cc < 8 ? 512 + h * 64 + cc * 8 : 1024 + h * 128 + (cc - 8) * 8));
            }
#pragma unroll
            for (int i = 0; i < 6; ++i) {
                const int qd = tid + NTHR * i, row = qd / 24, cc = qd % 24;
                char* d = ldsc + MLC_T + row * MLC_TS + cc * 16;
                *(u32x2*)d = (u32x2){rr[i].x, rr[i].y}; *(u32x2*)(d + 8) = (u32x2){rr[i].z, rr[i].w};
            }
        }
        float ig, bc, tot; int idx;
        ml_gates(p, G, row0, h, ig, bc, tot, idx);
        const float gl = tot - bc + ig;
        float mw = (tid < 256) ? wave_allmax(gl) : 0.f;
        if (tid < 256 && lane == 0) G[784 + wv] = mw;
        __syncthreads();
        if (tid < 256) {
            const int gi = tid >> 7;
            const float mc = fmaxf(G[784 + 2 * gi], G[784 + 2 * gi + 1]);
            G[512 + gi * 128 + idx] = __expf(gl - mc);
            if ((tid & 127) == 0) { p.BEMC[u * 4 + gi * 2 + 0] = tot; p.BEMC[u * 4 + gi * 2 + 1] = mc; }
        }
        __syncthreads();
        auto col8 = [&](int col, int l0) -> u32x4 {
            const char* s_ = ldsc + MLC_T + l0 * MLC_TS + col * 2;
            u32x4 w;
            w.x = (unsigned)*(const unsigned short*)(s_) | ((unsigned)*(const unsigned short*)(s_ + MLC_TS) << 16);
            w.y = (unsigned)*(const unsigned short*)(s_ + 2 * MLC_TS) | ((unsigned)*(const unsigned short*)(s_ + 3 * MLC_TS) << 16);
            w.z = (unsigned)*(const unsigned short*)(s_ + 4 * MLC_TS) | ((unsigned)*(const unsigned short*)(s_ + 5 * MLC_TS) << 16);
            w.w = (unsigned)*(const unsigned short*)(s_ + 6 * MLC_TS) | ((unsigned)*(const unsigned short*)(s_ + 7 * MLC_TS) << 16);
            return w;
        };
        f32x4 accf[4], accb[4];
#pragma unroll
        for (int n = 0; n < 4; ++n) { accf[n] = (f32x4){0.f, 0.f, 0.f, 0.f}; accb[n] = accf[n]; }
#pragma unroll
        for (int ks = 0; ks < 4; ++ks) {
            const int l0 = 32 * ks + 8 * fq;
            const bf16x8 va = __builtin_bit_cast(bf16x8, col8(64 + 16 * wv + fr, l0));
            const f32x4 wfa = *(const f32x4*)(G + 512 + l0), wfb = *(const f32x4*)(G + 512 + l0 + 4);
            const f32x4 wba = *(const f32x4*)(G + 640 + l0), wbb = *(const f32x4*)(G + 640 + l0 + 4);
#pragma unroll
            for (int n = 0; n < 4; ++n) {
                const u32x4 kr = col8(16 * n + fr, l0);
                const float k0 = bflo(kr.x), k1 = bfhi(kr.x), k2 = bflo(kr.y), k3 = bfhi(kr.y), k4 = bflo(kr.z), k5 = bfhi(kr.z), k6 = bflo(kr.w), k7 = bfhi(kr.w);
                u32x4 kf, kb;
                kf.x = cvt_pk_bf16(k0 * wfa[0], k1 * wfa[1]); kf.y = cvt_pk_bf16(k2 * wfa[2], k3 * wfa[3]);
                kf.z = cvt_pk_bf16(k4 * wfb[0], k5 * wfb[1]); kf.w = cvt_pk_bf16(k6 * wfb[2], k7 * wfb[3]);
                kb.x = cvt_pk_bf16(k0 * wba[0], k1 * wba[1]); kb.y = cvt_pk_bf16(k2 * wba[2], k3 * wba[3]);
                kb.z = cvt_pk_bf16(k4 * wbb[0], k5 * wbb[1]); kb.w = cvt_pk_bf16(k6 * wbb[2], k7 * wbb[3]);
                accf[n] = mfma16(va, __builtin_bit_cast(bf16x8, kf), accf[n]);
                accb[n] = mfma16(va, __builtin_bit_cast(bf16x8, kb), accb[n]);
            }
        }
        float* kvt = p.KVT + (size_t)u * 2 * 8192;
#pragma unroll
        for (int n = 0; n < 4; ++n)
#pragma unroll
            for (int j = 0; j < 4; ++j) {
                kvt[(16 * wv + 4 * fq + j) * 64 + 16 * n + fr] = accf[n][j];
                kvt[8192 + (16 * wv + 4 * fq + j) * 64 + 16 * n + fr] = accb[n][j];
            }
        if (tid < 128) {
            const int d = tid >> 6, k = tid & 63;
            float s = 0.f;
#pragma unroll 4
            for (int l = 0; l < 128; l += 8) {
                const u32x4 kq = col8(k, l);
                const f32x4 wa = *(const f32x4*)(G + 512 + d * 128 + l), wb = *(const f32x4*)(G + 512 + d * 128 + l + 4);
                s += bflo(kq.x) * wa[0] + bfhi(kq.x) * wa[1] + bflo(kq.y) * wa[2] + bfhi(kq.y) * wa[3]
                   + bflo(kq.z) * wb[0] + bfhi(kq.z) * wb[1] + bflo(kq.w) * wb[2] + bfhi(kq.w) * wb[3];
            }
            p.KS[(size_t)u * 128 + d * 64 + k] = s;
        }
        if (lat) {
            const int v = tid >> 2, part = tid & 3;
            bf16_t* dst = p.V1TL + ((size_t)(b * 1024 + h * 128 + v)) * TLB + blk * 128;
#pragma unroll
            for (int i = 0; i < 4; ++i) {
                const int tg = part + 4 * i;
                *(u32x4*)(dst + 8 * tg) = col8(64 + v, 8 * tg);
            }
        }
        __syncthreads();
    }
}

DI void ph_ml_scan(const Params& p) {
    const int tid = opaque_tid();
    for (int w = blockIdx.x; w < 256; w += gridDim.x) {
        const int chain = w & 31, slice = w >> 5;
        const int bh = chain >> 1, dir = chain & 1;
        const int e0 = slice * 1024 + tid * 2;
        float c0 = 0.f, c1 = 0.f, nn = 0.f, m = 0.f;
        const bool hasn = (slice == 0 && tid < 64);
        auto unit_of = [&](int s) -> int {
            if (s < 2) return 1024 + bh * 2 + (dir == 0 ? s : 1 - s);
            const int jj = s - 2; return bh * 64 + (dir == 0 ? jj : 63 - jj);
        };
        typedef float f32x2 __attribute__((ext_vector_type(2)));
        constexpr int DP = 6;
        f32x2 kvq[DP], bmq[DP]; float ksq[DP];
        const int nl = tid & 63;
#pragma unroll
        for (int j = 0; j < DP; ++j) {
            const int un = unit_of(j);
            kvq[j] = *(const f32x2*)(p.KVT + ((size_t)un * 2 + dir) * 8192 + e0);
            bmq[j] = *(const f32x2*)(p.BEMC + un * 4 + dir * 2);
            ksq[j] = p.KS[(size_t)un * 128 + dir * 64 + nl];
        }
#pragma unroll 1
        for (int s0 = 0; s0 < 66; s0 += DP) {
#pragma unroll
            for (int j = 0; j < DP; ++j) {
                const int s = s0 + j;
                const int u = unit_of(s);
                const f32x2 kv = kvq[j], bm = bmq[j]; const float ksv = ksq[j];
                {
                    const int sn = s + DP < 66 ? s + DP : 65;
                    const int un = unit_of(sn);
                    kvq[j] = *(const f32x2*)(p.KVT + ((size_t)un * 2 + dir) * 8192 + e0);
                    bmq[j] = *(const f32x2*)(p.BEMC + un * 4 + dir * 2);
                    ksq[j] = p.KS[(size_t)un * 128 + dir * 64 + nl];
                }
                {
                    bf16_t* ct = p.C0T + ((size_t)u * 2 + dir) * 8192;
                    *(unsigned*)(ct + e0) = cvt_pk_bf16(c0, c1);
                    if (hasn) p.N0[((size_t)u * 2 + dir) * 64 + tid] = nn;
                    if (slice == 0 && tid == 0) p.M0[u * 2 + dir] = m;
                }
                const float be = bm[0], mc = bm[1];
                const float mn = fmaxf(be + m, mc);
                const float fa = __expf(be + m - mn), fb = __expf(mc - mn);
                c0 = fa * c0 + fb * kv[0]; c1 = fa * c1 + fb * kv[1];
                nn = fa * nn + fb * ksv;
                m = mn;
            }
        }
    }
}

constexpr int MLO_K = 8192, MLO_VT = MLO_K + 16384, MLO_VTS = 272, MLO_C0 = MLO_VT + 128 * MLO_VTS, MLO_HS = 8192;
DI void ph_ml_out(const Params& p, char* ldsc) {
    float* G = (float*)ldsc;
    const int tid = opaque_tid(), lane = tid & 63, wv = tid >> 6, q = lane & 15, g = lane >> 4;
    for (int u = blockIdx.x; u < 1024; u += gridDim.x) {
        const int bh = u >> 6, blk = u & 63, b = bh >> 3, h = bh & 7;
        const int row0 = b * TLB + blk * 128;
        {
            u32x4 rk[2], rv[4], rc[4];
#pragma unroll
            for (int i = 0; i < 2; ++i) { const int pc = tid + i * NTHR; rk[i] = *(const u32x4*)(p.P1 + (size_t)(row0 + (pc >> 3)) * 3072 + 512 + h * 64 + (pc & 7) * 8); }
#pragma unroll
            for (int i = 0; i < 4; ++i) { const int pc = tid + i * NTHR; rv[i] = *(const u32x4*)(p.V1TL + ((size_t)(b * 1024 + h * 128 + (pc >> 4))) * TLB + blk * 128 + (pc & 15) * 8); }
#pragma unroll
            for (int i = 0; i < 4; ++i) { const int pc = tid + i * NTHR; rc[i] = *(const u32x4*)(p.C0T + (size_t)u * 2 * 8192 + (size_t)pc * 8); }
#pragma unroll
            for (int i = 0; i < 2; ++i) { const int pc = tid + i * NTHR; *(u32x4*)(ldsc + MLO_K + lds_byte(pc >> 3, (pc & 7) * 8)) = rk[i]; }
#pragma unroll
            for (int i = 0; i < 4; ++i) { const int pc = tid + i * NTHR; *(u32x4*)(ldsc + MLO_VT + (pc >> 4) * MLO_VTS + (pc & 15) * 16) = rv[i]; }
#pragma unroll
            for (int i = 0; i < 4; ++i) { const int pc = tid + i * NTHR; const int dd = pc >> 10, rr = (pc >> 3) & 127; *(u32x4*)(ldsc + MLO_C0 + dd * 16384 + lds_byte(rr, (pc & 7) * 8)) = rc[i]; }
        }
        float ig, bc, tot; int idx;
        ml_gates(p, G, row0, h, ig, bc, tot, idx);
        const float m0f = p.M0[u * 2 + 0], m0b = p.M0[u * 2 + 1];
        {
            float pm = (tid < 256) ? wave_incl_max(ig - bc, lane) : 0.f;
            if (tid < 256 && lane == 63) G[768 + wv] = pm;
            __syncthreads();
            if (tid < 256) {
                if (wv & 1) pm = fmaxf(pm, G[768 + wv - 1]);
                const int gi = tid >> 7;
                G[512 + gi * 128 + idx] = fmaxf(bc + pm, bc + (gi == 0 ? m0f : m0b));
            }
            __syncthreads();
        }
        const int tl = 16 * wv + q;
        const int trow = row0 + tl;
        bf16x8 qf[2];
#pragma unroll
        for (int ks = 0; ks < 2; ++ks) qf[ks] = *(const bf16x8*)(p.P1 + (size_t)trow * 3072 + h * 64 + 32 * ks + 8 * g);
        f32x4 st_[8];
#pragma unroll
        for (int st = 0; st < 8; ++st) {
            f32x4 s = (f32x4){0.f, 0.f, 0.f, 0.f};
#pragma unroll
            for (int ks = 0; ks < 2; ++ks) s = mfma16(*(const bf16x8*)(ldsc + MLO_K + lds_byte(16 * st + q, 32 * ks + 8 * g)), qf[ks], s);
            st_[st] = s;
        }
        f32x4 hsum[8];
#pragma unroll
        for (int vm = 0; vm < 8; ++vm) hsum[vm] = (f32x4){0.f, 0.f, 0.f, 0.f};
#pragma unroll 1
        for (int dir = 0; dir < 2; ++dir) {
            const float mt = G[512 + dir * 128 + tl];
            const float bt = G[256 + dir * 128 + tl];
            const float m0 = dir == 0 ? m0f : m0b;
            const float iw = __expf(bt + m0 - mt);
            const float* n0 = p.N0 + ((size_t)u * 2 + dir) * 64;
            float qn = 0.f;
#pragma unroll
            for (int ks = 0; ks < 2; ++ks) {
                const u32x4 w = __builtin_bit_cast(u32x4, qf[ks]);
                const f32x4 na = *(const f32x4*)(n0 + 32 * ks + 8 * g), nb = *(const f32x4*)(n0 + 32 * ks + 8 * g + 4);
                qn += bflo(w.x) * na[0] + bfhi(w.x) * na[1] + bflo(w.y) * na[2] + bfhi(w.y) * na[3] + bflo(w.z) * nb[0] + bfhi(w.z) * nb[1] + bflo(w.w) * nb[2] + bfhi(w.w) * nb[3];
            }
            qn += __shfl_xor(qn, 16); qn += __shfl_xor(qn, 32);
            f32x4 acc[8];
            const char* c0s = ldsc + MLO_C0 + dir * 16384;
#pragma unroll
            for (int vm = 0; vm < 8; ++vm) {
                f32x4 a = (f32x4){0.f, 0.f, 0.f, 0.f};
#pragma unroll
                for (int ks = 0; ks < 2; ++ks) a = mfma16(*(const bf16x8*)(c0s + lds_byte(16 * vm + q, 32 * ks + 8 * g)), qf[ks], a);
                acc[vm] = a * iw;
            }
            float rs = 0.f;
#pragma unroll
            for (int uu = 0; uu < 4; ++uu) {
                const bool need = dir == 0 ? (2 * uu <= wv) : (2 * uu + 1 >= wv);
                if (need) {
                    f32x4 pw[2];
#pragma unroll
                    for (int hf = 0; hf < 2; ++hf) {
                        const int st = 2 * uu + hf;
                        const f32x4 bs = *(const f32x4*)(G + 256 + dir * 128 + 16 * st + 4 * g);
                        const f32x4 is = *(const f32x4*)(G + dir * 128 + 16 * st + 4 * g);
                        f32x4 w;
#pragma unroll
                        for (int r = 0; r < 4; ++r) {
                            const int s = 16 * st + 4 * g + r;
                            const bool ok = dir == 0 ? (s <= tl) : (s >= tl);
                            const float dw = ok ? __expf(bt - bs[r] + is[r] - mt) : 0.f;
                            w[r] = st_[st][r] * dw;
                            rs += w[r];
                        }
                        pw[hf] = w;
                    }
                    const bf16x8 pb = pack8(pw[0], pw[1]);
#pragma unroll
                    for (int vm = 0; vm < 8; ++vm) {
                        const char* vr = ldsc + MLO_VT + (16 * vm + q) * MLO_VTS + (32 * uu + 4 * g) * 2;
                        const bf16x8 va = join8(*(const u32x2*)vr, *(const u32x2*)(vr + 32));
                        acc[vm] = mfma16(va, pb, acc[vm]);
                    }
                }
            }
            rs += __shfl_xor(rs, 16); rs += __shfl_xor(rs, 32);
            const float den = rs + iw * qn;
            const float dn = 1.0f / fmaxf(fabsf(den), __expf(-mt));
#pragma unroll
            for (int vm = 0; vm < 8; ++vm) hsum[vm] += acc[vm] * dn;
        }
        __syncthreads();
        float* HS = (float*)(ldsc + MLO_HS);
#pragma unroll
        for (int vm = 0; vm < 8; ++vm) *(f32x4*)(HS + tl * 132 + 16 * vm + 4 * g) = hsum[vm];
        __syncthreads();
        {
            const int t = tid >> 2, vq = (tid & 3) * 4;
            const float* hr = HS + t * 132 + vq;
            f32x4 hv[8];
            float ss = 0.f;
#pragma unroll
            for (int i = 0; i < 8; ++i) { hv[i] = *(const f32x4*)(hr + 16 * i); ss += (hv[i][0] * hv[i][0] + hv[i][1] * hv[i][1]) + (hv[i][2] * hv[i][2] + hv[i][3] * hv[i][3]); }
            ss += __shfl_xor(ss, 1); ss += __shfl_xor(ss, 2);
            const float rn = rsqrtf(ss * (1.0f / 128.0f) + 1e-6f);
            const size_t orow = (size_t)(row0 + t) * 1024 + h * 128 + vq;
#pragma unroll
            for (int i = 0; i < 8; ++i) {
                const f32x4 ng = *(const f32x4*)(p.ml_norm_g + h * 128 + vq + 16 * i);
                const u32x2 ow = *(const u32x2*)(p.P1 + (size_t)(row0 + t) * 3072 + 2048 + h * 128 + vq + 16 * i);
                f32x4 o;
                o[0] = hv[i][0] * rn * ng[0] * sigmoidf_(bflo(ow.x)); o[1] = hv[i][1] * rn * ng[1] * sigmoidf_(bfhi(ow.x));
                o[2] = hv[i][2] * rn * ng[2] * sigmoidf_(bflo(ow.y)); o[3] = hv[i][3] * rn * ng[3] * sigmoidf_(bfhi(ow.y));
                u32x2 w; w.x = cvt_pk_bf16(o[0], o[1]); w.y = cvt_pk_bf16(o[2], o[3]);
                *(u32x2*)(p.MIX + orow + 16 * i) = w;
            }
        }
        __syncthreads();
    }
}


#ifndef PROBE_MODE
#define PROBE_MODE 0
#endif
DI void ph_probe(const Params& p, char* lds) {
#if PROBE_MODE >= 1 && PROBE_MODE <= 4
    const int tid = opaque_tid();
    constexpr int NTN = 26, NTM = 66;
    gemm_stream<4, 2, 4, 4, PtrLoaderF, 4, PROBE_MODE>(lds, NTN * NTM, 16, [&](int u, PtrLoader<4>& al, PtrLoaderF& bl, const int (&nx)[4]) {
        int tm, tn; tile_of(u, NTM, NTN, tm, tn);
#pragma unroll
        for (int i = 0; i < 4; ++i) al.p[i] = (unsigned)((tm * 256 + a_row(tid) + 64 * i) * 1024 + a_c8(tid) * 8);
        al.base = p.Abuf;
        fill_bf(bl, p.ev_w_in, EVC, tn * 128, EVC);
    }, [&](int u, int (&nx)[4], int) {}, [&](int u, int mi, const f32x4 (&a)[4], f32x4 (&o)[4], int r0, int c0) {
#pragma unroll
        for (int ni = 0; ni < 4; ++ni) o[ni] = a[ni];
    }, [&](int u, int r, int c, f32x4 v, f32x4 pv) {
        int tm, tn; tile_of(u, NTM, NTN, tm, tn);
        const int row = tm * 256 + r, col = tn * 128 + c;
        if (tn < 12) {
            bf16_t* dst = (tn < 4 ? p.Q0 + col : (tn < 8 ? p.K0 + (col - 512) : p.V0 + (col - 1024))) + (size_t)row * 512;
            u32x2 w; w.x = cvt_pk_bf16(v[0], v[1]); w.y = cvt_pk_bf16(v[2], v[3]);
            *(u32x2*)dst = w;
        } else if (col < EVC) {
            *(f32x4*)(p.RWP + (size_t)row * RWC + (col - 1536)) = v;
        }
    });
#endif
}
constexpr int NPHASE = 27;
template <int PH>
DI void run_phase(const Params& p, char* lds) {
    if (PH == 0) ph_prologue(p, lds);
    if (PH == 1) ph_modulate0(p);
    if (PH == 2) ph_inproj0(p, lds);
    if (PH == 3) { for (int j = blockIdx.x; j < (TT / 64) * 8; j += gridDim.x) transpose_tile(lds, p.V0, 512, (j >> 3) * 64, (j & 7) * 64, p.VT0L, p.VT0C, 512); ph_rw_prep(p, lds); }
    if (PH == 4) ph_attn_cp<1>(p, lds);
    if (PH == 5) ph_sq(p, lds);
    if (PH == 6) ph_rw_readout(p);
    if (PH == 7) gemm_f32out(lds, p.MIX, TT, p.ev_w_out, 1024, p.YL);
    if (PH == 8) ph_ln1<0>(p);
    if (PH == 9) gemm_router(lds, p.Abuf, TT, p.moe_router, p.LOGITS);
    if (PH == 10) ph_route<0>(p, lds);
    if (PH == 11) ph_scatter<0>(p, lds);
    if (PH == 12) ph_moe1<0>(p, lds);
    if (PH == 13) ph_moe2<0>(p, lds);
    if (PH == 14) ph_combine<0>(p);
    if (PH == 15) ph_inproj1(p, lds);
    if (PH == 17) ph_ml_chunks(p, lds);
    if (PH == 18) ph_ml_scan(p);
    if (PH == 19) ph_ml_out(p, lds);
    if (PH == 20) gemm_f32out(lds, p.MIX, TL, p.od_w_out, 1024, p.YL);
    if (PH == 21) ph_ln1<1>(p);
    if (PH == 22) gemm_router(lds, p.Abuf, TL, p.moe_router + 1024 * 256, p.LOGITS);
    if (PH == 23) ph_route<1>(p, lds);
    if (PH == 24) ph_scatter<1>(p, lds);
    if (PH == 25) ph_moe1<1>(p, lds);
    if (PH == 26) ph_moe2<1>(p, lds);
    if (PH == 27) ph_combine<1>(p);
    if (PH == 28) { if (PROBE_MODE >= 1 && PROBE_MODE <= 4) ph_probe(p, lds); if (PROBE_MODE == 5) ph_attn_cp(p, lds); if (PROBE_MODE == 6) ph_sq(p, lds); if (PROBE_MODE == 7) ph_rw_prep(p, lds); if (PROBE_MODE == 17) ph_rw_prep<1>(p, lds); if (PROBE_MODE == 8) ph_attn_cp<1>(p, lds); if (PROBE_MODE == 9) ph_attn_cp<2>(p, lds); if (PROBE_MODE == 10) ph_route<0>(p, lds); if (PROBE_MODE == 11) ph_scatter<0>(p, lds); if (PROBE_MODE == 12) { ph_prologue(p, lds); } if (PROBE_MODE == 13) ph_rw_readout(p); if (PROBE_MODE == 14) gemm_f32out(lds, p.MIX, TT, p.ev_w_out, 1024, p.YL); if (PROBE_MODE == 15) { ph_ml_chunks(p, lds); } if (PROBE_MODE == 16) ph_ml_out(p, lds); }
}

#if MK_MULTI
template <int PH>
__global__ void __launch_bounds__(NTHR, 2) k_phase(Params p) {
    extern __shared__ __attribute__((aligned(16))) char lds[];
    run_phase<PH>(p, lds);
}
#else
template <int PH> struct PhaseSeq {
    static DI void run(const Params& p, char* lds, const XcdBarrier& bar) {
        PhaseSeq<PH - 1>::run(p, lds, bar);
        if constexpr (PH == 16) return;
        xcd_barrier(bar);
        if constexpr (((PROBE_DUP >> PH) & 1ull) != 0) {
            const int reps = 1 + (int)(__builtin_amdgcn_s_getreg((3 << 11) | 20) < 64u);
#pragma unroll 1
            for (int rep = 0; rep < reps; ++rep) run_phase<PH>(p, lds);
        } else run_phase<PH>(p, lds);
    }
};
template <> struct PhaseSeq<0> {
    static DI void run(const Params& p, char* lds, const XcdBarrier&) { if (PROBE_DUP & 1ull) run_phase<0>(p, lds); run_phase<0>(p, lds); }
};
__global__ void __launch_bounds__(NTHR, 2) k_mega(Params p) {
    extern __shared__ __attribute__((aligned(16))) char lds[];
    LAS unsigned* xb = (LAS unsigned*)(lds + LDS_XB);
    if (threadIdx.x == 0) { xb[0] = 0u; xb[1] = 0u; xb[2] = 0u; xb[3] = 0u; }
    __syncthreads();
    XcdBarrier bar = xcd_barrier_post(p.bar, (volatile LAS unsigned*)xb);
    PhaseSeq<PROBE_MODE ? 28 : 27>::run(p, lds, bar);
}
#endif

#if MK_MULTI
template <int PH> static void launch_all(const Params& p, hipStream_t s) {
    if constexpr (PH > 0) launch_all<PH - 1>(p, s);
    hipFuncSetAttribute((const void*)k_phase<PH>, hipFuncAttributeMaxDynamicSharedMemorySize, LDS_BYTES);
    hipLaunchKernelGGL(k_phase<PH>, dim3(256), dim3(NTHR), LDS_BYTES, s, p);
}
#endif

extern "C" void kernel_launch(void* const* d_in, const int* in_sizes, int n_in, void* d_out, int out_size, void* d_ws, size_t ws_size, hipStream_t stream) {
    Params p{};
    const float** f = (const float**)&p.x;
    for (int i = 0; i < 34; ++i) f[i] = (const float*)d_in[i];
    p.out = (float*)d_out;
    size_t off = 0;
    auto A = [&](size_t bytes) -> char* { char* r = (char*)d_ws + off; off += (bytes + 255) & ~(size_t)255; return r; };
    p.bar = (unsigned*)A(XCD_BAR_WORDS * 4);
    p.ictl = (int*)A(1026 * 4);
    p.mods = (float*)A((size_t)2 * 3 * 6144 * 4);
    p.Abuf = (bf16_t*)A((size_t)TT * 1024 * 2);
    p.CM = (bf16_t*)A((size_t)32 * CK_NCH * 4096 * 2);
    p.CRH = (bf16_t*)A((size_t)32 * CK_NCH * 1024 * 2);
    p.CN = (bf16_t*)A((size_t)32 * CK_NCH * 4096 * 2);
    p.CP3 = (bf16_t*)A((size_t)32 * CK_NCH * 1024 * 2);
    p.HA = (float*)A((size_t)TT * 1024 * 4);
    p.HB = (float*)A((size_t)TT * 1024 * 4);
    p.Q0 = (bf16_t*)A((size_t)TT * 512 * 2);
    p.K0 = (bf16_t*)A((size_t)TT * 512 * 2);
    p.V0 = (bf16_t*)A((size_t)TT * 512 * 2);
    p.VT0L = (bf16_t*)A((size_t)2 * 512 * TLB * 2);
    p.VT0C = (bf16_t*)A((size_t)2 * 512 * TCB * 2);
    p.RWP = (float*)A((size_t)TT * RWC * 4);
    p.MIX = (bf16_t*)A((size_t)TT * 1024 * 2);
    p.YL = (float*)A((size_t)TT * 1024 * 4);
    p.LOGITS = (float*)A((size_t)TT * 256 * 4);
    p.EIDX = (int*)A((size_t)TT * 8 * 4);
    p.EW = (float*)A((size_t)TT * 8 * 4);
    p.APOS = (int*)A((size_t)TT * 8 * 4);
    p.SLOT_TOK = (int*)A((size_t)2 * NSLOT * 4);
    p.SLOT_W = (float*)A((size_t)2 * NSLOT * 4);
    p.HIST = (int*)A((size_t)2 * 256 * 256 * 4);
    p.WF = (unsigned*)A((size_t)8 * 4 * 7 * 64 * 16);
    p.TILE_E = (int*)A((size_t)2 * MAXTILES * 4);
    p.TILE_R0 = (int*)A((size_t)2 * MAXTILES * 4);
    p.HBUF = (bf16_t*)A((size_t)NSLOT * 256 * 2);
    const size_t un0 = off;
    p.YB = (bf16_t*)A((size_t)NSLOT * 1024 * 2);
    const size_t un_end = off;
    off = un0;
    p.SW = (float*)A((size_t)2 * TT * 512 * 4);
    p.SBP = (unsigned*)A((size_t)TT * 512 * 4);
    p.SKP = (unsigned*)A((size_t)TT * 512 * 4);
    p.SNV = (unsigned*)A((size_t)TT * 512 * 4);
    p.SRG = (unsigned*)A((size_t)TT * 512 * 4);
    p.BONUS = (float*)A((size_t)TT * 8 * 4);
    p.YS = (float*)A((size_t)2 * TT * 512 * 4);
    const size_t m0_end = off;
    off = un0;
    p.P1 = (bf16_t*)A((size_t)TT * 3072 * 2);
    p.K1TL = (bf16_t*)A((size_t)2 * 512 * TLB * 2);
    p.K1TC = (bf16_t*)A((size_t)2 * 512 * TCB * 2);
    p.V1TL = (bf16_t*)A((size_t)2 * 1024 * TLB * 2);
    p.V1TC = (bf16_t*)A((size_t)2 * 1024 * TCB * 2);
    p.G1 = (float*)A((size_t)TT * 32 * 4);
    p.KVT = (float*)A((size_t)1056 * 2 * 8192 * 4);
    p.KS = (float*)A((size_t)1056 * 128 * 4);
    p.BEMC = (float*)A((size_t)1056 * 4 * 4);
    p.C0T = (bf16_t*)A((size_t)1056 * 2 * 8192 * 2);
    p.N0 = (float*)A((size_t)1056 * 2 * 64 * 4);
    p.M0 = (float*)A((size_t)1056 * 2 * 4);
    const size_t m1_end = off;
    off = un_end > m0_end ? un_end : m0_end; off = off > m1_end ? off : m1_end;
    if (off > ws_size) return;
    hipMemsetAsync(p.bar, 0, XCD_BAR_WORDS * 4, stream);
#if MK_MULTI
    launch_all<27>(p, stream);
#else
    hipFuncSetAttribute((const void*)k_mega, hipFuncAttributeMaxDynamicSharedMemorySize, LDS_BYTES);
    hipLaunchKernelGGL(k_mega, dim3(256), dim3(NTHR), LDS_BYTES, stream, p);
#endif
}
```

```cpp
#include <hip/hip_runtime.h>
#include <stdint.h>

#ifndef MK_MULTI
#define MK_MULTI 0
#endif

#ifndef PROBE_DUP
#define PROBE_DUP 0ull
#endif
#define DI __device__ __forceinline__
typedef unsigned short bf16_t;
typedef short bf16x8 __attribute__((ext_vector_type(8)));
typedef float f32x4 __attribute__((ext_vector_type(4)));
typedef unsigned u32x4 __attribute__((ext_vector_type(4)));
typedef unsigned u32x2 __attribute__((ext_vector_type(2)));

constexpr int NTHR = 512;
constexpr int TLB = 8192, TCB = 256, TL = 16384, TC = 512, TT = 16896;
constexpr int EVC = 3296, ODC = 3104, RWC = 1760;
constexpr float ALPHA = 1.41421356237f;
constexpr int SH_BASE = 200704;
constexpr int NSLOT = SH_BASE + TT;
constexpr int MAXTILES = 784 + 66;
constexpr int EPI_OFF = 98304, EPI_WAVE_B = 4352;
constexpr int LDS_XB = 153600;
constexpr int LDS_BYTES = LDS_XB + 256;

#define XB_TMO      128
#define XB_XCNT(j)  (256  + 64 * (j))
#define XB_XSUB(j)  (1280 + 64 * (j))
#define XB_XGEN(j)  (2304 + 64 * (j))
#define XB_TOP      3328
#define XB_TOPGEN   3392
#define XCD_BAR_WORDS 3456
#define XB_SPIN_CAP (1u << 18)
#define LAS __attribute__((address_space(3)))

__device__ __forceinline__ unsigned xb_ld(unsigned* p)              { return __hip_atomic_load(p, __ATOMIC_RELAXED, __HIP_MEMORY_SCOPE_AGENT); }
__device__ __forceinline__ unsigned xb_add(unsigned* p, unsigned v) { return __hip_atomic_fetch_add(p, v, __ATOMIC_RELAXED, __HIP_MEMORY_SCOPE_AGENT); }
__device__ __forceinline__ unsigned xb_xcc_id() { return (unsigned)__builtin_amdgcn_s_getreg((3 << 11) | 20) & 0xFu; }
#define XB_SPIN(cond, bar) do { unsigned _sp = 0; while (cond) { __builtin_amdgcn_s_sleep(1); \
    if ((++_sp & 255u) == 0u) { if (xb_ld(&(bar)[XB_TMO])) break; if (_sp > XB_SPIN_CAP) { atomicAdd(&(bar)[XB_TMO], 1u); break; } } } } while (0)

struct XcdBarrier {
    unsigned* bar; unsigned x;
    volatile LAS unsigned* st;
};
__device__ __forceinline__ XcdBarrier xcd_barrier_post(unsigned* bar, volatile LAS unsigned* st) {
    XcdBarrier b; b.bar = bar; b.x = xb_xcc_id(); b.st = st;
    if (threadIdx.x == 0) (void)xb_add(&bar[XB_XCNT(b.x)], 1u);
    return b;
}
__device__ __forceinline__ void xcd_barrier_complete(unsigned* bar, unsigned x, unsigned& nloc, unsigned& nx) {
    const unsigned G = gridDim.x * gridDim.y * gridDim.z;
    unsigned sum, cnt, mine, sp = 0u;
    for (;;) {
        sum = 0u; cnt = 0u; mine = 0u;
#pragma unroll
        for (unsigned j = 0; j < 16; ++j) { const unsigned c = xb_ld(&bar[XB_XCNT(j)]); sum += c; cnt += (c > 0u) ? 1u : 0u; mine = (j == x) ? c : mine; }
        if (sum == G) break;
        __builtin_amdgcn_s_sleep(1);
        if ((++sp & 255u) == 0u) { if (xb_ld(&bar[XB_TMO])) break; if (sp > XB_SPIN_CAP) { atomicAdd(&bar[XB_TMO], 1u); break; } }
    }
    nloc = mine > 0u ? mine : 1u; nx = cnt > 0u ? cnt : 1u;
}
__device__ __forceinline__ void xcd_barrier(const XcdBarrier& b) {
    asm volatile("s_waitcnt vmcnt(0)" ::: "memory");
    __syncthreads();
    if (threadIdx.x == 0) {
        unsigned* bar = b.bar;
        __builtin_amdgcn_s_waitcnt(0);
        unsigned nloc = b.st[0], nx = b.st[1];
        if (nloc == 0u) { xcd_barrier_complete(bar, b.x, nloc, nx); b.st[0] = nloc; b.st[1] = nx; }
        const unsigned old = xb_add(&bar[XB_XSUB(b.x)], 1u);
        const unsigned gen = old / nloc;
        if (old + 1u == (gen + 1u) * nloc) {
            __builtin_amdgcn_fence(__ATOMIC_RELEASE, "agent");
            asm volatile("s_waitcnt vmcnt(0)" ::: "memory");
            const unsigned og = xb_add(&bar[XB_TOP], 1u);
            const unsigned tg = og / nx;
            if (og + 1u == (tg + 1u) * nx) xb_add(&bar[XB_TOPGEN], 1u);
            else XB_SPIN(xb_ld(&bar[XB_TOPGEN]) == tg, bar);
            __builtin_amdgcn_fence(__ATOMIC_ACQUIRE, "agent");
            xb_add(&bar[XB_XGEN(b.x)], 1u);
            asm volatile("s_waitcnt vmcnt(0)" ::: "memory");
        } else {
            XB_SPIN(xb_ld(&bar[XB_XGEN(b.x)]) == gen, bar);
            __builtin_amdgcn_fence(__ATOMIC_ACQUIRE, "agent");
            asm volatile("s_waitcnt vmcnt(0)" ::: "memory");
        }
    }
    __syncthreads();
}

struct Params {
    const float *x, *c, *ctx, *c_ctx, *ada_w, *ada_b, *ln_g, *ln_b, *ev_w_in, *ev_w_out, *na_rpb, *rw_mu, *rw_w0, *rw_w_up, *rw_a0,
        *rw_a_up, *rw_g_up, *rw_k_k, *rw_k_a, *rw_r_k, *rw_gn_g, *rw_gn_b, *od_w_in, *od_w_out, *ml_gate_b, *ml_norm_g, *moe_router,
        *moe_bias, *moe_w_gate, *moe_w_up, *moe_w_down, *sh_w_gate, *sh_w_up, *sh_w_down;
    float* out;
    unsigned* bar;
    int* ictl;
    float* mods;
    bf16_t* Abuf;
    float *HA, *HB;
    bf16_t *Q0, *K0, *V0, *VT0L, *VT0C;
    float* RWP;
    unsigned* WF;
    float *SW, *BONUS, *YS;
    unsigned *SBP, *SKP, *SNV, *SRG;
    bf16_t *CM, *CRH, *CN, *CP3;
    bf16_t* MIX;
    float* YL;
    float* LOGITS;
    int *EIDX, *APOS, *SLOT_TOK, *TILE_E, *TILE_R0, *HIST;
    float *EW, *SLOT_W;
    bf16_t *HBUF, *YB;
    bf16_t *P1, *K1TL, *K1TC, *V1TL, *V1TC, *C0T;
    float *G1, *KVT, *KS, *BEMC, *N0, *M0;
};

DI int opaque_tid() { int t = threadIdx.x; asm volatile("" : "+v"(t)); return t; }
typedef __bf16 bf16x2_t __attribute__((ext_vector_type(2)));
typedef float f32x2_t __attribute__((ext_vector_type(2)));
DI unsigned cvt_pk_bf16_asm(float lo, float hi) { unsigned r; asm volatile("v_cvt_pk_bf16_f32 %0, %1, %2" : "=v"(r) : "v"(lo), "v"(hi)); return r; }
DI unsigned cvt_pk_bf16(float lo, float hi) { const f32x2_t v = {lo, hi}; return __builtin_bit_cast(unsigned, __builtin_convertvector(v, bf16x2_t)); }
DI float bf2f(bf16_t b) { return __uint_as_float(((unsigned)b) << 16); }
DI float bflo(unsigned w) { return __uint_as_float(w << 16); }
DI float bfhi(unsigned w) { return __uint_as_float(w & 0xffff0000u); }
DI float sigmoidf_(float x) { return 1.0f / (1.0f + __expf(-x)); }
DI float siluf_(float x) { return x / (1.0f + __expf(-x)); }
DI float tanhf_(float x) { return 1.0f - 2.0f / (__expf(2.0f * x) + 1.0f); }
DI float softplusf_(float x) { return fmaxf(x, 0.f) + __logf(1.0f + __expf(-fabsf(x))); }
DI float logsigmoidf_(float x) { return -softplusf_(-x); }
DI f32x4 mfma16(bf16x8 a, bf16x8 b, f32x4 c) { return __builtin_amdgcn_mfma_f32_16x16x32_bf16(a, b, c, 0, 0, 0); }
DI bf16x8 pack8(f32x4 a, f32x4 b) {
    u32x4 w; w.x = cvt_pk_bf16(a[0], a[1]); w.y = cvt_pk_bf16(a[2], a[3]); w.z = cvt_pk_bf16(b[0], b[1]); w.w = cvt_pk_bf16(b[2], b[3]);
    return __builtin_bit_cast(bf16x8, w);
}
DI bf16x8 join8(u32x2 lo, u32x2 hi) { u32x4 w; w.x = lo.x; w.y = lo.y; w.z = hi.x; w.w = hi.y; return __builtin_bit_cast(bf16x8, w); }
DI float wave_allsum(float v) {
#pragma unroll
    for (int d = 1; d < 64; d <<= 1) v += __shfl_xor(v, d);
    return v;
}
DI float wave_allmax(float v) {
#pragma unroll
    for (int d = 1; d < 64; d <<= 1) v = fmaxf(v, __shfl_xor(v, d));
    return v;
}
template <int CTRL, int RM> DI float dpp_f(float x) {
    return __builtin_bit_cast(float, __builtin_amdgcn_update_dpp(0, __builtin_bit_cast(int, x), CTRL, RM, 0xF, false));
}
DI float wave_sum63(float x) {
    x += dpp_f<0xB1, 0xF>(x);
    x += dpp_f<0x4E, 0xF>(x);
    x += dpp_f<0x141, 0xF>(x);
    x += dpp_f<0x140, 0xF>(x);
    x += dpp_f<0x142, 0xA>(x);
    x += dpp_f<0x143, 0xC>(x);
    return x;
}
template <int CTRL> DI float dpp_add(float x) { return x + __builtin_bit_cast(float, __builtin_amdgcn_update_dpp(0, __builtin_bit_cast(int, x), CTRL, 0xF, 0xF, false)); }
DI float row16_allsum(float x) { x = dpp_add<0xB1>(x); x = dpp_add<0x4E>(x); x = dpp_add<0x141>(x); x = dpp_add<0x140>(x); return x; }
DI void seq_info(int row, int& t, int& T) { if (row < TL) { t = row & (TLB - 1); T = TLB; } else { t = (row - TL) & (TCB - 1); T = TCB; } }
DI int mods_row(int row) { return row < TL ? (row >> 13) : 2; }

DI int lds_byte(int r, int c) { const int st = (r >> 4) * 2 + (c >> 5), rr = r & 15, cc = c & 31, ob = rr * 64 + cc * 2; return st * 1024 + (ob ^ (((ob >> 9) & 1) << 5)); }

DI int a_row(int tid) { return (tid >> 4) * 2 + ((tid >> 2) & 1); }
DI int a_c8(int tid) { return ((tid >> 3) & 1) * 4 + (tid & 3); }
template <int NP> struct PtrLoader { const bf16_t* base; unsigned p[NP]; };
struct PtrLoaderF { const float* base0; const float* base1; unsigned p[4]; int ld; };
typedef short s16x4 __attribute__((ext_vector_type(4)));
DI int b_img(int k, int seg, int bo) { return 256 * k + 32 * (seg ^ ((k & 3) + 4 * ((k >> 3) & 1))) + bo; }
DI bf16x8 tr_frag(const char* base, int xl, int c, int ks) {
    const char* a = base + (xl ^ (c << 5)) + 8192 * ks;
    const s16x4 lo = __builtin_amdgcn_ds_read_tr16_b64_v4i16((LAS s16x4*)(a));
    const s16x4 hi = __builtin_amdgcn_ds_read_tr16_b64_v4i16((LAS s16x4*)(a + 1024));
    return __builtin_shufflevector(lo, hi, 0, 1, 2, 3, 4, 5, 6, 7);
}

DI void tile_of(int u, int ntm, int ntn, int& tm, int& tn) {
    const int gid = u / (4 * ntn), within = u % (4 * ntn);
    const int gsz = (ntm - gid * 4) < 4 ? (ntm - gid * 4) : 4;
    tm = gid * 4 + within % gsz; tn = within / gsz;
}
DI void fill_bf(PtrLoaderF& bl, const float* W, int ld, int n0, int nvalid) {
    bl.ld = ld; bl.base0 = W; bl.base1 = W;
    const int tz = opaque_tid();
#pragma unroll
    for (int i = 0; i < 4; ++i) { int n = n0 + 32 * i + (tz & 7) * 4; n = n < nvalid ? n : nvalid - 4; bl.p[i] = (unsigned)((tz >> 3) * ld + n); }
}
template <int V> struct IC { static constexpr int value = V; };
template <int WR, int WC, int MT, int NT, class BL, int NTU, int MODE = 0, class MK, class PF, class PRE, class SINK>
DI void gemm_stream(char* lds, int nunits, int nk, MK&& mk, PF&& pf, PRE&& pre, SINK&& sink) {
    constexpr bool BF32 = __is_same(BL, PtrLoaderF);
    constexpr int BM = WR * MT * 16, BN = WC * NT * 16, APC = BM * 8 / NTHR, BPC = BF32 ? 4 : BN * 8 / NTHR;
    constexpr int ABYTES = BM * 128, STAGE = (BM + BN) * 128;
    static_assert(WR * WC == 8, "8 waves");
    static_assert(!BF32 || BN == 128, "f32 B path is written for 128-column tiles");
    const int tid = opaque_tid(), lane = tid & 63, wid = tid >> 6, wr = wid / WC, wc = wid % WC, fr = lane & 15, fq = lane >> 4;
    const int ubase = (blockIdx.x & 7) * 32 + (blockIdx.x >> 3), ustep = (int)gridDim.x;
    if (ubase >= nunits) return;
    int lu = ubase, lkt = 0, cu = ubase, ckt = 0;
    int lun = (lu + ustep < nunits) ? lu + ustep : lu;
    f32x4 acc[MT][NT];
#pragma unroll
    for (int m = 0; m < MT; ++m)
#pragma unroll
        for (int n = 0; n < NT; ++n) acc[m][n] = (f32x4){0.f, 0.f, 0.f, 0.f};
    const int sa0 = lds_byte(a_row(tid), a_c8(tid) * 8);
    const int xl = b_img(8 * fq + ((lane & 15) >> 2), 0, 8 * (lane & 3));
    auto sbo = [&](int i) -> int {
        if constexpr (BF32) { const int k = tid >> 3, n4 = 8 * i + (tid & 7); return ABYTES + b_img(k, n4 >> 2, 8 * (n4 & 3)); }
        else return ABYTES + lds_byte((tid >> 3) + 64 * i, (tid & 7) * 8);
    };
    PtrLoader<APC> al; BL bl;
    int nx[4] = {0, 0, 0, 0};
    pf(lu, nx, 2);
    mk(lu, al, bl, nx);
    pf(lun, nx, 2);
    u32x4 ra[APC], rb[BPC];
    auto issue = [&](auto hc) {
        if constexpr (MODE == 2) return;
#pragma unroll
        for (int i = 0; i < APC; ++i) ra[i] = *(const u32x4*)(al.base + al.p[i] + lkt * 64);
#pragma unroll
        for (int i = 0; i < BPC; ++i) {
            if constexpr (BF32) rb[i] = *(const u32x4*)(((i & 1) ? bl.base1 : bl.base0) + bl.p[i] + (size_t)lkt * 64 * bl.ld);
            else rb[i] = *(const u32x4*)(bl.base + bl.p[i] + lkt * 64);
        }
        const int use[4] = {nx[0], nx[1], nx[2], nx[3]};
        pf(lun, nx, 4 + (lkt & 3));
        if (++lkt == nk) { lkt = 0; lu = lun; lun = (lu + ustep < nunits) ? lu + ustep : lu; mk(lu, al, bl, use); }
    };
    auto stash = [&](char* st) {
        if constexpr (MODE == 2) return;
#pragma unroll
        for (int i = 0; i < APC; ++i) *(u32x4*)(st + sa0 + 8192 * i) = ra[i];
#pragma unroll
        for (int i = 0; i < BPC; ++i) {
            if constexpr (BF32) {
                u32x2 w; w.x = cvt_pk_bf16_asm(__uint_as_float(rb[i].x), __uint_as_float(rb[i].y)); w.y = cvt_pk_bf16_asm(__uint_as_float(rb[i].z), __uint_as_float(rb[i].w));
                *(u32x2*)(st + sbo(i)) = w;
            } else *(u32x4*)(st + sbo(i)) = rb[i];
        }
    };
    auto compute = [&](const char* st) {
        if constexpr (MODE == 1) return;
#pragma unroll
        for (int ks = 0; ks < 2; ++ks) {
            bf16x8 af[MT], bfr[NT];
#pragma unroll
            for (int m = 0; m < MT; ++m) af[m] = *(const bf16x8*)(st + lds_byte(wr * MT * 16 + m * 16 + fr, ks * 32 + fq * 8));
#pragma unroll
            for (int n = 0; n < NT; ++n) {
                if constexpr (BF32) bfr[n] = tr_frag(st + ABYTES, xl, wc * NT + n, ks);
                else bfr[n] = *(const bf16x8*)(st + ABYTES + lds_byte(wc * NT * 16 + n * 16 + fr, ks * 32 + fq * 8));
            }
#pragma unroll
            for (int m = 0; m < MT; ++m)
#pragma unroll
                for (int n = 0; n < NT; ++n) acc[m][n] = mfma16(bfr[n], af[m], acc[m][n]);
        }
    };
    auto ep = [&](int u, f32x4 (&a)[MT][NT], int, int) {
        float* W = (float*)(lds + EPI_OFF + wid * EPI_WAVE_B);
        constexpr int LPR = NTU * 4, RPI = 64 / LPR, NJ = 16 / RPI;
        const int c4 = lane % LPR, rb = lane / LPR;
#pragma unroll
        for (int mi = 0; mi < MT; ++mi) {
            f32x4 o[NTU];
            pre(u, mi, a[mi], o, wr * MT * 16 + mi * 16 + fr, wc * NT * 16 + 4 * fq);
#pragma unroll
            for (int ni = 0; ni < NTU; ++ni) *(f32x4*)(W + fr * 68 + ni * 16 + 4 * fq) = o[ni];
#pragma unroll
            for (int j = 0; j < NJ; ++j) {
                const f32x4 v = *(const f32x4*)(W + (rb + RPI * j) * 68 + 4 * c4);
                const f32x4 pv = *(const f32x4*)(W + (rb + RPI * j) * 68 + 4 * (c4 ^ 4));
                sink(u, wr * MT * 16 + mi * 16 + rb + RPI * j, wc * NTU * 16 + 4 * c4, v, pv);
            }
        }
    };
    issue(IC<0>{});
    stash(lds);
    if (wid >= 4) issue(IC<1>{});
    __syncthreads();
    bool first = true;
    auto epilogue = [&]() {
        if (ckt == 0 && !first) {
            if constexpr (MODE == 0 || MODE == 4) ep(cu - ustep, acc, wr * MT * 16 + fr, wc * NT * 16 + 4 * fq);
            else { asm volatile("" :: "v"(acc[0][0]), "v"(acc[MT - 1][NT - 1])); }
#pragma unroll
            for (int m = 0; m < MT; ++m)
#pragma unroll
                for (int n = 0; n < NT; ++n) acc[m][n] = (f32x4){0.f, 0.f, 0.f, 0.f};
        }
    };
    while (cu < nunits) {
        if (wid < 4) {
            epilogue(); issue(IC<1>{}); compute(lds); stash(lds + STAGE);
            __syncthreads();
            issue(IC<0>{}); compute(lds + STAGE); stash(lds);
            __syncthreads();
        } else {
            stash(lds + STAGE); epilogue(); issue(IC<0>{}); compute(lds);
            __syncthreads();
            stash(lds); issue(IC<1>{}); compute(lds + STAGE);
            __syncthreads();
        }
        first = false;
        ckt += 2;
        if (ckt == nk) { ckt = 0; cu += ustep; }
    }
    if constexpr (MODE == 0 || MODE == 4) ep(cu - ustep, acc, wr * MT * 16 + fr, wc * NT * 16 + 4 * fq);
    else {
#pragma unroll
        for (int m = 0; m < MT; ++m)
#pragma unroll
            for (int n = 0; n < NT; ++n) asm volatile("" :: "v"(acc[m][n]));
        if constexpr (MODE == 1) { asm volatile("" :: "v"(ra[0]), "v"(rb[0])); }
    }
}

DI void ph_prologue(const Params& p, char* lds) {
    const int tid = opaque_tid(), bid = blockIdx.x, nb = gridDim.x;
    for (int i = bid * NTHR + tid; i < 1026; i += nb * NTHR) p.ictl[i] = 0;
    for (int i = bid * NTHR + tid; i < 2 * NSLOT; i += nb * NTHR) {
        const int s = i % NSLOT;
        p.SLOT_TOK[i] = s >= SH_BASE ? s - SH_BASE : 0;
        p.SLOT_W[i] = s >= SH_BASE ? 1.0f : 0.0f;
    }
    if (bid >= 192) {
        for (int idx = (bid - 192) * NTHR + tid; idx < 8 * 4 * 7 * 64; idx += (nb - 192) * NTHR) {
            const int ln = idx & 63, s = (idx >> 6) % 7, hn = (idx >> 6) / 7;
            const int c = hn * 16 + (ln & 15);
            const float* wc_ = (s < 2 ? p.rw_w_up + s * 32 * 512 : (s < 4 ? p.rw_a_up + (s - 2) * 32 * 512 : p.rw_g_up + (s - 4) * 32 * 512)) + 8 * (ln >> 4) * 512 + c;
            u32x4 w;
            w.x = cvt_pk_bf16(wc_[0], wc_[512]); w.y = cvt_pk_bf16(wc_[1024], wc_[1536]); w.z = cvt_pk_bf16(wc_[2048], wc_[2560]); w.w = cvt_pk_bf16(wc_[3072], wc_[3584]);
            *(u32x4*)(p.WF + (size_t)idx * 4) = w;
        }
    }
    constexpr int J_MODS = 192;
    for (int job = bid; job < J_MODS; job += nb) {
        const int j = job;
        if (j < J_MODS) {
            const int l = j / 96, cb = j % 96;
            float* sc = (float*)lds;
            float* red = sc + 3072;
            for (int idx = tid; idx < 3072; idx += NTHR) {
                const int r = idx >> 10, k = idx & 1023;
                const float cv = r < 2 ? p.c[r * 1024 + k] : p.c_ctx[k];
                sc[idx] = siluf_(cv);
            }
            __syncthreads();
            const int kq = tid >> 6, cl = tid & 63, col = cb * 64 + cl;
            float a0 = 0.f, a1 = 0.f, a2 = 0.f;
            const float* w = p.ada_w + (size_t)l * 1024 * 6144 + col;
            for (int k = kq * 128; k < kq * 128 + 128; ++k) {
                const float wv = w[(size_t)k * 6144];
                a0 += sc[k] * wv; a1 += sc[1024 + k] * wv; a2 += sc[2048 + k] * wv;
            }
            red[(kq * 3 + 0) * 64 + cl] = a0; red[(kq * 3 + 1) * 64 + cl] = a1; red[(kq * 3 + 2) * 64 + cl] = a2;
            __syncthreads();
            if (tid < 192) {
                const int r = tid >> 6, c2 = tid & 63;
                float s = 0.f;
#pragma unroll
                for (int q = 0; q < 8; ++q) s += red[(q * 3 + r) * 64 + c2];
                p.mods[(size_t)(l * 3 + r) * 6144 + cb * 64 + c2] = s + p.ada_b[l * 6144 + cb * 64 + c2];
            }
            __syncthreads();
            continue;
        }
    }
}

DI void ph_modulate0(const Params& p) {
    const int nb = gridDim.x;
#pragma unroll 4
    for (int i = blockIdx.x * NTHR + opaque_tid(); i < TT * 256; i += nb * NTHR) {
        const int row = i >> 8, c = (i & 255) * 4;
        const float* src = row < TL ? p.x + (size_t)row * 1024 : p.ctx + (size_t)(row - TL) * 1024;
        const float* m = p.mods + (size_t)(0 * 3 + mods_row(row)) * 6144;
        const f32x4 v = *(const f32x4*)(src + c), sh = *(const f32x4*)(m + c), scv = *(const f32x4*)(m + 1024 + c);
        const f32x4 a = v * (1.0f + scv) + sh;
        u32x2 w; w.x = cvt_pk_bf16(a[0], a[1]); w.y = cvt_pk_bf16(a[2], a[3]);
        *(u32x2*)(p.Abuf + (size_t)row * 1024 + c) = w;
    }
}

DI void ph_inproj0(const Params& p, char* lds) {
    const int tid = opaque_tid();
    constexpr int NTN = 26, NTM = 66;
    gemm_stream<4, 2, 4, 4, PtrLoaderF, 4>(lds, NTN * NTM, 16, [&](int u, PtrLoader<4>& al, PtrLoaderF& bl, const int (&nx)[4]) {
        int tm, tn; tile_of(u, NTM, NTN, tm, tn);
#pragma unroll
        for (int i = 0; i < 4; ++i) al.p[i] = (unsigned)((tm * 256 + a_row(tid) + 64 * i) * 1024 + a_c8(tid) * 8);
        al.base = p.Abuf;
        fill_bf(bl, p.ev_w_in, EVC, tn * 128, EVC);
    }, [&](int u, int (&nx)[4], int) {}, [&](int u, int mi, const f32x4 (&a)[4], f32x4 (&o)[4], int r0, int c0) {
#pragma unroll
        for (int ni = 0; ni < 4; ++ni) o[ni] = a[ni];
    }, [&](int u, int r, int c, f32x4 v, f32x4 pv) {
        int tm, tn; tile_of(u, NTM, NTN, tm, tn);
        const int row = tm * 256 + r, col = tn * 128 + c;
        if (tn < 12) {
            bf16_t* dst = (tn < 4 ? p.Q0 + col : (tn < 8 ? p.K0 + (col - 512) : p.V0 + (col - 1024))) + (size_t)row * 512;
            u32x2 w; w.x = cvt_pk_bf16(v[0], v[1]); w.y = cvt_pk_bf16(v[2], v[3]);
            *(u32x2*)dst = w;
        } else if (col < EVC) {
            *(f32x4*)(p.RWP + (size_t)row * RWC + (col - 1536)) = v;
        }
    });
}

DI void transpose_tile(char* ldsc, const bf16_t* src, int ld, int row0, int col0, bf16_t* dstL, bf16_t* dstC, int ncols) {
    bf16_t* T = (bf16_t*)ldsc;
    const int tid = opaque_tid();
    {
        const int tok = tid >> 3, d8 = tid & 7;
        *(u32x4*)(T + tok * 72 + d8 * 8) = *(const u32x4*)(src + (size_t)(row0 + tok) * ld + col0 + d8 * 8);
    }
    __syncthreads();
    {
        const int d = tid >> 3, t8 = tid & 7;
        u32x4 w;
        w.x = (unsigned)T[(t8 * 8 + 0) * 72 + d] | ((unsigned)T[(t8 * 8 + 1) * 72 + d] << 16);
        w.y = (unsigned)T[(t8 * 8 + 2) * 72 + d] | ((unsigned)T[(t8 * 8 + 3) * 72 + d] << 16);
        w.z = (unsigned)T[(t8 * 8 + 4) * 72 + d] | ((unsigned)T[(t8 * 8 + 5) * 72 + d] << 16);
        w.w = (unsigned)T[(t8 * 8 + 6) * 72 + d] | ((unsigned)T[(t8 * 8 + 7) * 72 + d] << 16);
        bf16_t* dst;
        if (row0 < TL) dst = dstL + ((size_t)((row0 >> 13) * ncols + col0 + d)) * TLB + (row0 & (TLB - 1));
        else { const int rc = row0 - TL; dst = dstC + ((size_t)((rc >> 8) * ncols + col0 + d)) * TCB + (rc & (TCB - 1)); }
        *(u32x4*)(dst + t8 * 8) = w;
    }
    __syncthreads();
}

template <int NOSTORE = 0>
DI void ph_rw_prep(const Params& p, char* ldsc) {
    constexpr int TG = 16, LRP = 232;
    bf16_t* LR = (bf16_t*)ldsc;
    const int tid = opaque_tid(), lane = tid & 63, hh = tid >> 6, q = lane & 15, g = lane >> 4;
    bf16_t* SH = (bf16_t*)(ldsc + 8192);
    bf16x8 wq[7];
    auto wload = [&](int nt_) {
        unsigned co_ = (unsigned)(((hh * 4 + nt_) * 7 * 64 + lane) * 4); asm volatile("" : "+v"(co_));
#pragma unroll
        for (int s = 0; s < 7; ++s) wq[s] = __builtin_bit_cast(bf16x8, *(const u32x4*)(p.WF + co_ + s * 256));
    };
    wload(0);
    for (int grp = blockIdx.x; grp < TT / TG; grp += gridDim.x) {
        const int row0 = grp * TG;
        int t0, Tseq; seq_info(row0, t0, Tseq);
#pragma unroll 4
        for (int idx = tid; idx < TG * 440; idx += NTHR) {
            const int tk = idx / 440, c4 = (idx % 440) * 4;
            const int t = t0 + tk;
            const float* pr = p.RWP + (size_t)(row0 + tk) * RWC + c4;
            const f32x4 pc = *(const f32x4*)pr;
            const f32x4 pv = t > 0 ? *(const f32x4*)(pr - RWC) : (f32x4){0.f, 0.f, 0.f, 0.f};
            const f32x4 nx = t < Tseq - 1 ? *(const f32x4*)(pr + RWC) : (f32x4){0.f, 0.f, 0.f, 0.f};
            const f32x4 mu = *(const f32x4*)(p.rw_mu + c4);
            f32x4 v = pc + mu * (0.5f * (pv + nx) - pc);
            if (c4 < 1536) {
                u32x2 w; w.x = cvt_pk_bf16(v[0], v[1]); w.y = cvt_pk_bf16(v[2], v[3]);
                *(u32x2*)(SH + tk * 1536 + c4) = w;
            } else {
                const int j = c4 - 1536;
                if (j < 64) { v[0] = tanhf_(v[0]); v[1] = tanhf_(v[1]); v[2] = tanhf_(v[2]); v[3] = tanhf_(v[3]); }
                else if (j >= 128) { v[0] = sigmoidf_(v[0]); v[1] = sigmoidf_(v[1]); v[2] = sigmoidf_(v[2]); v[3] = sigmoidf_(v[3]); }
                u32x2 w; w.x = cvt_pk_bf16(v[0], v[1]); w.y = cvt_pk_bf16(v[2], v[3]);
                *(u32x2*)(LR + tk * LRP + j) = w;
            }
        }
        __syncthreads();
        float nrm[4];
#pragma unroll
        for (int r = 0; r < 4; ++r) {
            float ss = 0.f;
#pragma unroll
            for (int nt = 0; nt < 4; ++nt) {
                const int c = hh * 64 + 16 * nt + q;
                const float kk0 = bf2f(SH[(4 * g + r) * 1536 + 512 + c]) * p.rw_k_k[c];
                ss += kk0 * kk0;
            }
            nrm[r] = 1.0f / fmaxf(sqrtf(row16_allsum(ss)), 1e-12f);
        }
        float bon[4] = {0.f, 0.f, 0.f, 0.f};
        const f32x4 z4 = (f32x4){0.f, 0.f, 0.f, 0.f};
#pragma unroll
        for (int nt = 0; nt < 4; ++nt) {
            const int c = hh * 64 + 16 * nt + q;
            auto afrag = [&](int s) -> bf16x8 { return *(const bf16x8*)(LR + q * LRP + 32 * s + 8 * g); };
            f32x4 wl0, wl1, al0, al1, gl;
            {
                bf16x8 wc[7];
#pragma unroll
                for (int s = 0; s < 7; ++s) wc[s] = wq[s];
                wload((nt + 1) & 3);
                wl0 = mfma16(afrag(0), wc[0], z4); wl1 = mfma16(afrag(1), wc[1], z4); al0 = mfma16(afrag(2), wc[2], z4); al1 = mfma16(afrag(3), wc[3], z4);
                gl = mfma16(afrag(6), wc[6], mfma16(afrag(5), wc[5], mfma16(afrag(4), wc[4], z4)));
            }
            asm volatile("" ::: "memory");
            const float kkw = p.rw_k_k[c], kaw = p.rw_k_a[c], rkw = p.rw_r_k[c];
            const float w00 = p.rw_w0[c], w01 = p.rw_w0[512 + c], a00 = p.rw_a0[c], a01 = p.rw_a0[512 + c];
#pragma unroll
            for (int r = 0; r < 4; ++r) {
                const int row = row0 + 4 * g + r;
                const bf16_t* sh = SH + (4 * g + r) * 1536 + c;
                const float r_ = bf2f(sh[0]), k_ = bf2f(sh[512]), v_ = bf2f(sh[1024]);
                const float kk = k_ * kkw * nrm[r];
                const float wlog0 = -softplusf_(-(w00 + wl0[r])) - 0.5f, wlog1 = -softplusf_(-(w01 + wl1[r])) - 0.5f;
                const float dec0 = __expf(-__expf(wlog0)), dec1 = __expf(-__expf(wlog1));
                const float av0 = sigmoidf_(a00 + al0[r]), av1 = sigmoidf_(a01 + al1[r]);
                const float kd0 = k_ * (1.0f + (av0 - 1.0f) * kaw), kd1 = k_ * (1.0f + (av1 - 1.0f) * kaw);
                bon[r] += r_ * (kd0 + kd1) * rkw;
                const size_t o = (size_t)row * 512 + c;
                if (NOSTORE) { asm volatile("" :: "v"(dec0), "v"(dec1), "v"(kk * av0 + kk * av1 + kd0 + kd1 + v_ + gl[r])); continue; }
                typedef float f32x2s __attribute__((ext_vector_type(2)));
                *(f32x2s*)(p.SW + 2 * o) = (f32x2s){dec0, dec1};
                *(u32x4*)(p.SBP + 4 * o) = (u32x4){cvt_pk_bf16(kk * av0, kk * av1), cvt_pk_bf16(kd0, kd1), cvt_pk_bf16(-kk, v_), cvt_pk_bf16(r_, gl[r])};
                if (r & 1) asm volatile("" ::: "memory");
            }
        }
#pragma unroll
        for (int r = 0; r < 4; ++r) {
            const float bs = row16_allsum(bon[r]);
            if (q == 0) p.BONUS[(row0 + 4 * g + r) * 8 + hh] = bs;
        }
        __syncthreads();
    }
}

template <bool LAT>
DI void na_unit(const Params& p, int b, int r, int h, int w, int lane) {
    const int q = lane & 15, g = lane >> 4;
    const int j = 16 * w + q;
    const int qtok = LAT ? (b * TLB + r * 64 + j) : (TL + b * TCB + j);
    bf16x8 qf[2];
#pragma unroll
    for (int ks = 0; ks < 2; ++ks) qf[ks] = *(const bf16x8*)(p.Q0 + (size_t)qtok * 512 + h * 64 + 32 * ks + 8 * g);
    const int row_start = LAT ? (r - 4 < 0 ? 0 : (r - 4 > 120 ? 120 : r - 4)) : 0;
    const int c0 = LAT ? (w == 0 ? 0 : (w == 1 ? 8 : (w == 2 ? 24 : 32))) : 0;
    int cs = j - 8; cs = cs < 0 ? 0 : (cs > 48 ? 48 : cs);
    auto score_local = [&](int a, int tt) -> f32x4 {
        const int ktok = b * TLB + (row_start + a) * 64 + c0 + 16 * tt + q;
        f32x4 s = (f32x4){0.f, 0.f, 0.f, 0.f};
#pragma unroll
        for (int ks = 0; ks < 2; ++ks) {
            const bf16x8 kf = *(const bf16x8*)(p.K0 + (size_t)ktok * 512 + h * 64 + 32 * ks + 8 * g);
            s = mfma16(kf, qf[ks], s);
        }
        const int row_off = row_start + a - r + 7;
#pragma unroll
        for (int rr = 0; rr < 4; ++rr) {
            const int cc = c0 + 16 * tt + 4 * g + rr;
            int co = cc - j; co = co < -15 ? -15 : (co > 15 ? 15 : co);
            const bool in = (cc >= cs) && (cc < cs + 16);
            const float bias = p.na_rpb[(h * 15 + row_off) * 31 + co + 15];
            s[rr] = in ? (s[rr] * 0.125f + bias) : -1.0e30f;
        }
        return s;
    };
    auto score_ctx = [&](int ct) -> f32x4 {
        const int ktok = TL + b * TCB + 16 * ct + q;
        f32x4 s = (f32x4){0.f, 0.f, 0.f, 0.f};
#pragma unroll
        for (int ks = 0; ks < 2; ++ks) {
            const bf16x8 kf = *(const bf16x8*)(p.K0 + (size_t)ktok * 512 + h * 64 + 32 * ks + 8 * g);
            s = mfma16(kf, qf[ks], s);
        }
        return s * 0.125f;
    };
    float mx = -3.0e38f;
    if (LAT) {
        for (int a = 0; a < 8; ++a) {
#pragma unroll
            for (int tt = 0; tt < 2; ++tt) { const f32x4 s = score_local(a, tt); mx = fmaxf(mx, fmaxf(fmaxf(s[0], s[1]), fmaxf(s[2], s[3]))); }
        }
    }
    for (int ct = 0; ct < 16; ++ct) { const f32x4 s = score_ctx(ct); mx = fmaxf(mx, fmaxf(fmaxf(s[0], s[1]), fmaxf(s[2], s[3]))); }
    mx = fmaxf(mx, __shfl_xor(mx, 16)); mx = fmaxf(mx, __shfl_xor(mx, 32));
    float sum = 0.f;
    f32x4 o[4];
#pragma unroll
    for (int dm = 0; dm < 4; ++dm) o[dm] = (f32x4){0.f, 0.f, 0.f, 0.f};
    if (LAT) {
        for (int a = 0; a < 8; ++a) {
            f32x4 s0 = score_local(a, 0), s1 = score_local(a, 1);
#pragma unroll
            for (int rr = 0; rr < 4; ++rr) { s0[rr] = __expf(s0[rr] - mx); s1[rr] = __expf(s1[rr] - mx); sum += s0[rr] + s1[rr]; }
            const bf16x8 pb = pack8(s0, s1);
#pragma unroll
            for (int dm = 0; dm < 4; ++dm) {
                const bf16_t* vr = p.VT0L + ((size_t)(b * 512 + h * 64 + 16 * dm + q)) * TLB + (row_start + a) * 64 + c0 + 4 * g;
                const bf16x8 va = join8(*(const u32x2*)vr, *(const u32x2*)(vr + 16));
                o[dm] = mfma16(va, pb, o[dm]);
            }
        }
    }
    for (int u = 0; u < 8; ++u) {
        f32x4 s0 = score_ctx(2 * u), s1 = score_ctx(2 * u + 1);
#pragma unroll
        for (int rr = 0; rr < 4; ++rr) { s0[rr] = __expf(s0[rr] - mx); s1[rr] = __expf(s1[rr] - mx); sum += s0[rr] + s1[rr]; }
        const bf16x8 pb = pack8(s0, s1);
#pragma unroll
        for (int dm = 0; dm < 4; ++dm) {
            const bf16_t* vr = p.VT0C + ((size_t)(b * 512 + h * 64 + 16 * dm + q)) * TCB + 32 * u + 4 * g;
            const bf16x8 va = join8(*(const u32x2*)vr, *(const u32x2*)(vr + 16));
            o[dm] = mfma16(va, pb, o[dm]);
        }
    }
    sum += __shfl_xor(sum, 16); sum += __shfl_xor(sum, 32);
    const float inv = 1.0f / sum;
#pragma unroll
    for (int dm = 0; dm < 4; ++dm) {
        u32x2 wv; wv.x = cvt_pk_bf16(o[dm][0] * inv, o[dm][1] * inv); wv.y = cvt_pk_bf16(o[dm][2] * inv, o[dm][3] * inv);
        *(u32x2*)(p.MIX + (size_t)qtok * 1024 + h * 64 + 16 * dm + 4 * g) = wv;
    }
}

constexpr int CK_NCH = (TCB + TLB) / 16;
constexpr int CPW = 19200;
constexpr int CP_TMU = 0, CP_TMB = 2304, CP_TMK = 4608, CP_TMR = 6912, CP_TRU = 9216, CP_TRB = 11264, CP_TRV = 13312;
constexpr int CP_TT = 15360, CP_ARB = 15872, CP_AUKT = 16384, CP_H = 16896, CP_Q = 17408, CP_AUB = 17920, CP_G = 18944;
constexpr int CP_GT = CP_TMU, CP_WT = CP_TMB;

DI void cp_unit(const Params& p, char* W, int unit, int lane) {
    const int chain = unit / CK_NCH, c = unit % CK_NCH;
    const int b = chain >> 4, h = (chain >> 1) & 7, dir = chain & 1;
    const int q = lane & 15, g = lane >> 4;
    auto step_row = [&](int i) -> int {
        if (i < TCB) return TL + b * TCB + (dir == 0 ? i : TCB - 1 - i);
        const int jj = i - TCB;
        return b * TLB + (dir == 0 ? jj : TLB - 1 - jj);
    };
    {
        const float* SWd = p.SW + 2 * (h * 64 + lane) + dir;
        const u32x4* P4d = (const u32x4*)p.SBP + h * 64 + lane;
        float gam = 1.0f;
        unsigned pu[8], pb[8], pv[8];
        float lu = 0.f, lb = 0.f, lv = 0.f;
#pragma unroll
        for (int i4 = 0; i4 < 4; ++i4) {
            float w_[4], n_[4], b_[4], k_[4], r_[4], v_[4];
#pragma unroll
            for (int e = 0; e < 4; ++e) {
                const size_t ro = (size_t)step_row(c * 16 + 4 * i4 + e) * 512;
                w_[e] = SWd[2 * ro];
                { const u32x4 pk = P4d[ro]; const unsigned nv = pk.z, bw = pk.x, kw = pk.y, rw = pk.w;
                  n_[e] = bflo(nv); v_[e] = bfhi(nv); b_[e] = dir ? bfhi(bw) : bflo(bw); k_[e] = dir ? bfhi(kw) : bflo(kw); r_[e] = bflo(rw); }
            }
#pragma unroll
            for (int e = 0; e < 4; ++e) {
                const int i = 4 * i4 + e;
                const float gp = gam; gam *= w_[e];
                const float ig = 1.0f / gam;
                const float ut = gp * n_[e], bt = b_[e] * ig, kt = k_[e] * ig, rt = gam * r_[e];
                const unsigned wub = cvt_pk_bf16(ut, bt), wkr = cvt_pk_bf16(kt, rt);
                *(bf16_t*)(W + CP_TMU + i * 144 + lane * 2) = (bf16_t)(wub & 0xffff);
                *(bf16_t*)(W + CP_TMB + i * 144 + lane * 2) = (bf16_t)(wub >> 16);
                *(bf16_t*)(W + CP_TMK + i * 144 + lane * 2) = (bf16_t)(wkr & 0xffff);
                *(bf16_t*)(W + CP_TMR + i * 144 + lane * 2) = (bf16_t)(wkr >> 16);
                if (i & 1) { pu[i >> 1] = cvt_pk_bf16(lu, ut); pb[i >> 1] = cvt_pk_bf16(lb, bt); pv[i >> 1] = cvt_pk_bf16(lv, v_[e]); }
                else { lu = ut; lb = bt; lv = v_[e]; }
            }
        }
        *(u32x4*)(W + CP_TRU + lane * 32) = (u32x4){pu[0], pu[1], pu[2], pu[3]}; *(u32x4*)(W + CP_TRU + lane * 32 + 16) = (u32x4){pu[4], pu[5], pu[6], pu[7]};
        *(u32x4*)(W + CP_TRB + lane * 32) = (u32x4){pb[0], pb[1], pb[2], pb[3]}; *(u32x4*)(W + CP_TRB + lane * 32 + 16) = (u32x4){pb[4], pb[5], pb[6], pb[7]};
        *(u32x4*)(W + CP_TRV + lane * 32) = (u32x4){pv[0], pv[1], pv[2], pv[3]}; *(u32x4*)(W + CP_TRV + lane * 32 + 16) = (u32x4){pv[4], pv[5], pv[6], pv[7]};
        *(float*)(W + CP_G + lane * 4) = gam;
    }
    auto fr64 = [&](int off, int ks) -> bf16x8 { return *(const bf16x8*)(W + off + q * 144 + (32 * ks + 8 * g) * 2); };
    auto fr16 = [&](int off, int row) -> bf16x8 {
        u32x4 z = (u32x4){0u, 0u, 0u, 0u};
        if (g < 2) z = *(const u32x4*)(W + off + row * 32 + g * 16);
        return __builtin_bit_cast(bf16x8, z);
    };
    const f32x4 zero4 = (f32x4){0.f, 0.f, 0.f, 0.f};
    asm volatile("" ::: "memory");
    f32x4 arkT;
    {
        const bf16x8 fu0 = fr64(CP_TMU, 0), fu1 = fr64(CP_TMU, 1), fb0 = fr64(CP_TMB, 0), fb1 = fr64(CP_TMB, 1);
        const bf16x8 fk0 = fr64(CP_TMK, 0), fk1 = fr64(CP_TMK, 1), fr0 = fr64(CP_TMR, 0), fr1 = fr64(CP_TMR, 1);
        f32x4 d = mfma16(fb1, fu1, mfma16(fb0, fu0, zero4));
#pragma unroll
        for (int r = 0; r < 4; ++r) d[r] = (4 * g + r < q) ? d[r] : 0.f;
        *(f32x4*)(W + CP_AUB + q * 64 + 16 * g) = d;
        d = mfma16(fb1, fr1, mfma16(fb0, fr0, zero4));
#pragma unroll
        for (int r = 0; r < 4; ++r) d[r] = (4 * g + r <= q) ? d[r] : 0.f;
        { u32x2 w; w.x = cvt_pk_bf16(d[0], d[1]); w.y = cvt_pk_bf16(d[2], d[3]); *(u32x2*)(W + CP_ARB + q * 32 + 8 * g) = w; }
        d = mfma16(fu1, fk1, mfma16(fu0, fk0, zero4));
#pragma unroll
        for (int r = 0; r < 4; ++r) d[r] = (q < 4 * g + r) ? d[r] : 0.f;
        { u32x2 w; w.x = cvt_pk_bf16(d[0], d[1]); w.y = cvt_pk_bf16(d[2], d[3]); *(u32x2*)(W + CP_AUKT + q * 32 + 8 * g) = w; }
        arkT = mfma16(fk1, fr1, mfma16(fk0, fr0, zero4));
#pragma unroll
        for (int r = 0; r < 4; ++r) arkT[r] = (4 * g + r <= q) ? arkT[r] : 0.f;
    }
    asm volatile("" ::: "memory");
    {
        float t[16];
#pragma unroll
        for (int i = 0; i < 16; ++i) t[i] = 0.f;
#pragma unroll
        for (int i = 0; i < 16; ++i) {
            float s = (i == q) ? 1.0f : 0.f;
#pragma unroll
            for (int m4 = 0; m4 < 4; ++m4) {
                if (4 * m4 < i) {
                    const f32x4 a = *(const f32x4*)(W + CP_AUB + i * 64 + 16 * m4);
                    s += (a[0] * t[4 * m4] + a[1] * t[4 * m4 + 1]) + (a[2] * t[4 * m4 + 2] + a[3] * t[4 * m4 + 3]);
                }
            }
            t[i] = s;
        }
        if (g == 0) {
            *(u32x4*)(W + CP_TT + q * 32) = (u32x4){cvt_pk_bf16(t[0], t[1]), cvt_pk_bf16(t[2], t[3]), cvt_pk_bf16(t[4], t[5]), cvt_pk_bf16(t[6], t[7])};
            *(u32x4*)(W + CP_TT + q * 32 + 16) = (u32x4){cvt_pk_bf16(t[8], t[9]), cvt_pk_bf16(t[10], t[11]), cvt_pk_bf16(t[12], t[13]), cvt_pk_bf16(t[14], t[15])};
        }
    }
    asm volatile("" ::: "memory");
    {
        const f32x4 d = mfma16(fr16(CP_TT, q), fr16(CP_ARB, q), zero4);
        u32x2 w; w.x = cvt_pk_bf16(d[0], d[1]); w.y = cvt_pk_bf16(d[2], d[3]); *(u32x2*)(W + CP_H + q * 32 + 8 * g) = w;
    }
    asm volatile("" ::: "memory");
    {
        const f32x4 d = mfma16(fr16(CP_AUKT, q), fr16(CP_H, q), arkT);
        u32x2 w; w.x = cvt_pk_bf16(d[0], d[1]); w.y = cvt_pk_bf16(d[2], d[3]); *(u32x2*)(W + CP_Q + q * 32 + 8 * g) = w;
    }
    asm volatile("" ::: "memory");
    {
        const bf16x8 ft = fr16(CP_TT, q);
#pragma unroll
        for (int nt = 0; nt < 4; ++nt) {
            const f32x4 d = mfma16(ft, fr16(CP_TRB, 16 * nt + q), zero4);
            u32x2 w; w.x = cvt_pk_bf16(d[0], d[1]); w.y = cvt_pk_bf16(d[2], d[3]); *(u32x2*)(W + CP_GT + (16 * nt + q) * 32 + 8 * g) = w;
        }
    }
    asm volatile("" ::: "memory");
    {
        const bf16x8 fa = fr16(CP_AUKT, q);
#pragma unroll
        for (int nt = 0; nt < 4; ++nt) {
            f32x4 kt;
#pragma unroll
            for (int r = 0; r < 4; ++r) kt[r] = bf2f(*(const bf16_t*)(W + CP_TMK + (4 * g + r) * 144 + (16 * nt + q) * 2));
            const f32x4 d = mfma16(fa, fr16(CP_GT, 16 * nt + q), kt);
            u32x2 w; w.x = cvt_pk_bf16(d[0], d[1]); w.y = cvt_pk_bf16(d[2], d[3]); *(u32x2*)(W + CP_WT + (16 * nt + q) * 32 + 8 * g) = w;
        }
    }
    asm volatile("" ::: "memory");
    {
        const bf16x8 fh = fr16(CP_H, q), fq = fr16(CP_Q, q);
        bf16_t* RHg = p.CRH + (size_t)unit * 1024;
        bf16_t* P3g = p.CP3 + (size_t)unit * 1024;
        bf16_t* Mg = p.CM + (size_t)unit * 4096;
        bf16_t* Ng = p.CN + (size_t)unit * 4096;
#pragma unroll
        for (int mt = 0; mt < 4; ++mt) {
            const u32x2 rw = *(const u32x2*)(W + CP_TMR + q * 144 + (16 * mt + 4 * g) * 2);
            const f32x4 rt = (f32x4){bflo(rw.x), bfhi(rw.x), bflo(rw.y), bfhi(rw.y)};
            const f32x4 d = mfma16(fr16(CP_TRU, 16 * mt + q), fh, rt);
            u32x2 w; w.x = cvt_pk_bf16(d[0], d[1]); w.y = cvt_pk_bf16(d[2], d[3]);
            *(u32x2*)(RHg + (((mt >> 1) * 64 + lane) * 8 + (mt & 1) * 4)) = w;
        }
#pragma unroll
        for (int vs = 0; vs < 4; ++vs) {
            const f32x4 d = mfma16(fq, fr16(CP_TRV, 16 * vs + q), zero4);
            { u32x2 w; w.x = cvt_pk_bf16(d[0], d[1]); w.y = cvt_pk_bf16(d[2], d[3]); *(u32x2*)(P3g + (vs * 64 + lane) * 4) = w; }
        }
#pragma unroll
        for (int nt = 0; nt < 4; ++nt) {
            const bf16x8 fg = fr16(CP_GT, 16 * nt + q);
            const float gc = *(const float*)(W + CP_G + (16 * nt + q) * 4);
#pragma unroll
            for (int mt = 0; mt < 4; ++mt) {
                f32x4 d = mfma16(fr16(CP_TRU, 16 * mt + q), fg, zero4);
#pragma unroll
                for (int r = 0; r < 4; ++r) d[r] = gc * (d[r] + ((16 * mt + 4 * g + r == 16 * nt + q) ? 1.0f : 0.f));
                u32x2 w; w.x = cvt_pk_bf16(d[0], d[1]); w.y = cvt_pk_bf16(d[2], d[3]);
                *(u32x2*)(Mg + (((nt * 2 + (mt >> 1)) * 64 + lane) * 8 + (mt & 1) * 4)) = w;
            }
        }
#pragma unroll
        for (int mt = 0; mt < 4; ++mt) {
            const bf16x8 fw = fr16(CP_WT, 16 * mt + q);
            const f32x4 gc = *(const f32x4*)(W + CP_G + (16 * mt + 4 * g) * 4);
#pragma unroll
            for (int vs = 0; vs < 4; ++vs) {
                const f32x4 d = mfma16(fw, fr16(CP_TRV, 16 * vs + q), zero4) * gc;
                { u32x2 w; w.x = cvt_pk_bf16(d[0], d[1]); w.y = cvt_pk_bf16(d[2], d[3]); *(u32x2*)(Ng + ((vs * 4 + mt) * 64 + lane) * 4) = w; }
            }
        }
    }
    asm volatile("" ::: "memory");
}

DI void sq_wave(const Params& p, int chain, int vs, int lane) {
    const int b = chain >> 4, h = (chain >> 1) & 7, dir = chain & 1;
    const int q = lane & 15, g = lane >> 4;
    auto step_row = [&](int i) -> int {
        if (i < TCB) return TL + b * TCB + (dir == 0 ? i : TCB - 1 - i);
        const int jj = i - TCB;
        return b * TLB + (dir == 0 ? jj : TLB - 1 - jj);
    };
    float* YCd = p.YS + ((size_t)chain * CK_NCH * 4 + vs) * 256 + lane * 4;
    f32x4 st[4];
#pragma unroll
    for (int mt = 0; mt < 4; ++mt) st[mt] = (f32x4){0.f, 0.f, 0.f, 0.f};
    struct Ops { u32x4 m[4][2]; u32x4 r[2]; u32x2 n[4]; u32x2 p3; };
    auto load = [&](Ops& o, int c) {
        const size_t unit = (size_t)chain * CK_NCH + c;
        const bf16_t* Mg = p.CM + unit * 4096; const bf16_t* RHg = p.CRH + unit * 1024;
        const bf16_t* Ng = p.CN + unit * 4096 + (size_t)vs * 1024; const bf16_t* P3g = p.CP3 + unit * 1024 + vs * 256;
#pragma unroll
        for (int mt = 0; mt < 4; ++mt)
#pragma unroll
            for (int s = 0; s < 2; ++s) o.m[mt][s] = *(const u32x4*)(Mg + ((mt * 2 + s) * 64 + lane) * 8);
#pragma unroll
        for (int s = 0; s < 2; ++s) o.r[s] = *(const u32x4*)(RHg + (s * 64 + lane) * 8);
#pragma unroll
        for (int mt = 0; mt < 4; ++mt) o.n[mt] = *(const u32x2*)(Ng + (mt * 64 + lane) * 4);
        o.p3 = *(const u32x2*)(P3g + lane * 4);
    };
    auto stepc = [&](const Ops& o, int c) {
        const bf16x8 sb0 = pack8(st[0], st[1]), sb1 = pack8(st[2], st[3]);
        f32x4 y = mfma16(__builtin_bit_cast(bf16x8, o.r[0]), sb0, (f32x4){bflo(o.p3.x), bfhi(o.p3.x), bflo(o.p3.y), bfhi(o.p3.y)});
        y = mfma16(__builtin_bit_cast(bf16x8, o.r[1]), sb1, y);
#pragma unroll
        for (int mt = 0; mt < 4; ++mt) {
            f32x4 a = mfma16(__builtin_bit_cast(bf16x8, o.m[mt][0]), sb0, (f32x4){bflo(o.n[mt].x), bfhi(o.n[mt].x), bflo(o.n[mt].y), bfhi(o.n[mt].y)});
            st[mt] = mfma16(__builtin_bit_cast(bf16x8, o.m[mt][1]), sb1, a);
        }
        *(f32x4*)(YCd + ((size_t)c * 4) * 256) = y;
    };
    Ops oa, ob, oc;
    load(oa, 0); load(ob, 1); load(oc, 2);
    for (int c = 0; c < CK_NCH; c += 3) {
        stepc(oa, c);     __builtin_amdgcn_sched_barrier(0); load(oa, (c + 3 < CK_NCH) ? c + 3 : CK_NCH - 1); __builtin_amdgcn_sched_barrier(0);
        stepc(ob, c + 1); __builtin_amdgcn_sched_barrier(0); load(ob, (c + 4 < CK_NCH) ? c + 4 : CK_NCH - 1); __builtin_amdgcn_sched_barrier(0);
        stepc(oc, c + 2); __builtin_amdgcn_sched_barrier(0); load(oc, (c + 5 < CK_NCH) ? c + 5 : CK_NCH - 1); __builtin_amdgcn_sched_barrier(0);
    }
}

DI void na_block_unit(const Params& p, char* lds, int U) {
    const int tid = opaque_tid(), lane = tid & 63, wv = tid >> 6, q = lane & 15, g = lane >> 4;
    const bool lat = U < 1024;
    int b, r, hp, qb;
    if (lat) { hp = U & 3; r = (U >> 2) & 127; b = U >> 9; qb = 0; } else { const int V = U - 1024; qb = V & 3; hp = (V >> 2) & 3; b = V >> 4; r = 0; }
    const int hh = wv >> 2, w = wv & 3, h = 2 * hp + hh;
    const int j = 16 * w + q;
    const int qtok = lat ? (b * TLB + r * 64 + j) : (TL + b * TCB + 64 * qb + j);
    const int row_start = lat ? (r - 4 < 0 ? 0 : (r - 4 > 120 ? 120 : r - 4)) : 0;
    const int c0 = (w == 0 ? 0 : (w == 1 ? 8 : (w == 2 ? 24 : 32)));
    int cs = j - 8; cs = cs < 0 ? 0 : (cs > 48 ? 48 : cs);
    const int nch = lat ? 12 : 4, first_ctx = lat ? 8 : 0;
    bf16x8 qf[2];
#pragma unroll
    for (int ks = 0; ks < 2; ++ks) qf[ks] = *(const bf16x8*)(p.Q0 + (size_t)qtok * 512 + h * 64 + 32 * ks + 8 * g);
    u32x4 rk[2], rv[2];
    auto issue = [&](int ci) {
        const bool isctx = ci >= first_ctx;
        const int cc = ci - first_ctx;
#pragma unroll
        for (int i = 0; i < 2; ++i) {
            const int pc = tid + NTHR * i;
            const int key = pc >> 4, c16 = pc & 15;
            const int tok = isctx ? (TL + b * TCB + cc * 64 + key) : (b * TLB + (row_start + ci) * 64 + key);
            rk[i] = *(const u32x4*)(p.K0 + (size_t)tok * 512 + hp * 128 + c16 * 8);
            const int row = pc >> 3, k8 = pc & 7;
            const bf16_t* vsrc = isctx ? (p.VT0C + ((size_t)(b * 512 + hp * 128 + row)) * TCB + cc * 64 + k8 * 8)
                                       : (p.VT0L + ((size_t)(b * 512 + hp * 128 + row)) * TLB + (row_start + ci) * 64 + k8 * 8);
            rv[i] = *(const u32x4*)vsrc;
        }
    };
    auto stash = [&](char* st) {
#pragma unroll
        for (int i = 0; i < 2; ++i) {
            const int pc = tid + NTHR * i;
            const int key = pc >> 4, c16 = pc & 15;
            *(u32x4*)(st + (c16 >> 3) * 8192 + lds_byte(key, (c16 & 7) * 8)) = rk[i];
            const int row = pc >> 3, k8 = pc & 7;
            *(u32x4*)(st + 16384 + (row >> 6) * 8192 + lds_byte(row & 63, k8 * 8)) = rv[i];
        }
    };
    float m = -3.0e38f, sum = 0.f;
    f32x4 o[4];
#pragma unroll
    for (int dm = 0; dm < 4; ++dm) o[dm] = (f32x4){0.f, 0.f, 0.f, 0.f};
    auto qk = [&](const char* kimg, int kc0, f32x4 (&s)[2]) {
#pragma unroll
        for (int hf = 0; hf < 2; ++hf) {
            const int key = kc0 + 8 * (q >> 2) + 4 * hf + (q & 3);
            f32x4 a = (f32x4){0.f, 0.f, 0.f, 0.f};
#pragma unroll
            for (int ks = 0; ks < 2; ++ks) a = mfma16(*(const bf16x8*)(kimg + lds_byte(key, 32 * ks + 8 * g)), qf[ks], a);
            s[hf] = a;
        }
    };
    auto pv = [&](const char* vimg, int kc0, const f32x4 (&s)[2]) {
        const bf16x8 pb = pack8(s[0], s[1]);
#pragma unroll
        for (int dm = 0; dm < 4; ++dm) o[dm] = mfma16(*(const bf16x8*)(vimg + lds_byte(16 * dm + q, kc0 + 8 * g)), pb, o[dm]);
    };
    issue(0);
    stash(lds);
    __syncthreads();
    for (int ci = 0; ci < nch; ++ci) {
        const bool more = ci + 1 < nch;
        if (more) issue(ci + 1);
        const char* st = lds + (ci & 1) * 32768;
        const char* kimg = st + hh * 8192;
        const char* vimg = st + 16384 + hh * 8192;
        if (ci < first_ctx) {
            f32x4 s[2];
            qk(kimg, c0, s);
            const int row_off = row_start + ci - r + 7;
            float cmax = -3.0e38f;
#pragma unroll
            for (int hf = 0; hf < 2; ++hf)
#pragma unroll
                for (int rr = 0; rr < 4; ++rr) {
                    const int cc_ = c0 + 8 * g + 4 * hf + rr;
                    int co = cc_ - j; co = co < -15 ? -15 : (co > 15 ? 15 : co);
                    const bool in = (cc_ >= cs) && (cc_ < cs + 16);
                    const float bias = p.na_rpb[(h * 15 + row_off) * 31 + co + 15];
                    const float sv = in ? (s[hf][rr] * 0.125f + bias) : -1.0e30f;
                    s[hf][rr] = sv; cmax = fmaxf(cmax, sv);
                }
            cmax = fmaxf(cmax, __shfl_xor(cmax, 16)); cmax = fmaxf(cmax, __shfl_xor(cmax, 32));
            const float mn = fmaxf(m, cmax), al = __expf(m - mn);
            m = mn; sum *= al;
#pragma unroll
            for (int dm = 0; dm < 4; ++dm) o[dm] = o[dm] * al;
#pragma unroll
            for (int hf = 0; hf < 2; ++hf)
#pragma unroll
                for (int rr = 0; rr < 4; ++rr) { s[hf][rr] = __expf(s[hf][rr] - mn); sum += s[hf][rr]; }
            pv(vimg, c0, s);
        } else {
            f32x4 s0[2], s1[2];
            qk(kimg, 0, s0); qk(kimg, 32, s1);
            float cmax = -3.0e38f;
#pragma unroll
            for (int hf = 0; hf < 2; ++hf)
#pragma unroll
                for (int rr = 0; rr < 4; ++rr) { s0[hf][rr] *= 0.125f; s1[hf][rr] *= 0.125f; cmax = fmaxf(cmax, fmaxf(s0[hf][rr], s1[hf][rr])); }
            cmax = fmaxf(cmax, __shfl_xor(cmax, 16)); cmax = fmaxf(cmax, __shfl_xor(cmax, 32));
            const float mn = fmaxf(m, cmax), al = __expf(m - mn);
            m = mn; sum *= al;
#pragma unroll
            for (int dm = 0; dm < 4; ++dm) o[dm] = o[dm] * al;
#pragma unroll
            for (int hf = 0; hf < 2; ++hf)
#pragma unroll
                for (int rr = 0; rr < 4; ++rr) { s0[hf][rr] = __expf(s0[hf][rr] - mn); s1[hf][rr] = __expf(s1[hf][rr] - mn); sum += s0[hf][rr] + s1[hf][rr]; }
            pv(vimg, 0, s0); pv(vimg, 32, s1);
        }
        if (more) stash(lds + ((ci + 1) & 1) * 32768);
        __syncthreads();
    }
    sum += __shfl_xor(sum, 16); sum += __shfl_xor(sum, 32);
    const float inv = 1.0f / sum;
#pragma unroll
    for (int dm = 0; dm < 4; ++dm) {
        u32x2 wv_; wv_.x = cvt_pk_bf16(o[dm][0] * inv, o[dm][1] * inv); wv_.y = cvt_pk_bf16(o[dm][2] * inv, o[dm][3] * inv);
        *(u32x2*)(p.MIX + (size_t)qtok * 1024 + h * 64 + 16 * dm + 4 * g) = wv_;
    }
}

template <int PARTS = 3>
DI void ph_attn_cp(const Params& p, char* lds) {
    const int tz_ = opaque_tid(), lane = tz_ & 63, wv = tz_ >> 6;
    char* W = lds + wv * CPW;
    const int gw = blockIdx.x * 8 + wv, nw = (int)gridDim.x * 8;
    constexpr int NCP = 32 * CK_NCH;
    if (PARTS & 1) for (int U = gw; U < NCP; U += nw) cp_unit(p, W, U, lane);
    if (PARTS & 2) {
        __syncthreads();
        for (int U = blockIdx.x; U < 1024 + 32; U += gridDim.x) na_block_unit(p, lds, U);
    }
}
DI void ph_sq(const Params& p, char* lds) {
    const int tz_ = opaque_tid(), lane = tz_ & 63, wv = tz_ >> 6;
    const int nsq = gridDim.x >= 256 ? 128 : 0;
    if ((int)blockIdx.x < nsq) { if (wv == 0) sq_wave(p, blockIdx.x >> 2, blockIdx.x & 3, lane); return; }
    if (nsq == 0) { if (wv == 0) for (int u = blockIdx.x; u < 128; u += gridDim.x) sq_wave(p, u >> 2, u & 3, lane); __syncthreads(); }
    for (int U = (int)blockIdx.x - nsq; U < 1024 + 32; U += (int)gridDim.x - nsq) na_block_unit(p, lds, U);
}

DI void ph_rw_readout(const Params& p) {
    const int c = opaque_tid(), hh = c >> 6;
    const float gg = p.rw_gn_g[c], gb = p.rw_gn_b[c];
    for (int row = blockIdx.x; row < TT; row += gridDim.x) {
        const size_t o = (size_t)row * 512 + c;
        float y;
        {
            const bool lat = row < TL;
            const int bb = lat ? (row >> 13) : ((row - TL) >> 8), t = lat ? (row & (TLB - 1)) : ((row - TL) & (TCB - 1));
            const int pf = lat ? TCB + t : t, pb = lat ? TCB + (TLB - 1 - t) : (TCB - 1 - t);
            const int vs = (c >> 4) & 3, q = c & 15;
            const size_t cf = (size_t)((bb * 8 + hh) * 2 + 0) * CK_NCH + (pf >> 4), cb = (size_t)((bb * 8 + hh) * 2 + 1) * CK_NCH + (pb >> 4);
            y = p.YS[(cf * 4 + vs) * 256 + (16 * ((pf & 15) >> 2) + q) * 4 + (pf & 3)] + p.YS[(cb * 4 + vs) * 256 + (16 * ((pb & 15) >> 2) + q) * 4 + (pb & 3)];
        }
        const float mu = wave_allsum(y) * (1.0f / 64.0f);
        const float d = y - mu;
        const float var = wave_allsum(d * d) * (1.0f / 64.0f);
        const float yn = d * rsqrtf(var + 64e-5f) * gg + gb;
        const u32x2 nr = *(const u32x2*)(p.SBP + 4 * o + 2);
        const float outv = (yn + p.BONUS[row * 8 + hh] * bfhi(nr.x)) * bfhi(nr.y);
        p.MIX[(size_t)row * 1024 + 512 + c] = (bf16_t)(cvt_pk_bf16(outv, 0.f) & 0xffff);
    }
}

DI void gemm_f32out(char* lds, const bf16_t* A, int M, const float* W, int N, float* C) {
    const int tid = opaque_tid();
    const int ntn = N / 128, ntm = M / 256;
    gemm_stream<4, 2, 4, 4, PtrLoaderF, 4>(lds, ntn * ntm, 16, [&](int u, PtrLoader<4>& al, PtrLoaderF& bl, const int (&nx)[4]) {
        int tm, tn; tile_of(u, ntm, ntn, tm, tn);
#pragma unroll
        for (int i = 0; i < 4; ++i) al.p[i] = (unsigned)((tm * 256 + a_row(tid) + 64 * i) * 1024 + a_c8(tid) * 8);
        al.base = A;
        fill_bf(bl, W, N, tn * 128, N);
    }, [&](int u, int (&nx)[4], int) {}, [&](int u, int mi, const f32x4 (&a)[4], f32x4 (&o)[4], int r0, int c0) {
#pragma unroll
        for (int ni = 0; ni < 4; ++ni) o[ni] = a[ni];
    }, [&](int u, int r, int c, f32x4 v, f32x4 pv) {
        int tm, tn; tile_of(u, ntm, ntn, tm, tn);
        *(f32x4*)(C + (size_t)(tm * 256 + r) * N + tn * 128 + c) = v;
    });
}

DI void ln_row(f32x4 (&v)[4], const float* g, const float* bta, int lane) {
    float s = 0.f;
#pragma unroll
    for (int i = 0; i < 4; ++i) s += (v[i][0] + v[i][1]) + (v[i][2] + v[i][3]);
    const float mu = wave_allsum(s) * (1.0f / 1024.0f);
    float q = 0.f;
#pragma unroll
    for (int i = 0; i < 4; ++i) { v[i] = v[i] - mu; q += (v[i][0] * v[i][0] + v[i][1] * v[i][1]) + (v[i][2] * v[i][2] + v[i][3] * v[i][3]); }
    const float rstd = rsqrtf(wave_allsum(q) * (1.0f / 1024.0f) + 1e-5f);
#pragma unroll
    for (int i = 0; i < 4; ++i) {
        const int c = 4 * lane + 256 * i;
        v[i] = v[i] * rstd * (*(const f32x4*)(g + c)) + (*(const f32x4*)(bta + c));
    }
}

template <int L>
DI void ph_ln1(const Params& p) {
    const int tz_ = opaque_tid(), lane = tz_ & 63, wv = tz_ >> 6;
    const int nrows = (L == 0) ? TT : TL;
    for (int row = blockIdx.x * 8 + wv; row < nrows; row += gridDim.x * 8) {
        const float* hin = (L == 0) ? (row < TL ? p.x + (size_t)row * 1024 : p.ctx + (size_t)(row - TL) * 1024) : p.HB + (size_t)row * 1024;
        const float* m = p.mods + (size_t)(L * 3 + mods_row(row)) * 6144;
        f32x4 v[4];
#pragma unroll
        for (int i = 0; i < 4; ++i) {
            const int c = 4 * lane + 256 * i;
            v[i] = ALPHA * (*(const f32x4*)(hin + c)) + (*(const f32x4*)(m + 2048 + c)) * (*(const f32x4*)(p.YL + (size_t)row * 1024 + c));
        }
        ln_row(v, p.ln_g + (L * 2 + 0) * 1024, p.ln_b + (L * 2 + 0) * 1024, lane);
#pragma unroll
        for (int i = 0; i < 4; ++i) {
            const int c = 4 * lane + 256 * i;
            *(f32x4*)(p.HA + (size_t)row * 1024 + c) = v[i];
            const f32x4 f = v[i] * (1.0f + *(const f32x4*)(m + 4096 + c)) + *(const f32x4*)(m + 3072 + c);
            u32x2 w; w.x = cvt_pk_bf16(f[0], f[1]); w.y = cvt_pk_bf16(f[2], f[3]);
            *(u32x2*)(p.Abuf + (size_t)row * 1024 + c) = w;
        }
    }
}

template <int CTRL, int RM> DI float dpp_keep(float x) {
    return __builtin_bit_cast(float, __builtin_amdgcn_update_dpp(__builtin_bit_cast(int, x), __builtin_bit_cast(int, x), CTRL, RM, 0xF, false));
}
DI float wave_max_uniform(float x) {
    x = fmaxf(x, dpp_keep<0xB1, 0xF>(x)); x = fmaxf(x, dpp_keep<0x4E, 0xF>(x));
    x = fmaxf(x, dpp_keep<0x141, 0xF>(x)); x = fmaxf(x, dpp_keep<0x140, 0xF>(x));
    x = fmaxf(x, dpp_keep<0x142, 0xA>(x)); x = fmaxf(x, dpp_keep<0x143, 0xC>(x));
    return __builtin_bit_cast(float, __builtin_amdgcn_readlane(__builtin_bit_cast(int, x), 63));
}
template <int L>
DI void ph_route(const Params& p, char* ldsc) {
    const int tz_ = opaque_tid(), lane = tz_ & 63, wv = tz_ >> 6;
    const int nrows = (L == 0) ? TT : TL;
    int* hist = (int*)ldsc;
    if (tz_ < 256) hist[tz_] = 0;
    __syncthreads();
    const f32x4 bias = *(const f32x4*)(p.moe_bias + L * 256 + 4 * lane);
    for (int row = blockIdx.x * 8 + wv; row < nrows; row += gridDim.x * 8) {
        const f32x4 lg = *(const f32x4*)(p.LOGITS + (size_t)row * 256 + 4 * lane);
        const float s0 = sigmoidf_(lg[0]), s1 = sigmoidf_(lg[1]), s2 = sigmoidf_(lg[2]), s3 = sigmoidf_(lg[3]);
        float v0 = s0 + bias[0], v1 = s1 + bias[1], v2 = s2 + bias[2], v3 = s3 + bias[3];
        float m1 = fmaxf(v0, v1), m2 = fminf(v0, v1);
        { const float a = fmaxf(v2, v3), bq = fminf(v2, v3); const float n1 = fmaxf(m1, a); const float n2 = fmaxf(fminf(m1, a), fmaxf(m2, bq)); m1 = n1; m2 = n2; }
        { const float o1 = dpp_keep<0xB1, 0xF>(m1), o2 = dpp_keep<0xB1, 0xF>(m2); const float n1 = fmaxf(m1, o1), n2 = fmaxf(fminf(m1, o1), fmaxf(m2, o2)); m1 = n1; m2 = n2; }
        { const float o1 = dpp_keep<0x4E, 0xF>(m1), o2 = dpp_keep<0x4E, 0xF>(m2); const float n1 = fmaxf(m1, o1), n2 = fmaxf(fminf(m1, o1), fmaxf(m2, o2)); m1 = n1; m2 = n2; }
        { const float o1 = dpp_keep<0x141, 0xF>(m1), o2 = dpp_keep<0x141, 0xF>(m2); const float n1 = fmaxf(m1, o1), n2 = fmaxf(fminf(m1, o1), fmaxf(m2, o2)); m1 = n1; m2 = n2; }
        const float gs = m1 + m2;
        const int myg = lane >> 3;
        int rank = 0;
#pragma unroll
        for (int gg = 0; gg < 8; ++gg) {
            const float og = __builtin_bit_cast(float, __builtin_amdgcn_readlane(__builtin_bit_cast(int, gs), gg * 8));
            rank += ((og > gs) || (og == gs && gg < myg)) ? 1 : 0;
        }
        if (rank >= 4) { v0 = -1.0e30f; v1 = -1.0e30f; v2 = -1.0e30f; v3 = -1.0e30f; }
        int sel_e = 0; float sel_s = 0.f, ssum = 0.f;
#pragma unroll
        for (int rd = 0; rd < 8; ++rd) {
            float bv = v0; int bi = 0; float bs = s0;
            if (v1 > bv) { bv = v1; bi = 1; bs = s1; }
            if (v2 > bv) { bv = v2; bi = 2; bs = s2; }
            if (v3 > bv) { bv = v3; bi = 3; bs = s3; }
            const float mx = wave_max_uniform(bv);
            const unsigned long long bal = __ballot(bv == mx);
            const int ol = __builtin_amdgcn_readfirstlane((int)__builtin_ctzll(bal));
            const int oi = __builtin_amdgcn_readlane(bi, ol);
            const float sv = __builtin_bit_cast(float, __builtin_amdgcn_readlane(__builtin_bit_cast(int, bs), ol));
            if (lane == ol) { if (oi == 0) v0 = -3.0e30f; else if (oi == 1) v1 = -3.0e30f; else if (oi == 2) v2 = -3.0e30f; else v3 = -3.0e30f; }
            ssum += sv;
            if (lane == rd) { sel_e = 4 * ol + oi; sel_s = sv; }
        }
        if (lane < 8) {
            p.EIDX[(size_t)row * 8 + lane] = sel_e;
            p.EW[(size_t)row * 8 + lane] = sel_s / ssum * 2.5f;
            atomicAdd(&hist[sel_e], 1);
        }
    }
    __syncthreads();
    if (tz_ < 256) p.HIST[((size_t)L * 256 + blockIdx.x) * 256 + tz_] = hist[tz_];
    __syncthreads();
}

template <int L>
DI void ph_scatter(const Params& p, char* ldsc) {
    int* sbase = (int*)ldsc;
    int* cursor = sbase + 320;
    const int tid = opaque_tid(), lane = tid & 63, wv = tid >> 6;
    const int nrows = (L == 0) ? TT : TL;
    int mypre = 0;
    {
        int* part = sbase + 640;
        const int e = tid & 255, half = tid >> 8, nbh = ((int)gridDim.x + 1) >> 1;
        const int* hcol = p.HIST + (size_t)L * 256 * 256 + e;
        int tot = 0, pre = 0;
#pragma unroll 16
        for (int i = 0; i < nbh; ++i) {
            const int bq = half * nbh + i;
            const int hv = bq < (int)gridDim.x ? hcol[bq * 256] : 0;
            tot += hv; pre += (bq < (int)blockIdx.x) ? hv : 0;
        }
        part[half * 512 + e] = tot; part[half * 512 + 256 + e] = pre;
        __syncthreads();
        if (tid < 256) {
            tot = part[tid] + part[512 + tid]; mypre = part[256 + tid] + part[768 + tid];
            sbase[tid] = (tot + 255) & ~255;
        }
    }
    __syncthreads();
    {
        int pd = 0, inc = 0;
        if (tid < 256) {
            pd = sbase[tid]; inc = pd;
#pragma unroll
            for (int d = 1; d < 64; d <<= 1) { const int t = __shfl_up(inc, d); if (lane >= d) inc += t; }
            if (lane == 63) sbase[288 + wv] = inc;
        }
        __syncthreads();
        if (tid < 256) {
            int off = 0;
#pragma unroll
            for (int w = 0; w < 3; ++w) off += (w < wv) ? sbase[288 + w] : 0;
            const int excl = inc - pd + off;
            sbase[tid] = excl;
            if (tid == 255) sbase[256] = excl + pd;
        }
    }
    __syncthreads();
    if (tid < 256) cursor[tid] = sbase[tid] + mypre;
    if (blockIdx.x == 0) {
        int* te = p.TILE_E + L * MAXTILES; int* tr = p.TILE_R0 + L * MAXTILES;
        if (tid < 256) { const int b0 = sbase[tid], b1 = sbase[tid + 1]; for (int r = b0; r < b1; r += 256) { te[r >> 8] = tid; tr[r >> 8] = r; } }
        const int nt = sbase[256] >> 8, nsh = nrows / 256;
        for (int i = tid; i < nsh; i += NTHR) { te[nt + i] = 256; tr[nt + i] = SH_BASE + 256 * i; }
        if (tid == 0) p.ictl[1024 + L] = nt + nsh;
    }
    __syncthreads();
    int* stok = p.SLOT_TOK + (size_t)L * NSLOT; float* sw = p.SLOT_W + (size_t)L * NSLOT;
    for (int row = blockIdx.x * 8 + wv; row < nrows; row += gridDim.x * 8) {
        if (lane < 8) {
            const int a = row * 8 + lane;
            const int e = p.EIDX[a];
            const int pos = atomicAdd(&cursor[e], 1);
            stok[pos] = row; sw[pos] = p.EW[a]; p.APOS[a] = pos;
        }
    }
    __syncthreads();
}

template <int L>
DI void ph_moe1(const Params& p, char* lds) {
    const int tid = opaque_tid();
    const int ntiles = p.ictl[1024 + L];
    const int* te = p.TILE_E + L * MAXTILES; const int* tr = p.TILE_R0 + L * MAXTILES;
    const int* stok = p.SLOT_TOK + (size_t)L * NSLOT;
    int pend = 0, pendq = -1;
    gemm_stream<4, 2, 4, 4, PtrLoaderF, 2>(lds, ntiles * 4, 16, [&](int u, PtrLoader<4>& al, PtrLoaderF& bl, const int (&nx)[4]) {
        const int ti = u >> 2, tn = u & 3;
        const int e = te[ti];
#pragma unroll
        for (int i = 0; i < 4; ++i) al.p[i] = (unsigned)(nx[i] * 1024 + a_c8(tid) * 8);
        al.base = p.Abuf;
        const float* gsrc = e < 256 ? p.moe_w_gate + ((size_t)(L * 256 + e)) * 1024 * 256 : p.sh_w_gate + (size_t)L * 1024 * 256;
        const float* usrc = e < 256 ? p.moe_w_up + ((size_t)(L * 256 + e)) * 1024 * 256 : p.sh_w_up + (size_t)L * 1024 * 256;
        bl.ld = 256; bl.base0 = gsrc; bl.base1 = usrc;
#pragma unroll
        for (int i = 0; i < 4; ++i) bl.p[i] = (unsigned)((tid >> 3) * 256 + 32 * (2 * tn + (i >> 1)) + (tid & 7) * 4);
    }, [&](int u, int (&nx)[4], int sel) {
        const int row0 = tr[u >> 2];
        if (sel == 2) {
#pragma unroll
            for (int i = 0; i < 4; ++i) nx[i] = stok[row0 + a_row(tid) + 64 * i];
        } else {
#pragma unroll
            for (int i = 0; i < 4; ++i) nx[i] = (pendq == i) ? pend : nx[i];
            pendq = sel - 4;
            pend = stok[row0 + a_row(tid) + 64 * pendq];
        }
    }, [&](int u, int mi, const f32x4 (&a)[4], f32x4 (&o)[2], int r0, int c0) {
#pragma unroll
        for (int ni = 0; ni < 2; ++ni)
#pragma unroll
            for (int j = 0; j < 4; ++j) o[ni][j] = siluf_(a[ni][j]) * a[ni + 2][j];
    }, [&](int u, int r, int c, f32x4 v, f32x4 pv) {
        const int ti = u >> 2, tn = u & 3;
        u32x2 w; w.x = cvt_pk_bf16(v[0], v[1]); w.y = cvt_pk_bf16(v[2], v[3]);
        *(u32x2*)(p.HBUF + (size_t)(tr[ti] + r) * 256 + tn * 64 + c) = w;
    });
}
template <int L>
DI void ph_moe2(const Params& p, char* lds) {
    const int tid = opaque_tid();
    const int ntiles = p.ictl[1024 + L];
    const int* te = p.TILE_E + L * MAXTILES; const int* tr = p.TILE_R0 + L * MAXTILES;
    const float* sw = p.SLOT_W + (size_t)L * NSLOT;
    float sc4[4] = {0.f, 0.f, 0.f, 0.f};
    gemm_stream<4, 2, 4, 4, PtrLoaderF, 4>(lds, ntiles * 8, 4, [&](int u, PtrLoader<4>& al, PtrLoaderF& bl, const int (&nx)[4]) {
        const int ti = u >> 3, tn = u & 7;
        const int e = te[ti], row0 = tr[ti];
#pragma unroll
        for (int i = 0; i < 4; ++i) al.p[i] = (unsigned)((row0 + a_row(tid) + 64 * i) * 256 + a_c8(tid) * 8);
        al.base = p.HBUF;
        const float* dsrc = e < 256 ? p.moe_w_down + ((size_t)(L * 256 + e)) * 256 * 1024 : p.sh_w_down + (size_t)L * 256 * 1024;
        fill_bf(bl, dsrc, 1024, tn * 128, 1024);
    }, [&](int u, int (&nx)[4], int) {}, [&](int u, int mi, const f32x4 (&a)[4], f32x4 (&o)[4], int r0, int c0) {
        if (mi == 0) {
            const float* s_ = sw + tr[u >> 3] + r0;
#pragma unroll
            for (int m = 0; m < 4; ++m) sc4[m] = s_[16 * m];
        }
#pragma unroll
        for (int ni = 0; ni < 4; ++ni) o[ni] = a[ni] * sc4[mi];
    }, [&](int u, int r, int c, f32x4 v, f32x4 pv) {
        const int ti = u >> 3, tn = u & 7;
        const int row = tr[ti] + r;
        u32x2 w; w.x = cvt_pk_bf16(v[0], v[1]); w.y = cvt_pk_bf16(v[2], v[3]);
        *(u32x2*)(p.YB + (size_t)row * 1024 + tn * 128 + c) = w;
    });
}

template <int L>
DI void ph_combine(const Params& p) {
    const int tz_ = opaque_tid(), lane = tz_ & 63, wv = tz_ >> 6;
    const int nrows = (L == 0) ? TT : TL;
    for (int row = blockIdx.x * 8 + wv; row < nrows; row += gridDim.x * 8) {
        int rr[9];
#pragma unroll
        for (int k = 0; k < 8; ++k) rr[k] = p.APOS[(size_t)row * 8 + k];
        rr[8] = SH_BASE + row;
        const float* m = p.mods + (size_t)(L * 3 + mods_row(row)) * 6144;
        f32x4 v[4];
#pragma unroll
        for (int i = 0; i < 4; ++i) {
            const int c = 4 * lane + 256 * i;
            f32x4 ff = (f32x4){0.f, 0.f, 0.f, 0.f};
#pragma unroll
            for (int k = 0; k < 9; ++k) {
                const u32x2 w = *(const u32x2*)(p.YB + (size_t)rr[k] * 1024 + c);
                ff[0] += bflo(w.x); ff[1] += bfhi(w.x); ff[2] += bflo(w.y); ff[3] += bfhi(w.y);
            }
            v[i] = ALPHA * (*(const f32x4*)(p.HA + (size_t)row * 1024 + c)) + (*(const f32x4*)(m + 5120 + c)) * ff;
        }
        ln_row(v, p.ln_g + (L * 2 + 1) * 1024, p.ln_b + (L * 2 + 1) * 1024, lane);
        if (L == 0) {
            const float* m1 = p.mods + (size_t)(1 * 3 + mods_row(row)) * 6144;
#pragma unroll
            for (int i = 0; i < 4; ++i) {
                const int c = 4 * lane + 256 * i;
                *(f32x4*)(p.HB + (size_t)row * 1024 + c) = v[i];
                const f32x4 a = v[i] * (1.0f + *(const f32x4*)(m1 + 1024 + c)) + *(const f32x4*)(m1 + c);
                u32x2 w; w.x = cvt_pk_bf16(a[0], a[1]); w.y = cvt_pk_bf16(a[2], a[3]);
                *(u32x2*)(p.Abuf + (size_t)row * 1024 + c) = w;
            }
        } else {
#pragma unroll
            for (int i = 0; i < 4; ++i) *(f32x4*)(p.out + (size_t)row * 1024 + 4 * lane + 256 * i) = v[i];
        }
    }
}

DI void gemm_router(char* lds, const bf16_t* A, int M, const float* W, float* C) {
    const int tid = opaque_tid();
    const int ntn = 2, ntm = M / 128;
    gemm_stream<2, 4, 4, 2, PtrLoaderF, 2>(lds, ntn * ntm, 16, [&](int u, PtrLoader<2>& al, PtrLoaderF& bl, const int (&nx)[4]) {
        int tm, tn; tile_of(u, ntm, ntn, tm, tn);
#pragma unroll
        for (int i = 0; i < 2; ++i) al.p[i] = (unsigned)((tm * 128 + a_row(tid) + 64 * i) * 1024 + a_c8(tid) * 8);
        al.base = A;
        fill_bf(bl, W, 256, tn * 128, 256);
    }, [&](int u, int (&nx)[4], int) {}, [&](int u, int mi, const f32x4 (&a)[2], f32x4 (&o)[2], int r0, int c0) {
#pragma unroll
        for (int ni = 0; ni < 2; ++ni) o[ni] = a[ni];
    }, [&](int u, int r, int c, f32x4 v, f32x4 pv) {
        int tm, tn; tile_of(u, ntm, ntn, tm, tn);
        *(f32x4*)(C + (size_t)(tm * 128 + r) * 256 + tn * 128 + c) = v;
    });
}

DI void ph_inproj1(const Params& p, char* lds) {
    const int tid = opaque_tid();
    constexpr int NTN = 25, NTM = 66;
    gemm_stream<4, 2, 4, 4, PtrLoaderF, 4>(lds, NTN * NTM, 16, [&](int u, PtrLoader<4>& al, PtrLoaderF& bl, const int (&nx)[4]) {
        int tm, tn; tile_of(u, NTM, NTN, tm, tn);
#pragma unroll
        for (int i = 0; i < 4; ++i) al.p[i] = (unsigned)((tm * 256 + a_row(tid) + 64 * i) * 1024 + a_c8(tid) * 8);
        al.base = p.Abuf;
        fill_bf(bl, p.od_w_in, ODC, tn * 128, ODC);
    }, [&](int u, int (&nx)[4], int) {}, [&](int u, int mi, const f32x4 (&a)[4], f32x4 (&o)[4], int r0, int c0) {
#pragma unroll
        for (int ni = 0; ni < 4; ++ni) o[ni] = a[ni];
    }, [&](int u, int r, int c, f32x4 v, f32x4 pv) {
        int tm, tn; tile_of(u, NTM, NTN, tm, tn);
        const int row = tm * 256 + r, col = tn * 128 + c;
        if (tn < 8 && row < TL) {
            const int t = row & (TLB - 1);
            const float pos = (c & 32) ? (float)(t & 63) : (float)(t >> 6);
            const float sgn = (c & 16) ? 1.0f : -1.0f;
#pragma unroll
            for (int j = 0; j < 4; ++j) {
                const float ang = pos * exp2f(-(float)((c & 15) + j) * (13.287712379549449f / 16.0f));
                v[j] = v[j] * __cosf(ang) + sgn * pv[j] * __sinf(ang);
            }
            if (tn < 4) v = v * 0.125f;
        }
        if (tn < 24) {
            u32x2 w; w.x = cvt_pk_bf16(v[0], v[1]); w.y = cvt_pk_bf16(v[2], v[3]);
            *(u32x2*)(p.P1 + (size_t)row * 3072 + col) = w;
        } else if (col < ODC) *(f32x4*)(p.G1 + (size_t)row * 32 + (col - 3072)) = v;
    });
}

DI float wave_incl_sum(float v, int lane) {
#pragma unroll
    for (int d = 1; d < 64; d <<= 1) { const float t = __shfl_up(v, d); if (lane >= d) v += t; }
    return v;
}
DI float wave_incl_max(float v, int lane) {
#pragma unroll
    for (int d = 1; d < 64; d <<= 1) { const float t = __shfl_up(v, d); if (lane >= d) v = fmaxf(v, t); }
    return v;
}
DI void ml_gates(const Params& p, float* G, int row0, int h, float& ig, float& bc, float& tot, int& idx) {
    const int tid = opaque_tid(), lane = tid & 63, wv = tid >> 6;
    const int gi = (tid >> 7) & 1, e = tid & 127;
    idx = gi == 0 ? e : 127 - e;
    float c = 0.f; ig = 0.f;
    if (tid < 256) {
        const float* g = p.G1 + (size_t)(row0 + idx) * 32;
        ig = g[8 * gi + h] + p.ml_gate_b[8 * gi + h];
        const float lf = logsigmoidf_(g[16 + 8 * gi + h] + p.ml_gate_b[16 + 8 * gi + h]);
        c = wave_incl_sum(lf, lane);
        if (lane == 63) G[768 + wv] = c;
    }
    __syncthreads();
    if (tid < 256) {
        if (wv & 1) c += G[768 + wv - 1];
        G[gi * 128 + idx] = ig; G[256 + gi * 128 + idx] = c;
        if (e == 127) G[776 + gi] = c;
    }
    __syncthreads();
    bc = c; tot = G[776 + gi];
}

constexpr int MLC_T = 4096, MLC_TS = 392;
DI void ph_ml_chunks(const Params& p, char* ldsc) {
    float* G = (float*)ldsc;
    const int tid = opaque_tid(), lane = tid & 63, wv = tid >> 6, fr = lane & 15, fq = lane >> 4;
    for (int u = blockIdx.x; u < 1056; u += gridDim.x) {
        const bool lat = u < 1024;
        const int bh = lat ? (u >> 6) : ((u - 1024) >> 1), blk = lat ? (u & 63) : ((u - 1024) & 1);
        const int b = bh >> 3, h = bh & 7;
        const int Tseq = lat ? TLB : TCB;
        const int row0 = (lat ? b * TLB : TL + b * TCB) + blk * 128;
        {
            u32x4 rr[6];
#pragma unroll
            for (int i = 0; i < 6; ++i) {
                const int qd = tid + NTHR * i, row = qd / 24, cc = qd % 24;
                rr[i] = *(const u32x4*)(p.P1 + (size_t)(row0 + row) * 3072 + (cc < 8 ? 512 + h * 64 + cc * 8 : 1024 + h * 128 + (cc - 8) * 8));
            }
#pragma unroll
            for (int i = 0; i < 6; ++i) {
                const int qd = tid + NTHR * i, row = qd / 24, cc = qd % 24;
                char* d = ldsc + MLC_T + row * MLC_TS + cc * 16;
                *(u32x2*)d = (u32x2){rr[i].x, rr[i].y}; *(u32x2*)(d + 8) = (u32x2){rr[i].z, rr[i].w};
            }
        }
        float ig, bc, tot; int idx;
        ml_gates(p, G, row0, h, ig, bc, tot, idx);
        const float gl = tot - bc + ig;
        float mw = (tid < 256) ? wave_allmax(gl) : 0.f;
        if (tid < 256 && lane == 0) G[784 + wv] = mw;
        __syncthreads();
        if (tid < 256) {
            const int gi = tid >> 7;
            const float mc = fmaxf(G[784 + 2 * gi], G[784 + 2 * gi + 1]);
            G[512 + gi * 128 + idx] = __expf(gl - mc);
            if ((tid & 127) == 0) { p.BEMC[u * 4 + gi * 2 + 0] = tot; p.BEMC[u * 4 + gi * 2 + 1] = mc; }
        }
        __syncthreads();
        auto col8 = [&](int col, int l0) -> u32x4 {
            const char* s_ = ldsc + MLC_T + l0 * MLC_TS + col * 2;
            u32x4 w;
            w.x = (unsigned)*(const unsigned short*)(s_) | ((unsigned)*(const unsigned short*)(s_ + MLC_TS) << 16);
            w.y = (unsigned)*(const unsigned short*)(s_ + 2 * MLC_TS) | ((unsigned)*(const unsigned short*)(s_ + 3 * MLC_TS) << 16);
            w.z = (unsigned)*(const unsigned short*)(s_ + 4 * MLC_TS) | ((unsigned)*(const unsigned short*)(s_ + 5 * MLC_TS) << 16);
            w.w = (unsigned)*(const unsigned short*)(s_ + 6 * MLC_TS) | ((unsigned)*(const unsigned short*)(s_ + 7 * MLC_TS) << 16);
            return w;
        };
        f32x4 accf[4], accb[4];
#pragma unroll
        for (int n = 0; n < 4; ++n) { accf[n] = (f32x4){0.f, 0.f, 0.f, 0.f}; accb[n] = accf[n]; }
#pragma unroll
        for (int ks = 0; ks < 4; ++ks) {
            const int l0 = 32 * ks + 8 * fq;
            const bf16x8 va = __builtin_bit_cast(bf16x8, col8(64 + 16 * wv + fr, l0));
            const f32x4 wfa = *(const f32x4*)(G + 512 + l0), wfb = *(const f32x4*)(G + 512 + l0 + 4);
            const f32x4 wba = *(const f32x4*)(G + 640 + l0), wbb = *(const f32x4*)(G + 640 + l0 + 4);
#pragma unroll
            for (int n = 0; n < 4; ++n) {
                const u32x4 kr = col8(16 * n + fr, l0);
                const float k0 = bflo(kr.x), k1 = bfhi(kr.x), k2 = bflo(kr.y), k3 = bfhi(kr.y), k4 = bflo(kr.z), k5 = bfhi(kr.z), k6 = bflo(kr.w), k7 = bfhi(kr.w);
                u32x4 kf, kb;
                kf.x = cvt_pk_bf16(k0 * wfa[0], k1 * wfa[1]); kf.y = cvt_pk_bf16(k2 * wfa[2], k3 * wfa[3]);
                kf.z = cvt_pk_bf16(k4 * wfb[0], k5 * wfb[1]); kf.w = cvt_pk_bf16(k6 * wfb[2], k7 * wfb[3]);
                kb.x = cvt_pk_bf16(k0 * wba[0], k1 * wba[1]); kb.y = cvt_pk_bf16(k2 * wba[2], k3 * wba[3]);
                kb.z = cvt_pk_bf16(k4 * wbb[0], k5 * wbb[1]); kb.w = cvt_pk_bf16(k6 * wbb[2], k7 * wbb[3]);
                accf[n] = mfma16(va, __builtin_bit_cast(bf16x8, kf), accf[n]);
                accb[n] = mfma16(va, __builtin_bit_cast(bf16x8, kb), accb[n]);
            }
        }
        float* kvt = p.KVT + (size_t)u * 2 * 8192;
#pragma unroll
        for (int n = 0; n < 4; ++n)
#pragma unroll
            for (int j = 0; j < 4; ++j) {
                kvt[(16 * wv + 4 * fq + j) * 64 + 16 * n + fr] = accf[n][j];
                kvt[8192 + (16 * wv + 4 * fq + j) * 64 + 16 * n + fr] = accb[n][j];
            }
        if (tid < 128) {
            const int d = tid >> 6, k = tid & 63;
            float s = 0.f;
#pragma unroll 4
            for (int l = 0; l < 128; l += 8) {
                const u32x4 kq = col8(k, l);
                const f32x4 wa = *(const f32x4*)(G + 512 + d * 128 + l), wb = *(const f32x4*)(G + 512 + d * 128 + l + 4);
                s += bflo(kq.x) * wa[0] + bfhi(kq.x) * wa[1] + bflo(kq.y) * wa[2] + bfhi(kq.y) * wa[3]
                   + bflo(kq.z) * wb[0] + bfhi(kq.z) * wb[1] + bflo(kq.w) * wb[2] + bfhi(kq.w) * wb[3];
            }
            p.KS[(size_t)u * 128 + d * 64 + k] = s;
        }
        if (lat) {
            const int v = tid >> 2, part = tid & 3;
            bf16_t* dst = p.V1TL + ((size_t)(b * 1024 + h * 128 + v)) * TLB + blk * 128;
#pragma unroll
            for (int i = 0; i < 4; ++i) {
                const int tg = part + 4 * i;
                *(u32x4*)(dst + 8 * tg) = col8(64 + v, 8 * tg);
            }
        }
        __syncthreads();
    }
}

DI void ph_ml_scan(const Params& p) {
    const int tid = opaque_tid();
    for (int w = blockIdx.x; w < 256; w += gridDim.x) {
        const int chain = w & 31, slice = w >> 5;
        const int bh = chain >> 1, dir = chain & 1;
        const int e0 = slice * 1024 + tid * 2;
        float c0 = 0.f, c1 = 0.f, nn = 0.f, m = 0.f;
        const bool hasn = (slice == 0 && tid < 64);
        auto unit_of = [&](int s) -> int {
            if (s < 2) return 1024 + bh * 2 + (dir == 0 ? s : 1 - s);
            const int jj = s - 2; return bh * 64 + (dir == 0 ? jj : 63 - jj);
        };
        typedef float f32x2 __attribute__((ext_vector_type(2)));
        constexpr int DP = 6;
        f32x2 kvq[DP], bmq[DP]; float ksq[DP];
        const int nl = tid & 63;
#pragma unroll
        for (int j = 0; j < DP; ++j) {
            const int un = unit_of(j);
            kvq[j] = *(const f32x2*)(p.KVT + ((size_t)un * 2 + dir) * 8192 + e0);
            bmq[j] = *(const f32x2*)(p.BEMC + un * 4 + dir * 2);
            ksq[j] = p.KS[(size_t)un * 128 + dir * 64 + nl];
        }
#pragma unroll 1
        for (int s0 = 0; s0 < 66; s0 += DP) {
#pragma unroll
            for (int j = 0; j < DP; ++j) {
                const int s = s0 + j;
                const int u = unit_of(s);
                const f32x2 kv = kvq[j], bm = bmq[j]; const float ksv = ksq[j];
                {
                    const int sn = s + DP < 66 ? s + DP : 65;
                    const int un = unit_of(sn);
                    kvq[j] = *(const f32x2*)(p.KVT + ((size_t)un * 2 + dir) * 8192 + e0);
                    bmq[j] = *(const f32x2*)(p.BEMC + un * 4 + dir * 2);
                    ksq[j] = p.KS[(size_t)un * 128 + dir * 64 + nl];
                }
                {
                    bf16_t* ct = p.C0T + ((size_t)u * 2 + dir) * 8192;
                    *(unsigned*)(ct + e0) = cvt_pk_bf16(c0, c1);
                    if (hasn) p.N0[((size_t)u * 2 + dir) * 64 + tid] = nn;
                    if (slice == 0 && tid == 0) p.M0[u * 2 + dir] = m;
                }
                const float be = bm[0], mc = bm[1];
                const float mn = fmaxf(be + m, mc);
                const float fa = __expf(be + m - mn), fb = __expf(mc - mn);
                c0 = fa * c0 + fb * kv[0]; c1 = fa * c1 + fb * kv[1];
                nn = fa * nn + fb * ksv;
                m = mn;
            }
        }
    }
}

constexpr int MLO_K = 8192, MLO_VT = MLO_K + 16384, MLO_VTS = 272, MLO_C0 = MLO_VT + 128 * MLO_VTS, MLO_HS = 8192;
DI void ph_ml_out(const Params& p, char* ldsc) {
    float* G = (float*)ldsc;
    const int tid = opaque_tid(), lane = tid & 63, wv = tid >> 6, q = lane & 15, g = lane >> 4;
    for (int u = blockIdx.x; u < 1024; u += gridDim.x) {
        const int bh = u >> 6, blk = u & 63, b = bh >> 3, h = bh & 7;
        const int row0 = b * TLB + blk * 128;
        {
            u32x4 rk[2], rv[4], rc[4];
#pragma unroll
            for (int i = 0; i < 2; ++i) { const int pc = tid + i * NTHR; rk[i] = *(const u32x4*)(p.P1 + (size_t)(row0 + (pc >> 3)) * 3072 + 512 + h * 64 + (pc & 7) * 8); }
#pragma unroll
            for (int i = 0; i < 4; ++i) { const int pc = tid + i * NTHR; rv[i] = *(const u32x4*)(p.V1TL + ((size_t)(b * 1024 + h * 128 + (pc >> 4))) * TLB + blk * 128 + (pc & 15) * 8); }
#pragma unroll
            for (int i = 0; i < 4; ++i) { const int pc = tid + i * NTHR; rc[i] = *(const u32x4*)(p.C0T + (size_t)u * 2 * 8192 + (size_t)pc * 8); }
#pragma unroll
            for (int i = 0; i < 2; ++i) { const int pc = tid + i * NTHR; *(u32x4*)(ldsc + MLO_K + lds_byte(pc >> 3, (pc & 7) * 8)) = rk[i]; }
#pragma unroll
            for (int i = 0; i < 4; ++i) { const int pc = tid + i * NTHR; *(u32x4*)(ldsc + MLO_VT + (pc >> 4) * MLO_VTS + (pc & 15) * 16) = rv[i]; }
#pragma unroll
            for (int i = 0; i < 4; ++i) { const int pc = tid + i * NTHR; const int dd = pc >> 10, rr = (pc >> 3) & 127; *(u32x4*)(ldsc + MLO_C0 + dd * 16384 + lds_byte(rr, (pc & 7) * 8)) = rc[i]; }
        }
        float ig, bc, tot; int idx;
        ml_gates(p, G, row0, h, ig, bc, tot, idx);
        const float m0f = p.M0[u * 2 + 0], m0b = p.M0[u * 2 + 1];
        {
            float pm = (tid < 256) ? wave_incl_max(ig - bc, lane) : 0.f;
            if (tid < 256 && lane == 63) G[768 + wv] = pm;
            __syncthreads();
            if (tid < 256) {
                if (wv & 1) pm = fmaxf(pm, G[768 + wv - 1]);
                const int gi = tid >> 7;
                G[512 + gi * 128 + idx] = fmaxf(bc + pm, bc + (gi == 0 ? m0f : m0b));
            }
            __syncthreads();
        }
        const int tl = 16 * wv + q;
        const int trow = row0 + tl;
        bf16x8 qf[2];
#pragma unroll
        for (int ks = 0; ks < 2; ++ks) qf[ks] = *(const bf16x8*)(p.P1 + (size_t)trow * 3072 + h * 64 + 32 * ks + 8 * g);
        f32x4 st_[8];
#pragma unroll
        for (int st = 0; st < 8; ++st) {
            f32x4 s = (f32x4){0.f, 0.f, 0.f, 0.f};
#pragma unroll
            for (int ks = 0; ks < 2; ++ks) s = mfma16(*(const bf16x8*)(ldsc + MLO_K + lds_byte(16 * st + q, 32 * ks + 8 * g)), qf[ks], s);
            st_[st] = s;
        }
        f32x4 hsum[8];
#pragma unroll
        for (int vm = 0; vm < 8; ++vm) hsum[vm] = (f32x4){0.f, 0.f, 0.f, 0.f};
#pragma unroll 1
        for (int dir = 0; dir < 2; ++dir) {
            const float mt = G[512 + dir * 128 + tl];
            const float bt = G[256 + dir * 128 + tl];
            const float m0 = dir == 0 ? m0f : m0b;
            const float iw = __expf(bt + m0 - mt);
            const float* n0 = p.N0 + ((size_t)u * 2 + dir) * 64;
            float qn = 0.f;
#pragma unroll
            for (int ks = 0; ks < 2; ++ks) {
                const u32x4 w = __builtin_bit_cast(u32x4, qf[ks]);
                const f32x4 na = *(const f32x4*)(n0 + 32 * ks + 8 * g), nb = *(const f32x4*)(n0 + 32 * ks + 8 * g + 4);
                qn += bflo(w.x) * na[0] + bfhi(w.x) * na[1] + bflo(w.y) * na[2] + bfhi(w.y) * na[3] + bflo(w.z) * nb[0] + bfhi(w.z) * nb[1] + bflo(w.w) * nb[2] + bfhi(w.w) * nb[3];
            }
            qn += __shfl_xor(qn, 16); qn += __shfl_xor(qn, 32);
            f32x4 acc[8];
            const char* c0s = ldsc + MLO_C0 + dir * 16384;
#pragma unroll
            for (int vm = 0; vm < 8; ++vm) {
                f32x4 a = (f32x4){0.f, 0.f, 0.f, 0.f};
#pragma unroll
                for (int ks = 0; ks < 2; ++ks) a = mfma16(*(const bf16x8*)(c0s + lds_byte(16 * vm + q, 32 * ks + 8 * g)), qf[ks], a);
                acc[vm] = a * iw;
            }
            float rs = 0.f;
#pragma unroll
            for (int uu = 0; uu < 4; ++uu) {
                const bool need = dir == 0 ? (2 * uu <= wv) : (2 * uu + 1 >= wv);
                if (need) {
                    f32x4 pw[2];
#pragma unroll
                    for (int hf = 0; hf < 2; ++hf) {
                        const int st = 2 * uu + hf;
                        const f32x4 bs = *(const f32x4*)(G + 256 + dir * 128 + 16 * st + 4 * g);
                        const f32x4 is = *(const f32x4*)(G + dir * 128 + 16 * st + 4 * g);
                        f32x4 w;
#pragma unroll
                        for (int r = 0; r < 4; ++r) {
                            const int s = 16 * st + 4 * g + r;
                            const bool ok = dir == 0 ? (s <= tl) : (s >= tl);
                            const float dw = ok ? __expf(bt - bs[r] + is[r] - mt) : 0.f;
                            w[r] = st_[st][r] * dw;
                            rs += w[r];
                        }
                        pw[hf] = w;
                    }
                    const bf16x8 pb = pack8(pw[0], pw[1]);
#pragma unroll
                    for (int vm = 0; vm < 8; ++vm) {
                        const char* vr = ldsc + MLO_VT + (16 * vm + q) * MLO_VTS + (32 * uu + 4 * g) * 2;
                        const bf16x8 va = join8(*(const u32x2*)vr, *(const u32x2*)(vr + 32));
                        acc[vm] = mfma16(va, pb, acc[vm]);
                    }
                }
            }
            rs += __shfl_xor(rs, 16); rs += __shfl_xor(rs, 32);
            const float den = rs + iw * qn;
            const float dn = 1.0f / fmaxf(fabsf(den), __expf(-mt));
#pragma unroll
            for (int vm = 0; vm < 8; ++vm) hsum[vm] += acc[vm] * dn;
        }
        __syncthreads();
        float* HS = (float*)(ldsc + MLO_HS);
#pragma unroll
        for (int vm = 0; vm < 8; ++vm) *(f32x4*)(HS + tl * 132 + 16 * vm + 4 * g) = hsum[vm];
        __syncthreads();
        {
            const int t = tid >> 2, vq = (tid & 3) * 4;
            const float* hr = HS + t * 132 + vq;
            f32x4 hv[8];
            float ss = 0.f;
#pragma unroll
            for (int i = 0; i < 8; ++i) { hv[i] = *(const f32x4*)(hr + 16 * i); ss += (hv[i][0] * hv[i][0] + hv[i][1] * hv[i][1]) + (hv[i][2] * hv[i][2] + hv[i][3] * hv[i][3]); }
            ss += __shfl_xor(ss, 1); ss += __shfl_xor(ss, 2);
            const float rn = rsqrtf(ss * (1.0f / 128.0f) + 1e-6f);
            const size_t orow = (size_t)(row0 + t) * 1024 + h * 128 + vq;
#pragma unroll
            for (int i = 0; i < 8; ++i) {
                const f32x4 ng = *(const f32x4*)(p.ml_norm_g + h * 128 + vq + 16 * i);
                const u32x2 ow = *(const u32x2*)(p.P1 + (size_t)(row0 + t) * 3072 + 2048 + h * 128 + vq + 16 * i);
                f32x4 o;
                o[0] = hv[i][0] * rn * ng[0] * sigmoidf_(bflo(ow.x)); o[1] = hv[i][1] * rn * ng[1] * sigmoidf_(bfhi(ow.x));
                o[2] = hv[i][2] * rn * ng[2] * sigmoidf_(bflo(ow.y)); o[3] = hv[i][3] * rn * ng[3] * sigmoidf_(bfhi(ow.y));
                u32x2 w; w.x = cvt_pk_bf16(o[0], o[1]); w.y = cvt_pk_bf16(o[2], o[3]);
                *(u32x2*)(p.MIX + orow + 16 * i) = w;
            }
        }
        __syncthreads();
    }
}


#ifndef PROBE_MODE
#define PROBE_MODE 0
#endif
DI void ph_probe(const Params& p, char* lds) {
#if PROBE_MODE >= 1 && PROBE_MODE <= 4
    const int tid = opaque_tid();
    constexpr int NTN = 26, NTM = 66;
    gemm_stream<4, 2, 4, 4, PtrLoaderF, 4, PROBE_MODE>(lds, NTN * NTM, 16, [&](int u, PtrLoader<4>& al, PtrLoaderF& bl, const int (&nx)[4]) {
        int tm, tn; tile_of(u, NTM, NTN, tm, tn);
#pragma unroll
        for (int i = 0; i < 4; ++i) al.p[i] = (unsigned)((tm * 256 + a_row(tid) + 64 * i) * 1024 + a_c8(tid) * 8);
        al.base = p.Abuf;
        fill_bf(bl, p.ev_w_in, EVC, tn * 128, EVC);
    }, [&](int u, int (&nx)[4], int) {}, [&](int u, int mi, const f32x4 (&a)[4], f32x4 (&o)[4], int r0, int c0) {
#pragma unroll
        for (int ni = 0; ni < 4; ++ni) o[ni] = a[ni];
    }, [&](int u, int r, int c, f32x4 v, f32x4 pv) {
        int tm, tn; tile_of(u, NTM, NTN, tm, tn);
        const int row = tm * 256 + r, col = tn * 128 + c;
        if (tn < 12) {
            bf16_t* dst = (tn < 4 ? p.Q0 + col : (tn < 8 ? p.K0 + (col - 512) : p.V0 + (col - 1024))) + (size_t)row * 512;
            u32x2 w; w.x = cvt_pk_bf16(v[0], v[1]); w.y = cvt_pk_bf16(v[2], v[3]);
            *(u32x2*)dst = w;
        } else if (col < EVC) {
            *(f32x4*)(p.RWP + (size_t)row * RWC + (col - 1536)) = v;
        }
    });
#endif
}
constexpr int NPHASE = 27;
template <int PH>
DI void run_phase(const Params& p, char* lds) {
    if (PH == 0) ph_prologue(p, lds);
    if (PH == 1) ph_modulate0(p);
    if (PH == 2) ph_inproj0(p, lds);
    if (PH == 3) { for (int j = blockIdx.x; j < (TT / 64) * 8; j += gridDim.x) transpose_tile(lds, p.V0, 512, (j >> 3) * 64, (j & 7) * 64, p.VT0L, p.VT0C, 512); ph_rw_prep(p, lds); }
    if (PH == 4) ph_attn_cp<1>(p, lds);
    if (PH == 5) ph_sq(p, lds);
    if (PH == 6) ph_rw_readout(p);
    if (PH == 7) gemm_f32out(lds, p.MIX, TT, p.ev_w_out, 1024, p.YL);
    if (PH == 8) ph_ln1<0>(p);
    if (PH == 9) gemm_router(lds, p.Abuf, TT, p.moe_router, p.LOGITS);
    if (PH == 10) ph_route<0>(p, lds);
    if (PH == 11) ph_scatter<0>(p, lds);
    if (PH == 12) ph_moe1<0>(p, lds);
    if (PH == 13) ph_moe2<0>(p, lds);
    if (PH == 14) ph_combine<0>(p);
    if (PH == 15) ph_inproj1(p, lds);
    if (PH == 17) ph_ml_chunks(p, lds);
    if (PH == 18) ph_ml_scan(p);
    if (PH == 19) ph_ml_out(p, lds);
    if (PH == 20) gemm_f32out(lds, p.MIX, TL, p.od_w_out, 1024, p.YL);
    if (PH == 21) ph_ln1<1>(p);
    if (PH == 22) gemm_router(lds, p.Abuf, TL, p.moe_router + 1024 * 256, p.LOGITS);
    if (PH == 23) ph_route<1>(p, lds);
    if (PH == 24) ph_scatter<1>(p, lds);
    if (PH == 25) ph_moe1<1>(p, lds);
    if (PH == 26) ph_moe2<1>(p, lds);
    if (PH == 27) ph_combine<1>(p);
    if (PH == 28) { if (PROBE_MODE >= 1 && PROBE_MODE <= 4) ph_probe(p, lds); if (PROBE_MODE == 5) ph_attn_cp(p, lds); if (PROBE_MODE == 6) ph_sq(p, lds); if (PROBE_MODE == 7) ph_rw_prep(p, lds); if (PROBE_MODE == 17) ph_rw_prep<1>(p, lds); if (PROBE_MODE == 8) ph_attn_cp<1>(p, lds); if (PROBE_MODE == 9) ph_attn_cp<2>(p, lds); if (PROBE_MODE == 10) ph_route<0>(p, lds); if (PROBE_MODE == 11) ph_scatter<0>(p, lds); if (PROBE_MODE == 12) { ph_prologue(p, lds); } if (PROBE_MODE == 13) ph_rw_readout(p); if (PROBE_MODE == 14) gemm_f32out(lds, p.MIX, TT, p.ev_w_out, 1024, p.YL); if (PROBE_MODE == 15) { ph_ml_chunks(p, lds); } if (PROBE_MODE == 16) ph_ml_out(p, lds); }
}

#if MK_MULTI
template <int PH>
__global__ void __launch_bounds__(NTHR, 2) k_phase(Params p) {
    extern __shared__ __attribute__((aligned(16))) char lds[];
    run_phase<PH>(p, lds);
}
#else
template <int PH> struct PhaseSeq {
    static DI void run(const Params& p, char* lds, const XcdBarrier& bar) {
        PhaseSeq<PH - 1>::run(p, lds, bar);
        if constexpr (PH == 16) return;
        xcd_barrier(bar);
        if constexpr (((PROBE_DUP >> PH) & 1ull) != 0) {
            const int reps = 1 + (int)(__builtin_amdgcn_s_getreg((3 << 11) | 20) < 64u);
#pragma unroll 1
            for (int rep = 0; rep < reps; ++rep) run_phase<PH>(p, lds);
        } else run_phase<PH>(p, lds);
    }
};
template <> struct PhaseSeq<0> {
    static DI void run(const Params& p, char* lds, const XcdBarrier&) { if (PROBE_DUP & 1ull) run_phase<0>(p, lds); run_phase<0>(p, lds); }
};
__global__ void __launch_bounds__(NTHR, 2) k_mega(Params p) {
    extern __shared__ __attribute__((aligned(16))) char lds[];
    LAS unsigned* xb = (LAS unsigned*)(lds + LDS_XB);
    if (threadIdx.x == 0) { xb[0] = 0u; xb[1] = 0u; xb[2] = 0u; xb[3] = 0u; }
    __syncthreads();
    XcdBarrier bar = xcd_barrier_post(p.bar, (volatile LAS unsigned*)xb);
    PhaseSeq<PROBE_MODE ? 28 : 27>::run(p, lds, bar);
}
#endif

#if MK_MULTI
template <int PH> static void launch_all(const Params& p, hipStream_t s) {
    if constexpr (PH > 0) launch_all<PH - 1>(p, s);
    hipFuncSetAttribute((const void*)k_phase<PH>, hipFuncAttributeMaxDynamicSharedMemorySize, LDS_BYTES);
    hipLaunchKernelGGL(k_phase<PH>, dim3(256), dim3(NTHR), LDS_BYTES, s, p);
}
#endif

extern "C" void kernel_launch(void* const* d_in, const int* in_sizes, int n_in, void* d_out, int out_size, void* d_ws, size_t ws_size, hipStream_t stream) {
    Params p{};
    const float** f = (const float**)&p.x;
    for (int i = 0; i < 34; ++i) f[i] = (const float*)d_in[i];
    p.out = (float*)d_out;
    size_t off = 0;
    auto A = [&](size_t bytes) -> char* { char* r = (char*)d_ws + off; off += (bytes + 255) & ~(size_t)255; return r; };
    p.bar = (unsigned*)A(XCD_BAR_WORDS * 4);
    p.ictl = (int*)A(1026 * 4);
    p.mods = (float*)A((size_t)2 * 3 * 6144 * 4);
    p.Abuf = (bf16_t*)A((size_t)TT * 1024 * 2);
    p.CM = (bf16_t*)A((size_t)32 * CK_NCH * 4096 * 2);
    p.CRH = (bf16_t*)A((size_t)32 * CK_NCH * 1024 * 2);
    p.CN = (bf16_t*)A((size_t)32 * CK_NCH * 4096 * 2);
    p.CP3 = (bf16_t*)A((size_t)32 * CK_NCH * 1024 * 2);
    p.HA = (float*)A((size_t)TT * 1024 * 4);
    p.HB = (float*)A((size_t)TT * 1024 * 4);
    p.Q0 = (bf16_t*)A((size_t)TT * 512 * 2);
    p.K0 = (bf16_t*)A((size_t)TT * 512 * 2);
    p.V0 = (bf16_t*)A((size_t)TT * 512 * 2);
    p.VT0L = (bf16_t*)A((size_t)2 * 512 * TLB * 2);
    p.VT0C = (bf16_t*)A((size_t)2 * 512 * TCB * 2);
    p.RWP = (float*)A((size_t)TT * RWC * 4);
    p.MIX = (bf16_t*)A((size_t)TT * 1024 * 2);
    p.YL = (float*)A((size_t)TT * 1024 * 4);
    p.LOGITS = (float*)A((size_t)TT * 256 * 4);
    p.EIDX = (int*)A((size_t)TT * 8 * 4);
    p.EW = (float*)A((size_t)TT * 8 * 4);
    p.APOS = (int*)A((size_t)TT * 8 * 4);
    p.SLOT_TOK = (int*)A((size_t)2 * NSLOT * 4);
    p.SLOT_W = (float*)A((size_t)2 * NSLOT * 4);
    p.HIST = (int*)A((size_t)2 * 256 * 256 * 4);
    p.WF = (unsigned*)A((size_t)8 * 4 * 7 * 64 * 16);
    p.TILE_E = (int*)A((size_t)2 * MAXTILES * 4);
    p.TILE_R0 = (int*)A((size_t)2 * MAXTILES * 4);
    p.HBUF = (bf16_t*)A((size_t)NSLOT * 256 * 2);
    const size_t un0 = off;
    p.YB = (bf16_t*)A((size_t)NSLOT * 1024 * 2);
    const size_t un_end = off;
    off = un0;
    p.SW = (float*)A((size_t)2 * TT * 512 * 4);
    p.SBP = (unsigned*)A((size_t)TT * 512 * 16);
    p.SKP = p.SBP; p.SNV = p.SBP; p.SRG = p.SBP;
    p.BONUS = (float*)A((size_t)TT * 8 * 4);
    p.YS = (float*)A((size_t)2 * TT * 512 * 4);
    const size_t m0_end = off;
    off = un0;
    p.P1 = (bf16_t*)A((size_t)TT * 3072 * 2);
    p.K1TL = (bf16_t*)A((size_t)2 * 512 * TLB * 2);
    p.K1TC = (bf16_t*)A((size_t)2 * 512 * TCB * 2);
    p.V1TL = (bf16_t*)A((size_t)2 * 1024 * TLB * 2);
    p.V1TC = (bf16_t*)A((size_t)2 * 1024 * TCB * 2);
    p.G1 = (float*)A((size_t)TT * 32 * 4);
    p.KVT = (float*)A((size_t)1056 * 2 * 8192 * 4);
    p.KS = (float*)A((size_t)1056 * 128 * 4);
    p.BEMC = (float*)A((size_t)1056 * 4 * 4);
    p.C0T = (bf16_t*)A((size_t)1056 * 2 * 8192 * 2);
    p.N0 = (float*)A((size_t)1056 * 2 * 64 * 4);
    p.M0 = (float*)A((size_t)1056 * 2 * 4);
    const size_t m1_end = off;
    off = un_end > m0_end ? un_end : m0_end; off = off > m1_end ? off : m1_end;
    if (off > ws_size) return;
    hipMemsetAsync(p.bar, 0, XCD_BAR_WORDS * 4, stream);
#if MK_MULTI
    launch_all<27>(p, stream);
#else
    hipFuncSetAttribute((const void*)k_mega, hipFuncAttributeMaxDynamicSharedMemorySize, LDS_BYTES);
    hipLaunchKernelGGL(k_mega, dim3(256), dim3(NTHR), LDS_BYTES, stream, p);
#endif
}
```

```cpp
#include <hip/hip_runtime.h>
#include <stdint.h>

#ifndef MK_MULTI
#define MK_MULTI 0
#endif

#ifndef PROBE_DUP
#define PROBE_DUP 0ull
#endif
#define DI __device__ __forceinline__
typedef unsigned short bf16_t;
typedef short bf16x8 __attribute__((ext_vector_type(8)));
typedef float f32x4 __attribute__((ext_vector_type(4)));
typedef unsigned u32x4 __attribute__((ext_vector_type(4)));
typedef unsigned u32x2 __attribute__((ext_vector_type(2)));

constexpr int NTHR = 512;
constexpr int TLB = 8192, TCB = 256, TL = 16384, TC = 512, TT = 16896;
constexpr int EVC = 3296, ODC = 3104, RWC = 1760;
constexpr float ALPHA = 1.41421356237f;
constexpr int SH_BASE = 200704;
constexpr int NSLOT = SH_BASE + TT;
constexpr int MAXTILES = 784 + 66;
constexpr int EPI_OFF = 98304, EPI_WAVE_B = 4352;
constexpr int LDS_XB = 153600;
constexpr int LDS_BYTES = LDS_XB + 256;

#define XB_TMO      128
#define XB_XCNT(j)  (256  + 64 * (j))
#define XB_XSUB(j)  (1280 + 64 * (j))
#define XB_XGEN(j)  (2304 + 64 * (j))
#define XB_TOP      3328
#define XB_TOPGEN   3392
#define XCD_BAR_WORDS 3456
#define XB_SPIN_CAP (1u << 18)
#define LAS __attribute__((address_space(3)))

__device__ __forceinline__ unsigned xb_ld(unsigned* p)              { return __hip_atomic_load(p, __ATOMIC_RELAXED, __HIP_MEMORY_SCOPE_AGENT); }
__device__ __forceinline__ unsigned xb_add(unsigned* p, unsigned v) { return __hip_atomic_fetch_add(p, v, __ATOMIC_RELAXED, __HIP_MEMORY_SCOPE_AGENT); }
__device__ __forceinline__ unsigned xb_xcc_id() { return (unsigned)__builtin_amdgcn_s_getreg((3 << 11) | 20) & 0xFu; }
#define XB_SPIN(cond, bar) do { unsigned _sp = 0; while (cond) { __builtin_amdgcn_s_sleep(1); \
    if ((++_sp & 255u) == 0u) { if (xb_ld(&(bar)[XB_TMO])) break; if (_sp > XB_SPIN_CAP) { atomicAdd(&(bar)[XB_TMO], 1u); break; } } } } while (0)

struct XcdBarrier {
    unsigned* bar; unsigned x;
    volatile LAS unsigned* st;
};
__device__ __forceinline__ XcdBarrier xcd_barrier_post(unsigned* bar, volatile LAS unsigned* st) {
    XcdBarrier b; b.bar = bar; b.x = xb_xcc_id(); b.st = st;
    if (threadIdx.x == 0) (void)xb_add(&bar[XB_XCNT(b.x)], 1u);
    return b;
}
__device__ __forceinline__ void xcd_barrier_complete(unsigned* bar, unsigned x, unsigned& nloc, unsigned& nx) {
    const unsigned G = gridDim.x * gridDim.y * gridDim.z;
    unsigned sum, cnt, mine, sp = 0u;
    for (;;) {
        sum = 0u; cnt = 0u; mine = 0u;
#pragma unroll
        for (unsigned j = 0; j < 16; ++j) { const unsigned c = xb_ld(&bar[XB_XCNT(j)]); sum += c; cnt += (c > 0u) ? 1u : 0u; mine = (j == x) ? c : mine; }
        if (sum == G) break;
        __builtin_amdgcn_s_sleep(1);
        if ((++sp & 255u) == 0u) { if (xb_ld(&bar[XB_TMO])) break; if (sp > XB_SPIN_CAP) { atomicAdd(&bar[XB_TMO], 1u); break; } }
    }
    nloc = mine > 0u ? mine : 1u; nx = cnt > 0u ? cnt : 1u;
}
__device__ __forceinline__ void xcd_barrier(const XcdBarrier& b) {
    asm volatile("s_waitcnt vmcnt(0)" ::: "memory");
    __syncthreads();
    if (threadIdx.x == 0) {
        unsigned* bar = b.bar;
        __builtin_amdgcn_s_waitcnt(0);
        unsigned nloc = b.st[0], nx = b.st[1];
        if (nloc == 0u) { xcd_barrier_complete(bar, b.x, nloc, nx); b.st[0] = nloc; b.st[1] = nx; }
        const unsigned old = xb_add(&bar[XB_XSUB(b.x)], 1u);
        const unsigned gen = old / nloc;
        if (old + 1u == (gen + 1u) * nloc) {
            __builtin_amdgcn_fence(__ATOMIC_RELEASE, "agent");
            asm volatile("s_waitcnt vmcnt(0)" ::: "memory");
            const unsigned og = xb_add(&bar[XB_TOP], 1u);
            const unsigned tg = og / nx;
            if (og + 1u == (tg + 1u) * nx) xb_add(&bar[XB_TOPGEN], 1u);
            else XB_SPIN(xb_ld(&bar[XB_TOPGEN]) == tg, bar);
            __builtin_amdgcn_fence(__ATOMIC_ACQUIRE, "agent");
            xb_add(&bar[XB_XGEN(b.x)], 1u);
            asm volatile("s_waitcnt vmcnt(0)" ::: "memory");
        } else {
            XB_SPIN(xb_ld(&bar[XB_XGEN(b.x)]) == gen, bar);
            __builtin_amdgcn_fence(__ATOMIC_ACQUIRE, "agent");
            asm volatile("s_waitcnt vmcnt(0)" ::: "memory");
        }
    }
    __syncthreads();
}

struct Params {
    const float *x, *c, *ctx, *c_ctx, *ada_w, *ada_b, *ln_g, *ln_b, *ev_w_in, *ev_w_out, *na_rpb, *rw_mu, *rw_w0, *rw_w_up, *rw_a0,
        *rw_a_up, *rw_g_up, *rw_k_k, *rw_k_a, *rw_r_k, *rw_gn_g, *rw_gn_b, *od_w_in, *od_w_out, *ml_gate_b, *ml_norm_g, *moe_router,
        *moe_bias, *moe_w_gate, *moe_w_up, *moe_w_down, *sh_w_gate, *sh_w_up, *sh_w_down;
    float* out;
    unsigned* bar;
    int* ictl;
    float* mods;
    bf16_t* Abuf;
    float *HA, *HB;
    bf16_t *Q0, *K0, *V0, *VT0L, *VT0C;
    float* RWP;
    unsigned* WF;
    float *SW, *BONUS, *YS;
    unsigned *SBP, *SKP, *SNV, *SRG;
    bf16_t *CM, *CRH, *CN, *CP3;
    bf16_t* MIX;
    float* YL;
    float* LOGITS;
    int *EIDX, *APOS, *SLOT_TOK, *TILE_E, *TILE_R0, *HIST;
    float *EW, *SLOT_W;
    bf16_t *HBUF, *YB;
    bf16_t *P1, *K1TL, *K1TC, *V1TL, *V1TC, *C0T;
    float *G1, *KVT, *KS, *BEMC, *N0, *M0;
};

DI int opaque_tid() { int t = threadIdx.x; asm volatile("" : "+v"(t)); return t; }
typedef __bf16 bf16x2_t __attribute__((ext_vector_type(2)));
typedef float f32x2_t __attribute__((ext_vector_type(2)));
DI unsigned cvt_pk_bf16_asm(float lo, float hi) { unsigned r; asm volatile("v_cvt_pk_bf16_f32 %0, %1, %2" : "=v"(r) : "v"(lo), "v"(hi)); return r; }
DI unsigned cvt_pk_bf16(float lo, float hi) { const f32x2_t v = {lo, hi}; return __builtin_bit_cast(unsigned, __builtin_convertvector(v, bf16x2_t)); }
DI float bf2f(bf16_t b) { return __uint_as_float(((unsigned)b) << 16); }
DI float bflo(unsigned w) { return __uint_as_float(w << 16); }
DI float bfhi(unsigned w) { return __uint_as_float(w & 0xffff0000u); }
DI float sigmoidf_(float x) { return 1.0f / (1.0f + __expf(-x)); }
DI float siluf_(float x) { return x / (1.0f + __expf(-x)); }
DI float tanhf_(float x) { return 1.0f - 2.0f / (__expf(2.0f * x) + 1.0f); }
DI float softplusf_(float x) { return fmaxf(x, 0.f) + __logf(1.0f + __expf(-fabsf(x))); }
DI float logsigmoidf_(float x) { return -softplusf_(-x); }
DI f32x4 mfma16(bf16x8 a, bf16x8 b, f32x4 c) { return __builtin_amdgcn_mfma_f32_16x16x32_bf16(a, b, c, 0, 0, 0); }
DI bf16x8 pack8(f32x4 a, f32x4 b) {
    u32x4 w; w.x = cvt_pk_bf16(a[0], a[1]); w.y = cvt_pk_bf16(a[2], a[3]); w.z = cvt_pk_bf16(b[0], b[1]); w.w = cvt_pk_bf16(b[2], b[3]);
    return __builtin_bit_cast(bf16x8, w);
}
DI bf16x8 join8(u32x2 lo, u32x2 hi) { u32x4 w; w.x = lo.x; w.y = lo.y; w.z = hi.x; w.w = hi.y; return __builtin_bit_cast(bf16x8, w); }
DI float wave_allsum(float v) {
#pragma unroll
    for (int d = 1; d < 64; d <<= 1) v += __shfl_xor(v, d);
    return v;
}
DI float wave_allmax(float v) {
#pragma unroll
    for (int d = 1; d < 64; d <<= 1) v = fmaxf(v, __shfl_xor(v, d));
    return v;
}
template <int CTRL, int RM> DI float dpp_f(float x) {
    return __builtin_bit_cast(float, __builtin_amdgcn_update_dpp(0, __builtin_bit_cast(int, x), CTRL, RM, 0xF, false));
}
DI float wave_sum63(float x) {
    x += dpp_f<0xB1, 0xF>(x);
    x += dpp_f<0x4E, 0xF>(x);
    x += dpp_f<0x141, 0xF>(x);
    x += dpp_f<0x140, 0xF>(x);
    x += dpp_f<0x142, 0xA>(x);
    x += dpp_f<0x143, 0xC>(x);
    return x;
}
template <int CTRL> DI float dpp_add(float x) { return x + __builtin_bit_cast(float, __builtin_amdgcn_update_dpp(0, __builtin_bit_cast(int, x), CTRL, 0xF, 0xF, false)); }
DI float row16_allsum(float x) { x = dpp_add<0xB1>(x); x = dpp_add<0x4E>(x); x = dpp_add<0x141>(x); x = dpp_add<0x140>(x); return x; }
DI void seq_info(int row, int& t, int& T) { if (row < TL) { t = row & (TLB - 1); T = TLB; } else { t = (row - TL) & (TCB - 1); T = TCB; } }
DI int mods_row(int row) { return row < TL ? (row >> 13) : 2; }

DI int lds_byte(int r, int c) { const int st = (r >> 4) * 2 + (c >> 5), rr = r & 15, cc = c & 31, ob = rr * 64 + cc * 2; return st * 1024 + (ob ^ (((ob >> 9) & 1) << 5)); }

DI int a_row(int tid) { return (tid >> 4) * 2 + ((tid >> 2) & 1); }
DI int a_c8(int tid) { return ((tid >> 3) & 1) * 4 + (tid & 3); }
template <int NP> struct PtrLoader { const bf16_t* base; unsigned p[NP]; };
struct PtrLoaderF { const float* base0; const float* base1; unsigned p[4]; int ld; };
typedef short s16x4 __attribute__((ext_vector_type(4)));
DI int b_img(int k, int seg, int bo) { return 256 * k + 32 * (seg ^ ((k & 3) + 4 * ((k >> 3) & 1))) + bo; }
DI bf16x8 tr_frag(const char* base, int xl, int c, int ks) {
    const char* a = base + (xl ^ (c << 5)) + 8192 * ks;
    const s16x4 lo = __builtin_amdgcn_ds_read_tr16_b64_v4i16((LAS s16x4*)(a));
    const s16x4 hi = __builtin_amdgcn_ds_read_tr16_b64_v4i16((LAS s16x4*)(a + 1024));
    return __builtin_shufflevector(lo, hi, 0, 1, 2, 3, 4, 5, 6, 7);
}

DI void tile_of(int u, int ntm, int ntn, int& tm, int& tn) {
    const int gid = u / (4 * ntn), within = u % (4 * ntn);
    const int gsz = (ntm - gid * 4) < 4 ? (ntm - gid * 4) : 4;
    tm = gid * 4 + within % gsz; tn = within / gsz;
}
DI void fill_bf(PtrLoaderF& bl, const float* W, int ld, int n0, int nvalid) {
    bl.ld = ld; bl.base0 = W; bl.base1 = W;
    const int tz = opaque_tid();
#pragma unroll
    for (int i = 0; i < 4; ++i) { int n = n0 + 32 * i + (tz & 7) * 4; n = n < nvalid ? n : nvalid - 4; bl.p[i] = (unsigned)((tz >> 3) * ld + n); }
}
template <int V> struct IC { static constexpr int value = V; };
template <int WR, int WC, int MT, int NT, class BL, int NTU, int MODE = 0, class MK, class PF, class PRE, class SINK>
DI void gemm_stream(char* lds, int nunits, int nk, MK&& mk, PF&& pf, PRE&& pre, SINK&& sink) {
    constexpr bool BF32 = __is_same(BL, PtrLoaderF);
    constexpr int BM = WR * MT * 16, BN = WC * NT * 16, APC = BM * 8 / NTHR, BPC = BF32 ? 4 : BN * 8 / NTHR;
    constexpr int ABYTES = BM * 128, STAGE = (BM + BN) * 128;
    static_assert(WR * WC == 8, "8 waves");
    static_assert(!BF32 || BN == 128, "f32 B path is written for 128-column tiles");
    const int tid = opaque_tid(), lane = tid & 63, wid = tid >> 6, wr = wid / WC, wc = wid % WC, fr = lane & 15, fq = lane >> 4;
    const int ubase = (blockIdx.x & 7) * 32 + (blockIdx.x >> 3), ustep = (int)gridDim.x;
    if (ubase >= nunits) return;
    int lu = ubase, lkt = 0, cu = ubase, ckt = 0;
    int lun = (lu + ustep < nunits) ? lu + ustep : lu;
    f32x4 acc[MT][NT];
#pragma unroll
    for (int m = 0; m < MT; ++m)
#pragma unroll
        for (int n = 0; n < NT; ++n) acc[m][n] = (f32x4){0.f, 0.f, 0.f, 0.f};
    const int sa0 = lds_byte(a_row(tid), a_c8(tid) * 8);
    const int xl = b_img(8 * fq + ((lane & 15) >> 2), 0, 8 * (lane & 3));
    auto sbo = [&](int i) -> int {
        if constexpr (BF32) { const int k = tid >> 3, n4 = 8 * i + (tid & 7); return ABYTES + b_img(k, n4 >> 2, 8 * (n4 & 3)); }
        else return ABYTES + lds_byte((tid >> 3) + 64 * i, (tid & 7) * 8);
    };
    PtrLoader<APC> al; BL bl;
    int nx[4] = {0, 0, 0, 0};
    pf(lu, nx, 2);
    mk(lu, al, bl, nx);
    pf(lun, nx, 2);
    u32x4 ra[APC], rb[BPC];
    auto issue = [&](auto hc) {
        if constexpr (MODE == 2) return;
#pragma unroll
        for (int i = 0; i < APC; ++i) ra[i] = *(const u32x4*)(al.base + al.p[i] + lkt * 64);
#pragma unroll
        for (int i = 0; i < BPC; ++i) {
            if constexpr (BF32) rb[i] = *(const u32x4*)(((i & 1) ? bl.base1 : bl.base0) + bl.p[i] + (size_t)lkt * 64 * bl.ld);
            else rb[i] = *(const u32x4*)(bl.base + bl.p[i] + lkt * 64);
        }
        const int use[4] = {nx[0], nx[1], nx[2], nx[3]};
        pf(lun, nx, 4 + (lkt & 3));
        if (++lkt == nk) { lkt = 0; lu = lun; lun = (lu + ustep < nunits) ? lu + ustep : lu; mk(lu, al, bl, use); }
    };
    auto stash = [&](char* st) {
        if constexpr (MODE == 2) return;
#pragma unroll
        for (int i = 0; i < APC; ++i) *(u32x4*)(st + sa0 + 8192 * i) = ra[i];
#pragma unroll
        for (int i = 0; i < BPC; ++i) {
            if constexpr (BF32) {
                u32x2 w; w.x = cvt_pk_bf16_asm(__uint_as_float(rb[i].x), __uint_as_float(rb[i].y)); w.y = cvt_pk_bf16_asm(__uint_as_float(rb[i].z), __uint_as_float(rb[i].w));
                *(u32x2*)(st + sbo(i)) = w;
            } else *(u32x4*)(st + sbo(i)) = rb[i];
        }
    };
    auto compute = [&](const char* st) {
        if constexpr (MODE == 1) return;
#pragma unroll
        for (int ks = 0; ks < 2; ++ks) {
            bf16x8 af[MT], bfr[NT];
#pragma unroll
            for (int m = 0; m < MT; ++m) af[m] = *(const bf16x8*)(st + lds_byte(wr * MT * 16 + m * 16 + fr, ks * 32 + fq * 8));
#pragma unroll
            for (int n = 0; n < NT; ++n) {
                if constexpr (BF32) bfr[n] = tr_frag(st + ABYTES, xl, wc * NT + n, ks);
                else bfr[n] = *(const bf16x8*)(st + ABYTES + lds_byte(wc * NT * 16 + n * 16 + fr, ks * 32 + fq * 8));
            }
#pragma unroll
            for (int m = 0; m < MT; ++m)
#pragma unroll
                for (int n = 0; n < NT; ++n) acc[m][n] = mfma16(bfr[n], af[m], acc[m][n]);
        }
    };
    auto ep = [&](int u, f32x4 (&a)[MT][NT], int, int) {
        float* W = (float*)(lds + EPI_OFF + wid * EPI_WAVE_B);
        constexpr int LPR = NTU * 4, RPI = 64 / LPR, NJ = 16 / RPI;
        const int c4 = lane % LPR, rb = lane / LPR;
#pragma unroll
        for (int mi = 0; mi < MT; ++mi) {
            f32x4 o[NTU];
            pre(u, mi, a[mi], o, wr * MT * 16 + mi * 16 + fr, wc * NT * 16 + 4 * fq);
#pragma unroll
            for (int ni = 0; ni < NTU; ++ni) *(f32x4*)(W + fr * 68 + ni * 16 + 4 * fq) = o[ni];
#pragma unroll
            for (int j = 0; j < NJ; ++j) {
                const f32x4 v = *(const f32x4*)(W + (rb + RPI * j) * 68 + 4 * c4);
                const f32x4 pv = *(const f32x4*)(W + (rb + RPI * j) * 68 + 4 * (c4 ^ 4));
                sink(u, wr * MT * 16 + mi * 16 + rb + RPI * j, wc * NTU * 16 + 4 * c4, v, pv);
            }
        }
    };
    issue(IC<0>{});
    stash(lds);
    if (wid >= 4) issue(IC<1>{});
    __syncthreads();
    bool first = true;
    auto epilogue = [&]() {
        if (ckt == 0 && !first) {
            if constexpr (MODE == 0 || MODE == 4) ep(cu - ustep, acc, wr * MT * 16 + fr, wc * NT * 16 + 4 * fq);
            else { asm volatile("" :: "v"(acc[0][0]), "v"(acc[MT - 1][NT - 1])); }
#pragma unroll
            for (int m = 0; m < MT; ++m)
#pragma unroll
                for (int n = 0; n < NT; ++n) acc[m][n] = (f32x4){0.f, 0.f, 0.f, 0.f};
        }
    };
    while (cu < nunits) {
        if (wid < 4) {
            epilogue(); issue(IC<1>{}); compute(lds); stash(lds + STAGE);
            __syncthreads();
            issue(IC<0>{}); compute(lds + STAGE); stash(lds);
            __syncthreads();
        } else {
            stash(lds + STAGE); epilogue(); issue(IC<0>{}); compute(lds);
            __syncthreads();
            stash(lds); issue(IC<1>{}); compute(lds + STAGE);
            __syncthreads();
        }
        first = false;
        ckt += 2;
        if (ckt == nk) { ckt = 0; cu += ustep; }
    }
    if constexpr (MODE == 0 || MODE == 4) ep(cu - ustep, acc, wr * MT * 16 + fr, wc * NT * 16 + 4 * fq);
    else {
#pragma unroll
        for (int m = 0; m < MT; ++m)
#pragma unroll
            for (int n = 0; n < NT; ++n) asm volatile("" :: "v"(acc[m][n]));
        if constexpr (MODE == 1) { asm volatile("" :: "v"(ra[0]), "v"(rb[0])); }
    }
}

DI void ph_prologue(const Params& p, char* lds) {
    const int tid = opaque_tid(), bid = blockIdx.x, nb = gridDim.x;
    for (int i = bid * NTHR + tid; i < 1026; i += nb * NTHR) p.ictl[i] = 0;
    for (int i = bid * NTHR + tid; i < 2 * NSLOT; i += nb * NTHR) {
        const int s = i % NSLOT;
        p.SLOT_TOK[i] = s >= SH_BASE ? s - SH_BASE : 0;
        p.SLOT_W[i] = s >= SH_BASE ? 1.0f : 0.0f;
    }
    if (bid >= 192) {
        for (int idx = (bid - 192) * NTHR + tid; idx < 8 * 4 * 7 * 64; idx += (nb - 192) * NTHR) {
            const int ln = idx & 63, s = (idx >> 6) % 7, hn = (idx >> 6) / 7;
            const int c = hn * 16 + (ln & 15);
            const float* wc_ = (s < 2 ? p.rw_w_up + s * 32 * 512 : (s < 4 ? p.rw_a_up + (s - 2) * 32 * 512 : p.rw_g_up + (s - 4) * 32 * 512)) + 8 * (ln >> 4) * 512 + c;
            u32x4 w;
            w.x = cvt_pk_bf16(wc_[0], wc_[512]); w.y = cvt_pk_bf16(wc_[1024], wc_[1536]); w.z = cvt_pk_bf16(wc_[2048], wc_[2560]); w.w = cvt_pk_bf16(wc_[3072], wc_[3584]);
            *(u32x4*)(p.WF + (size_t)idx * 4) = w;
        }
    }
    constexpr int J_MODS = 192;
    for (int job = bid; job < J_MODS; job += nb) {
        const int j = job;
        if (j < J_MODS) {
            const int l = j / 96, cb = j % 96;
            float* sc = (float*)lds;
            float* red = sc + 3072;
            for (int idx = tid; idx < 3072; idx += NTHR) {
                const int r = idx >> 10, k = idx & 1023;
                const float cv = r < 2 ? p.c[r * 1024 + k] : p.c_ctx[k];
                sc[idx] = siluf_(cv);
            }
            __syncthreads();
            const int kq = tid >> 6, cl = tid & 63, col = cb * 64 + cl;
            float a0 = 0.f, a1 = 0.f, a2 = 0.f;
            const float* w = p.ada_w + (size_t)l * 1024 * 6144 + col;
            for (int k = kq * 128; k < kq * 128 + 128; ++k) {
                const float wv = w[(size_t)k * 6144];
                a0 += sc[k] * wv; a1 += sc[1024 + k] * wv; a2 += sc[2048 + k] * wv;
            }
            red[(kq * 3 + 0) * 64 + cl] = a0; red[(kq * 3 + 1) * 64 + cl] = a1; red[(kq * 3 + 2) * 64 + cl] = a2;
            __syncthreads();
            if (tid < 192) {
                const int r = tid >> 6, c2 = tid & 63;
                float s = 0.f;
#pragma unroll
                for (int q = 0; q < 8; ++q) s += red[(q * 3 + r) * 64 + c2];
                p.mods[(size_t)(l * 3 + r) * 6144 + cb * 64 + c2] = s + p.ada_b[l * 6144 + cb * 64 + c2];
            }
            __syncthreads();
            continue;
        }
    }
}

DI void ph_modulate0(const Params& p) {
    const int nb = gridDim.x;
#pragma unroll 4
    for (int i = blockIdx.x * NTHR + opaque_tid(); i < TT * 256; i += nb * NTHR) {
        const int row = i >> 8, c = (i & 255) * 4;
        const float* src = row < TL ? p.x + (size_t)row * 1024 : p.ctx + (size_t)(row - TL) * 1024;
        const float* m = p.mods + (size_t)(0 * 3 + mods_row(row)) * 6144;
        const f32x4 v = *(const f32x4*)(src + c), sh = *(const f32x4*)(m + c), scv = *(const f32x4*)(m + 1024 + c);
        const f32x4 a = v * (1.0f + scv) + sh;
        u32x2 w; w.x = cvt_pk_bf16(a[0], a[1]); w.y = cvt_pk_bf16(a[2], a[3]);
        *(u32x2*)(p.Abuf + (size_t)row * 1024 + c) = w;
    }
}

DI void ph_inproj0(const Params& p, char* lds) {
    const int tid = opaque_tid();
    constexpr int NTN = 26, NTM = 66;
    gemm_stream<4, 2, 4, 4, PtrLoaderF, 4>(lds, NTN * NTM, 16, [&](int u, PtrLoader<4>& al, PtrLoaderF& bl, const int (&nx)[4]) {
        int tm, tn; tile_of(u, NTM, NTN, tm, tn);
#pragma unroll
        for (int i = 0; i < 4; ++i) al.p[i] = (unsigned)((tm * 256 + a_row(tid) + 64 * i) * 1024 + a_c8(tid) * 8);
        al.base = p.Abuf;
        fill_bf(bl, p.ev_w_in, EVC, tn * 128, EVC);
    }, [&](int u, int (&nx)[4], int) {}, [&](int u, int mi, const f32x4 (&a)[4], f32x4 (&o)[4], int r0, int c0) {
#pragma unroll
        for (int ni = 0; ni < 4; ++ni) o[ni] = a[ni];
    }, [&](int u, int r, int c, f32x4 v, f32x4 pv) {
        int tm, tn; tile_of(u, NTM, NTN, tm, tn);
        const int row = tm * 256 + r, col = tn * 128 + c;
        if (tn < 12) {
            bf16_t* dst = (tn < 4 ? p.Q0 + col : (tn < 8 ? p.K0 + (col - 512) : p.V0 + (col - 1024))) + (size_t)row * 512;
            u32x2 w; w.x = cvt_pk_bf16(v[0], v[1]); w.y = cvt_pk_bf16(v[2], v[3]);
            *(u32x2*)dst = w;
        } else if (col < EVC) {
            *(f32x4*)(p.RWP + (size_t)row * RWC + (col - 1536)) = v;
        }
    });
}

DI void transpose_tile(char* ldsc, const bf16_t* src, int ld, int row0, int col0, bf16_t* dstL, bf16_t* dstC, int ncols) {
    bf16_t* T = (bf16_t*)ldsc;
    const int tid = opaque_tid();
    {
        const int tok = tid >> 3, d8 = tid & 7;
        *(u32x4*)(T + tok * 72 + d8 * 8) = *(const u32x4*)(src + (size_t)(row0 + tok) * ld + col0 + d8 * 8);
    }
    __syncthreads();
    {
        const int d = tid >> 3, t8 = tid & 7;
        u32x4 w;
        w.x = (unsigned)T[(t8 * 8 + 0) * 72 + d] | ((unsigned)T[(t8 * 8 + 1) * 72 + d] << 16);
        w.y = (unsigned)T[(t8 * 8 + 2) * 72 + d] | ((unsigned)T[(t8 * 8 + 3) * 72 + d] << 16);
        w.z = (unsigned)T[(t8 * 8 + 4) * 72 + d] | ((unsigned)T[(t8 * 8 + 5) * 72 + d] << 16);
        w.w = (unsigned)T[(t8 * 8 + 6) * 72 + d] | ((unsigned)T[(t8 * 8 + 7) * 72 + d] << 16);
        bf16_t* dst;
        if (row0 < TL) dst = dstL + ((size_t)((row0 >> 13) * ncols + col0 + d)) * TLB + (row0 & (TLB - 1));
        else { const int rc = row0 - TL; dst = dstC + ((size_t)((rc >> 8) * ncols + col0 + d)) * TCB + (rc & (TCB - 1)); }
        *(u32x4*)(dst + t8 * 8) = w;
    }
    __syncthreads();
}

template <int NOSTORE = 0>
DI void ph_rw_prep(const Params& p, char* ldsc) {
    constexpr int TG = 16, LRP = 232;
    bf16_t* LR = (bf16_t*)ldsc;
    const int tid = opaque_tid(), lane = tid & 63, hh = tid >> 6, q = lane & 15, g = lane >> 4;
    bf16_t* SH = (bf16_t*)(ldsc + 8192);
    bf16x8 wq[7];
    auto wload = [&](int nt_) {
        unsigned co_ = (unsigned)(((hh * 4 + nt_) * 7 * 64 + lane) * 4); asm volatile("" : "+v"(co_));
#pragma unroll
        for (int s = 0; s < 7; ++s) wq[s] = __builtin_bit_cast(bf16x8, *(const u32x4*)(p.WF + co_ + s * 256));
    };
    wload(0);
    for (int grp = blockIdx.x; grp < TT / TG; grp += gridDim.x) {
        const int row0 = grp * TG;
        int t0, Tseq; seq_info(row0, t0, Tseq);
#pragma unroll 4
        for (int idx = tid; idx < TG * 440; idx += NTHR) {
            const int tk = idx / 440, c4 = (idx % 440) * 4;
            const int t = t0 + tk;
            const float* pr = p.RWP + (size_t)(row0 + tk) * RWC + c4;
            const f32x4 pc = *(const f32x4*)pr;
            const f32x4 pv = t > 0 ? *(const f32x4*)(pr - RWC) : (f32x4){0.f, 0.f, 0.f, 0.f};
            const f32x4 nx = t < Tseq - 1 ? *(const f32x4*)(pr + RWC) : (f32x4){0.f, 0.f, 0.f, 0.f};
            const f32x4 mu = *(const f32x4*)(p.rw_mu + c4);
            f32x4 v = pc + mu * (0.5f * (pv + nx) - pc);
            if (c4 < 1536) {
                u32x2 w; w.x = cvt_pk_bf16(v[0], v[1]); w.y = cvt_pk_bf16(v[2], v[3]);
                *(u32x2*)(SH + tk * 1536 + c4) = w;
            } else {
                const int j = c4 - 1536;
                if (j < 64) { v[0] = tanhf_(v[0]); v[1] = tanhf_(v[1]); v[2] = tanhf_(v[2]); v[3] = tanhf_(v[3]); }
                else if (j >= 128) { v[0] = sigmoidf_(v[0]); v[1] = sigmoidf_(v[1]); v[2] = sigmoidf_(v[2]); v[3] = sigmoidf_(v[3]); }
                u32x2 w; w.x = cvt_pk_bf16(v[0], v[1]); w.y = cvt_pk_bf16(v[2], v[3]);
                *(u32x2*)(LR + tk * LRP + j) = w;
            }
        }
        __syncthreads();
        float nrm[4];
#pragma unroll
        for (int r = 0; r < 4; ++r) {
            float ss = 0.f;
#pragma unroll
            for (int nt = 0; nt < 4; ++nt) {
                const int c = hh * 64 + 16 * nt + q;
                const float kk0 = bf2f(SH[(4 * g + r) * 1536 + 512 + c]) * p.rw_k_k[c];
                ss += kk0 * kk0;
            }
            nrm[r] = 1.0f / fmaxf(sqrtf(row16_allsum(ss)), 1e-12f);
        }
        float bon[4] = {0.f, 0.f, 0.f, 0.f};
        const f32x4 z4 = (f32x4){0.f, 0.f, 0.f, 0.f};
#pragma unroll
        for (int nt = 0; nt < 4; ++nt) {
            const int c = hh * 64 + 16 * nt + q;
            auto afrag = [&](int s) -> bf16x8 { return *(const bf16x8*)(LR + q * LRP + 32 * s + 8 * g); };
            f32x4 wl0, wl1, al0, al1, gl;
            {
                bf16x8 wc[7];
#pragma unroll
                for (int s = 0; s < 7; ++s) wc[s] = wq[s];
                wload((nt + 1) & 3);
                wl0 = mfma16(afrag(0), wc[0], z4); wl1 = mfma16(afrag(1), wc[1], z4); al0 = mfma16(afrag(2), wc[2], z4); al1 = mfma16(afrag(3), wc[3], z4);
                gl = mfma16(afrag(6), wc[6], mfma16(afrag(5), wc[5], mfma16(afrag(4), wc[4], z4)));
            }
            asm volatile("" ::: "memory");
            const float kkw = p.rw_k_k[c], kaw = p.rw_k_a[c], rkw = p.rw_r_k[c];
            const float w00 = p.rw_w0[c], w01 = p.rw_w0[512 + c], a00 = p.rw_a0[c], a01 = p.rw_a0[512 + c];
#pragma unroll
            for (int r = 0; r < 4; ++r) {
                const int row = row0 + 4 * g + r;
                const bf16_t* sh = SH + (4 * g + r) * 1536 + c;
                const float r_ = bf2f(sh[0]), k_ = bf2f(sh[512]), v_ = bf2f(sh[1024]);
                const float kk = k_ * kkw * nrm[r];
                const float wlog0 = -softplusf_(-(w00 + wl0[r])) - 0.5f, wlog1 = -softplusf_(-(w01 + wl1[r])) - 0.5f;
                const float dec0 = __expf(-__expf(wlog0)), dec1 = __expf(-__expf(wlog1));
                const float av0 = sigmoidf_(a00 + al0[r]), av1 = sigmoidf_(a01 + al1[r]);
                const float kd0 = k_ * (1.0f + (av0 - 1.0f) * kaw), kd1 = k_ * (1.0f + (av1 - 1.0f) * kaw);
                bon[r] += r_ * (kd0 + kd1) * rkw;
                const size_t o = (size_t)row * 512 + c;
                if (NOSTORE) { asm volatile("" :: "v"(dec0), "v"(dec1), "v"(kk * av0 + kk * av1 + kd0 + kd1 + v_ + gl[r])); continue; }
                typedef float f32x2s __attribute__((ext_vector_type(2)));
                *(f32x2s*)(p.SW + 2 * o) = (f32x2s){dec0, dec1};
                *(u32x4*)(p.SBP + 4 * o) = (u32x4){cvt_pk_bf16(kk * av0, kk * av1), cvt_pk_bf16(kd0, kd1), cvt_pk_bf16(-kk, v_), cvt_pk_bf16(r_, gl[r])};
                if (r & 1) asm volatile("" ::: "memory");
            }
        }
#pragma unroll
        for (int r = 0; r < 4; ++r) {
            const float bs = row16_allsum(bon[r]);
            if (q == 0) p.BONUS[(row0 + 4 * g + r) * 8 + hh] = bs;
        }
        __syncthreads();
    }
}

template <bool LAT>
DI void na_unit(const Params& p, int b, int r, int h, int w, int lane) {
    const int q = lane & 15, g = lane >> 4;
    const int j = 16 * w + q;
    const int qtok = LAT ? (b * TLB + r * 64 + j) : (TL + b * TCB + j);
    bf16x8 qf[2];
#pragma unroll
    for (int ks = 0; ks < 2; ++ks) qf[ks] = *(const bf16x8*)(p.Q0 + (size_t)qtok * 512 + h * 64 + 32 * ks + 8 * g);
    const int row_start = LAT ? (r - 4 < 0 ? 0 : (r - 4 > 120 ? 120 : r - 4)) : 0;
    const int c0 = LAT ? (w == 0 ? 0 : (w == 1 ? 8 : (w == 2 ? 24 : 32))) : 0;
    int cs = j - 8; cs = cs < 0 ? 0 : (cs > 48 ? 48 : cs);
    auto score_local = [&](int a, int tt) -> f32x4 {
        const int ktok = b * TLB + (row_start + a) * 64 + c0 + 16 * tt + q;
        f32x4 s = (f32x4){0.f, 0.f, 0.f, 0.f};
#pragma unroll
        for (int ks = 0; ks < 2; ++ks) {
            const bf16x8 kf = *(const bf16x8*)(p.K0 + (size_t)ktok * 512 + h * 64 + 32 * ks + 8 * g);
            s = mfma16(kf, qf[ks], s);
        }
        const int row_off = row_start + a - r + 7;
#pragma unroll
        for (int rr = 0; rr < 4; ++rr) {
            const int cc = c0 + 16 * tt + 4 * g + rr;
            int co = cc - j; co = co < -15 ? -15 : (co > 15 ? 15 : co);
            const bool in = (cc >= cs) && (cc < cs + 16);
            const float bias = p.na_rpb[(h * 15 + row_off) * 31 + co + 15];
            s[rr] = in ? (s[rr] * 0.125f + bias) : -1.0e30f;
        }
        return s;
    };
    auto score_ctx = [&](int ct) -> f32x4 {
        const int ktok = TL + b * TCB + 16 * ct + q;
        f32x4 s = (f32x4){0.f, 0.f, 0.f, 0.f};
#pragma unroll
        for (int ks = 0; ks < 2; ++ks) {
            const bf16x8 kf = *(const bf16x8*)(p.K0 + (size_t)ktok * 512 + h * 64 + 32 * ks + 8 * g);
            s = mfma16(kf, qf[ks], s);
        }
        return s * 0.125f;
    };
    float mx = -3.0e38f;
    if (LAT) {
        for (int a = 0; a < 8; ++a) {
#pragma unroll
            for (int tt = 0; tt < 2; ++tt) { const f32x4 s = score_local(a, tt); mx = fmaxf(mx, fmaxf(fmaxf(s[0], s[1]), fmaxf(s[2], s[3]))); }
        }
    }
    for (int ct = 0; ct < 16; ++ct) { const f32x4 s = score_ctx(ct); mx = fmaxf(mx, fmaxf(fmaxf(s[0], s[1]), fmaxf(s[2], s[3]))); }
    mx = fmaxf(mx, __shfl_xor(mx, 16)); mx = fmaxf(mx, __shfl_xor(mx, 32));
    float sum = 0.f;
    f32x4 o[4];
#pragma unroll
    for (int dm = 0; dm < 4; ++dm) o[dm] = (f32x4){0.f, 0.f, 0.f, 0.f};
    if (LAT) {
        for (int a = 0; a < 8; ++a) {
            f32x4 s0 = score_local(a, 0), s1 = score_local(a, 1);
#pragma unroll
            for (int rr = 0; rr < 4; ++rr) { s0[rr] = __expf(s0[rr] - mx); s1[rr] = __expf(s1[rr] - mx); sum += s0[rr] + s1[rr]; }
            const bf16x8 pb = pack8(s0, s1);
#pragma unroll
            for (int dm = 0; dm < 4; ++dm) {
                const bf16_t* vr = p.VT0L + ((size_t)(b * 512 + h * 64 + 16 * dm + q)) * TLB + (row_start + a) * 64 + c0 + 4 * g;
                const bf16x8 va = join8(*(const u32x2*)vr, *(const u32x2*)(vr + 16));
                o[dm] = mfma16(va, pb, o[dm]);
            }
        }
    }
    for (int u = 0; u < 8; ++u) {
        f32x4 s0 = score_ctx(2 * u), s1 = score_ctx(2 * u + 1);
#pragma unroll
        for (int rr = 0; rr < 4; ++rr) { s0[rr] = __expf(s0[rr] - mx); s1[rr] = __expf(s1[rr] - mx); sum += s0[rr] + s1[rr]; }
        const bf16x8 pb = pack8(s0, s1);
#pragma unroll
        for (int dm = 0; dm < 4; ++dm) {
            const bf16_t* vr = p.VT0C + ((size_t)(b * 512 + h * 64 + 16 * dm + q)) * TCB + 32 * u + 4 * g;
            const bf16x8 va = join8(*(const u32x2*)vr, *(const u32x2*)(vr + 16));
            o[dm] = mfma16(va, pb, o[dm]);
        }
    }
    sum += __shfl_xor(sum, 16); sum += __shfl_xor(sum, 32);
    const float inv = 1.0f / sum;
#pragma unroll
    for (int dm = 0; dm < 4; ++dm) {
        u32x2 wv; wv.x = cvt_pk_bf16(o[dm][0] * inv, o[dm][1] * inv); wv.y = cvt_pk_bf16(o[dm][2] * inv, o[dm][3] * inv);
        *(u32x2*)(p.MIX + (size_t)qtok * 1024 + h * 64 + 16 * dm + 4 * g) = wv;
    }
}

constexpr int CK_NCH = (TCB + TLB) / 16;
constexpr int CPW = 19200;
constexpr int CP_TMU = 0, CP_TMB = 2304, CP_TMK = 4608, CP_TMR = 6912, CP_TRU = 9216, CP_TRB = 11264, CP_TRV = 13312;
constexpr int CP_TT = 15360, CP_ARB = 15872, CP_AUKT = 16384, CP_H = 16896, CP_Q = 17408, CP_AUB = 17920, CP_G = 18944;
constexpr int CP_GT = CP_TMU, CP_WT = CP_TMB;

DI void cp_unit(const Params& p, char* W, int unit, int lane) {
    const int chain = unit / CK_NCH, c = unit % CK_NCH;
    const int b = chain >> 4, h = (chain >> 1) & 7, dir = chain & 1;
    const int q = lane & 15, g = lane >> 4;
    auto step_row = [&](int i) -> int {
        if (i < TCB) return TL + b * TCB + (dir == 0 ? i : TCB - 1 - i);
        const int jj = i - TCB;
        return b * TLB + (dir == 0 ? jj : TLB - 1 - jj);
    };
    {
        const float* SWd = p.SW + 2 * (h * 64 + lane) + dir;
        const u32x4* P4d = (const u32x4*)p.SBP + h * 64 + lane;
        float gam = 1.0f;
        unsigned pu[8], pb[8], pv[8];
        float lu = 0.f, lb = 0.f, lv = 0.f;
#pragma unroll
        for (int i4 = 0; i4 < 4; ++i4) {
            float w_[4], n_[4], b_[4], k_[4], r_[4], v_[4];
#pragma unroll
            for (int e = 0; e < 4; ++e) {
                const size_t ro = (size_t)step_row(c * 16 + 4 * i4 + e) * 512;
                w_[e] = SWd[2 * ro];
                { const u32x4 pk = P4d[ro]; const unsigned nv = pk.z, bw = pk.x, kw = pk.y, rw = pk.w;
                  n_[e] = bflo(nv); v_[e] = bfhi(nv); b_[e] = dir ? bfhi(bw) : bflo(bw); k_[e] = dir ? bfhi(kw) : bflo(kw); r_[e] = bflo(rw); }
            }
#pragma unroll
            for (int e = 0; e < 4; ++e) {
                const int i = 4 * i4 + e;
                const float gp = gam; gam *= w_[e];
                const float ig = 1.0f / gam;
                const float ut = gp * n_[e], bt = b_[e] * ig, kt = k_[e] * ig, rt = gam * r_[e];
                const unsigned wub = cvt_pk_bf16(ut, bt), wkr = cvt_pk_bf16(kt, rt);
                *(bf16_t*)(W + CP_TMU + i * 144 + lane * 2) = (bf16_t)(wub & 0xffff);
                *(bf16_t*)(W + CP_TMB + i * 144 + lane * 2) = (bf16_t)(wub >> 16);
                *(bf16_t*)(W + CP_TMK + i * 144 + lane * 2) = (bf16_t)(wkr & 0xffff);
                *(bf16_t*)(W + CP_TMR + i * 144 + lane * 2) = (bf16_t)(wkr >> 16);
                if (i & 1) { pu[i >> 1] = cvt_pk_bf16(lu, ut); pb[i >> 1] = cvt_pk_bf16(lb, bt); pv[i >> 1] = cvt_pk_bf16(lv, v_[e]); }
                else { lu = ut; lb = bt; lv = v_[e]; }
            }
        }
        *(u32x4*)(W + CP_TRU + lane * 32) = (u32x4){pu[0], pu[1], pu[2], pu[3]}; *(u32x4*)(W + CP_TRU + lane * 32 + 16) = (u32x4){pu[4], pu[5], pu[6], pu[7]};
        *(u32x4*)(W + CP_TRB + lane * 32) = (u32x4){pb[0], pb[1], pb[2], pb[3]}; *(u32x4*)(W + CP_TRB + lane * 32 + 16) = (u32x4){pb[4], pb[5], pb[6], pb[7]};
        *(u32x4*)(W + CP_TRV + lane * 32) = (u32x4){pv[0], pv[1], pv[2], pv[3]}; *(u32x4*)(W + CP_TRV + lane * 32 + 16) = (u32x4){pv[4], pv[5], pv[6], pv[7]};
        *(float*)(W + CP_G + lane * 4) = gam;
    }
    auto fr64 = [&](int off, int ks) -> bf16x8 { return *(const bf16x8*)(W + off + q * 144 + (32 * ks + 8 * g) * 2); };
    auto fr16 = [&](int off, int row) -> bf16x8 {
        u32x4 z = (u32x4){0u, 0u, 0u, 0u};
        if (g < 2) z = *(const u32x4*)(W + off + row * 32 + g * 16);
        return __builtin_bit_cast(bf16x8, z);
    };
    const f32x4 zero4 = (f32x4){0.f, 0.f, 0.f, 0.f};
    asm volatile("" ::: "memory");
    f32x4 arkT;
    {
        const bf16x8 fu0 = fr64(CP_TMU, 0), fu1 = fr64(CP_TMU, 1), fb0 = fr64(CP_TMB, 0), fb1 = fr64(CP_TMB, 1);
        const bf16x8 fk0 = fr64(CP_TMK, 0), fk1 = fr64(CP_TMK, 1), fr0 = fr64(CP_TMR, 0), fr1 = fr64(CP_TMR, 1);
        f32x4 d = mfma16(fb1, fu1, mfma16(fb0, fu0, zero4));
#pragma unroll
        for (int r = 0; r < 4; ++r) d[r] = (4 * g + r < q) ? d[r] : 0.f;
        *(f32x4*)(W + CP_AUB + q * 64 + 16 * g) = d;
        d = mfma16(fb1, fr1, mfma16(fb0, fr0, zero4));
#pragma unroll
        for (int r = 0; r < 4; ++r) d[r] = (4 * g + r <= q) ? d[r] : 0.f;
        { u32x2 w; w.x = cvt_pk_bf16(d[0], d[1]); w.y = cvt_pk_bf16(d[2], d[3]); *(u32x2*)(W + CP_ARB + q * 32 + 8 * g) = w; }
        d = mfma16(fu1, fk1, mfma16(fu0, fk0, zero4));
#pragma unroll
        for (int r = 0; r < 4; ++r) d[r] = (q < 4 * g + r) ? d[r] : 0.f;
        { u32x2 w; w.x = cvt_pk_bf16(d[0], d[1]); w.y = cvt_pk_bf16(d[2], d[3]); *(u32x2*)(W + CP_AUKT + q * 32 + 8 * g) = w; }
        arkT = mfma16(fk1, fr1, mfma16(fk0, fr0, zero4));
#pragma unroll
        for (int r = 0; r < 4; ++r) arkT[r] = (4 * g + r <= q) ? arkT[r] : 0.f;
    }
    asm volatile("" ::: "memory");
    {
        float t[16];
#pragma unroll
        for (int i = 0; i < 16; ++i) t[i] = 0.f;
#pragma unroll
        for (int i = 0; i < 16; ++i) {
            float s = (i == q) ? 1.0f : 0.f;
#pragma unroll
            for (int m4 = 0; m4 < 4; ++m4) {
                if (4 * m4 < i) {
                    const f32x4 a = *(const f32x4*)(W + CP_AUB + i * 64 + 16 * m4);
                    s += (a[0] * t[4 * m4] + a[1] * t[4 * m4 + 1]) + (a[2] * t[4 * m4 + 2] + a[3] * t[4 * m4 + 3]);
                }
            }
            t[i] = s;
        }
        if (g == 0) {
            *(u32x4*)(W + CP_TT + q * 32) = (u32x4){cvt_pk_bf16(t[0], t[1]), cvt_pk_bf16(t[2], t[3]), cvt_pk_bf16(t[4], t[5]), cvt_pk_bf16(t[6], t[7])};
            *(u32x4*)(W + CP_TT + q * 32 + 16) = (u32x4){cvt_pk_bf16(t[8], t[9]), cvt_pk_bf16(t[10], t[11]), cvt_pk_bf16(t[12], t[13]), cvt_pk_bf16(t[14], t[15])};
        }
    }
    asm volatile("" ::: "memory");
    {
        const f32x4 d = mfma16(fr16(CP_TT, q), fr16(CP_ARB, q), zero4);
        u32x2 w; w.x = cvt_pk_bf16(d[0], d[1]); w.y = cvt_pk_bf16(d[2], d[3]); *(u32x2*)(W + CP_H + q * 32 + 8 * g) = w;
    }
    asm volatile("" ::: "memory");
    {
        const f32x4 d = mfma16(fr16(CP_AUKT, q), fr16(CP_H, q), arkT);
        u32x2 w; w.x = cvt_pk_bf16(d[0], d[1]); w.y = cvt_pk_bf16(d[2], d[3]); *(u32x2*)(W + CP_Q + q * 32 + 8 * g) = w;
    }
    asm volatile("" ::: "memory");
    {
        const bf16x8 ft = fr16(CP_TT, q);
#pragma unroll
        for (int nt = 0; nt < 4; ++nt) {
            const f32x4 d = mfma16(ft, fr16(CP_TRB, 16 * nt + q), zero4);
            u32x2 w; w.x = cvt_pk_bf16(d[0], d[1]); w.y = cvt_pk_bf16(d[2], d[3]); *(u32x2*)(W + CP_GT + (16 * nt + q) * 32 + 8 * g) = w;
        }
    }
    asm volatile("" ::: "memory");
    {
        const bf16x8 fa = fr16(CP_AUKT, q);
#pragma unroll
        for (int nt = 0; nt < 4; ++nt) {
            f32x4 kt;
#pragma unroll
            for (int r = 0; r < 4; ++r) kt[r] = bf2f(*(const bf16_t*)(W + CP_TMK + (4 * g + r) * 144 + (16 * nt + q) * 2));
            const f32x4 d = mfma16(fa, fr16(CP_GT, 16 * nt + q), kt);
            u32x2 w; w.x = cvt_pk_bf16(d[0], d[1]); w.y = cvt_pk_bf16(d[2], d[3]); *(u32x2*)(W + CP_WT + (16 * nt + q) * 32 + 8 * g) = w;
        }
    }
    asm volatile("" ::: "memory");
    {
        const bf16x8 fh = fr16(CP_H, q), fq = fr16(CP_Q, q);
        bf16_t* RHg = p.CRH + (size_t)unit * 1024;
        bf16_t* P3g = p.CP3 + (size_t)unit * 1024;
        bf16_t* Mg = p.CM + (size_t)unit * 4096;
        bf16_t* Ng = p.CN + (size_t)unit * 4096;
#pragma unroll
        for (int mt = 0; mt < 4; ++mt) {
            const u32x2 rw = *(const u32x2*)(W + CP_TMR + q * 144 + (16 * mt + 4 * g) * 2);
            const f32x4 rt = (f32x4){bflo(rw.x), bfhi(rw.x), bflo(rw.y), bfhi(rw.y)};
            const f32x4 d = mfma16(fr16(CP_TRU, 16 * mt + q), fh, rt);
            u32x2 w; w.x = cvt_pk_bf16(d[0], d[1]); w.y = cvt_pk_bf16(d[2], d[3]);
            *(u32x2*)(RHg + (((mt >> 1) * 64 + lane) * 8 + (mt & 1) * 4)) = w;
        }
#pragma unroll
        for (int vs = 0; vs < 4; ++vs) {
            const f32x4 d = mfma16(fq, fr16(CP_TRV, 16 * vs + q), zero4);
            { u32x2 w; w.x = cvt_pk_bf16(d[0], d[1]); w.y = cvt_pk_bf16(d[2], d[3]); *(u32x2*)(P3g + (vs * 64 + lane) * 4) = w; }
        }
#pragma unroll
        for (int nt = 0; nt < 4; ++nt) {
            const bf16x8 fg = fr16(CP_GT, 16 * nt + q);
            const float gc = *(const float*)(W + CP_G + (16 * nt + q) * 4);
#pragma unroll
            for (int mt = 0; mt < 4; ++mt) {
                f32x4 d = mfma16(fr16(CP_TRU, 16 * mt + q), fg, zero4);
#pragma unroll
                for (int r = 0; r < 4; ++r) d[r] = gc * (d[r] + ((16 * mt + 4 * g + r == 16 * nt + q) ? 1.0f : 0.f));
                u32x2 w; w.x = cvt_pk_bf16(d[0], d[1]); w.y = cvt_pk_bf16(d[2], d[3]);
                *(u32x2*)(Mg + (((nt * 2 + (mt >> 1)) * 64 + lane) * 8 + (mt & 1) * 4)) = w;
            }
        }
#pragma unroll
        for (int mt = 0; mt < 4; ++mt) {
            const bf16x8 fw = fr16(CP_WT, 16 * mt + q);
            const f32x4 gc = *(const f32x4*)(W + CP_G + (16 * mt + 4 * g) * 4);
#pragma unroll
            for (int vs = 0; vs < 4; ++vs) {
                const f32x4 d = mfma16(fw, fr16(CP_TRV, 16 * vs + q), zero4) * gc;
                { u32x2 w; w.x = cvt_pk_bf16(d[0], d[1]); w.y = cvt_pk_bf16(d[2], d[3]); *(u32x2*)(Ng + ((vs * 4 + mt) * 64 + lane) * 4) = w; }
            }
        }
    }
    asm volatile("" ::: "memory");
}

DI void sq_wave(const Params& p, int chain, int vs, int lane) {
    const int b = chain >> 4, h = (chain >> 1) & 7, dir = chain & 1;
    const int q = lane & 15, g = lane >> 4;
    auto step_row = [&](int i) -> int {
        if (i < TCB) return TL + b * TCB + (dir == 0 ? i : TCB - 1 - i);
        const int jj = i - TCB;
        return b * TLB + (dir == 0 ? jj : TLB - 1 - jj);
    };
    float* YCd = p.YS + ((size_t)chain * CK_NCH * 4 + vs) * 256 + lane * 4;
    f32x4 st[4];
#pragma unroll
    for (int mt = 0; mt < 4; ++mt) st[mt] = (f32x4){0.f, 0.f, 0.f, 0.f};
    struct Ops { u32x4 m[4][2]; u32x4 r[2]; u32x2 n[4]; u32x2 p3; };
    auto load = [&](Ops& o, int c) {
        const size_t unit = (size_t)chain * CK_NCH + c;
        const bf16_t* Mg = p.CM + unit * 4096; const bf16_t* RHg = p.CRH + unit * 1024;
        const bf16_t* Ng = p.CN + unit * 4096 + (size_t)vs * 1024; const bf16_t* P3g = p.CP3 + unit * 1024 + vs * 256;
#pragma unroll
        for (int mt = 0; mt < 4; ++mt)
#pragma unroll
            for (int s = 0; s < 2; ++s) o.m[mt][s] = *(const u32x4*)(Mg + ((mt * 2 + s) * 64 + lane) * 8);
#pragma unroll
        for (int s = 0; s < 2; ++s) o.r[s] = *(const u32x4*)(RHg + (s * 64 + lane) * 8);
#pragma unroll
        for (int mt = 0; mt < 4; ++mt) o.n[mt] = *(const u32x2*)(Ng + (mt * 64 + lane) * 4);
        o.p3 = *(const u32x2*)(P3g + lane * 4);
    };
    auto stepc = [&](const Ops& o, int c) {
        const bf16x8 sb0 = pack8(st[0], st[1]), sb1 = pack8(st[2], st[3]);
        f32x4 y = mfma16(__builtin_bit_cast(bf16x8, o.r[0]), sb0, (f32x4){bflo(o.p3.x), bfhi(o.p3.x), bflo(o.p3.y), bfhi(o.p3.y)});
        y = mfma16(__builtin_bit_cast(bf16x8, o.r[1]), sb1, y);
#pragma unroll
        for (int mt = 0; mt < 4; ++mt) {
            f32x4 a = mfma16(__builtin_bit_cast(bf16x8, o.m[mt][0]), sb0, (f32x4){bflo(o.n[mt].x), bfhi(o.n[mt].x), bflo(o.n[mt].y), bfhi(o.n[mt].y)});
            st[mt] = mfma16(__builtin_bit_cast(bf16x8, o.m[mt][1]), sb1, a);
        }
        *(f32x4*)(YCd + ((size_t)c * 4) * 256) = y;
    };
    Ops oa, ob, oc;
    load(oa, 0); load(ob, 1); load(oc, 2);
    for (int c = 0; c < CK_NCH; c += 3) {
        stepc(oa, c);     __builtin_amdgcn_sched_barrier(0); load(oa, (c + 3 < CK_NCH) ? c + 3 : CK_NCH - 1); __builtin_amdgcn_sched_barrier(0);
        stepc(ob, c + 1); __builtin_amdgcn_sched_barrier(0); load(ob, (c + 4 < CK_NCH) ? c + 4 : CK_NCH - 1); __builtin_amdgcn_sched_barrier(0);
        stepc(oc, c + 2); __builtin_amdgcn_sched_barrier(0); load(oc, (c + 5 < CK_NCH) ? c + 5 : CK_NCH - 1); __builtin_amdgcn_sched_barrier(0);
    }
}

DI void na_block_unit(const Params& p, char* lds, int U) {
    const int tid = opaque_tid(), lane = tid & 63, wv = tid >> 6, q = lane & 15, g = lane >> 4;
    const bool lat = U < 1024;
    int b, r, hp, qb;
    if (lat) { hp = U & 3; r = (U >> 2) & 127; b = U >> 9; qb = 0; } else { const int V = U - 1024; qb = V & 3; hp = (V >> 2) & 3; b = V >> 4; r = 0; }
    const int hh = wv >> 2, w = wv & 3, h = 2 * hp + hh;
    const int j = 16 * w + q;
    const int qtok = lat ? (b * TLB + r * 64 + j) : (TL + b * TCB + 64 * qb + j);
    const int row_start = lat ? (r - 4 < 0 ? 0 : (r - 4 > 120 ? 120 : r - 4)) : 0;
    const int c0 = (w == 0 ? 0 : (w == 1 ? 8 : (w == 2 ? 24 : 32)));
    int cs = j - 8; cs = cs < 0 ? 0 : (cs > 48 ? 48 : cs);
    const int nch = lat ? 12 : 4, first_ctx = lat ? 8 : 0;
    bf16x8 qf[2];
#pragma unroll
    for (int ks = 0; ks < 2; ++ks) qf[ks] = *(const bf16x8*)(p.Q0 + (size_t)qtok * 512 + h * 64 + 32 * ks + 8 * g);
    u32x4 rk[2], rv[2];
    auto issue = [&](int ci) {
        const bool isctx = ci >= first_ctx;
        const int cc = ci - first_ctx;
#pragma unroll
        for (int i = 0; i < 2; ++i) {
            const int pc = tid + NTHR * i;
            const int key = pc >> 4, c16 = pc & 15;
            const int tok = isctx ? (TL + b * TCB + cc * 64 + key) : (b * TLB + (row_start + ci) * 64 + key);
            rk[i] = *(const u32x4*)(p.K0 + (size_t)tok * 512 + hp * 128 + c16 * 8);
            const int row = pc >> 3, k8 = pc & 7;
            const bf16_t* vsrc = isctx ? (p.VT0C + ((size_t)(b * 512 + hp * 128 + row)) * TCB + cc * 64 + k8 * 8)
                                       : (p.VT0L + ((size_t)(b * 512 + hp * 128 + row)) * TLB + (row_start + ci) * 64 + k8 * 8);
            rv[i] = *(const u32x4*)vsrc;
        }
    };
    auto stash = [&](char* st) {
#pragma unroll
        for (int i = 0; i < 2; ++i) {
            const int pc = tid + NTHR * i;
            const int key = pc >> 4, c16 = pc & 15;
            *(u32x4*)(st + (c16 >> 3) * 8192 + lds_byte(key, (c16 & 7) * 8)) = rk[i];
            const int row = pc >> 3, k8 = pc & 7;
            *(u32x4*)(st + 16384 + (row >> 6) * 8192 + lds_byte(row & 63, k8 * 8)) = rv[i];
        }
    };
    float m = -3.0e38f, sum = 0.f;
    f32x4 o[4];
#pragma unroll
    for (int dm = 0; dm < 4; ++dm) o[dm] = (f32x4){0.f, 0.f, 0.f, 0.f};
    auto qk = [&](const char* kimg, int kc0, f32x4 (&s)[2]) {
#pragma unroll
        for (int hf = 0; hf < 2; ++hf) {
            const int key = kc0 + 8 * (q >> 2) + 4 * hf + (q & 3);
            f32x4 a = (f32x4){0.f, 0.f, 0.f, 0.f};
#pragma unroll
            for (int ks = 0; ks < 2; ++ks) a = mfma16(*(const bf16x8*)(kimg + lds_byte(key, 32 * ks + 8 * g)), qf[ks], a);
            s[hf] = a;
        }
    };
    auto pv = [&](const char* vimg, int kc0, const f32x4 (&s)[2]) {
        const bf16x8 pb = pack8(s[0], s[1]);
#pragma unroll
        for (int dm = 0; dm < 4; ++dm) o[dm] = mfma16(*(const bf16x8*)(vimg + lds_byte(16 * dm + q, kc0 + 8 * g)), pb, o[dm]);
    };
    issue(0);
    stash(lds);
    __syncthreads();
    for (int ci = 0; ci < nch; ++ci) {
        const bool more = ci + 1 < nch;
        if (more) issue(ci + 1);
        const char* st = lds + (ci & 1) * 32768;
        const char* kimg = st + hh * 8192;
        const char* vimg = st + 16384 + hh * 8192;
        if (ci < first_ctx) {
            f32x4 s[2];
            qk(kimg, c0, s);
            const int row_off = row_start + ci - r + 7;
            float cmax = -3.0e38f;
#pragma unroll
            for (int hf = 0; hf < 2; ++hf)
#pragma unroll
                for (int rr = 0; rr < 4; ++rr) {
                    const int cc_ = c0 + 8 * g + 4 * hf + rr;
                    int co = cc_ - j; co = co < -15 ? -15 : (co > 15 ? 15 : co);
                    const bool in = (cc_ >= cs) && (cc_ < cs + 16);
                    const float bias = p.na_rpb[(h * 15 + row_off) * 31 + co + 15];
                    const float sv = in ? (s[hf][rr] * 0.125f + bias) : -1.0e30f;
                    s[hf][rr] = sv; cmax = fmaxf(cmax, sv);
                }
            cmax = fmaxf(cmax, __shfl_xor(cmax, 16)); cmax = fmaxf(cmax, __shfl_xor(cmax, 32));
            const float mn = fmaxf(m, cmax), al = __expf(m - mn);
            m = mn; sum *= al;
#pragma unroll
            for (int dm = 0; dm < 4; ++dm) o[dm] = o[dm] * al;
#pragma unroll
            for (int hf = 0; hf < 2; ++hf)
#pragma unroll
                for (int rr = 0; rr < 4; ++rr) { s[hf][rr] = __expf(s[hf][rr] - mn); sum += s[hf][rr]; }
            pv(vimg, c0, s);
        } else {
            f32x4 s0[2], s1[2];
            qk(kimg, 0, s0); qk(kimg, 32, s1);
            float cmax = -3.0e38f;
#pragma unroll
            for (int hf = 0; hf < 2; ++hf)
#pragma unroll
                for (int rr = 0; rr < 4; ++rr) { s0[hf][rr] *= 0.125f; s1[hf][rr] *= 0.125f; cmax = fmaxf(cmax, fmaxf(s0[hf][rr], s1[hf][rr])); }
            cmax = fmaxf(cmax, __shfl_xor(cmax, 16)); cmax = fmaxf(cmax, __shfl_xor(cmax, 32));
            const float mn = fmaxf(m, cmax), al = __expf(m - mn);
            m = mn; sum *= al;
#pragma unroll
            for (int dm = 0; dm < 4; ++dm) o[dm] = o[dm] * al;
#pragma unroll
            for (int hf = 0; hf < 2; ++hf)
#pragma unroll
                for (int rr = 0; rr < 4; ++rr) { s0[hf][rr] = __expf(s0[hf][rr] - mn); s1[hf][rr] = __expf(s1[hf][rr] - mn); sum += s0[hf][rr] + s1[hf][rr]; }
            pv(vimg, 0, s0); pv(vimg, 32, s1);
        }
        if (more) stash(lds + ((ci + 1) & 1) * 32768);
        __syncthreads();
    }
    sum += __shfl_xor(sum, 16); sum += __shfl_xor(sum, 32);
    const float inv = 1.0f / sum;
#pragma unroll
    for (int dm = 0; dm < 4; ++dm) {
        u32x2 wv_; wv_.x = cvt_pk_bf16(o[dm][0] * inv, o[dm][1] * inv); wv_.y = cvt_pk_bf16(o[dm][2] * inv, o[dm][3] * inv);
        *(u32x2*)(p.MIX + (size_t)qtok * 1024 + h * 64 + 16 * dm + 4 * g) = wv_;
    }
}

template <int PARTS = 3>
DI void ph_attn_cp(const Params& p, char* lds) {
    const int tz_ = opaque_tid(), lane = tz_ & 63, wv = tz_ >> 6;
    char* W = lds + wv * CPW;
    const int gw = blockIdx.x * 8 + wv, nw = (int)gridDim.x * 8;
    constexpr int NCP = 32 * CK_NCH;
    if (PARTS & 1) for (int U = gw; U < NCP; U += nw) cp_unit(p, W, U, lane);
    if (PARTS & 2) {
        __syncthreads();
        for (int U = blockIdx.x; U < 1024 + 32; U += gridDim.x) na_block_unit(p, lds, U);
    }
}
DI void ph_sq(const Params& p, char* lds) {
    const int tz_ = opaque_tid(), lane = tz_ & 63, wv = tz_ >> 6;
    const int nsq = gridDim.x >= 256 ? 128 : 0;
    if ((int)blockIdx.x < nsq) { if (wv == 0) sq_wave(p, blockIdx.x >> 2, blockIdx.x & 3, lane); return; }
    if (nsq == 0) { if (wv == 0) for (int u = blockIdx.x; u < 128; u += gridDim.x) sq_wave(p, u >> 2, u & 3, lane); __syncthreads(); }
    for (int U = (int)blockIdx.x - nsq; U < 1024 + 32; U += (int)gridDim.x - nsq) na_block_unit(p, lds, U);
}

DI void ph_rw_readout(const Params& p) {
    const int c = opaque_tid(), hh = c >> 6;
    const float gg = p.rw_gn_g[c], gb = p.rw_gn_b[c];
    const int vs = (c >> 4) & 3, q = c & 15;
    for (int G = blockIdx.x; G < TT / 4; G += gridDim.x) {
        const int row0 = G * 4;
        const bool lat = row0 < TL;
        const int bb = lat ? (row0 >> 13) : ((row0 - TL) >> 8), t0 = lat ? (row0 & (TLB - 1)) : ((row0 - TL) & (TCB - 1));
        const int pf = lat ? TCB + t0 : t0, pb = lat ? TCB + (TLB - 1 - t0) : (TCB - 1 - t0);
        const size_t cf = (size_t)((bb * 8 + hh) * 2 + 0) * CK_NCH + (pf >> 4), cb = (size_t)((bb * 8 + hh) * 2 + 1) * CK_NCH + (pb >> 4);
        const f32x4 yf = *(const f32x4*)(p.YS + (cf * 4 + vs) * 256 + (16 * ((pf & 15) >> 2) + q) * 4);
        const f32x4 yb = *(const f32x4*)(p.YS + (cb * 4 + vs) * 256 + (16 * ((pb & 15) >> 2) + q) * 4);
        u32x2 nr[4]; float bo[4];
#pragma unroll
        for (int j = 0; j < 4; ++j) {
            const size_t o = (size_t)(row0 + j) * 512 + c;
            nr[j] = *(const u32x2*)(p.SBP + 4 * o + 2);
            bo[j] = p.BONUS[(row0 + j) * 8 + hh];
        }
#pragma unroll
        for (int j = 0; j < 4; ++j) {
            const float y = yf[j] + yb[3 - j];
            const float mu = wave_allsum(y) * (1.0f / 64.0f);
            const float d = y - mu;
            const float var = wave_allsum(d * d) * (1.0f / 64.0f);
            const float yn = d * rsqrtf(var + 64e-5f) * gg + gb;
            const float outv = (yn + bo[j] * bfhi(nr[j].x)) * bfhi(nr[j].y);
            p.MIX[(size_t)(row0 + j) * 1024 + 512 + c] = (bf16_t)(cvt_pk_bf16(outv, 0.f) & 0xffff);
        }
    }
}

DI void gemm_f32out(char* lds, const bf16_t* A, int M, const float* W, int N, float* C) {
    const int tid = opaque_tid();
    const int ntn = N / 128, ntm = M / 256;
    gemm_stream<4, 2, 4, 4, PtrLoaderF, 4>(lds, ntn * ntm, 16, [&](int u, PtrLoader<4>& al, PtrLoaderF& bl, const int (&nx)[4]) {
        int tm, tn; tile_of(u, ntm, ntn, tm, tn);
#pragma unroll
        for (int i = 0; i < 4; ++i) al.p[i] = (unsigned)((tm * 256 + a_row(tid) + 64 * i) * 1024 + a_c8(tid) * 8);
        al.base = A;
        fill_bf(bl, W, N, tn * 128, N);
    }, [&](int u, int (&nx)[4], int) {}, [&](int u, int mi, const f32x4 (&a)[4], f32x4 (&o)[4], int r0, int c0) {
#pragma unroll
        for (int ni = 0; ni < 4; ++ni) o[ni] = a[ni];
    }, [&](int u, int r, int c, f32x4 v, f32x4 pv) {
        int tm, tn; tile_of(u, ntm, ntn, tm, tn);
        *(f32x4*)(C + (size_t)(tm * 256 + r) * N + tn * 128 + c) = v;
    });
}

DI void ln_row(f32x4 (&v)[4], const float* g, const float* bta, int lane) {
    float s = 0.f;
#pragma unroll
    for (int i = 0; i < 4; ++i) s += (v[i][0] + v[i][1]) + (v[i][2] + v[i][3]);
    const float mu = wave_allsum(s) * (1.0f / 1024.0f);
    float q = 0.f;
#pragma unroll
    for (int i = 0; i < 4; ++i) { v[i] = v[i] - mu; q += (v[i][0] * v[i][0] + v[i][1] * v[i][1]) + (v[i][2] * v[i][2] + v[i][3] * v[i][3]); }
    const float rstd = rsqrtf(wave_allsum(q) * (1.0f / 1024.0f) + 1e-5f);
#pragma unroll
    for (int i = 0; i < 4; ++i) {
        const int c = 4 * lane + 256 * i;
        v[i] = v[i] * rstd * (*(const f32x4*)(g + c)) + (*(const f32x4*)(bta + c));
    }
}

template <int L>
DI void ph_ln1(const Params& p) {
    const int tz_ = opaque_tid(), lane = tz_ & 63, wv = tz_ >> 6;
    const int nrows = (L == 0) ? TT : TL;
    for (int row = blockIdx.x * 8 + wv; row < nrows; row += gridDim.x * 8) {
        const float* hin = (L == 0) ? (row < TL ? p.x + (size_t)row * 1024 : p.ctx + (size_t)(row - TL) * 1024) : p.HB + (size_t)row * 1024;
        const float* m = p.mods + (size_t)(L * 3 + mods_row(row)) * 6144;
        f32x4 v[4];
#pragma unroll
        for (int i = 0; i < 4; ++i) {
            const int c = 4 * lane + 256 * i;
            v[i] = ALPHA * (*(const f32x4*)(hin + c)) + (*(const f32x4*)(m + 2048 + c)) * (*(const f32x4*)(p.YL + (size_t)row * 1024 + c));
        }
        ln_row(v, p.ln_g + (L * 2 + 0) * 1024, p.ln_b + (L * 2 + 0) * 1024, lane);
#pragma unroll
        for (int i = 0; i < 4; ++i) {
            const int c = 4 * lane + 256 * i;
            *(f32x4*)(p.HA + (size_t)row * 1024 + c) = v[i];
            const f32x4 f = v[i] * (1.0f + *(const f32x4*)(m + 4096 + c)) + *(const f32x4*)(m + 3072 + c);
            u32x2 w; w.x = cvt_pk_bf16(f[0], f[1]); w.y = cvt_pk_bf16(f[2], f[3]);
            *(u32x2*)(p.Abuf + (size_t)row * 1024 + c) = w;
        }
    }
}

template <int CTRL, int RM> DI float dpp_keep(float x) {
    return __builtin_bit_cast(float, __builtin_amdgcn_update_dpp(__builtin_bit_cast(int, x), __builtin_bit_cast(int, x), CTRL, RM, 0xF, false));
}
DI float wave_max_uniform(float x) {
    x = fmaxf(x, dpp_keep<0xB1, 0xF>(x)); x = fmaxf(x, dpp_keep<0x4E, 0xF>(x));
    x = fmaxf(x, dpp_keep<0x141, 0xF>(x)); x = fmaxf(x, dpp_keep<0x140, 0xF>(x));
    x = fmaxf(x, dpp_keep<0x142, 0xA>(x)); x = fmaxf(x, dpp_keep<0x143, 0xC>(x));
    return __builtin_bit_cast(float, __builtin_amdgcn_readlane(__builtin_bit_cast(int, x), 63));
}
template <int L>
DI void ph_route(const Params& p, char* ldsc) {
    const int tz_ = opaque_tid(), lane = tz_ & 63, wv = tz_ >> 6;
    const int nrows = (L == 0) ? TT : TL;
    int* hist = (int*)ldsc;
    if (tz_ < 256) hist[tz_] = 0;
    __syncthreads();
    const f32x4 bias = *(const f32x4*)(p.moe_bias + L * 256 + 4 * lane);
    for (int row = blockIdx.x * 8 + wv; row < nrows; row += gridDim.x * 8) {
        const f32x4 lg = *(const f32x4*)(p.LOGITS + (size_t)row * 256 + 4 * lane);
        const float s0 = sigmoidf_(lg[0]), s1 = sigmoidf_(lg[1]), s2 = sigmoidf_(lg[2]), s3 = sigmoidf_(lg[3]);
        float v0 = s0 + bias[0], v1 = s1 + bias[1], v2 = s2 + bias[2], v3 = s3 + bias[3];
        float m1 = fmaxf(v0, v1), m2 = fminf(v0, v1);
        { const float a = fmaxf(v2, v3), bq = fminf(v2, v3); const float n1 = fmaxf(m1, a); const float n2 = fmaxf(fminf(m1, a), fmaxf(m2, bq)); m1 = n1; m2 = n2; }
        { const float o1 = dpp_keep<0xB1, 0xF>(m1), o2 = dpp_keep<0xB1, 0xF>(m2); const float n1 = fmaxf(m1, o1), n2 = fmaxf(fminf(m1, o1), fmaxf(m2, o2)); m1 = n1; m2 = n2; }
        { const float o1 = dpp_keep<0x4E, 0xF>(m1), o2 = dpp_keep<0x4E, 0xF>(m2); const float n1 = fmaxf(m1, o1), n2 = fmaxf(fminf(m1, o1), fmaxf(m2, o2)); m1 = n1; m2 = n2; }
        { const float o1 = dpp_keep<0x141, 0xF>(m1), o2 = dpp_keep<0x141, 0xF>(m2); const float n1 = fmaxf(m1, o1), n2 = fmaxf(fminf(m1, o1), fmaxf(m2, o2)); m1 = n1; m2 = n2; }
        const float gs = m1 + m2;
        const int myg = lane >> 3;
        int rank = 0;
#pragma unroll
        for (int gg = 0; gg < 8; ++gg) {
            const float og = __builtin_bit_cast(float, __builtin_amdgcn_readlane(__builtin_bit_cast(int, gs), gg * 8));
            rank += ((og > gs) || (og == gs && gg < myg)) ? 1 : 0;
        }
        if (rank >= 4) { v0 = -1.0e30f; v1 = -1.0e30f; v2 = -1.0e30f; v3 = -1.0e30f; }
        int sel_e = 0; float sel_s = 0.f, ssum = 0.f;
#pragma unroll
        for (int rd = 0; rd < 8; ++rd) {
            float bv = v0; int bi = 0; float bs = s0;
            if (v1 > bv) { bv = v1; bi = 1; bs = s1; }
            if (v2 > bv) { bv = v2; bi = 2; bs = s2; }
            if (v3 > bv) { bv = v3; bi = 3; bs = s3; }
            const float mx = wave_max_uniform(bv);
            const unsigned long long bal = __ballot(bv == mx);
            const int ol = __builtin_amdgcn_readfirstlane((int)__builtin_ctzll(bal));
            const int oi = __builtin_amdgcn_readlane(bi, ol);
            const float sv = __builtin_bit_cast(float, __builtin_amdgcn_readlane(__builtin_bit_cast(int, bs), ol));
            if (lane == ol) { if (oi == 0) v0 = -3.0e30f; else if (oi == 1) v1 = -3.0e30f; else if (oi == 2) v2 = -3.0e30f; else v3 = -3.0e30f; }
            ssum += sv;
            if (lane == rd) { sel_e = 4 * ol + oi; sel_s = sv; }
        }
        if (lane < 8) {
            p.EIDX[(size_t)row * 8 + lane] = sel_e;
            p.EW[(size_t)row * 8 + lane] = sel_s / ssum * 2.5f;
            atomicAdd(&hist[sel_e], 1);
        }
    }
    __syncthreads();
    if (tz_ < 256) p.HIST[((size_t)L * 256 + blockIdx.x) * 256 + tz_] = hist[tz_];
    __syncthreads();
}

template <int L>
DI void ph_scatter(const Params& p, char* ldsc) {
    int* sbase = (int*)ldsc;
    int* cursor = sbase + 320;
    const int tid = opaque_tid(), lane = tid & 63, wv = tid >> 6;
    const int nrows = (L == 0) ? TT : TL;
    int mypre = 0;
    {
        int* part = sbase + 640;
        const int e = tid & 255, half = tid >> 8, nbh = ((int)gridDim.x + 1) >> 1;
        const int* hcol = p.HIST + (size_t)L * 256 * 256 + e;
        int tot = 0, pre = 0;
#pragma unroll 16
        for (int i = 0; i < nbh; ++i) {
            const int bq = half * nbh + i;
            const int hv = bq < (int)gridDim.x ? hcol[bq * 256] : 0;
            tot += hv; pre += (bq < (int)blockIdx.x) ? hv : 0;
        }
        part[half * 512 + e] = tot; part[half * 512 + 256 + e] = pre;
        __syncthreads();
        if (tid < 256) {
            tot = part[tid] + part[512 + tid]; mypre = part[256 + tid] + part[768 + tid];
            sbase[tid] = (tot + 255) & ~255;
        }
    }
    __syncthreads();
    {
        int pd = 0, inc = 0;
        if (tid < 256) {
            pd = sbase[tid]; inc = pd;
#pragma unroll
            for (int d = 1; d < 64; d <<= 1) { const int t = __shfl_up(inc, d); if (lane >= d) inc += t; }
            if (lane == 63) sbase[288 + wv] = inc;
        }
        __syncthreads();
        if (tid < 256) {
            int off = 0;
#pragma unroll
            for (int w = 0; w < 3; ++w) off += (w < wv) ? sbase[288 + w] : 0;
            const int excl = inc - pd + off;
            sbase[tid] = excl;
            if (tid == 255) sbase[256] = excl + pd;
        }
    }
    __syncthreads();
    if (tid < 256) cursor[tid] = sbase[tid] + mypre;
    if (blockIdx.x == 0) {
        int* te = p.TILE_E + L * MAXTILES; int* tr = p.TILE_R0 + L * MAXTILES;
        if (tid < 256) { const int b0 = sbase[tid], b1 = sbase[tid + 1]; for (int r = b0; r < b1; r += 256) { te[r >> 8] = tid; tr[r >> 8] = r; } }
        const int nt = sbase[256] >> 8, nsh = nrows / 256;
        for (int i = tid; i < nsh; i += NTHR) { te[nt + i] = 256; tr[nt + i] = SH_BASE + 256 * i; }
        if (tid == 0) p.ictl[1024 + L] = nt + nsh;
    }
    __syncthreads();
    int* stok = p.SLOT_TOK + (size_t)L * NSLOT; float* sw = p.SLOT_W + (size_t)L * NSLOT;
    for (int row = blockIdx.x * 8 + wv; row < nrows; row += gridDim.x * 8) {
        if (lane < 8) {
            const int a = row * 8 + lane;
            const int e = p.EIDX[a];
            const int pos = atomicAdd(&cursor[e], 1);
            stok[pos] = row; sw[pos] = p.EW[a]; p.APOS[a] = pos;
        }
    }
    __syncthreads();
}

template <int L>
DI void ph_moe1(const Params& p, char* lds) {
    const int tid = opaque_tid();
    const int ntiles = p.ictl[1024 + L];
    const int* te = p.TILE_E + L * MAXTILES; const int* tr = p.TILE_R0 + L * MAXTILES;
    const int* stok = p.SLOT_TOK + (size_t)L * NSLOT;
    int pend = 0, pendq = -1;
    gemm_stream<4, 2, 4, 4, PtrLoaderF, 2>(lds, ntiles * 4, 16, [&](int u, PtrLoader<4>& al, PtrLoaderF& bl, const int (&nx)[4]) {
        const int ti = u >> 2, tn = u & 3;
        const int e = te[ti];
#pragma unroll
        for (int i = 0; i < 4; ++i) al.p[i] = (unsigned)(nx[i] * 1024 + a_c8(tid) * 8);
        al.base = p.Abuf;
        const float* gsrc = e < 256 ? p.moe_w_gate + ((size_t)(L * 256 + e)) * 1024 * 256 : p.sh_w_gate + (size_t)L * 1024 * 256;
        const float* usrc = e < 256 ? p.moe_w_up + ((size_t)(L * 256 + e)) * 1024 * 256 : p.sh_w_up + (size_t)L * 1024 * 256;
        bl.ld = 256; bl.base0 = gsrc; bl.base1 = usrc;
#pragma unroll
        for (int i = 0; i < 4; ++i) bl.p[i] = (unsigned)((tid >> 3) * 256 + 32 * (2 * tn + (i >> 1)) + (tid & 7) * 4);
    }, [&](int u, int (&nx)[4], int sel) {
        const int row0 = tr[u >> 2];
        if (sel == 2) {
#pragma unroll
            for (int i = 0; i < 4; ++i) nx[i] = stok[row0 + a_row(tid) + 64 * i];
        } else {
#pragma unroll
            for (int i = 0; i < 4; ++i) nx[i] = (pendq == i) ? pend : nx[i];
            pendq = sel - 4;
            pend = stok[row0 + a_row(tid) + 64 * pendq];
        }
    }, [&](int u, int mi, const f32x4 (&a)[4], f32x4 (&o)[2], int r0, int c0) {
#pragma unroll
        for (int ni = 0; ni < 2; ++ni)
#pragma unroll
            for (int j = 0; j < 4; ++j) o[ni][j] = siluf_(a[ni][j]) * a[ni + 2][j];
    }, [&](int u, int r, int c, f32x4 v, f32x4 pv) {
        const int ti = u >> 2, tn = u & 3;
        u32x2 w; w.x = cvt_pk_bf16(v[0], v[1]); w.y = cvt_pk_bf16(v[2], v[3]);
        *(u32x2*)(p.HBUF + (size_t)(tr[ti] + r) * 256 + tn * 64 + c) = w;
    });
}
template <int L>
DI void ph_moe2(const Params& p, char* lds) {
    const int tid = opaque_tid();
    const int ntiles = p.ictl[1024 + L];
    const int* te = p.TILE_E + L * MAXTILES; const int* tr = p.TILE_R0 + L * MAXTILES;
    const float* sw = p.SLOT_W + (size_t)L * NSLOT;
    float sc4[4] = {0.f, 0.f, 0.f, 0.f};
    gemm_stream<4, 2, 4, 4, PtrLoaderF, 4>(lds, ntiles * 8, 4, [&](int u, PtrLoader<4>& al, PtrLoaderF& bl, const int (&nx)[4]) {
        const int ti = u >> 3, tn = u & 7;
        const int e = te[ti], row0 = tr[ti];
#pragma unroll
        for (int i = 0; i < 4; ++i) al.p[i] = (unsigned)((row0 + a_row(tid) + 64 * i) * 256 + a_c8(tid) * 8);
        al.base = p.HBUF;
        const float* dsrc = e < 256 ? p.moe_w_down + ((size_t)(L * 256 + e)) * 256 * 1024 : p.sh_w_down + (size_t)L * 256 * 1024;
        fill_bf(bl, dsrc, 1024, tn * 128, 1024);
    }, [&](int u, int (&nx)[4], int) {}, [&](int u, int mi, const f32x4 (&a)[4], f32x4 (&o)[4], int r0, int c0) {
        if (mi == 0) {
            const float* s_ = sw + tr[u >> 3] + r0;
#pragma unroll
            for (int m = 0; m < 4; ++m) sc4[m] = s_[16 * m];
        }
#pragma unroll
        for (int ni = 0; ni < 4; ++ni) o[ni] = a[ni] * sc4[mi];
    }, [&](int u, int r, int c, f32x4 v, f32x4 pv) {
        const int ti = u >> 3, tn = u & 7;
        const int row = tr[ti] + r;
        u32x2 w; w.x = cvt_pk_bf16(v[0], v[1]); w.y = cvt_pk_bf16(v[2], v[3]);
        *(u32x2*)(p.YB + (size_t)row * 1024 + tn * 128 + c) = w;
    });
}

template <int L>
DI void ph_combine(const Params& p) {
    const int tz_ = opaque_tid(), lane = tz_ & 63, wv = tz_ >> 6;
    const int nrows = (L == 0) ? TT : TL;
    for (int row = blockIdx.x * 8 + wv; row < nrows; row += gridDim.x * 8) {
        int rr[9];
#pragma unroll
        for (int k = 0; k < 8; ++k) rr[k] = p.APOS[(size_t)row * 8 + k];
        rr[8] = SH_BASE + row;
        const float* m = p.mods + (size_t)(L * 3 + mods_row(row)) * 6144;
        f32x4 v[4];
#pragma unroll
        for (int i = 0; i < 4; ++i) {
            const int c = 4 * lane + 256 * i;
            f32x4 ff = (f32x4){0.f, 0.f, 0.f, 0.f};
#pragma unroll
            for (int k = 0; k < 9; ++k) {
                const u32x2 w = *(const u32x2*)(p.YB + (size_t)rr[k] * 1024 + c);
                ff[0] += bflo(w.x); ff[1] += bfhi(w.x); ff[2] += bflo(w.y); ff[3] += bfhi(w.y);
            }
            v[i] = ALPHA * (*(const f32x4*)(p.HA + (size_t)row * 1024 + c)) + (*(const f32x4*)(m + 5120 + c)) * ff;
        }
        ln_row(v, p.ln_g + (L * 2 + 1) * 1024, p.ln_b + (L * 2 + 1) * 1024, lane);
        if (L == 0) {
            const float* m1 = p.mods + (size_t)(1 * 3 + mods_row(row)) * 6144;
#pragma unroll
            for (int i = 0; i < 4; ++i) {
                const int c = 4 * lane + 256 * i;
                *(f32x4*)(p.HB + (size_t)row * 1024 + c) = v[i];
                const f32x4 a = v[i] * (1.0f + *(const f32x4*)(m1 + 1024 + c)) + *(const f32x4*)(m1 + c);
                u32x2 w; w.x = cvt_pk_bf16(a[0], a[1]); w.y = cvt_pk_bf16(a[2], a[3]);
                *(u32x2*)(p.Abuf + (size_t)row * 1024 + c) = w;
            }
        } else {
#pragma unroll
            for (int i = 0; i < 4; ++i) *(f32x4*)(p.out + (size_t)row * 1024 + 4 * lane + 256 * i) = v[i];
        }
    }
}

DI void gemm_router(char* lds, const bf16_t* A, int M, const float* W, float* C) {
    const int tid = opaque_tid();
    const int ntn = 2, ntm = M / 128;
    gemm_stream<2, 4, 4, 2, PtrLoaderF, 2>(lds, ntn * ntm, 16, [&](int u, PtrLoader<2>& al, PtrLoaderF& bl, const int (&nx)[4]) {
        int tm, tn; tile_of(u, ntm, ntn, tm, tn);
#pragma unroll
        for (int i = 0; i < 2; ++i) al.p[i] = (unsigned)((tm * 128 + a_row(tid) + 64 * i) * 1024 + a_c8(tid) * 8);
        al.base = A;
        fill_bf(bl, W, 256, tn * 128, 256);
    }, [&](int u, int (&nx)[4], int) {}, [&](int u, int mi, const f32x4 (&a)[2], f32x4 (&o)[2], int r0, int c0) {
#pragma unroll
        for (int ni = 0; ni < 2; ++ni) o[ni] = a[ni];
    }, [&](int u, int r, int c, f32x4 v, f32x4 pv) {
        int tm, tn; tile_of(u, ntm, ntn, tm, tn);
        *(f32x4*)(C + (size_t)(tm * 128 + r) * 256 + tn * 128 + c) = v;
    });
}

DI void ph_inproj1(const Params& p, char* lds) {
    const int tid = opaque_tid();
    constexpr int NTN = 25, NTM = 66;
    gemm_stream<4, 2, 4, 4, PtrLoaderF, 4>(lds, NTN * NTM, 16, [&](int u, PtrLoader<4>& al, PtrLoaderF& bl, const int (&nx)[4]) {
        int tm, tn; tile_of(u, NTM, NTN, tm, tn);
#pragma unroll
        for (int i = 0; i < 4; ++i) al.p[i] = (unsigned)((tm * 256 + a_row(tid) + 64 * i) * 1024 + a_c8(tid) * 8);
        al.base = p.Abuf;
        fill_bf(bl, p.od_w_in, ODC, tn * 128, ODC);
    }, [&](int u, int (&nx)[4], int) {}, [&](int u, int mi, const f32x4 (&a)[4], f32x4 (&o)[4], int r0, int c0) {
#pragma unroll
        for (int ni = 0; ni < 4; ++ni) o[ni] = a[ni];
    }, [&](int u, int r, int c, f32x4 v, f32x4 pv) {
        int tm, tn; tile_of(u, NTM, NTN, tm, tn);
        const int row = tm * 256 + r, col = tn * 128 + c;
        if (tn < 8 && row < TL) {
            const int t = row & (TLB - 1);
            const float pos = (c & 32) ? (float)(t & 63) : (float)(t >> 6);
            const float sgn = (c & 16) ? 1.0f : -1.0f;
#pragma unroll
            for (int j = 0; j < 4; ++j) {
                const float ang = pos * exp2f(-(float)((c & 15) + j) * (13.287712379549449f / 16.0f));
                v[j] = v[j] * __cosf(ang) + sgn * pv[j] * __sinf(ang);
            }
            if (tn < 4) v = v * 0.125f;
        }
        if (tn < 24) {
            u32x2 w; w.x = cvt_pk_bf16(v[0], v[1]); w.y = cvt_pk_bf16(v[2], v[3]);
            *(u32x2*)(p.P1 + (size_t)row * 3072 + col) = w;
        } else if (col < ODC) *(f32x4*)(p.G1 + (size_t)row * 32 + (col - 3072)) = v;
    });
}

DI float wave_incl_sum(float v, int lane) {
#pragma unroll
    for (int d = 1; d < 64; d <<= 1) { const float t = __shfl_up(v, d); if (lane >= d) v += t; }
    return v;
}
DI float wave_incl_max(float v, int lane) {
#pragma unroll
    for (int d = 1; d < 64; d <<= 1) { const float t = __shfl_up(v, d); if (lane >= d) v = fmaxf(v, t); }
    return v;
}
DI void ml_gates(const Params& p, float* G, int row0, int h, float& ig, float& bc, float& tot, int& idx) {
    const int tid = opaque_tid(), lane = tid & 63, wv = tid >> 6;
    const int gi = (tid >> 7) & 1, e = tid & 127;
    idx = gi == 0 ? e : 127 - e;
    float c = 0.f; ig = 0.f;
    if (tid < 256) {
        const float* g = p.G1 + (size_t)(row0 + idx) * 32;
        ig = g[8 * gi + h] + p.ml_gate_b[8 * gi + h];
        const float lf = logsigmoidf_(g[16 + 8 * gi + h] + p.ml_gate_b[16 + 8 * gi + h]);
        c = wave_incl_sum(lf, lane);
        if (lane == 63) G[768 + wv] = c;
    }
    __syncthreads();
    if (tid < 256) {
        if (wv & 1) c += G[768 + wv - 1];
        G[gi * 128 + idx] = ig; G[256 + gi * 128 + idx] = c;
        if (e == 127) G[776 + gi] = c;
    }
    __syncthreads();
    bc = c; tot = G[776 + gi];
}

constexpr int MLC_T = 4096, MLC_TS = 392;
DI void ph_ml_chunks(const Params& p, char* ldsc) {
    float* G = (float*)ldsc;
    const int tid = opaque_tid(), lane = tid & 63, wv = tid >> 6, fr = lane & 15, fq = lane >> 4;
    for (int u = blockIdx.x; u < 1056; u += gridDim.x) {
        const bool lat = u < 1024;
        const int bh = lat ? (u >> 6) : ((u - 1024) >> 1), blk = lat ? (u & 63) : ((u - 1024) & 1);
        const int b = bh >> 3, h = bh & 7;
        const int Tseq = lat ? TLB : TCB;
        const int row0 = (lat ? b * TLB : TL + b * TCB) + blk * 128;
        {
            u32x4 rr[6];
#pragma unroll
            for (int i = 0; i < 6; ++i) {
                const int qd = tid + NTHR * i, row = qd / 24, cc = qd % 24;
                rr[i] = *(const u32x4*)(p.P1 + (size_t)(row0 + row) * 3072 + (cc < 8 ? 512 + h * 64 + cc * 8 : 1024 + h * 128 + (cc - 8) * 8));
            }
#pragma unroll
            for (int i = 0; i < 6; ++i) {
                const int qd = tid + NTHR * i, row = qd / 24, cc = qd % 24;
                char* d = ldsc + MLC_T + row * MLC_TS + cc * 16;
                *(u32x2*)d = (u32x2){rr[i].x, rr[i].y}; *(u32x2*)(d + 8) = (u32x2){rr[i].z, rr[i].w};
            }
        }
        float ig, bc, tot; int idx;
        ml_gates(p, G, row0, h, ig, bc, tot, idx);
        const float gl = tot - bc + ig;
        float mw = (tid < 256) ? wave_allmax(gl) : 0.f;
        if (tid < 256 && lane == 0) G[784 + wv] = mw;
        __syncthreads();
        if (tid < 256) {
            const int gi = tid >> 7;
            const float mc = fmaxf(G[784 + 2 * gi], G[784 + 2 * gi + 1]);
            G[512 + gi * 128 + idx] = __expf(gl - mc);
            if ((tid & 127) == 0) { p.BEMC[u * 4 + gi * 2 + 0] = tot; p.BEMC[u * 4 + gi * 2 + 1] = mc; }
        }
        __syncthreads();
        auto col8 = [&](int col, int l0) -> u32x4 {
            const char* s_ = ldsc + MLC_T + l0 * MLC_TS + col * 2;
            u32x4 w;
            w.x = (unsigned)*(const unsigned short*)(s_) | ((unsigned)*(const unsigned short*)(s_ + MLC_TS) << 16);
            w.y = (unsigned)*(const unsigned short*)(s_ + 2 * MLC_TS) | ((unsigned)*(const unsigned short*)(s_ + 3 * MLC_TS) << 16);
            w.z = (unsigned)*(const unsigned short*)(s_ + 4 * MLC_TS) | ((unsigned)*(const unsigned short*)(s_ + 5 * MLC_TS) << 16);
            w.w = (unsigned)*(const unsigned short*)(s_ + 6 * MLC_TS) | ((unsigned)*(const unsigned short*)(s_ + 7 * MLC_TS) << 16);
            return w;
        };
        f32x4 accf[4], accb[4];
#pragma unroll
        for (int n = 0; n < 4; ++n) { accf[n] = (f32x4){0.f, 0.f, 0.f, 0.f}; accb[n] = accf[n]; }
#pragma unroll
        for (int ks = 0; ks < 4; ++ks) {
            const int l0 = 32 * ks + 8 * fq;
            const bf16x8 va = __builtin_bit_cast(bf16x8, col8(64 + 16 * wv + fr, l0));
            const f32x4 wfa = *(const f32x4*)(G + 512 + l0), wfb = *(const f32x4*)(G + 512 + l0 + 4);
            const f32x4 wba = *(const f32x4*)(G + 640 + l0), wbb = *(const f32x4*)(G + 640 + l0 + 4);
#pragma unroll
            for (int n = 0; n < 4; ++n) {
                const u32x4 kr = col8(16 * n + fr, l0);
                const float k0 = bflo(kr.x), k1 = bfhi(kr.x), k2 = bflo(kr.y), k3 = bfhi(kr.y), k4 = bflo(kr.z), k5 = bfhi(kr.z), k6 = bflo(kr.w), k7 = bfhi(kr.w);
                u32x4 kf, kb;
                kf.x = cvt_pk_bf16(k0 * wfa[0], k1 * wfa[1]); kf.y = cvt_pk_bf16(k2 * wfa[2], k3 * wfa[3]);
                kf.z = cvt_pk_bf16(k4 * wfb[0], k5 * wfb[1]); kf.w = cvt_pk_bf16(k6 * wfb[2], k7 * wfb[3]);
                kb.x = cvt_pk_bf16(k0 * wba[0], k1 * wba[1]); kb.y = cvt_pk_bf16(k2 * wba[2], k3 * wba[3]);
                kb.z = cvt_pk_bf16(k4 * wbb[0], k5 * wbb[1]); kb.w = cvt_pk_bf16(k6 * wbb[2], k7 * wbb[3]);
                accf[n] = mfma16(va, __builtin_bit_cast(bf16x8, kf), accf[n]);
                accb[n] = mfma16(va, __builtin_bit_cast(bf16x8, kb), accb[n]);
            }
        }
        float* kvt = p.KVT + (size_t)u * 2 * 8192;
#pragma unroll
        for (int n = 0; n < 4; ++n)
#pragma unroll
            for (int j = 0; j < 4; ++j) {
                kvt[(16 * wv + 4 * fq + j) * 64 + 16 * n + fr] = accf[n][j];
                kvt[8192 + (16 * wv + 4 * fq + j) * 64 + 16 * n + fr] = accb[n][j];
            }
        if (tid < 128) {
            const int d = tid >> 6, k = tid & 63;
            float s = 0.f;
#pragma unroll 4
            for (int l = 0; l < 128; l += 8) {
                const u32x4 kq = col8(k, l);
                const f32x4 wa = *(const f32x4*)(G + 512 + d * 128 + l), wb = *(const f32x4*)(G + 512 + d * 128 + l + 4);
                s += bflo(kq.x) * wa[0] + bfhi(kq.x) * wa[1] + bflo(kq.y) * wa[2] + bfhi(kq.y) * wa[3]
                   + bflo(kq.z) * wb[0] + bfhi(kq.z) * wb[1] + bflo(kq.w) * wb[2] + bfhi(kq.w) * wb[3];
            }
            p.KS[(size_t)u * 128 + d * 64 + k] = s;
        }
        if (lat) {
            const int v = tid >> 2, part = tid & 3;
            bf16_t* dst = p.V1TL + ((size_t)(b * 1024 + h * 128 + v)) * TLB + blk * 128;
#pragma unroll
            for (int i = 0; i < 4; ++i) {
                const int tg = part + 4 * i;
                *(u32x4*)(dst + 8 * tg) = col8(64 + v, 8 * tg);
            }
        }
        __syncthreads();
    }
}

DI void ph_ml_scan(const Params& p) {
    const int tid = opaque_tid();
    for (int w = blockIdx.x; w < 256; w += gridDim.x) {
        const int chain = w & 31, slice = w >> 5;
        const int bh = chain >> 1, dir = chain & 1;
        const int e0 = slice * 1024 + tid * 2;
        float c0 = 0.f, c1 = 0.f, nn = 0.f, m = 0.f;
        const bool hasn = (slice == 0 && tid < 64);
        auto unit_of = [&](int s) -> int {
            if (s < 2) return 1024 + bh * 2 + (dir == 0 ? s : 1 - s);
            const int jj = s - 2; return bh * 64 + (dir == 0 ? jj : 63 - jj);
        };
        typedef float f32x2 __attribute__((ext_vector_type(2)));
        constexpr int DP = 6;
        f32x2 kvq[DP], bmq[DP]; float ksq[DP];
        const int nl = tid & 63;
#pragma unroll
        for (int j = 0; j < DP; ++j) {
            const int un = unit_of(j);
            kvq[j] = *(const f32x2*)(p.KVT + ((size_t)un * 2 + dir) * 8192 + e0);
            bmq[j] = *(const f32x2*)(p.BEMC + un * 4 + dir * 2);
            ksq[j] = p.KS[(size_t)un * 128 + dir * 64 + nl];
        }
#pragma unroll 1
        for (int s0 = 0; s0 < 66; s0 += DP) {
#pragma unroll
            for (int j = 0; j < DP; ++j) {
                const int s = s0 + j;
                const int u = unit_of(s);
                const f32x2 kv = kvq[j], bm = bmq[j]; const float ksv = ksq[j];
                {
                    const int sn = s + DP < 66 ? s + DP : 65;
                    const int un = unit_of(sn);
                    kvq[j] = *(const f32x2*)(p.KVT + ((size_t)un * 2 + dir) * 8192 + e0);
                    bmq[j] = *(const f32x2*)(p.BEMC + un * 4 + dir * 2);
                    ksq[j] = p.KS[(size_t)un * 128 + dir * 64 + nl];
                }
                {
                    bf16_t* ct = p.C0T + ((size_t)u * 2 + dir) * 8192;
                    *(unsigned*)(ct + e0) = cvt_pk_bf16(c0, c1);
                    if (hasn) p.N0[((size_t)u * 2 + dir) * 64 + tid] = nn;
                    if (slice == 0 && tid == 0) p.M0[u * 2 + dir] = m;
                }
                const float be = bm[0], mc = bm[1];
                const float mn = fmaxf(be + m, mc);
                const float fa = __expf(be + m - mn), fb = __expf(mc - mn);
                c0 = fa * c0 + fb * kv[0]; c1 = fa * c1 + fb * kv[1];
                nn = fa * nn + fb * ksv;
                m = mn;
            }
        }
    }
}

constexpr int MLO_K = 8192, MLO_VT = MLO_K + 16384, MLO_VTS = 272, MLO_C0 = MLO_VT + 128 * MLO_VTS, MLO_HS = 8192;
DI void ph_ml_out(const Params& p, char* ldsc) {
    float* G = (float*)ldsc;
    const int tid = opaque_tid(), lane = tid & 63, wv = tid >> 6, q = lane & 15, g = lane >> 4;
    for (int u = blockIdx.x; u < 1024; u += gridDim.x) {
        const int bh = u >> 6, blk = u & 63, b = bh >> 3, h = bh & 7;
        const int row0 = b * TLB + blk * 128;
        {
            u32x4 rk[2], rv[4], rc[4];
#pragma unroll
            for (int i = 0; i < 2; ++i) { const int pc = tid + i * NTHR; rk[i] = *(const u32x4*)(p.P1 + (size_t)(row0 + (pc >> 3)) * 3072 + 512 + h * 64 + (pc & 7) * 8); }
#pragma unroll
            for (int i = 0; i < 4; ++i) { const int pc = tid + i * NTHR; rv[i] = *(const u32x4*)(p.V1TL + ((size_t)(b * 1024 + h * 128 + (pc >> 4))) * TLB + blk * 128 + (pc & 15) * 8); }
#pragma unroll
            for (int i = 0; i < 4; ++i) { const int pc = tid + i * NTHR; rc[i] = *(const u32x4*)(p.C0T + (size_t)u * 2 * 8192 + (size_t)pc * 8); }
#pragma unroll
            for (int i = 0; i < 2; ++i) { const int pc = tid + i * NTHR; *(u32x4*)(ldsc + MLO_K + lds_byte(pc >> 3, (pc & 7) * 8)) = rk[i]; }
#pragma unroll
            for (int i = 0; i < 4; ++i) { const int pc = tid + i * NTHR; *(u32x4*)(ldsc + MLO_VT + (pc >> 4) * MLO_VTS + (pc & 15) * 16) = rv[i]; }
#pragma unroll
            for (int i = 0; i < 4; ++i) { const int pc = tid + i * NTHR; const int dd = pc >> 10, rr = (pc >> 3) & 127; *(u32x4*)(ldsc + MLO_C0 + dd * 16384 + lds_byte(rr, (pc & 7) * 8)) = rc[i]; }
        }
        float ig, bc, tot; int idx;
        ml_gates(p, G, row0, h, ig, bc, tot, idx);
        const float m0f = p.M0[u * 2 + 0], m0b = p.M0[u * 2 + 1];
        {
            float pm = (tid < 256) ? wave_incl_max(ig - bc, lane) : 0.f;
            if (tid < 256 && lane == 63) G[768 + wv] = pm;
            __syncthreads();
            if (tid < 256) {
                if (wv & 1) pm = fmaxf(pm, G[768 + wv - 1]);
                const int gi = tid >> 7;
                G[512 + gi * 128 + idx] = fmaxf(bc + pm, bc + (gi == 0 ? m0f : m0b));
            }
            __syncthreads();
        }
        const int tl = 16 * wv + q;
        const int trow = row0 + tl;
        bf16x8 qf[2];
#pragma unroll
        for (int ks = 0; ks < 2; ++ks) qf[ks] = *(const bf16x8*)(p.P1 + (size_t)trow * 3072 + h * 64 + 32 * ks + 8 * g);
        f32x4 st_[8];
#pragma unroll
        for (int st = 0; st < 8; ++st) {
            f32x4 s = (f32x4){0.f, 0.f, 0.f, 0.f};
#pragma unroll
            for (int ks = 0; ks < 2; ++ks) s = mfma16(*(const bf16x8*)(ldsc + MLO_K + lds_byte(16 * st + q, 32 * ks + 8 * g)), qf[ks], s);
            st_[st] = s;
        }
        f32x4 hsum[8];
#pragma unroll
        for (int vm = 0; vm < 8; ++vm) hsum[vm] = (f32x4){0.f, 0.f, 0.f, 0.f};
#pragma unroll 1
        for (int dir = 0; dir < 2; ++dir) {
            const float mt = G[512 + dir * 128 + tl];
            const float bt = G[256 + dir * 128 + tl];
            const float m0 = dir == 0 ? m0f : m0b;
            const float iw = __expf(bt + m0 - mt);
            const float* n0 = p.N0 + ((size_t)u * 2 + dir) * 64;
            float qn = 0.f;
#pragma unroll
            for (int ks = 0; ks < 2; ++ks) {
                const u32x4 w = __builtin_bit_cast(u32x4, qf[ks]);
                const f32x4 na = *(const f32x4*)(n0 + 32 * ks + 8 * g), nb = *(const f32x4*)(n0 + 32 * ks + 8 * g + 4);
                qn += bflo(w.x) * na[0] + bfhi(w.x) * na[1] + bflo(w.y) * na[2] + bfhi(w.y) * na[3] + bflo(w.z) * nb[0] + bfhi(w.z) * nb[1] + bflo(w.w) * nb[2] + bfhi(w.w) * nb[3];
            }
            qn += __shfl_xor(qn, 16); qn += __shfl_xor(qn, 32);
            f32x4 acc[8];
            const char* c0s = ldsc + MLO_C0 + dir * 16384;
#pragma unroll
            for (int vm = 0; vm < 8; ++vm) {
                f32x4 a = (f32x4){0.f, 0.f, 0.f, 0.f};
#pragma unroll
                for (int ks = 0; ks < 2; ++ks) a = mfma16(*(const bf16x8*)(c0s + lds_byte(16 * vm + q, 32 * ks + 8 * g)), qf[ks], a);
                acc[vm] = a * iw;
            }
            float rs = 0.f;
#pragma unroll
            for (int uu = 0; uu < 4; ++uu) {
                const bool need = dir == 0 ? (2 * uu <= wv) : (2 * uu + 1 >= wv);
                if (need) {
                    f32x4 pw[2];
#pragma unroll
                    for (int hf = 0; hf < 2; ++hf) {
                        const int st = 2 * uu + hf;
                        const f32x4 bs = *(const f32x4*)(G + 256 + dir * 128 + 16 * st + 4 * g);
                        const f32x4 is = *(const f32x4*)(G + dir * 128 + 16 * st + 4 * g);
                        f32x4 w;
#pragma unroll
                        for (int r = 0; r < 4; ++r) {
                            const int s = 16 * st + 4 * g + r;
                            const bool ok = dir == 0 ? (s <= tl) : (s >= tl);
                            const float dw = ok ? __expf(bt - bs[r] + is[r] - mt) : 0.f;
                            w[r] = st_[st][r] * dw;
                            rs += w[r];
                        }
                        pw[hf] = w;
                    }
                    const bf16x8 pb = pack8(pw[0], pw[1]);
#pragma unroll
                    for (int vm = 0; vm < 8; ++vm) {
                        const char* vr = ldsc + MLO_VT + (16 * vm + q) * MLO_VTS + (32 * uu + 4 * g) * 2;
                        const bf16x8 va = join8(*(const u32x2*)vr, *(const u32x2*)(vr + 32));
                        acc[vm] = mfma16(va, pb, acc[vm]);
                    }
                }
            }
            rs += __shfl_xor(rs, 16); rs += __shfl_xor(rs, 32);
            const float den = rs + iw * qn;
            const float dn = 1.0f / fmaxf(fabsf(den), __expf(-mt));
#pragma unroll
            for (int vm = 0; vm < 8; ++vm) hsum[vm] += acc[vm] * dn;
        }
        __syncthreads();
        float* HS = (float*)(ldsc + MLO_HS);
#pragma unroll
        for (int vm = 0; vm < 8; ++vm) *(f32x4*)(HS + tl * 132 + 16 * vm + 4 * g) = hsum[vm];
        __syncthreads();
        {
            const int t = tid >> 2, vq = (tid & 3) * 4;
            const float* hr = HS + t * 132 + vq;
            f32x4 hv[8];
            float ss = 0.f;
#pragma unroll
            for (int i = 0; i < 8; ++i) { hv[i] = *(const f32x4*)(hr + 16 * i); ss += (hv[i][0] * hv[i][0] + hv[i][1] * hv[i][1]) + (hv[i][2] * hv[i][2] + hv[i][3] * hv[i][3]); }
            ss += __shfl_xor(ss, 1); ss += __shfl_xor(ss, 2);
            const float rn = rsqrtf(ss * (1.0f / 128.0f) + 1e-6f);
            const size_t orow = (size_t)(row0 + t) * 1024 + h * 128 + vq;
#pragma unroll
            for (int i = 0; i < 8; ++i) {
                const f32x4 ng = *(const f32x4*)(p.ml_norm_g + h * 128 + vq + 16 * i);
                const u32x2 ow = *(const u32x2*)(p.P1 + (size_t)(row0 + t) * 3072 + 2048 + h * 128 + vq + 16 * i);
                f32x4 o;
                o[0] = hv[i][0] * rn * ng[0] * sigmoidf_(bflo(ow.x)); o[1] = hv[i][1] * rn * ng[1] * sigmoidf_(bfhi(ow.x));
                o[2] = hv[i][2] * rn * ng[2] * sigmoidf_(bflo(ow.y)); o[3] = hv[i][3] * rn * ng[3] * sigmoidf_(bfhi(ow.y));
                u32x2 w; w.x = cvt_pk_bf16(o[0], o[1]); w.y = cvt_pk_bf16(o[2], o[3]);
                *(u32x2*)(p.MIX + orow + 16 * i) = w;
            }
        }
        __syncthreads();
    }
}


#ifndef PROBE_MODE
#define PROBE_MODE 0
#endif
DI void ph_probe(const Params& p, char* lds) {
#if PROBE_MODE >= 1 && PROBE_MODE <= 4
    const int tid = opaque_tid();
    constexpr int NTN = 26, NTM = 66;
    gemm_stream<4, 2, 4, 4, PtrLoaderF, 4, PROBE_MODE>(lds, NTN * NTM, 16, [&](int u, PtrLoader<4>& al, PtrLoaderF& bl, const int (&nx)[4]) {
        int tm, tn; tile_of(u, NTM, NTN, tm, tn);
#pragma unroll
        for (int i = 0; i < 4; ++i) al.p[i] = (unsigned)((tm * 256 + a_row(tid) + 64 * i) * 1024 + a_c8(tid) * 8);
        al.base = p.Abuf;
        fill_bf(bl, p.ev_w_in, EVC, tn * 128, EVC);
    }, [&](int u, int (&nx)[4], int) {}, [&](int u, int mi, const f32x4 (&a)[4], f32x4 (&o)[4], int r0, int c0) {
#pragma unroll
        for (int ni = 0; ni < 4; ++ni) o[ni] = a[ni];
    }, [&](int u, int r, int c, f32x4 v, f32x4 pv) {
        int tm, tn; tile_of(u, NTM, NTN, tm, tn);
        const int row = tm * 256 + r, col = tn * 128 + c;
        if (tn < 12) {
            bf16_t* dst = (tn < 4 ? p.Q0 + col : (tn < 8 ? p.K0 + (col - 512) : p.V0 + (col - 1024))) + (size_t)row * 512;
            u32x2 w; w.x = cvt_pk_bf16(v[0], v[1]); w.y = cvt_pk_bf16(v[2], v[3]);
            *(u32x2*)dst = w;
        } else if (col < EVC) {
            *(f32x4*)(p.RWP + (size_t)row * RWC + (col - 1536)) = v;
        }
    });
#endif
}
constexpr int NPHASE = 27;
template <int PH>
DI void run_phase(const Params& p, char* lds) {
    if (PH == 0) ph_prologue(p, lds);
    if (PH == 1) ph_modulate0(p);
    if (PH == 2) ph_inproj0(p, lds);
    if (PH == 3) { for (int j = blockIdx.x; j < (TT / 64) * 8; j += gridDim.x) transpose_tile(lds, p.V0, 512, (j >> 3) * 64, (j & 7) * 64, p.VT0L, p.VT0C, 512); ph_rw_prep(p, lds); }
    if (PH == 4) ph_attn_cp<1>(p, lds);
    if (PH == 5) ph_sq(p, lds);
    if (PH == 6) ph_rw_readout(p);
    if (PH == 7) gemm_f32out(lds, p.MIX, TT, p.ev_w_out, 1024, p.YL);
    if (PH == 8) ph_ln1<0>(p);
    if (PH == 9) gemm_router(lds, p.Abuf, TT, p.moe_router, p.LOGITS);
    if (PH == 10) ph_route<0>(p, lds);
    if (PH == 11) ph_scatter<0>(p, lds);
    if (PH == 12) ph_moe1<0>(p, lds);
    if (PH == 13) ph_moe2<0>(p, lds);
    if (PH == 14) ph_combine<0>(p);
    if (PH == 15) ph_inproj1(p, lds);
    if (PH == 17) ph_ml_chunks(p, lds);
    if (PH == 18) ph_ml_scan(p);
    if (PH == 19) ph_ml_out(p, lds);
    if (PH == 20) gemm_f32out(lds, p.MIX, TL, p.od_w_out, 1024, p.YL);
    if (PH == 21) ph_ln1<1>(p);
    if (PH == 22) gemm_router(lds, p.Abuf, TL, p.moe_router + 1024 * 256, p.LOGITS);
    if (PH == 23) ph_route<1>(p, lds);
    if (PH == 24) ph_scatter<1>(p, lds);
    if (PH == 25) ph_moe1<1>(p, lds);
    if (PH == 26) ph_moe2<1>(p, lds);
    if (PH == 27) ph_combine<1>(p);
    if (PH == 28) { if (PROBE_MODE >= 1 && PROBE_MODE <= 4) ph_probe(p, lds); if (PROBE_MODE == 5) ph_attn_cp(p, lds); if (PROBE_MODE == 6) ph_sq(p, lds); if (PROBE_MODE == 7) ph_rw_prep(p, lds); if (PROBE_MODE == 17) ph_rw_prep<1>(p, lds); if (PROBE_MODE == 8) ph_attn_cp<1>(p, lds); if (PROBE_MODE == 9) ph_attn_cp<2>(p, lds); if (PROBE_MODE == 10) ph_route<0>(p, lds); if (PROBE_MODE == 11) ph_scatter<0>(p, lds); if (PROBE_MODE == 12) { ph_prologue(p, lds); } if (PROBE_MODE == 13) ph_rw_readout(p); if (PROBE_MODE == 14) gemm_f32out(lds, p.MIX, TT, p.ev_w_out, 1024, p.YL); if (PROBE_MODE == 15) { ph_ml_chunks(p, lds); } if (PROBE_MODE == 16) ph_ml_out(p, lds); }
}

#if MK_MULTI
template <int PH>
__global__ void __launch_bounds__(NTHR, 2) k_phase(Params p) {
    extern __shared__ __attribute__((aligned(16))) char lds[];
    run_phase<PH>(p, lds);
}
#else
template <int PH> struct PhaseSeq {
    static DI void run(const Params& p, char* lds, const XcdBarrier& bar) {
        PhaseSeq<PH - 1>::run(p, lds, bar);
        if constexpr (PH == 16) return;
        xcd_barrier(bar);
        if constexpr (((PROBE_DUP >> PH) & 1ull) != 0) {
            const int reps = 1 + (int)(__builtin_amdgcn_s_getreg((3 << 11) | 20) < 64u);
#pragma unroll 1
            for (int rep = 0; rep < reps; ++rep) run_phase<PH>(p, lds);
        } else run_phase<PH>(p, lds);
    }
};
template <> struct PhaseSeq<0> {
    static DI void run(const Params& p, char* lds, const XcdBarrier&) { if (PROBE_DUP & 1ull) run_phase<0>(p, lds); run_phase<0>(p, lds); }
};
__global__ void __launch_bounds__(NTHR, 2) k_mega(Params p) {
    extern __shared__ __attribute__((aligned(16))) char lds[];
    LAS unsigned* xb = (LAS unsigned*)(lds + LDS_XB);
    if (threadIdx.x == 0) { xb[0] = 0u; xb[1] = 0u; xb[2] = 0u; xb[3] = 0u; }
    __syncthreads();
    XcdBarrier bar = xcd_barrier_post(p.bar, (volatile LAS unsigned*)xb);
    PhaseSeq<PROBE_MODE ? 28 : 27>::run(p, lds, bar);
}
#endif

#if MK_MULTI
template <int PH> static void launch_all(const Params& p, hipStream_t s) {
    if constexpr (PH > 0) launch_all<PH - 1>(p, s);
    hipFuncSetAttribute((const void*)k_phase<PH>, hipFuncAttributeMaxDynamicSharedMemorySize, LDS_BYTES);
    hipLaunchKernelGGL(k_phase<PH>, dim3(256), dim3(NTHR), LDS_BYTES, s, p);
}
#endif

extern "C" void kernel_launch(void* const* d_in, const int* in_sizes, int n_in, void* d_out, int out_size, void* d_ws, size_t ws_size, hipStream_t stream) {
    Params p{};
    const float** f = (const float**)&p.x;
    for (int i = 0; i < 34; ++i) f[i] = (const float*)d_in[i];
    p.out = (float*)d_out;
    size_t off = 0;
    auto A = [&](size_t bytes) -> char* { char* r = (char*)d_ws + off; off += (bytes + 255) & ~(size_t)255; return r; };
    p.bar = (unsigned*)A(XCD_BAR_WORDS * 4);
    p.ictl = (int*)A(1026 * 4);
    p.mods = (float*)A((size_t)2 * 3 * 6144 * 4);
    p.Abuf = (bf16_t*)A((size_t)TT * 1024 * 2);
    p.CM = (bf16_t*)A((size_t)32 * CK_NCH * 4096 * 2);
    p.CRH = (bf16_t*)A((size_t)32 * CK_NCH * 1024 * 2);
    p.CN = (bf16_t*)A((size_t)32 * CK_NCH * 4096 * 2);
    p.CP3 = (bf16_t*)A((size_t)32 * CK_NCH * 1024 * 2);
    p.HA = (float*)A((size_t)TT * 1024 * 4);
    p.HB = (float*)A((size_t)TT * 1024 * 4);
    p.Q0 = (bf16_t*)A((size_t)TT * 512 * 2);
    p.K0 = (bf16_t*)A((size_t)TT * 512 * 2);
    p.V0 = (bf16_t*)A((size_t)TT * 512 * 2);
    p.VT0L = (bf16_t*)A((size_t)2 * 512 * TLB * 2);
    p.VT0C = (bf16_t*)A((size_t)2 * 512 * TCB * 2);
    p.RWP = (float*)A((size_t)TT * RWC * 4);
    p.MIX = (bf16_t*)A((size_t)TT * 1024 * 2);
    p.YL = (float*)A((size_t)TT * 1024 * 4);
    p.LOGITS = (float*)A((size_t)TT * 256 * 4);
    p.EIDX = (int*)A((size_t)TT * 8 * 4);
    p.EW = (float*)A((size_t)TT * 8 * 4);
    p.APOS = (int*)A((size_t)TT * 8 * 4);
    p.SLOT_TOK = (int*)A((size_t)2 * NSLOT * 4);
    p.SLOT_W = (float*)A((size_t)2 * NSLOT * 4);
    p.HIST = (int*)A((size_t)2 * 256 * 256 * 4);
    p.WF = (unsigned*)A((size_t)8 * 4 * 7 * 64 * 16);
    p.TILE_E = (int*)A((size_t)2 * MAXTILES * 4);
    p.TILE_R0 = (int*)A((size_t)2 * MAXTILES * 4);
    p.HBUF = (bf16_t*)A((size_t)NSLOT * 256 * 2);
    const size_t un0 = off;
    p.YB = (bf16_t*)A((size_t)NSLOT * 1024 * 2);
    const size_t un_end = off;
    off = un0;
    p.SW = (float*)A((size_t)2 * TT * 512 * 4);
    p.SBP = (unsigned*)A((size_t)TT * 512 * 16);
    p.SKP = p.SBP; p.SNV = p.SBP; p.SRG = p.SBP;
    p.BONUS = (float*)A((size_t)TT * 8 * 4);
    p.YS = (float*)A((size_t)2 * TT * 512 * 4);
    const size_t m0_end = off;
    off = un0;
    p.P1 = (bf16_t*)A((size_t)TT * 3072 * 2);
    p.K1TL = (bf16_t*)A((size_t)2 * 512 * TLB * 2);
    p.K1TC = (bf16_t*)A((size_t)2 * 512 * TCB * 2);
    p.V1TL = (bf16_t*)A((size_t)2 * 1024 * TLB * 2);
    p.V1TC = (bf16_t*)A((size_t)2 * 1024 * TCB * 2);
    p.G1 = (float*)A((size_t)TT * 32 * 4);
    p.KVT = (float*)A((size_t)1056 * 2 * 8192 * 4);
    p.KS = (float*)A((size_t)1056 * 128 * 4);
    p.BEMC = (float*)A((size_t)1056 * 4 * 4);
    p.C0T = (bf16_t*)A((size_t)1056 * 2 * 8192 * 2);
    p.N0 = (float*)A((size_t)1056 * 2 * 64 * 4);
    p.M0 = (float*)A((size_t)1056 * 2 * 4);
    const size_t m1_end = off;
    off = un_end > m0_end ? un_end : m0_end; off = off > m1_end ? off : m1_end;
    if (off > ws_size) return;
    hipMemsetAsync(p.bar, 0, XCD_BAR_WORDS * 4, stream);
#if MK_MULTI
    launch_all<27>(p, stream);
#else
    hipFuncSetAttribute((const void*)k_mega, hipFuncAttributeMaxDynamicSharedMemorySize, LDS_BYTES);
    hipLaunchKernelGGL(k_mega, dim3(256), dim3(NTHR), LDS_BYTES, stream, p);
#endif
}
```
